# Optimizing an MI355X kernel written in HIP

```python
import jax, jax.numpy as jnp
from jax import lax
import numpy as np

D_MODEL = 1024
BATCH = 2
SEQ = 8192
DEPTH = 2
DEC_BATCH = 16
DEC_SEQ = 4096
PAST_LEN = 128

N_EVEN = (DEPTH + 1) // 2
N_ODD = DEPTH // 2
EPS = 1e-6
MLA_HEADS = 8
Q_LORA = 256
KV_LORA = 128
QK_NOPE = 64
QK_ROPE = 32
V_HEAD = 64
ROPE_THETA = 10000.0
Q_BLOCK = 128
MLA_WIDTH = MLA_HEADS * V_HEAD
M_HEADS = 4
M_HEAD_DIM = 128
M_WIDTH = M_HEADS * M_HEAD_DIM
M_CHUNK = 128
AB_IN = Q_LORA + KV_LORA + QK_ROPE + 4 * M_WIDTH + 4 * M_HEADS
AB_CUTS = [int(c) for c in np.cumsum([Q_LORA, KV_LORA, QK_ROPE, 2 * M_WIDTH, M_WIDTH, M_WIDTH])]
G_GROUPS = 8
G_CHUNK = 128
G_WIDTH = D_MODEL
G_CH = G_WIDTH // G_GROUPS
D_FF = 2816
CONV_W = 3

kernel_name = 'hybrid_mla_mlstm_gmlp_encoder'


def rmsnorm(x, g):
    xf = x.astype(jnp.float32)
    y = xf * lax.rsqrt(jnp.mean(xf * xf, axis=-1, keepdims=True) + EPS)
    return (y * g.astype(jnp.float32)).astype(x.dtype)


def dwconv3(x, w, b):
    xp = jnp.pad(x, ((0, 0), (1, 1), (0, 0)))
    return xp[:, :-2] * w[0] + xp[:, 1:-1] * w[1] + xp[:, 2:] * w[2] + b


def rope_tables(S):
    pos = jnp.arange(S, dtype=jnp.float32)
    inv = 1.0 / (ROPE_THETA ** (jnp.arange(0, QK_ROPE, 2, dtype=jnp.float32) / QK_ROPE))
    ang = pos[:, None] * inv[None, :]
    return jnp.cos(ang), jnp.sin(ang)


def apply_rope(x, cos, sin):
    x1, x2 = jnp.split(x, 2, axis=-1)
    cos = cos.astype(x.dtype)
    sin = sin.astype(x.dtype)
    return jnp.concatenate([x1 * cos - x2 * sin, x2 * cos + x1 * sin], axis=-1)


def mla_attention(q_nope, q_rope, k_nope, k_rope, v):
    B, S, H, _ = q_nope.shape
    nq = S // Q_BLOCK
    scale = (QK_NOPE + QK_ROPE) ** -0.5
    qn_b = q_nope.reshape(B, nq, Q_BLOCK, H, QK_NOPE).transpose(1, 0, 2, 3, 4)
    qr_b = q_rope.reshape(B, nq, Q_BLOCK, H, QK_ROPE).transpose(1, 0, 2, 3, 4)

    def block(args):
        qn_i, qr_i = args
        s = jnp.einsum('bqhd,bkhd->bhqk', qn_i, k_nope) + jnp.einsum('bqhr,bkr->bhqk', qr_i, k_rope)
        p = jax.nn.softmax(s.astype(jnp.float32) * scale, axis=-1).astype(v.dtype)
        return jnp.einsum('bhqk,bkhd->bqhd', p, v)

    o = lax.map(block, (qn_b, qr_b))
    return o.transpose(1, 0, 2, 3, 4).reshape(B, S, H * V_HEAD)


def mlstm_chunkwise(q, k, v, li, lf):
    B, H, S, dh = q.shape
    L = M_CHUNK
    nc = S // L
    q = q.reshape(B, H, nc, L, dh)
    k = k.reshape(B, H, nc, L, dh)
    v = v.reshape(B, H, nc, L, dh)
    li = li.reshape(B, H, nc, L)
    lf = lf.reshape(B, H, nc, L)
    b = jnp.cumsum(lf, axis=-1)
    bL = b[..., -1]
    mask = jnp.tril(jnp.ones((L, L), dtype=bool))
    dlog = jnp.where(mask, b[..., :, None] - b[..., None, :] + li[..., None, :], -jnp.inf)
    g = bL[..., None] - b + li
    m_loc = jnp.max(g, axis=-1)
    w_loc = jnp.exp(g - m_loc[..., None])
    C_loc = jnp.einsum('bhnl,bhnld,bhnle->bhnde', w_loc, v, k)
    n_loc = jnp.einsum('bhnl,bhnld->bhnd', w_loc, k)

    def step(carry, xs):
        C, n, m = carry
        bL_c, C_l, n_l, m_l = xs
        m_new = jnp.maximum(bL_c + m, m_l)
        a = jnp.exp(bL_c + m - m_new)
        c = jnp.exp(m_l - m_new)
        C_new = a[..., None, None] * C + c[..., None, None] * C_l
        n_new = a[..., None] * n + c[..., None] * n_l
        return (C_new, n_new, m_new), (C, n, m)

    init = (jnp.zeros((B, H, dh, dh), jnp.float32), jnp.zeros((B, H, dh), jnp.float32), jnp.zeros((B, H), jnp.float32))
    xs = (jnp.moveaxis(bL, 2, 0), jnp.moveaxis(C_loc, 2, 0), jnp.moveaxis(n_loc, 2, 0), jnp.moveaxis(m_loc, 2, 0))
    _, (C_prev, n_prev, m_prev) = lax.scan(step, init, xs)
    C_prev = jnp.moveaxis(C_prev, 0, 2)
    n_prev = jnp.moveaxis(n_prev, 0, 2)
    m_prev = jnp.moveaxis(m_prev, 0, 2)
    a_t = b + m_prev[..., None]
    m_t = jnp.maximum(a_t, jnp.max(dlog, axis=-1))
    inter = jnp.exp(a_t - m_t)
    qk = jnp.einsum('bhntd,bhnsd->bhnts', q, k) * jnp.exp(dlog - m_t[..., None])
    num = inter[..., None] * jnp.einsum('bhnde,bhnte->bhntd', C_prev, q) + jnp.einsum('bhnts,bhnsd->bhntd', qk, v)
    den = inter * jnp.einsum('bhnd,bhntd->bhnt', n_prev, q) + jnp.sum(qk, axis=-1)
    h = num / jnp.maximum(jnp.abs(den), jnp.exp(-m_t))[..., None]
    return h.reshape(B, H, S, dh)


def mixer_ab(xn, w_in, q_norm, w_uq, kv_norm, w_ukv, conv_w, conv_b, gate_bias, out_norm, w_out):
    B, S, _ = xn.shape
    h = xn @ w_in
    c_q, c_kv, k_r, m_qk, m_v, m_o, m_g = jnp.split(h, AB_CUTS, axis=-1)
    cos, sin = rope_tables(S)
    q = (rmsnorm(c_q, q_norm) @ w_uq).reshape(B, S, MLA_HEADS, QK_NOPE + QK_ROPE)
    q_nope = q[..., :QK_NOPE]
    q_rope = apply_rope(q[..., QK_NOPE:], cos[:, None], sin[:, None])
    kv = (rmsnorm(c_kv, kv_norm) @ w_ukv).reshape(B, S, MLA_HEADS, QK_NOPE + V_HEAD)
    k_nope = kv[..., :QK_NOPE]
    v_att = kv[..., QK_NOPE:]
    k_rope = apply_rope(k_r, cos, sin)
    y_att = mla_attention(q_nope, q_rope, k_nope, k_rope, v_att)
    qk = jax.nn.silu(dwconv3(m_qk, conv_w, conv_b))

    def heads(t):
        return t.reshape(B, S, M_HEADS, M_HEAD_DIM).transpose(0, 2, 1, 3).astype(jnp.float32)

    mq = heads(qk[..., :M_WIDTH])
    mk = heads(qk[..., M_WIDTH:]) * (M_HEAD_DIM ** -0.5)
    mv = heads(m_v)
    g = (m_g.astype(jnp.float32) + gate_bias.astype(jnp.float32)).transpose(0, 2, 1)
    i_f, f_f, i_b, f_b = jnp.split(g, 4, axis=1)
    h_f = mlstm_chunkwise(mq, mk, mv, i_f, jax.nn.log_sigmoid(f_f))
    fl = lambda t: jnp.flip(t, axis=2)
    h_b = fl(mlstm_chunkwise(fl(mq), fl(mk), fl(mv), fl(i_b), fl(jax.nn.log_sigmoid(f_b))))
    hs = (h_f + h_b).transpose(0, 2, 1, 3)
    hs = hs * lax.rsqrt(jnp.mean(hs * hs, axis=-1, keepdims=True) + EPS)
    hs = hs.reshape(B, S, M_WIDTH) * out_norm.astype(jnp.float32)
    y_m = (jax.nn.sigmoid(m_o.astype(jnp.float32)) * hs).astype(xn.dtype)
    return jnp.concatenate([y_att, y_m], axis=-1) @ w_out


def mixer_c(xn, w_in, v_norm, w_s, b_s, w_out):
    B, S, _ = xn.shape
    h = jax.nn.gelu(xn @ w_in, approximate=False)
    u, v = jnp.split(h, 2, axis=-1)
    v = rmsnorm(v, v_norm).reshape(B, S // G_CHUNK, G_CHUNK, G_GROUPS, G_CH)
    sv = jnp.einsum('gts,bnsgc->bntgc', w_s, v) + b_s.T[:, :, None]
    return (u * sv.reshape(B, S, G_WIDTH)) @ w_out


def conv_ffn(xn, w_up, conv_w, conv_b, w_down):
    a = dwconv3(xn @ w_up, conv_w, conv_b)
    gate, val = jnp.split(a, 2, axis=-1)
    return (jax.nn.silu(gate) * val) @ w_down


def forward(x, p):
    for layer in range(DEPTH):
        if layer % 2 == 0:
            i = layer // 2
            x = x + mixer_ab(rmsnorm(x, p['ab_norm'][i]), p['ab_w_in'][i], p['mla_q_norm'][i], p['mla_w_uq'][i],
                             p['mla_kv_norm'][i], p['mla_w_ukv'][i], p['mlstm_conv_w'][i], p['mlstm_conv_b'][i],
                             p['mlstm_gate_bias'][i], p['mlstm_out_norm'][i], p['ab_w_out'][i])
        else:
            i = layer // 2
            x = x + mixer_c(rmsnorm(x, p['c_norm'][i]), p['c_w_in'][i], p['c_v_norm'][i], p['c_w_spatial'][i],
                            p['c_b_spatial'][i], p['c_w_out'][i])
        x = x + conv_ffn(rmsnorm(x, p['ffn_norm'][layer]), p['ffn_w_up'][layer], p['ffn_conv_w'][layer],
                         p['ffn_conv_b'][layer], p['ffn_w_down'][layer])
    return rmsnorm(x, p['final_norm'])


def setup_inputs(seed: int = 0) -> dict:
    key = jax.random.key(seed)
    ks = jax.random.split(key, 40)
    f32 = jnp.float32

    def nrm(k, shape, scale):
        return jax.random.normal(k, shape, f32) * scale

    def gain(k, shape):
        return 1.0 + 0.05 * jax.random.normal(k, shape, f32)

    f_lin = jnp.linspace(3.0, 6.0, M_HEADS, dtype=f32)[None, :]
    gate_bias = jnp.concatenate([
        nrm(ks[10], (N_EVEN, M_HEADS), 0.1),
        f_lin + nrm(ks[11], (N_EVEN, M_HEADS), 0.1),
        nrm(ks[12], (N_EVEN, M_HEADS), 0.1),
        f_lin + nrm(ks[13], (N_EVEN, M_HEADS), 0.1)], axis=-1)
    return {
        'x_prompt': nrm(ks[0], (BATCH, SEQ, D_MODEL), 1.0),
        'x_sample': nrm(ks[1], (DEC_BATCH, DEC_SEQ, D_MODEL), 1.0),
        'ab_norm': gain(ks[2], (N_EVEN, D_MODEL)),
        'ab_w_in': nrm(ks[3], (N_EVEN, D_MODEL, AB_IN), D_MODEL ** -0.5),
        'mla_q_norm': gain(ks[4], (N_EVEN, Q_LORA)),
        'mla_w_uq': nrm(ks[5], (N_EVEN, Q_LORA, MLA_HEADS * (QK_NOPE + QK_ROPE)), Q_LORA ** -0.5),
        'mla_kv_norm': gain(ks[6], (N_EVEN, KV_LORA)),
        'mla_w_ukv': nrm(ks[7], (N_EVEN, KV_LORA, MLA_HEADS * (QK_NOPE + V_HEAD)), KV_LORA ** -0.5),
        'mlstm_conv_w': nrm(ks[8], (N_EVEN, CONV_W, 2 * M_WIDTH), CONV_W ** -0.5),
        'mlstm_conv_b': nrm(ks[9], (N_EVEN, 2 * M_WIDTH), 0.01),
        'mlstm_gate_bias': gate_bias,
        'mlstm_out_norm': gain(ks[14], (N_EVEN, M_WIDTH)),
        'ab_w_out': nrm(ks[15], (N_EVEN, MLA_WIDTH + M_WIDTH, D_MODEL), (MLA_WIDTH + M_WIDTH) ** -0.5),
        'c_norm': gain(ks[16], (N_ODD, D_MODEL)),
        'c_w_in': nrm(ks[17], (N_ODD, D_MODEL, 2 * G_WIDTH), D_MODEL ** -0.5),
        'c_v_norm': gain(ks[18], (N_ODD, G_WIDTH)),
        'c_w_spatial': nrm(ks[19], (N_ODD, G_GROUPS, G_CHUNK, G_CHUNK), G_CHUNK ** -0.5),
        'c_b_spatial': nrm(ks[20], (N_ODD, G_GROUPS, G_CHUNK), 0.01),
        'c_w_out': nrm(ks[21], (N_ODD, G_WIDTH, D_MODEL), G_WIDTH ** -0.5),
        'ffn_norm': gain(ks[22], (DEPTH, D_MODEL)),
        'ffn_w_up': nrm(ks[23], (DEPTH, D_MODEL, 2 * D_FF), D_MODEL ** -0.5),
        'ffn_conv_w': nrm(ks[24], (DEPTH, CONV_W, 2 * D_FF), CONV_W ** -0.5),
        'ffn_conv_b': nrm(ks[25], (DEPTH, 2 * D_FF), 0.01),
        'ffn_w_down': nrm(ks[26], (DEPTH, D_FF, D_MODEL), D_FF ** -0.5),
        'final_norm': gain(ks[27], (D_MODEL,)),
    }


def reference(x_prompt, x_sample, ab_norm, ab_w_in, mla_q_norm, mla_w_uq, mla_kv_norm, mla_w_ukv, mlstm_conv_w,
              mlstm_conv_b, mlstm_gate_bias, mlstm_out_norm, ab_w_out, c_norm, c_w_in, c_v_norm, c_w_spatial,
              c_b_spatial, c_w_out, ffn_norm, ffn_w_up, ffn_conv_w, ffn_conv_b, ffn_w_down, final_norm):
    p = {
        'ab_norm': ab_norm, 'ab_w_in': ab_w_in, 'mla_q_norm': mla_q_norm, 'mla_w_uq': mla_w_uq,
        'mla_kv_norm': mla_kv_norm, 'mla_w_ukv': mla_w_ukv, 'mlstm_conv_w': mlstm_conv_w,
        'mlstm_conv_b': mlstm_conv_b, 'mlstm_gate_bias': mlstm_gate_bias, 'mlstm_out_norm': mlstm_out_norm,
        'ab_w_out': ab_w_out, 'c_norm': c_norm, 'c_w_in': c_w_in, 'c_v_norm': c_v_norm,
        'c_w_spatial': c_w_spatial, 'c_b_spatial': c_b_spatial, 'c_w_out': c_w_out, 'ffn_norm': ffn_norm,
        'ffn_w_up': ffn_w_up, 'ffn_conv_w': ffn_conv_w, 'ffn_conv_b': ffn_conv_b, 'ffn_w_down': ffn_w_down,
        'final_norm': final_norm,
    }
    y_prompt = forward(x_prompt, p)
    y_sample = forward(x_sample, p)
    return (y_prompt, y_sample)
```

```cpp
#include <hip/hip_runtime.h>
#include <hip/hip_cooperative_groups.h>
#include <cstdio>
#include <cstdint>
namespace cg = cooperative_groups;

typedef unsigned short bf16;
typedef short bf16x8 __attribute__((ext_vector_type(8)));
typedef short s16x4 __attribute__((ext_vector_type(4)));
typedef float f32x2 __attribute__((ext_vector_type(2)));
typedef float f32x4 __attribute__((ext_vector_type(4)));
typedef float f32x16 __attribute__((ext_vector_type(16)));
typedef unsigned u32x2 __attribute__((ext_vector_type(2)));
typedef unsigned u32x4 __attribute__((ext_vector_type(4)));
typedef __bf16 bf2_t __attribute__((ext_vector_type(2)));
#define DI __device__ __forceinline__
#define MFMA32(a, b, c) __builtin_amdgcn_mfma_f32_32x32x16_bf16((a), (b), (c), 0, 0, 0)

constexpr int NTHR = 512;
constexpr int T_TOK = 81920, TP = 16384, DM = 1024;
constexpr int NCHUNK = T_TOK / 128;
constexpr int DFF = 2816;
constexpr float EPS = 1e-6f;
constexpr int LDS_BYTES = 147456;

constexpr size_t AL(size_t x) { return (x + 255) & ~(size_t)255; }
constexpr size_t O_WIN = 0;
constexpr size_t O_WQKV = O_WIN + AL((size_t)2560 * 1024 * 2);
constexpr size_t O_WOUT = O_WQKV + AL((size_t)1792 * 384 * 2);
constexpr size_t O_WCIN = O_WOUT + AL((size_t)1024 * 1024 * 2);
constexpr size_t O_WCOUT = O_WCIN + AL((size_t)2048 * 1024 * 2);
constexpr size_t O_WUP = O_WCOUT + AL((size_t)1024 * 1024 * 2);
constexpr size_t O_WDN = O_WUP + 2 * AL((size_t)5632 * 1024 * 2);
constexpr size_t O_WSP = O_WDN + 2 * AL((size_t)1024 * 2816 * 2);
constexpr size_t O_ROPE = O_WSP + AL((size_t)8 * 128 * 128 * 2);
constexpr size_t O_SS = O_ROPE + AL((size_t)8192 * 32 * 4);
constexpr size_t O_VSS = O_SS + AL((size_t)T_TOK * 16);
constexpr size_t O_RQ = O_VSS + AL((size_t)T_TOK * 16);
constexpr size_t O_RKV = O_RQ + AL((size_t)T_TOK * 4);
constexpr size_t O_KR = O_RKV + AL((size_t)T_TOK * 4);
constexpr size_t O_G = O_KR + AL((size_t)T_TOK * 32 * 2);
constexpr size_t O_NS = O_G + AL((size_t)T_TOK * 16 * 4);
constexpr size_t O_ML = O_NS + AL((size_t)5120 * 128 * 4);
constexpr size_t O_BL = O_ML + AL((size_t)5120 * 4);
constexpr size_t O_MP = O_BL + AL((size_t)5120 * 4);
constexpr size_t O_XB = O_MP + AL((size_t)5120 * 4);
constexpr size_t O_AR = O_XB + AL((size_t)T_TOK * 1024 * 2);
constexpr size_t O_CQKV = O_AR;
constexpr size_t O_QC = O_CQKV + AL((size_t)T_TOK * 384 * 2);
constexpr size_t O_KC = O_QC + AL((size_t)T_TOK * 512 * 2);
constexpr size_t O_MV = O_KC + AL((size_t)T_TOK * 512 * 2);
constexpr size_t O_MO = O_MV + AL((size_t)T_TOK * 512 * 2);
constexpr size_t O_CS = O_MO + AL((size_t)T_TOK * 512 * 2);
constexpr size_t O_Y = O_CS + AL((size_t)5120 * 16384 * 2);
constexpr size_t O_END0 = O_Y + AL((size_t)T_TOK * 1024 * 2);
constexpr size_t O_Q = O_QC;
constexpr size_t O_KN = O_Q + AL((size_t)T_TOK * 768 * 2);
constexpr size_t O_VT = O_KN + AL((size_t)T_TOK * 512 * 2);
static_assert(O_VT + (size_t)T_TOK * 512 * 2 <= O_CS, "attention operands overlay");
constexpr size_t O_HID = O_AR;
constexpr size_t O_U = O_AR;
constexpr size_t O_V = O_U + AL((size_t)T_TOK * 1024 * 2);
constexpr size_t O_Z = O_V + AL((size_t)T_TOK * 1024 * 2);
constexpr size_t WS_NEED = O_END0;
static_assert(O_HID + (size_t)T_TOK * 2816 * 2 <= O_END0 && O_Z + (size_t)T_TOK * 2048 <= O_END0, "arena");

struct Params {
    const float* x_prompt; const float* x_sample;
    const float *ab_norm, *ab_w_in, *q_norm, *w_uq, *kv_norm, *w_ukv, *m_conv_w, *m_conv_b, *gate_bias, *m_out_norm, *ab_w_out;
    const float *c_norm, *c_w_in, *c_v_norm, *c_w_sp, *c_b_sp, *c_w_out;
    const float *ffn_norm, *ffn_w_up, *ffn_conv_w, *ffn_conv_b, *ffn_w_down, *final_norm;
    float* out; unsigned char* ws;
};

extern __shared__ __attribute__((aligned(16))) unsigned char g_lds[];

DI unsigned pk2(float lo, float hi) { f32x2 v = {lo, hi}; bf2_t b = __builtin_convertvector(v, bf2_t); return __builtin_bit_cast(unsigned, b); }
DI bf16 f2bf(float x) { return (bf16)(pk2(x, 0.f) & 0xffffu); }
DI float bf2f(bf16 x) { return __uint_as_float(((unsigned)x) << 16); }
DI float bflo(unsigned u) { return __uint_as_float(u << 16); }
DI float bfhi(unsigned u) { return __uint_as_float(u & 0xffff0000u); }
DI int seq_start(int sq) { return sq < 2 ? (sq << 13) : TP + ((sq - 2) << 12); }
DI int seq_len(int sq) { return sq < 2 ? 8192 : 4096; }
DI int seq_of(int t) { return t < TP ? (t >> 13) : 2 + ((t - TP) >> 12); }
DI float wave_sum(float v) {
#pragma unroll
    for (int o = 1; o < 64; o <<= 1) v += __shfl_xor(v, o);
    return v;
}
DI float frcp(float x) { return __builtin_amdgcn_rcpf(x); }
DI float sigmoidf_(float x) { return frcp(1.f + __builtin_amdgcn_exp2f(-1.4426950408889634f * x)); }
DI float siluf_(float x) { return x * frcp(1.f + __builtin_amdgcn_exp2f(-1.4426950408889634f * x)); }
DI float logsigmoidf_(float x) { return fminf(x, 0.f) - log1pf(__expf(-fabsf(x))); }
DI float geluf_(float v) {
    const float av = fabsf(v), t = frcp(1.f + 0.2316418882f * av);
    float q = t * 0.5307027145f + (-0.7265760135f); q = q * t + 0.7107068705f; q = q * t + (-0.142248368f); q = q * t + 0.127414796f; q = q * t;
    const float e = __builtin_amdgcn_exp2f(v * v * (-0.72134752044f));
    const float m = v * (q * e);
    return v < 0.f ? m : v - m;
}
DI f32x4 ld_ss(const f32x4* SS, int t) { return SS[t]; }
DI float rs_of(const f32x4* SS, int t) { f32x4 s = SS[t]; return rsqrtf(((s.x + s.y) + (s.z + s.w)) * (1.f / 1024.f) + EPS); }
DI const float* xin_row(const Params& p, int t) { return t < TP ? p.x_prompt + (size_t)t * DM : p.x_sample + (size_t)(t - TP) * DM; }

DI int srccol(int perm, int n) {
    if (perm == 1) { if (n < 416) return n; if (n < 432) return 2464 + (n - 416); if (n < 512) return -1; return n - 96; }
    if (perm == 2) { const int hd = (n & 511) >> 6, d = n & 63; return hd * 128 + (n >= 512 ? 64 : 0) + d; }
    if (perm == 3) { const int pn = n >> 8, c = n & 255; return c < 128 ? pn * 128 + c : 2816 + pn * 128 + (c - 128); }
    return n;
}
struct P0Job { const float* src; const float* gain; bf16* dst; int Nsrc, dld, dcol0, perm, k0, n0; };
DI void p0_job(const Params& p, int it, P0Job& J) {
    unsigned char* ws = p.ws; int r = it; int Nd;
    if (r < 640) { J.src = p.ab_w_in; J.Nsrc = 2480; Nd = 2560; J.dst = (bf16*)(ws + O_WIN); J.dld = 1024; J.dcol0 = 0; J.gain = p.ab_norm; J.perm = 1; }
    else if ((r -= 640) < 48) { J.src = p.w_uq; J.Nsrc = 768; Nd = 768; J.dst = (bf16*)(ws + O_WQKV); J.dld = 384; J.dcol0 = 0; J.gain = p.q_norm; J.perm = 0; }
    else if ((r -= 48) < 32) { J.src = p.w_ukv; J.Nsrc = 1024; Nd = 1024; J.dst = (bf16*)(ws + O_WQKV) + (size_t)768 * 384; J.dld = 384; J.dcol0 = 256; J.gain = p.kv_norm; J.perm = 2; }
    else if ((r -= 32) < 256) { J.src = p.ab_w_out; J.Nsrc = 1024; Nd = 1024; J.dst = (bf16*)(ws + O_WOUT); J.dld = 1024; J.dcol0 = 0; J.gain = nullptr; J.perm = 0; }
    else if ((r -= 256) < 512) { J.src = p.c_w_in; J.Nsrc = 2048; Nd = 2048; J.dst = (bf16*)(ws + O_WCIN); J.dld = 1024; J.dcol0 = 0; J.gain = p.c_norm; J.perm = 0; }
    else if ((r -= 512) < 256) { J.src = p.c_w_out; J.Nsrc = 1024; Nd = 1024; J.dst = (bf16*)(ws + O_WCOUT); J.dld = 1024; J.dcol0 = 0; J.gain = nullptr; J.perm = 0; }
    else if ((r -= 256) < 2816) { const int l = r / 1408; r -= l * 1408; J.src = p.ffn_w_up + (size_t)l * 1024 * 5632; J.Nsrc = 5632; Nd = 5632;
        J.dst = (bf16*)(ws + O_WUP + l * AL((size_t)5632 * 1024 * 2)); J.dld = 1024; J.dcol0 = 0; J.gain = p.ffn_norm + l * 1024; J.perm = 3; }
    else { r -= 2816; const int l = r / 704; r -= l * 704; J.src = p.ffn_w_down + (size_t)l * 2816 * 1024; J.Nsrc = 1024; Nd = 1024;
        J.dst = (bf16*)(ws + O_WDN + l * AL((size_t)1024 * 2816 * 2)); J.dld = 2816; J.dcol0 = 0; J.gain = nullptr; J.perm = 0; }
    const int nnt = Nd / 64; J.k0 = (r / nnt) * 64; J.n0 = (r % nnt) * 64;
}
DI void p0_load(const P0Job& J, int tid, float (&v)[8]) {
    const int j = tid & 63, sc = srccol(J.perm, J.n0 + j);
#pragma unroll
    for (int r = 0; r < 8; ++r) { const int k = J.k0 + (tid >> 6) + 8 * r; float x = 0.f; if (sc >= 0) { x = J.src[(size_t)k * J.Nsrc + sc]; if (J.gain) x *= J.gain[k]; } v[r] = x; }
}
DI void p0_row(const Params& p, int t, int lane) {
    bf16* XB = (bf16*)(p.ws + O_XB); f32x4* SS = (f32x4*)(p.ws + O_SS);
    const f32x4* xr = (const f32x4*)xin_row(p, t) + lane;
    f32x4 v[4]; float s = 0.f;
#pragma unroll
    for (int j = 0; j < 4; ++j) { v[j] = xr[64 * j]; s += (v[j].x * v[j].x + v[j].y * v[j].y) + (v[j].z * v[j].z + v[j].w * v[j].w); }
    s = wave_sum(s);
    u32x2* o = (u32x2*)(XB + (size_t)t * DM) + lane;
#pragma unroll
    for (int j = 0; j < 4; ++j) { u32x2 w; w.x = pk2(v[j].x, v[j].y); w.y = pk2(v[j].z, v[j].w); o[64 * j] = w; }
    if (lane == 0) { f32x4 q = {s, 0.f, 0.f, 0.f}; SS[t] = q; }
}
DI void p0_prologue(const Params& p) {
    unsigned char* ws = p.ws;
    int tid_ = threadIdx.x; asm volatile("" : "+v"(tid_)); const int tid = tid_;
    const int lane = tid & 63, NGW = gridDim.x * 8; int trow = blockIdx.x * 8 + (tid >> 6);
    constexpr int NJ = 5968;
    {
        float* tile = (float*)g_lds;
        P0Job J; float v[8]; int it = blockIdx.x;
        if (it < NJ) { p0_job(p, it, J); p0_load(J, tid, v); }
        for (; it < NJ; it += gridDim.x) {
#pragma unroll
            for (int r = 0; r < 8; ++r) tile[((tid >> 6) + 8 * r) * 65 + (tid & 63)] = v[r];
            __syncthreads();
            P0Job Jn = J; const int nit = it + gridDim.x;
            if (nit < NJ) { p0_job(p, nit, Jn); p0_load(Jn, tid, v); }
            const int n = tid >> 3, kc = (tid & 7) * 8;
            u32x4 o;
            o.x = pk2(tile[(kc + 0) * 65 + n], tile[(kc + 1) * 65 + n]); o.y = pk2(tile[(kc + 2) * 65 + n], tile[(kc + 3) * 65 + n]);
            o.z = pk2(tile[(kc + 4) * 65 + n], tile[(kc + 5) * 65 + n]); o.w = pk2(tile[(kc + 6) * 65 + n], tile[(kc + 7) * 65 + n]);
            *(u32x4*)(J.dst + (size_t)(J.n0 + n) * J.dld + J.dcol0 + J.k0 + kc) = o;
            if (trow < T_TOK) { p0_row(p, trow, lane); trow += NGW; }
            if (trow < T_TOK) { p0_row(p, trow, lane); trow += NGW; }
            __syncthreads();
            J = Jn;
        }
    }
    for (; trow < T_TOK; trow += NGW) p0_row(p, trow, lane);
    const int gt = blockIdx.x * NTHR + tid, GT = gridDim.x * NTHR;
    {
        bf16* W = (bf16*)(ws + O_WQKV); const u32x4 z = {0u, 0u, 0u, 0u};
        for (int v = gt; v < 768 * 16 + 1024 * 32; v += GT) {
            if (v < 768 * 16) { const int row = v >> 4, c = v & 15; *(u32x4*)(W + (size_t)row * 384 + 256 + c * 8) = z; }
            else { const int u = v - 768 * 16, row = 768 + (u >> 5), c = u & 31; *(u32x4*)(W + (size_t)row * 384 + c * 8) = z; }
        }
    }
    { bf16* W = (bf16*)(ws + O_WSP); for (int v = gt; v < 8 * 128 * 128; v += GT) W[v] = f2bf(p.c_w_sp[v]); }
    { float* RC = (float*)(ws + O_ROPE); float* RSN = RC + 8192 * 16;
      for (int v = gt; v < 8192 * 16; v += GT) { const int pos = v >> 4, i = v & 15; const float inv = 1.0f / powf(10000.f, (float)i * (1.f / 16.f)); const float ang = (float)pos * inv;
        float s, c; sincosf(ang, &s, &c); RC[v] = c; RSN[v] = s; } }
}

#define LAS __attribute__((address_space(3)))
constexpr int STAGE_BYTES = 131072;
constexpr int EPI_OFF = 131072;
DI int lds_byte(int r, int c) { const int st = (r >> 4) * 2 + (c >> 5), rr = r & 15, cc = c & 31, ob = rr * 64 + cc * 2; return st * 1024 + (ob ^ (((ob >> 9) & 1) << 5)); }
DI void stage_rc(int b, int& R, int& C) { const int st = b / 1024, sb = b % 1024, swz = sb ^ (((sb >> 9) & 1) << 5); R = (st >> 1) * 16 + swz / 64; C = (st & 1) * 32 + (swz % 64) / 2; }

struct Gemm { const bf16* A; const bf16* Bt; int K, nM, nN, overlap; int kmode = 0; };
typedef f32x4 Acc[2][2][4][2];
struct Unit { int pm, pn, tbase, kofs, nt; };

DI void tile_rows(int overlap, int pm, int& tbase, int& s0, int& slen) {
    s0 = 0; slen = T_TOK;
    if (!overlap) tbase = pm * 256; else tbase = 254 * pm - 1;
}
DI bool seq_first(int t) { return t < TP ? (t & 8191) == 0 : (t & 4095) == 0; }
DI bool tile_has_seam(int tbase) { const int nb = ((tbase + 1 + 4095) >> 12) << 12; return nb <= tbase + 255; }
constexpr int NM_PLAIN = 320, NM_OVL = 323;
DI bool next_unit(const Gemm& g, int i, Unit& u) {
    const int nM = g.nM, nN = g.nN, nwg = nM * nN; const long L = (long)i * gridDim.x + blockIdx.x; if (L >= nwg) return false;
    int wgid = (int)L; { const int q = nwg / 8, r = nwg % 8, xcd = wgid % 8, off = wgid / 8; wgid = (xcd < r ? xcd * (q + 1) : r * (q + 1) + (xcd - r) * q) + off; }
    const int nig = 8 * nN, gid = wgid / nig, fm = gid * 8, gsz = (nM - fm) < 8 ? (nM - fm) : 8;
    u.pm = fm + ((wgid % nig) % gsz); u.pn = (wgid % nig) / gsz;
    int s0, slen; tile_rows(g.overlap, u.pm, u.tbase, s0, slen);
    if (g.kmode) { u.kofs = u.pn < 3 ? 0 : 512; u.nt = u.pn < 3 ? 4 : 2; } else { u.kofs = 0; u.nt = g.K / 64; }
    return true;
}

#define DPP_ROR1(x) __builtin_bit_cast(float, __builtin_amdgcn_update_dpp(0, __builtin_bit_cast(int, (x)), 0x121, 0xf, 0xf, false))
#define DPP_ROL1(x) __builtin_bit_cast(float, __builtin_amdgcn_update_dpp(0, __builtin_bit_cast(int, (x)), 0x12F, 0xf, 0xf, false))

template <class F> DI void row_reduce(float (&part)[2][4], int wr, int wc, int fr, int fq, F&& f) {
    float* red = (float*)(g_lds + EPI_OFF);
#pragma unroll
    for (int ai = 0; ai < 2; ++ai)
#pragma unroll
        for (int m = 0; m < 4; ++m) { float v = part[ai][m]; v += __shfl_xor(v, 16); v += __shfl_xor(v, 32);
            if (fq == 0) red[(ai * 128 + wr * 64 + m * 16 + fr) * 4 + wc] = v; }
    __syncthreads();
    if (threadIdx.x < 256) { const f32x4 s = *(const f32x4*)(red + threadIdx.x * 4); f((int)threadIdx.x, (s.x + s.y) + (s.z + s.w)); }
    __syncthreads();
}
DI void conv_exchange(const Acc& acc, int wr, int wc, int fr, int fq) {
    float* bnd = (float*)(g_lds + EPI_OFF + 4096);
#pragma unroll
    for (int ai = 0; ai < 2; ++ai)
#pragma unroll
        for (int bj = 0; bj < 2; ++bj)
#pragma unroll
            for (int n = 0; n < 2; ++n) { const int colL = bj * 128 + wc * 32 + n * 16 + fq * 4, rb = ai * 2 + wr;
                if (fr == 0) *(f32x4*)(bnd + (0 * 4 + rb) * 256 + colL) = acc[ai][bj][0][n];
                if (fr == 15) *(f32x4*)(bnd + (1 * 4 + rb) * 256 + colL) = acc[ai][bj][3][n]; }
    __syncthreads();
}
#undef DPP_ROR1
#undef DPP_ROL1
#define DPP_ROR1(x) __builtin_bit_cast(float, __builtin_amdgcn_update_dpp(__builtin_bit_cast(int, (x)), __builtin_bit_cast(int, (x)), 0x121, 0xf, 0xf, false))
#define DPP_ROL1(x) __builtin_bit_cast(float, __builtin_amdgcn_update_dpp(__builtin_bit_cast(int, (x)), __builtin_bit_cast(int, (x)), 0x12F, 0xf, 0xf, false))
DI f32x4 ror4(const f32x4 v) { f32x4 r; asm volatile("s_nop 1\n\tv_mov_b32_dpp %0, %4 row_ror:1 row_mask:0xf bank_mask:0xf\n\tv_mov_b32_dpp %1, %5 row_ror:1 row_mask:0xf bank_mask:0xf\n\tv_mov_b32_dpp %2, %6 row_ror:1 row_mask:0xf bank_mask:0xf\n\tv_mov_b32_dpp %3, %7 row_ror:1 row_mask:0xf bank_mask:0xf"
    : "=&v"(r.x), "=&v"(r.y), "=&v"(r.z), "=&v"(r.w) : "v"(v.x), "v"(v.y), "v"(v.z), "v"(v.w)); return r; }
DI f32x4 rol4(const f32x4 v) { f32x4 r; asm volatile("s_nop 1\n\tv_mov_b32_dpp %0, %4 row_ror:15 row_mask:0xf bank_mask:0xf\n\tv_mov_b32_dpp %1, %5 row_ror:15 row_mask:0xf bank_mask:0xf\n\tv_mov_b32_dpp %2, %6 row_ror:15 row_mask:0xf bank_mask:0xf\n\tv_mov_b32_dpp %3, %7 row_ror:15 row_mask:0xf bank_mask:0xf"
    : "=&v"(r.x), "=&v"(r.y), "=&v"(r.z), "=&v"(r.w) : "v"(v.x), "v"(v.y), "v"(v.z), "v"(v.w)); return r; }
template <int BJ, int N, int AI, int M> DI f32x4 conv_row(const Acc& acc, const f32x4 w0, const f32x4 w1, const f32x4 w2, const f32x4 b, const f32x4 upB, const f32x4 dnB, int fr) {
    const f32x4 v = acc[AI][BJ][M][N];
    const f32x4 pu = M > 0 ? ror4(acc[AI][BJ][M > 0 ? M - 1 : 0][N]) : upB;
    const f32x4 nd = M < 3 ? rol4(acc[AI][BJ][M < 3 ? M + 1 : 3][N]) : dnB;
    const f32x4 rv_ = ror4(v), lv_ = rol4(v);
    const f32x4 up = fr > 0 ? rv_ : pu, dn = fr < 15 ? lv_ : nd;
    f32x4 r_ = w0 * up + w1 * v + w2 * dn + b;
    asm volatile("" : "+v"(r_.x), "+v"(r_.y), "+v"(r_.z), "+v"(r_.w));
    return r_;
}
template <int BJ, int N, int AI> DI void conv_bnd(int wr, int wc, int fq, f32x4& upB, f32x4& dnB) {
    const float* bnd = (const float*)(g_lds + EPI_OFF + 4096);
    const int colL = BJ * 128 + wc * 32 + N * 16 + fq * 4, rb = AI * 2 + wr; const f32x4 z4 = {0.f, 0.f, 0.f, 0.f};
    upB = rb > 0 ? *(const f32x4*)(bnd + (4 + rb - 1) * 256 + colL) : z4; dnB = rb < 3 ? *(const f32x4*)(bnd + (rb + 1) * 256 + colL) : z4;
}

template <int BJ, int N, int AI> DI void conv4(const Acc& acc, const f32x4 w0, const f32x4 w1, const f32x4 w2, const f32x4 b, const f32x4 upB, const f32x4 dnB, int fr, f32x4 (&out)[4]) {
    f32x4 rprev = upB, lcur = rol4(acc[AI][BJ][0][N]);
#pragma unroll
    for (int M = 0; M < 4; ++M) { const f32x4 v = acc[AI][BJ][M][N]; const f32x4 rv_ = ror4(v); f32x4 lnext = dnB; if (M < 3) lnext = rol4(acc[AI][BJ][M < 3 ? M + 1 : 3][N]);
        const f32x4 up = fr > 0 ? rv_ : rprev, dn = fr < 15 ? lcur : lnext;
        out[M] = w0 * up + w1 * v + w2 * dn + b; rprev = rv_; lcur = lnext; }
}
#define FOR_ROWS(...) _Pragma("unroll") for (int ai = 0; ai < 2; ++ai) _Pragma("unroll") for (int m = 0; m < 4; ++m) { \
    const int row = ai * 128 + wr * 64 + m * 16 + fr; const int tg = tbase + row; const bool ok = (tg >= s0) && (tg < s0 + slen) && (!OVL || (row >= 1 && row <= 254)); (void)ok; __VA_ARGS__ }
#define FOR_COLS(...) _Pragma("unroll") for (int bj = 0; bj < 2; ++bj) _Pragma("unroll") for (int n = 0; n < 2; ++n) { const int colL = bj * 128 + wc * 32 + n * 16 + fq * 4; (void)colL; __VA_ARGS__ }
DI void st_bf4(bf16* p, const f32x4 v) { u32x2 w; w.x = pk2(v.x, v.y); w.y = pk2(v.z, v.w); *(u32x2*)p = w; }
DI void st_bf8(bf16* p, const f32x4 a, const f32x4 b) { u32x4 w; w.x = pk2(a.x, a.y); w.y = pk2(a.z, a.w); w.z = pk2(b.x, b.y); w.w = pk2(b.z, b.w); *(u32x4*)p = w; }
DI float sq4(const f32x4 v) { return (v.x * v.x + v.y * v.y) + (v.z * v.z + v.w * v.w); }

struct EpiIn {
    Params p;
    DI void operator()(Acc& acc, const Unit& u, int wr, int wc, int fr, int fq) const {
        constexpr bool OVL = true; unsigned char* ws = p.ws; const int pn = u.pn; int tbase, s0, slen; tile_rows(1, u.pm, tbase, s0, slen); const bool hb_ = tile_has_seam(tbase); (void)hb_;
        const f32x4* SS = (const f32x4*)(ws + O_SS);
        FOR_ROWS({ const bool val = (tg >= s0) && (tg < s0 + slen); const float rs = val ? rs_of(SS, tg) : 0.f;
            _Pragma("unroll") for (int bj = 0; bj < 2; ++bj) _Pragma("unroll") for (int n = 0; n < 2; ++n) acc[ai][bj][m][n] = val ? acc[ai][bj][m][n] * rs : (f32x4){0.f, 0.f, 0.f, 0.f}; })
        if (pn == 0) {
            bf16* CQ = (bf16*)(ws + O_CQKV); float* RQ = (float*)(ws + O_RQ); float part[2][4];
            FOR_ROWS({ float s = 0.f; FOR_COLS({ const f32x4 v = acc[ai][bj][m][n]; s += sq4(v); if (ok) st_bf4(CQ + (size_t)tg * 384 + colL, v); }) part[ai][m] = s; })
            row_reduce(part, wr, wc, fr, fq, [&](int row, float ss) { const int tg = tbase + row; if (tg >= s0 && tg < s0 + slen && row >= 1 && row <= 254) RQ[tg] = rsqrtf(ss * (1.f / 256.f) + EPS); });
        } else if (pn == 1) {
            bf16* CQ = (bf16*)(ws + O_CQKV); float* RKV = (float*)(ws + O_RKV); float part[2][4];
            FOR_ROWS({ float s = 0.f; _Pragma("unroll") for (int n = 0; n < 2; ++n) { const f32x4 v = acc[ai][0][m][n]; s += sq4(v); if (ok) st_bf4(CQ + (size_t)tg * 384 + 256 + wc * 32 + n * 16 + fq * 4, v); } part[ai][m] = s; })
            row_reduce(part, wr, wc, fr, fq, [&](int row, float ss) { const int tg = tbase + row; if (tg >= s0 && tg < s0 + slen && row >= 1 && row <= 254) RKV[tg] = rsqrtf(ss * (1.f / 128.f) + EPS); });
            if (wc == 0) {
                const float* RC = (const float*)(ws + O_ROPE); const float* RSN = RC + 8192 * 16; bf16* KR = (bf16*)(ws + O_KR);
                FOR_ROWS({ if (ok) { const int pos = tg - seq_start(seq_of(tg)); const f32x4 c = *(const f32x4*)(RC + pos * 16 + fq * 4), s = *(const f32x4*)(RSN + pos * 16 + fq * 4); const f32x4 x1 = acc[ai][1][m][0], x2 = acc[ai][1][m][1];
                    st_bf4(KR + (size_t)tg * 32 + fq * 4, x1 * c - x2 * s); st_bf4(KR + (size_t)tg * 32 + 16 + fq * 4, x2 * c + x1 * s); } })
            } else if (wc == 1) {
                float* G = (float*)(ws + O_G); const f32x4 gb = *(const f32x4*)(p.gate_bias + fq * 4); const bool isf = fq & 1;
                FOR_ROWS({ if (ok) { f32x4 v = acc[ai][1][m][0] + gb; if (isf) { v.x = logsigmoidf_(v.x); v.y = logsigmoidf_(v.y); v.z = logsigmoidf_(v.z); v.w = logsigmoidf_(v.w); } *(f32x4*)(G + (size_t)tg * 16 + fq * 4) = v; } })
            }
        } else if (pn < 6) {
            conv_exchange(acc, wr, wc, fr, fq);
            const float* cw = p.m_conv_w; const float* cb = p.m_conv_b; const int chb = (pn - 2) * 256 + wc * 32 + fq * 4;
            const bool isK = pn >= 4; bf16* dst = (bf16*)(ws + (isK ? O_KC : O_QC)); const float sc = isK ? 0.08838834764831845f : 1.f; const int cb0 = (pn - (isK ? 4 : 2)) * 256;
#define CA_(BJ, N, AI) { f32x4 upB, dnB; conv_bnd<BJ, N, AI>(wr, wc, fq, upB, dnB); f32x4 rp_ = upB, lc_ = rol4(acc[AI][BJ][0][N]); \
        _Pragma("unroll") for (int M = 0; M < 4; ++M) { const int row = AI * 128 + wr * 64 + M * 16 + fr, tg = tbase + row; const f32x4 a_ = acc[AI][BJ][M][N]; const f32x4 ra_ = ror4(a_); f32x4 ln_ = dnB; if (M < 3) ln_ = rol4(acc[AI][BJ][M < 3 ? M + 1 : 3][N]); \
            f32x4 up_ = fr > 0 ? ra_ : rp_, dn_ = fr < 15 ? lc_ : ln_; if (hb_) { const f32x4 z_ = {0.f, 0.f, 0.f, 0.f}; if (seq_first(tg)) up_ = z_; if (seq_first(tg + 1)) dn_ = z_; } const f32x4 v = w0 * up_ + w1 * a_ + w2 * dn_ + bb; rp_ = ra_; lc_ = ln_; \
            if ((tg >= s0) && (tg < s0 + slen) && row >= 1 && row <= 254) st_bf4(dst + (size_t)tg * 512 + cb0 + BJ * 128 + wc * 32 + N * 16 + fq * 4, (f32x4){siluf_(v.x) * sc, siluf_(v.y) * sc, siluf_(v.z) * sc, siluf_(v.w) * sc}); __builtin_amdgcn_sched_barrier(0); } }
#define CS_(BJ, N) { const int ch = chb + BJ * 128 + N * 16; const f32x4 w0 = *(const f32x4*)(cw + ch), w1 = *(const f32x4*)(cw + 1024 + ch), w2 = *(const f32x4*)(cw + 2048 + ch), bb = *(const f32x4*)(cb + ch); CA_(BJ, N, 0) CA_(BJ, N, 1) }
            CS_(0, 0) CS_(0, 1) CS_(1, 0) CS_(1, 1)
#undef CS_
#undef CA_
        } else if (pn < 8) {
            bf16* MV = (bf16*)(ws + O_MV); const int cb0 = (pn - 6) * 256;
            FOR_ROWS({ if (ok) { FOR_COLS({ st_bf4(MV + (size_t)tg * 512 + cb0 + colL, acc[ai][bj][m][n]); }) } })
        } else {
            bf16* MO = (bf16*)(ws + O_MO); const int cb0 = (pn - 8) * 256;
            FOR_ROWS({ if (ok) { FOR_COLS({ const f32x4 v = acc[ai][bj][m][n]; st_bf4(MO + (size_t)tg * 512 + cb0 + colL, (f32x4){sigmoidf_(v.x), sigmoidf_(v.y), sigmoidf_(v.z), sigmoidf_(v.w)}); }) } })
        }
    }
};
struct EpiQkv {
    Params p;
    DI void operator()(Acc& acc, const Unit& u, int wr, int wc, int fr, int fq) const {
        constexpr bool OVL = false; const int s0 = 0, slen = T_TOK, tbase = u.tbase, pn = u.pn; unsigned char* ws = p.ws;
        const float* RS = (const float*)(ws + (pn < 3 ? O_RQ : O_RKV));
        if (pn < 3) {
            bf16* Q = (bf16*)(ws + O_Q); const float* RC = (const float*)(ws + O_ROPE); const float* RSN = RC + 8192 * 16;
            const float qs = 0.10206207261596577f * 1.4426950408889634f;
            FOR_ROWS({ const float rs = RS[tg] * qs; const int sq = seq_of(tg), pos = tg - seq_start(sq);
                _Pragma("unroll") for (int bj = 0; bj < 2; ++bj) { const int base32 = pn * 256 + bj * 128 + wc * 32; const f32x4 v0 = acc[ai][bj][m][0] * rs, v1 = acc[ai][bj][m][1] * rs;
                    f32x4 o0 = v0, o1 = v1;
                    if (base32 % 96 == 64) { const f32x4 c = *(const f32x4*)(RC + pos * 16 + fq * 4), s = *(const f32x4*)(RSN + pos * 16 + fq * 4); o0 = v0 * c - v1 * s; o1 = v1 * c + v0 * s; }
                    st_bf4(Q + (size_t)tg * 768 + base32 + fq * 4, o0); st_bf4(Q + (size_t)tg * 768 + base32 + 16 + fq * 4, o1); } })
        } else if (pn < 5) {
            bf16* KN = (bf16*)(ws + O_KN); const int cb0 = (pn - 3) * 256;
            FOR_ROWS({ const float rs = RS[tg]; FOR_COLS({ st_bf4(KN + (size_t)tg * 512 + cb0 + colL, acc[ai][bj][m][n] * rs); }) })
        } else {
            bf16* VT = (bf16*)(ws + O_VT); const int cb0 = (pn - 5) * 256;
            FOR_ROWS({ const float rs = RS[tg]; const int sq = seq_of(tg), st = seq_start(sq), S = seq_len(sq), pos = tg - st; bf16* base = VT + (size_t)st * 512 + pos;
                FOR_COLS({ const int c = cb0 + colL; const f32x4 v = acc[ai][bj][m][n] * rs;
                    base[(size_t)c * S] = f2bf(v.x); base[(size_t)(c + 1) * S] = f2bf(v.y); base[(size_t)(c + 2) * S] = f2bf(v.z); base[(size_t)(c + 3) * S] = f2bf(v.w); }) })
        }
    }
};
struct EpiRes {
    Params p; int first;
    DI void operator()(Acc& acc, const Unit& u, int wr, int wc, int fr, int fq) const {
        const int tbase = u.tbase, pn = u.pn; unsigned char* ws = p.ws;
        bf16* XB = (bf16*)(ws + O_XB); float* SS = (float*)(ws + O_SS); float part[2][4];
#pragma unroll
        for (int ai = 0; ai < 2; ++ai) { f32x4 res[4][2][2];
#pragma unroll
            for (int m = 0; m < 4; ++m) { const int tg = tbase + ai * 128 + wr * 64 + m * 16 + fr; const float* rr = (first ? xin_row(p, tg) : p.out + (size_t)tg * DM) + pn * 256 + wc * 32 + 8 * fq;
#pragma unroll
                for (int bj = 0; bj < 2; ++bj) { res[m][bj][0] = *(const f32x4*)(rr + bj * 128); res[m][bj][1] = *(const f32x4*)(rr + bj * 128 + 4); } }
#pragma unroll
            for (int m = 0; m < 4; ++m) { const int tg = tbase + ai * 128 + wr * 64 + m * 16 + fr; const int c0 = pn * 256 + wc * 32 + 8 * fq; float* orow = p.out + (size_t)tg * DM + c0; bf16* xrow = XB + (size_t)tg * DM + c0; float s = 0.f;
#pragma unroll
                for (int bj = 0; bj < 2; ++bj) { const f32x4 v0 = res[m][bj][0] + acc[ai][bj][m][0], v1 = res[m][bj][1] + acc[ai][bj][m][1];
                    *(f32x4*)(orow + bj * 128) = v0; *(f32x4*)(orow + bj * 128 + 4) = v1; st_bf8(xrow + bj * 128, v0, v1); s += sq4(v0) + sq4(v1); }
                part[ai][m] = s; } }
        row_reduce(part, wr, wc, fr, fq, [&](int row, float ss) { SS[(size_t)(tbase + row) * 4 + pn] = ss; });
    }
};
struct EpiUp {
    Params p; int layer;
    DI void operator()(Acc& acc, const Unit& u, int wr, int wc, int fr, int fq) const {
        constexpr bool OVL = true; unsigned char* ws = p.ws; const int pn = u.pn; int tbase, s0, slen; tile_rows(1, u.pm, tbase, s0, slen); const bool hb_ = tile_has_seam(tbase); (void)hb_;
        const f32x4* SS = (const f32x4*)(ws + O_SS);
        FOR_ROWS({ const bool val = (tg >= s0) && (tg < s0 + slen); const float rs = val ? rs_of(SS, tg) : 0.f;
            _Pragma("unroll") for (int bj = 0; bj < 2; ++bj) _Pragma("unroll") for (int n = 0; n < 2; ++n) acc[ai][bj][m][n] = val ? acc[ai][bj][m][n] * rs : (f32x4){0.f, 0.f, 0.f, 0.f}; })
        conv_exchange(acc, wr, wc, fr, fq);
        const float* cw = p.ffn_conv_w + (size_t)layer * 3 * 5632; const float* cb = p.ffn_conv_b + (size_t)layer * 5632; const int chb = pn * 128 + wc * 32 + fq * 4;
        bf16* HID = (bf16*)(ws + O_HID);
#define CA_(N, AI) { f32x4 upG, dnG, upV, dnV; conv_bnd<0, N, AI>(wr, wc, fq, upG, dnG); conv_bnd<1, N, AI>(wr, wc, fq, upV, dnV); \
        f32x4 rpg_ = upG, lcg_ = rol4(acc[AI][0][0][N]), rpv_ = upV, lcv_ = rol4(acc[AI][1][0][N]); \
        _Pragma("unroll") for (int M = 0; M < 4; ++M) { const int row = AI * 128 + wr * 64 + M * 16 + fr, tg = tbase + row; const f32x4 a_ = acc[AI][0][M][N], b_ = acc[AI][1][M][N]; const f32x4 rga_ = ror4(a_), rvb_ = ror4(b_); \
            f32x4 lng_ = dnG, lnv_ = dnV; if (M < 3) { lng_ = rol4(acc[AI][0][M < 3 ? M + 1 : 3][N]); lnv_ = rol4(acc[AI][1][M < 3 ? M + 1 : 3][N]); } \
            f32x4 ug_ = fr > 0 ? rga_ : rpg_, dg_ = fr < 15 ? lcg_ : lng_, uv_ = fr > 0 ? rvb_ : rpv_, dv_ = fr < 15 ? lcv_ : lnv_; if (hb_) { const f32x4 z_ = {0.f, 0.f, 0.f, 0.f}; if (seq_first(tg)) { ug_ = z_; uv_ = z_; } if (seq_first(tg + 1)) { dg_ = z_; dv_ = z_; } } const f32x4 g = g0 * ug_ + g1 * a_ + g2 * dg_ + gb, v = v0 * uv_ + v1 * b_ + v2 * dv_ + vb; rpg_ = rga_; lcg_ = lng_; rpv_ = rvb_; lcv_ = lnv_; \
            if ((tg >= s0) && (tg < s0 + slen) && row >= 1 && row <= 254) st_bf4(HID + (size_t)tg * DFF + chb + N * 16, (f32x4){siluf_(g.x) * v.x, siluf_(g.y) * v.y, siluf_(g.z) * v.z, siluf_(g.w) * v.w}); __builtin_amdgcn_sched_barrier(0); } }
#define CS_(N) { const int cg_ = chb + N * 16, cv2_ = 2816 + chb + N * 16; \
        const f32x4 g0 = *(const f32x4*)(cw + cg_), g1 = *(const f32x4*)(cw + 5632 + cg_), g2 = *(const f32x4*)(cw + 11264 + cg_), gb = *(const f32x4*)(cb + cg_); \
        const f32x4 v0 = *(const f32x4*)(cw + cv2_), v1 = *(const f32x4*)(cw + 5632 + cv2_), v2 = *(const f32x4*)(cw + 11264 + cv2_), vb = *(const f32x4*)(cb + cv2_); CA_(N, 0) CA_(N, 1) }
        CS_(0) CS_(1)
#undef CS_
#undef CA_
    }
};
struct EpiGin {
    Params p;
    DI void operator()(Acc& acc, const Unit& u, int wr, int wc, int fr, int fq) const {
        constexpr bool OVL = false; const int s0 = 0, slen = T_TOK, tbase = u.tbase, pn = u.pn; unsigned char* ws = p.ws;
        const f32x4* SS = (const f32x4*)(ws + O_SS);
        bf16* dst = (bf16*)(ws + (pn < 4 ? O_U : O_V)); const int cb0 = (pn & 3) * 256 + wc * 32 + 8 * fq; float part[2][4];
        float rsv[2][4]; FOR_ROWS({ rsv[ai][m] = rs_of(SS, tg); })
        FOR_ROWS({ const float rs = rsv[ai][m]; float s = 0.f;
            _Pragma("unroll") for (int bj = 0; bj < 2; ++bj) { f32x4 v0 = acc[ai][bj][m][0] * rs, v1 = acc[ai][bj][m][1] * rs;
                v0.x = geluf_(v0.x); v0.y = geluf_(v0.y); v0.z = geluf_(v0.z); v0.w = geluf_(v0.w); v1.x = geluf_(v1.x); v1.y = geluf_(v1.y); v1.z = geluf_(v1.z); v1.w = geluf_(v1.w);
                s += sq4(v0) + sq4(v1); st_bf8(dst + (size_t)tg * DM + cb0 + bj * 128, v0, v1); } part[ai][m] = s; })
        if (pn >= 4) { float* VSS = (float*)(ws + O_VSS); row_reduce(part, wr, wc, fr, fq, [&](int row, float ss) { VSS[(size_t)(tbase + row) * 4 + (pn - 4)] = ss; }); }
    }
};

DI int perm32(int rho) { const int n = rho >> 4, i = rho & 15; return 8 * (i >> 2) + 4 * n + (i & 3); }
template <class Epi, bool PERM = false> DI void gemm_phase(const Gemm g, const Epi& E) {
    LAS unsigned char* lds = (LAS unsigned char*)g_lds;
    int tid_ = threadIdx.x; asm volatile("" : "+v"(tid_));
    const int tid = tid_, wid = __builtin_amdgcn_readfirstlane(tid >> 6), lane = tid & 63, wr = wid >> 2, wc = wid & 3, fr = lane & 15, fq = lane >> 4;
    const int K = g.K;
    unsigned voff[2], voffB[2];
#pragma unroll
    for (int i = 0; i < 2; ++i) { int R, C; stage_rc(tid * 16 + i * 8192, R, C); voff[i] = (unsigned)(R * K + C) * 2u; const int Rb = PERM ? ((R & ~31) + perm32(R & 31)) : R; voffB[i] = (unsigned)(Rb * K + C) * 2u; }
    const size_t kstep = 128, hstep = (size_t)128 * K * 2, tstep = 2 * hstep;
    const unsigned ldsw = (unsigned)wid * 1024u;
    const int aoff = lds_byte(wr * 64 + fr, fq * 8), boff = lds_byte(wc * 32 + fr, fq * 8);
#define PG8_SA(b, h) (((b) * 2 + (h)) * 16384)
#define PG8_SB(b, h) ((4 + (b) * 2 + (h)) * 16384)
#define PG8_STAGEX(bufoff, gbase, vo) do { _Pragma("unroll") for (int _i = 0; _i < 2; ++_i) \
        __builtin_amdgcn_global_load_lds((const unsigned*)((const char*)(gbase) + vo[_i]), (LAS unsigned*)(lds + (bufoff) + ldsw + _i * 8192), 16, 0, 0); } while (0)
#define PG8_LDA(dst, b, h) do { _Pragma("unroll") for (int m = 0; m < 4; ++m) _Pragma("unroll") for (int k = 0; k < 2; ++k) dst[m][k] = *(const LAS bf16x8*)(lds + PG8_SA(b, h) + aoff + m * 2048 + k * 1024); } while (0)
#define PG8_LDB(dst, b, h) do { _Pragma("unroll") for (int n = 0; n < 2; ++n) _Pragma("unroll") for (int k = 0; k < 2; ++k) dst[n][k] = *(const LAS bf16x8*)(lds + PG8_SB(b, h) + boff + n * 2048 + k * 1024); } while (0)
#define PG8_MMA(ai, bj, At, Bt) do { __builtin_amdgcn_s_setprio(1); _Pragma("unroll") for (int m = 0; m < 4; ++m) _Pragma("unroll") for (int n = 0; n < 2; ++n) _Pragma("unroll") for (int k = 0; k < 2; ++k) \
        acc[ai][bj][m][n] = __builtin_amdgcn_mfma_f32_16x16x32_bf16(Bt[n][k], At[m][k], acc[ai][bj][m][n], 0, 0, 0); __builtin_amdgcn_s_setprio(0); } while (0)
#define PG8_WAIT_V(n) asm volatile("s_waitcnt vmcnt(" #n ")" ::: "memory")
#define PG8_WAIT_L(n) asm volatile("s_waitcnt lgkmcnt(" #n ")" ::: "memory")
#define PG8_BAR __builtin_amdgcn_s_barrier()
#define PG8_SCHED __builtin_amdgcn_sched_barrier(0)
    Unit cur, nxt; int ui = 0;
    if (!next_unit(g, 0, cur)) return;
    Acc acc;
#pragma unroll
    for (int a = 0; a < 2; ++a)
#pragma unroll
        for (int b = 0; b < 2; ++b)
#pragma unroll
            for (int m = 0; m < 4; ++m)
#pragma unroll
                for (int n = 0; n < 2; ++n) acc[a][b][m][n] = (f32x4){0.f, 0.f, 0.f, 0.f};
    bf16x8 At[4][2], B0[2][2], B1[2][2];
    const char* cA = (const char*)g.A + (ptrdiff_t)cur.tbase * (ptrdiff_t)(K * 2) + cur.kofs; const char* cB = (const char*)g.Bt + (size_t)cur.pn * tstep + cur.kofs;
    PG8_STAGEX(PG8_SB(0, 0), cB, voffB); PG8_STAGEX(PG8_SB(0, 1), cB + hstep, voffB); PG8_STAGEX(PG8_SA(0, 0), cA, voff); PG8_STAGEX(PG8_SA(0, 1), cA + hstep, voff);
    if (wr == 1) PG8_BAR;
    PG8_WAIT_V(2); PG8_BAR;
    PG8_STAGEX(PG8_SB(1, 0), cB + kstep, voffB); PG8_STAGEX(PG8_SA(1, 0), cA + kstep, voff); PG8_STAGEX(PG8_SB(1, 1), cB + hstep + kstep, voffB);
    PG8_WAIT_V(6); PG8_BAR;
    for (;;) {
        const bool has_next = next_unit(g, ui + 1, nxt);
        const char* nA = has_next ? (const char*)g.A + (ptrdiff_t)nxt.tbase * (ptrdiff_t)(K * 2) + nxt.kofs : cA; const char* nB = has_next ? (const char*)g.Bt + (size_t)nxt.pn * tstep + nxt.kofs : cB;
        const int nt = cur.nt;
        for (int t = 0; t < nt; t += 2) {
            const bool last = (t == nt - 2);
            const char* a1 = cA + (size_t)(t + 1) * kstep;
            const char* a2 = last ? nA : cA + (size_t)(t + 2) * kstep; const char* b2 = last ? nB : cB + (size_t)(t + 2) * kstep;
            const char* a3 = a2 + kstep; const char* b3 = b2 + kstep;
            PG8_LDB(B0, 0, 0); PG8_LDB(B1, 0, 1); PG8_SCHED; PG8_LDA(At, 0, 0); PG8_STAGEX(PG8_SA(1, 1), a1 + hstep, voff);
            PG8_WAIT_V(8); PG8_WAIT_L(0); PG8_BAR; PG8_MMA(0, 0, At, B0); PG8_MMA(0, 1, At, B1); PG8_BAR; PG8_SCHED;
            PG8_LDA(At, 0, 1); PG8_STAGEX(PG8_SB(0, 0), b2, voffB); PG8_STAGEX(PG8_SB(0, 1), b2 + hstep, voffB); PG8_STAGEX(PG8_SA(0, 0), a2, voff);
            PG8_WAIT_V(8); PG8_WAIT_L(0); PG8_BAR; PG8_MMA(1, 0, At, B0); PG8_MMA(1, 1, At, B1); PG8_BAR; PG8_SCHED;
            PG8_LDB(B0, 1, 0); PG8_LDB(B1, 1, 1); PG8_SCHED; PG8_LDA(At, 1, 0); PG8_STAGEX(PG8_SA(0, 1), a2 + hstep, voff);
            PG8_WAIT_V(8); PG8_WAIT_L(0); PG8_BAR; PG8_MMA(0, 0, At, B0); PG8_MMA(0, 1, At, B1); PG8_BAR; PG8_SCHED;
            PG8_LDA(At, 1, 1); PG8_STAGEX(PG8_SB(1, 0), b3, voffB); PG8_STAGEX(PG8_SB(1, 1), b3 + hstep, voffB); PG8_STAGEX(PG8_SA(1, 0), a3, voff);
            PG8_WAIT_V(8); PG8_WAIT_L(0); PG8_BAR; PG8_MMA(1, 0, At, B0); PG8_MMA(1, 1, At, B1); PG8_BAR; PG8_SCHED;
        }
        if (wr == 0) PG8_BAR;
        { int fr2 = fr, fq2 = fq; asm volatile("" : "+v"(fr2), "+v"(fq2)); E(acc, cur, wr, wc, fr2, fq2); }
        if (!has_next) break;
#pragma unroll
        for (int a = 0; a < 2; ++a)
#pragma unroll
            for (int b = 0; b < 2; ++b)
#pragma unroll
                for (int m = 0; m < 4; ++m)
#pragma unroll
                    for (int n = 0; n < 2; ++n) acc[a][b][m][n] = (f32x4){0.f, 0.f, 0.f, 0.f};
        cur = nxt; cA = nA; cB = nB; ++ui;
        if (wr == 1) PG8_BAR;
    }
    PG8_WAIT_V(0);
    PG8_BAR;
    __syncthreads();
}

constexpr int LDT = 136;
constexpr int TILE_B = 128 * LDT * 2;
DI int crow(int i, int h) { return (i & 3) + 8 * (i >> 2) + 4 * h; }
template <int KS> DI void mm_lds(f32x16 (&acc)[2], const bf16* sA, const bf16* sB, int rb, int cb0, int lane) {
    const int r = lane & 31, h = lane >> 5;
#pragma unroll
    for (int ks = 0; ks < KS; ++ks) {
        const bf16x8 a = *(const bf16x8*)(sA + (32 * rb + r) * LDT + 16 * ks + 8 * h);
#pragma unroll
        for (int c = 0; c < 2; ++c) { const bf16x8 b = *(const bf16x8*)(sB + (32 * (cb0 + c) + r) * LDT + 16 * ks + 8 * h); acc[c] = MFMA32(a, b, acc[c]); }
    }
}
DI float scan_add(float v, int lane) {
#pragma unroll
    for (int o = 1; o < 64; o <<= 1) { const float t = __shfl_up(v, o); if (lane >= o) v += t; }
    return v;
}
DI float scan_max(float v, int lane) {
#pragma unroll
    for (int o = 1; o < 64; o <<= 1) { const float t = __shfl_up(v, o); if (lane >= o) v = fmaxf(v, t); }
    return v;
}
DI float wave_max(float v) {
#pragma unroll
    for (int o = 1; o < 64; o <<= 1) v = fmaxf(v, __shfl_xor(v, o));
    return v;
}
DI void load_tile_nat(bf16* sT, const bf16* g, int gld, int tid) {
#pragma unroll
    for (int i = 0; i < 4; ++i) { const int id = tid + 512 * i, row = id >> 4, c = (id & 15) * 8; *(u32x4*)(sT + row * LDT + c) = *(const u32x4*)(g + (size_t)row * gld + c); }
}
DI void load_tile_tr(bf16* sT, const bf16* g, int gld, const float* w, int tid) {
#pragma unroll
    for (int i = 0; i < 4; ++i) { const int id = tid + 512 * i, row = id & 127, c = (id >> 7) * 8; const u32x4 v = *(const u32x4*)(g + (size_t)row * gld + c); const float ww = w ? w[row] : 1.f;
        const unsigned uu[4] = {v.x, v.y, v.z, v.w};
#pragma unroll
        for (int e = 0; e < 4; ++e) { sT[(c + 2 * e) * LDT + row] = f2bf(bflo(uu[e]) * ww); sT[(c + 2 * e + 1) * LDT + row] = f2bf(bfhi(uu[e]) * ww); } }
}

DI void write_tile_tr(bf16* sT, const u32x4 (&v)[4], const float* w, int tid) {
#pragma unroll
    for (int i = 0; i < 4; ++i) { const int id = tid + 512 * i, row = id & 127, c = (id >> 7) * 8; const float ww = w ? w[row] : 1.f;
        const unsigned uu[4] = {v[i].x, v[i].y, v[i].z, v[i].w};
#pragma unroll
        for (int e = 0; e < 4; ++e) { sT[(c + 2 * e) * LDT + row] = f2bf(bflo(uu[e]) * ww); sT[(c + 2 * e + 1) * LDT + row] = f2bf(bfhi(uu[e]) * ww); } }
}
DI void mlstm_local(const Params& p) {
    unsigned char* ws = p.ws; int tid_ = threadIdx.x; asm volatile("" : "+v"(tid_)); const int tid = tid_, lane = tid & 63, wid = tid >> 6;
    bf16* sV = (bf16*)g_lds; bf16* sK = (bf16*)(g_lds + TILE_B); float* sW = (float*)(g_lds + 2 * TILE_B);
    const float* G = (const float*)(ws + O_G); const bf16* MV = (const bf16*)(ws + O_MV); const bf16* KC = (const bf16*)(ws + O_KC);
    bf16* CS = (bf16*)(ws + O_CS); float* NS = (float*)(ws + O_NS); float* ML = (float*)(ws + O_ML); float* BL = (float*)(ws + O_BL);
    const int rb = wid & 3, cb0 = (wid >> 2) * 2;
    for (int it2 = blockIdx.x; it2 < 2560; it2 += gridDim.x) {
        const int cgk = it2 >> 2, h = it2 & 3, t0 = cgk * 128;
        u32x4 vr[4], kr[4];
#pragma unroll
        for (int i = 0; i < 4; ++i) { const int id = tid + 512 * i, row = id & 127, c = (id >> 7) * 8; vr[i] = *(const u32x4*)(MV + (size_t)(t0 + row) * 512 + h * 128 + c); kr[i] = *(const u32x4*)(KC + (size_t)(t0 + row) * 512 + h * 128 + c); }
        if (wid < 2) { const int dir = wid, item = it2 * 2 + dir;
            const int o0 = dir ? 127 - lane : lane, o1 = dir ? 63 - lane : lane + 64;
            const float lf0 = G[(size_t)(t0 + o0) * 16 + dir * 8 + 4 + h], li0 = G[(size_t)(t0 + o0) * 16 + dir * 8 + h];
            const float lf1 = G[(size_t)(t0 + o1) * 16 + dir * 8 + 4 + h], li1 = G[(size_t)(t0 + o1) * 16 + dir * 8 + h];
            const float b0 = scan_add(lf0, lane), tot0 = __shfl(b0, 63), b1 = scan_add(lf1, lane) + tot0, bL = __shfl(b1, 63);
            const float g0 = bL - b0 + li0, g1 = bL - b1 + li1, ml = wave_max(fmaxf(g0, g1));
            sW[dir * 128 + o0] = __expf(g0 - ml); sW[dir * 128 + o1] = __expf(g1 - ml);
            if (lane == 0) { ML[item] = ml; BL[item] = bL; }
        }
        write_tile_tr(sK, kr, nullptr, tid);
        __syncthreads();
#pragma unroll 1
        for (int dir = 0; dir < 2; ++dir) { const int item = it2 * 2 + dir; const float* sWd = sW + dir * 128;
            write_tile_tr(sV, vr, sWd, tid);
            __syncthreads();
            if (tid < 128) { float s = 0.f;
#pragma unroll 4
                for (int l = 0; l < 128; l += 8) { const u32x4 kk = *(const u32x4*)(sK + tid * LDT + l); const f32x4 wa = *(const f32x4*)(sWd + l), wb = *(const f32x4*)(sWd + l + 4);
                    s += (wa.x * bflo(kk.x) + wa.y * bfhi(kk.x)) + (wa.z * bflo(kk.y) + wa.w * bfhi(kk.y)) + (wb.x * bflo(kk.z) + wb.y * bfhi(kk.z)) + (wb.z * bflo(kk.w) + wb.w * bfhi(kk.w)); }
                NS[(size_t)item * 128 + tid] = s; }
            f32x16 acc[2];
#pragma unroll
            for (int c = 0; c < 2; ++c)
#pragma unroll
                for (int i = 0; i < 16; ++i) acc[c][i] = 0.f;
            mm_lds<8>(acc, sV, sK, rb, cb0, lane);
            bf16* Co = CS + (size_t)item * 16384;
#pragma unroll
            for (int c = 0; c < 2; ++c)
#pragma unroll
                for (int i = 0; i < 16; ++i) Co[(32 * rb + crow(i, lane >> 5)) * 128 + 32 * (cb0 + c) + (lane & 31)] = f2bf(acc[c][i]);
            __syncthreads();
        }
    }
}
DI void mlstm_scan(const Params& p) {
    unsigned char* ws = p.ws; int tid_ = threadIdx.x; asm volatile("" : "+v"(tid_)); const int gt = blockIdx.x * NTHR + tid_, GT = gridDim.x * NTHR;
    bf16* CS = (bf16*)(ws + O_CS); float* NS = (float*)(ws + O_NS); const float* ML = (const float*)(ws + O_ML); const float* BL = (const float*)(ws + O_BL); float* MP = (float*)(ws + O_MP);
    for (int u = gt; u < 144 * 2080; u += GT) {
        const int st = u / 2080, v = u % 2080, sq = st >> 3, h = (st >> 1) & 3, dir = st & 1, nc = seq_len(sq) >> 7, c0 = seq_start(sq) >> 7;
        float m = 0.f;
        if (v < 2048) {
            float C[8];
#pragma unroll
            for (int e = 0; e < 8; ++e) C[e] = 0.f;
            for (int j = 0; j < nc; j += 4) {
                u32x4 t[4]; float bl[4], mlv[4]; int itm[4];
#pragma unroll
                for (int q = 0; q < 4; ++q) { const int n = dir ? nc - 1 - (j + q) : j + q; itm[q] = ((c0 + n) * 4 + h) * 2 + dir; t[q] = *(const u32x4*)(CS + (size_t)itm[q] * 16384 + v * 8); bl[q] = BL[itm[q]]; mlv[q] = ML[itm[q]]; }
#pragma unroll
                for (int q = 0; q < 4; ++q) { u32x4 o; o.x = pk2(C[0], C[1]); o.y = pk2(C[2], C[3]); o.z = pk2(C[4], C[5]); o.w = pk2(C[6], C[7]); *(u32x4*)(CS + (size_t)itm[q] * 16384 + v * 8) = o;
                    if (v == 0) MP[itm[q]] = m;
                    const float mn = fmaxf(bl[q] + m, mlv[q]), a = __expf(bl[q] + m - mn), c = __expf(mlv[q] - mn);
                    C[0] = a * C[0] + c * bflo(t[q].x); C[1] = a * C[1] + c * bfhi(t[q].x); C[2] = a * C[2] + c * bflo(t[q].y); C[3] = a * C[3] + c * bfhi(t[q].y);
                    C[4] = a * C[4] + c * bflo(t[q].z); C[5] = a * C[5] + c * bfhi(t[q].z); C[6] = a * C[6] + c * bflo(t[q].w); C[7] = a * C[7] + c * bfhi(t[q].w); m = mn; }
            }
        } else {
            f32x4 N = {0.f, 0.f, 0.f, 0.f};
            for (int j = 0; j < nc; j += 4) {
                f32x4 t[4]; float bl[4], mlv[4]; int itm[4];
#pragma unroll
                for (int q = 0; q < 4; ++q) { const int n = dir ? nc - 1 - (j + q) : j + q; itm[q] = ((c0 + n) * 4 + h) * 2 + dir; t[q] = *(const f32x4*)(NS + (size_t)itm[q] * 128 + (v - 2048) * 4); bl[q] = BL[itm[q]]; mlv[q] = ML[itm[q]]; }
#pragma unroll
                for (int q = 0; q < 4; ++q) { *(f32x4*)(NS + (size_t)itm[q] * 128 + (v - 2048) * 4) = N;
                    const float mn = fmaxf(bl[q] + m, mlv[q]), a = __expf(bl[q] + m - mn), c = __expf(mlv[q] - mn); N = a * N + c * t[q]; m = mn; }
            }
        }
    }
}
DI void mlstm_out(const Params& p) {
    unsigned char* ws = p.ws; int tid_ = threadIdx.x; asm volatile("" : "+v"(tid_)); const int tid = tid_, lane = tid & 63, wid = tid >> 6, hh = lane >> 5;
    bf16* sQ = (bf16*)g_lds; bf16* sK = (bf16*)(g_lds + TILE_B); bf16* sVT = (bf16*)(g_lds + 2 * TILE_B); bf16* sC = (bf16*)(g_lds + 3 * TILE_B); bf16* sP = sK;
    float* sBv2 = (float*)(g_lds + 4 * TILE_B); float* sLi2 = sBv2 + 256; float* sMt2 = sBv2 + 512; float* sInter2 = sBv2 + 768; float* sInv = sBv2 + 1024; float* sN = sBv2 + 1152;
    float* sH = (float*)g_lds;
    const float* G = (const float*)(ws + O_G); const bf16* QC = (const bf16*)(ws + O_QC); const bf16* KC = (const bf16*)(ws + O_KC); const bf16* MV = (const bf16*)(ws + O_MV); const bf16* MO = (const bf16*)(ws + O_MO);
    const bf16* CS = (const bf16*)(ws + O_CS); const float* NS = (const float*)(ws + O_NS); const float* MP = (const float*)(ws + O_MP); bf16* Y = (bf16*)(ws + O_Y);
    const int rb = wid & 3, cb0 = (wid >> 2) * 2;
    for (int item = blockIdx.x; item < 2560; item += gridDim.x) {
        const int cgk = item >> 2, h = item & 3, t0 = cgk * 128;
        load_tile_nat(sQ, QC + (size_t)t0 * 512 + h * 128, 512, tid);
        load_tile_nat(sK, KC + (size_t)t0 * 512 + h * 128, 512, tid);
        load_tile_tr(sVT, MV + (size_t)t0 * 512 + h * 128, 512, nullptr, tid);
        if (wid < 2) {
            const int dir = wid, itemd = (cgk * 4 + h) * 2 + dir; const float mprev = MP[itemd];
            const int o0 = dir ? 127 - lane : lane, o1 = dir ? 63 - lane : lane + 64;
            const float lf0 = G[(size_t)(t0 + o0) * 16 + dir * 8 + 4 + h], li0 = G[(size_t)(t0 + o0) * 16 + dir * 8 + h];
            const float lf1 = G[(size_t)(t0 + o1) * 16 + dir * 8 + 4 + h], li1 = G[(size_t)(t0 + o1) * 16 + dir * 8 + h];
            const float b0 = scan_add(lf0, lane), tot0 = __shfl(b0, 63), b1 = scan_add(lf1, lane) + tot0;
            const float pm0 = scan_max(li0 - b0, lane), mx0 = __shfl(pm0, 63), pm1 = fmaxf(scan_max(li1 - b1, lane), mx0);
            const float a0 = b0 + mprev, a1 = b1 + mprev, mt0 = fmaxf(a0, b0 + pm0), mt1 = fmaxf(a1, b1 + pm1);
            float* B_ = sBv2 + dir * 128; float* L_ = sLi2 + dir * 128; float* M_ = sMt2 + dir * 128; float* I_ = sInter2 + dir * 128;
            B_[o0] = b0; B_[o1] = b1; L_[o0] = li0; L_[o1] = li1; M_[o0] = mt0; M_[o1] = mt1; I_[o0] = __expf(a0 - mt0); I_[o1] = __expf(a1 - mt1);
        }
        __syncthreads();
        f32x16 S[2], hs[2];
#pragma unroll
        for (int c = 0; c < 2; ++c)
#pragma unroll
            for (int i = 0; i < 16; ++i) { S[c][i] = 0.f; hs[c][i] = 0.f; }
        mm_lds<8>(S, sQ, sK, rb, cb0, lane);
#pragma unroll 1
        for (int dir = 0; dir < 2; ++dir) {
            __syncthreads();
            const int itemd = (cgk * 4 + h) * 2 + dir;
            const float* sBv = sBv2 + dir * 128; const float* sLi = sLi2 + dir * 128; const float* sMt = sMt2 + dir * 128; const float* sInter = sInter2 + dir * 128;
            load_tile_nat(sC, CS + (size_t)itemd * 16384, 128, tid);
            if (tid >= 64 && tid < 96) *(f32x4*)(sN + (tid - 64) * 4) = *(const f32x4*)(NS + (size_t)itemd * 128 + (tid - 64) * 4);
            __syncthreads();
#pragma unroll
            for (int c = 0; c < 2; ++c) { const int s = 32 * (cb0 + c) + (lane & 31); const float bs = sBv[s] - sLi[s];
#pragma unroll
                for (int i = 0; i < 16; ++i) { const int t = 32 * rb + crow(i, hh); const bool valid = dir ? (s >= t) : (s <= t);
                    const float pv = valid ? S[c][i] * __expf(sBv[t] - bs - sMt[t]) : 0.f; sP[t * LDT + s] = f2bf(pv); } }
            __syncthreads();
            if (tid < 128) { const int t = tid; float dot = 0.f, rsum = 0.f;
#pragma unroll 4
                for (int e = 0; e < 128; e += 8) { const u32x4 qq = *(const u32x4*)(sQ + t * LDT + e), pq = *(const u32x4*)(sP + t * LDT + e); const f32x4 na = *(const f32x4*)(sN + e), nb = *(const f32x4*)(sN + e + 4);
                    dot += (na.x * bflo(qq.x) + na.y * bfhi(qq.x)) + (na.z * bflo(qq.y) + na.w * bfhi(qq.y)) + (nb.x * bflo(qq.z) + nb.y * bfhi(qq.z)) + (nb.z * bflo(qq.w) + nb.w * bfhi(qq.w));
                    rsum += (bflo(pq.x) + bfhi(pq.x)) + (bflo(pq.y) + bfhi(pq.y)) + (bflo(pq.z) + bfhi(pq.z)) + (bflo(pq.w) + bfhi(pq.w)); }
                const float den = sInter[t] * dot + rsum; sInv[t] = 1.f / fmaxf(fabsf(den), __expf(-sMt[t])); }
            f32x16 num[2];
#pragma unroll
            for (int c = 0; c < 2; ++c)
#pragma unroll
                for (int i = 0; i < 16; ++i) num[c][i] = 0.f;
            mm_lds<8>(num, sQ, sC, rb, cb0, lane);
#pragma unroll
            for (int i = 0; i < 16; ++i) { const float it = sInter[32 * rb + crow(i, hh)]; num[0][i] *= it; num[1][i] *= it; }
            mm_lds<8>(num, sP, sVT, rb, cb0, lane);
            __syncthreads();
#pragma unroll
            for (int i = 0; i < 16; ++i) { const float iv = sInv[32 * rb + crow(i, hh)]; hs[0][i] += num[0][i] * iv; hs[1][i] += num[1][i] * iv; }
        }
        __syncthreads();
#pragma unroll
        for (int c = 0; c < 2; ++c)
#pragma unroll
            for (int i = 0; i < 16; ++i) sH[(32 * rb + crow(i, hh)) * 132 + 32 * (cb0 + c) + (lane & 31)] = hs[c][i];
        __syncthreads();
        { const int t = tid >> 2, d0 = (tid & 3) * 32; f32x4 v[8]; float ss = 0.f;
#pragma unroll
          for (int e = 0; e < 8; ++e) { v[e] = *(const f32x4*)(sH + t * 132 + d0 + 4 * e); ss += sq4(v[e]); }
          ss += __shfl_xor(ss, 1); ss += __shfl_xor(ss, 2);
          const float rstd = rsqrtf(ss * (1.f / 128.f) + EPS);
          const bf16* mo = MO + (size_t)(t0 + t) * 512 + h * 128 + d0; const float* on = p.m_out_norm + h * 128 + d0; bf16* yo = Y + (size_t)(t0 + t) * 1024 + 512 + h * 128 + d0;
#pragma unroll
          for (int e = 0; e < 4; ++e) { const u32x4 g = *(const u32x4*)(mo + 8 * e); const f32x4 n0 = *(const f32x4*)(on + 8 * e), n1 = *(const f32x4*)(on + 8 * e + 4); const f32x4 a = v[2 * e] * rstd * n0, b = v[2 * e + 1] * rstd * n1;
              u32x4 o; o.x = pk2(a.x * bflo(g.x), a.y * bfhi(g.x)); o.y = pk2(a.z * bflo(g.y), a.w * bfhi(g.y)); o.z = pk2(b.x * bflo(g.z), b.y * bfhi(g.z)); o.w = pk2(b.z * bflo(g.w), b.w * bfhi(g.w));
              *(u32x4*)(yo + 8 * e) = o; } }
        __syncthreads();
    }
}
DI void attn_phase(const Params& p) {
    unsigned char* ws = p.ws; int tid_ = threadIdx.x; asm volatile("" : "+v"(tid_)); const int tid = tid_, lane = tid & 63, wid = tid >> 6, r = lane & 31, hh = lane >> 5;
    const bf16* Q = (const bf16*)(ws + O_Q); const bf16* KN = (const bf16*)(ws + O_KN); const bf16* KR = (const bf16*)(ws + O_KR); const bf16* VT = (const bf16*)(ws + O_VT); bf16* Y = (bf16*)(ws + O_Y);
    constexpr int KB_B = 128 * 208, VB_B = 64 * 272, VOFF = 2 * KB_B, SOFF = 0;
    for (int item = blockIdx.x; item < 1280; item += gridDim.x) {
        int sq, head, qb;
        if (item < 256) { sq = item >> 7; head = (item & 127) >> 4; qb = item & 15; } else { const int it = item - 256; sq = 2 + (it >> 6); head = (it & 63) >> 3; qb = it & 7; }
        const int S = seq_len(sq), t0 = seq_start(sq), nkt = S >> 7, tq0 = t0 + qb * 512 + wid * 64;
        bf16x8 qf[2][6];
#pragma unroll
        for (int j = 0; j < 2; ++j)
#pragma unroll
            for (int ks = 0; ks < 6; ++ks) qf[j][ks] = *(const bf16x8*)(Q + (size_t)(tq0 + j * 32 + r) * 768 + head * 96 + 16 * ks + 8 * hh);
        f32x16 o[2][2];
#pragma unroll
        for (int j = 0; j < 2; ++j)
#pragma unroll
            for (int c = 0; c < 2; ++c)
#pragma unroll
                for (int i = 0; i < 16; ++i) o[j][c][i] = 0.f;
        float mrun[2] = {0.f, 0.f}, lrun[2] = {0.f, 0.f};
        const bf16* gk = KN + (size_t)(t0 + (tid >> 3)) * 512 + head * 64 + (tid & 7) * 8;
        const bf16* gr = KR + (size_t)(t0 + (tid >> 2)) * 32 + (tid & 3) * 8;
        const bf16* gv = VT + (size_t)t0 * 512 + (size_t)(head * 64 + (tid >> 3)) * S + (tid & 7) * 8;
        unsigned char* lk = g_lds + (tid >> 3) * 208 + (tid & 7) * 16; unsigned char* lr = g_lds + (tid >> 2) * 208 + 128 + (tid & 3) * 16; unsigned char* lv = g_lds + VOFF + (tid >> 3) * 272 + ((tid & 7) >> 1) * 32 + (tid & 1) * 8;
        u32x4 rk, rk2, rr, rv, rv2;
#define ALD_(kt_) { rk = *(const u32x4*)(gk + (size_t)(kt_) * 128 * 512); rk2 = *(const u32x4*)(gk + (size_t)((kt_) * 128 + 64) * 512); rr = *(const u32x4*)(gr + (size_t)(kt_) * 128 * 32); rv = *(const u32x4*)(gv + (kt_) * 128); rv2 = *(const u32x4*)(gv + (kt_) * 128 + 64); }
#define AST_(b_) { *(u32x4*)(lk + (b_) * KB_B) = rk; *(u32x4*)(lk + (b_) * KB_B + 64 * 208) = rk2; *(u32x4*)(lr + (b_) * KB_B) = rr; \
            *(u32x2*)(lv + (b_) * VB_B) = (u32x2){rv.x, rv.y}; *(u32x2*)(lv + (b_) * VB_B + 16) = (u32x2){rv.z, rv.w}; *(u32x2*)(lv + (b_) * VB_B + 128) = (u32x2){rv2.x, rv2.y}; *(u32x2*)(lv + (b_) * VB_B + 144) = (u32x2){rv2.z, rv2.w}; }
        ALD_(0) AST_(0)
        __syncthreads();
        for (int kt = 0; kt < nkt; ++kt) {
            const int buf = kt & 1; const bool more = kt + 1 < nkt;
            if (more) ALD_(kt + 1)
            const unsigned char* Kb = g_lds + buf * KB_B; const unsigned char* Vb = g_lds + VOFF + buf * VB_B;
#pragma unroll 2
            for (int kb = 0; kb < 4; ++kb) {
                f32x16 st[2];
#pragma unroll
                for (int j = 0; j < 2; ++j) { const float nm = -mrun[j];
#pragma unroll
                    for (int i = 0; i < 16; ++i) st[j][i] = nm; }
#pragma unroll
                for (int ks = 0; ks < 6; ++ks) { const bf16x8 a = *(const bf16x8*)(Kb + (32 * kb + r) * 208 + (16 * ks + 8 * hh) * 2); st[0] = MFMA32(a, qf[0][ks], st[0]); st[1] = MFMA32(a, qf[1][ks], st[1]); }
                bf16x8 pf[2][2];
                const bool first = (kt == 0) && (kb == 0);
#pragma unroll
                for (int j = 0; j < 2; ++j) {
                    float mx = st[j][0];
#pragma unroll
                    for (int i = 1; i < 16; ++i) mx = fmaxf(mx, st[j][i]);
                    mx = fmaxf(mx, __shfl_xor(mx, 32));
                    if (first || __builtin_amdgcn_ballot_w64(mx > 8.f) != 0ull) {
                        const float d = first ? mx : fmaxf(mx, 0.f);
                        if (!first) { const float alpha = __builtin_amdgcn_exp2f(-d); lrun[j] *= alpha;
#pragma unroll
                            for (int c = 0; c < 2; ++c)
#pragma unroll
                                for (int i = 0; i < 16; ++i) o[j][c][i] *= alpha; }
#pragma unroll
                        for (int i = 0; i < 16; ++i) st[j][i] -= d;
                        mrun[j] += d;
                    }
                    float ps = 0.f;
#pragma unroll
                    for (int i = 0; i < 16; ++i) { const float e = __builtin_amdgcn_exp2f(st[j][i]); st[j][i] = e; ps += e; }
                    lrun[j] += ps;
#pragma unroll
                    for (int s2 = 0; s2 < 2; ++s2) {
                        u32x4 pp; pp.x = pk2(st[j][8 * s2 + 0], st[j][8 * s2 + 1]); pp.y = pk2(st[j][8 * s2 + 2], st[j][8 * s2 + 3]); pp.z = pk2(st[j][8 * s2 + 4], st[j][8 * s2 + 5]); pp.w = pk2(st[j][8 * s2 + 6], st[j][8 * s2 + 7]);
                        pf[j][s2] = __builtin_bit_cast(bf16x8, pp); }
                }
#pragma unroll
                for (int s2 = 0; s2 < 2; ++s2)
#pragma unroll
                    for (int db = 0; db < 2; ++db) { const bf16x8 a = *(const bf16x8*)(Vb + (32 * db + r) * 272 + (32 * kb + 16 * s2) * 2 + hh * 16);
                        o[0][db] = MFMA32(a, pf[0][s2], o[0][db]); o[1][db] = MFMA32(a, pf[1][s2], o[1][db]); }
            }
            if (more) AST_(buf ^ 1)
            __syncthreads();
        }
#undef ALD_
#undef AST_
        unsigned char* stg = g_lds + SOFF + wid * 8704;
#pragma unroll
        for (int j = 0; j < 2; ++j) { float l = lrun[j]; l += __shfl_xor(l, 32); const float inv = 1.f / l;
#pragma unroll
            for (int db = 0; db < 2; ++db)
#pragma unroll
                for (int g4 = 0; g4 < 4; ++g4) { u32x2 w; w.x = pk2(o[j][db][4 * g4] * inv, o[j][db][4 * g4 + 1] * inv); w.y = pk2(o[j][db][4 * g4 + 2] * inv, o[j][db][4 * g4 + 3] * inv);
                    *(u32x2*)(stg + (j * 32 + r) * 136 + (32 * db + 8 * g4 + 4 * hh) * 2) = w; } }
        __syncthreads();
#pragma unroll
        for (int j = 0; j < 8; ++j) { const int id = lane + 64 * j, row = id >> 3, c = id & 7; const u32x2 a = *(const u32x2*)(stg + row * 136 + c * 16), b = *(const u32x2*)(stg + row * 136 + c * 16 + 8);
            *(u32x4*)(Y + (size_t)(tq0 + row) * 1024 + head * 64 + c * 8) = (u32x4){a.x, a.y, b.x, b.y}; }
        __syncthreads();
    }
}
DI void spatial_phase(const Params& p) {
    unsigned char* ws = p.ws; int tid_ = threadIdx.x; asm volatile("" : "+v"(tid_)); const int tid = tid_, lane = tid & 63, wid = tid >> 6, hh = lane >> 5;
    bf16* sW = (bf16*)g_lds; bf16* sVn = (bf16*)(g_lds + TILE_B); float* sR = (float*)(g_lds + 2 * TILE_B);
    const bf16* WSP = (const bf16*)(ws + O_WSP); const bf16* U = (const bf16*)(ws + O_U); const bf16* V = (const bf16*)(ws + O_V); const f32x4* VSS = (const f32x4*)(ws + O_VSS); bf16* Z = (bf16*)(ws + O_Z);
    const int rb = wid & 3, cb0 = (wid >> 2) * 2;
    const int G8 = (gridDim.x & 7) == 0 ? (int)(gridDim.x >> 3) : 0;
    if (G8 == 0) return;
    const int g = blockIdx.x & 7;
    load_tile_nat(sW, WSP + (size_t)g * 16384, 128, tid);
    const f32x4 n0 = *(const f32x4*)(p.c_v_norm + g * 128 + (tid >> 7) * 8), n1 = *(const f32x4*)(p.c_v_norm + g * 128 + (tid >> 7) * 8 + 4), n2 = *(const f32x4*)(p.c_v_norm + g * 128 + (tid >> 7) * 8 + 32), n3 = *(const f32x4*)(p.c_v_norm + g * 128 + (tid >> 7) * 8 + 36);
    const f32x4 n4 = *(const f32x4*)(p.c_v_norm + g * 128 + (tid >> 7) * 8 + 64), n5 = *(const f32x4*)(p.c_v_norm + g * 128 + (tid >> 7) * 8 + 68), n6 = *(const f32x4*)(p.c_v_norm + g * 128 + (tid >> 7) * 8 + 96), n7 = *(const f32x4*)(p.c_v_norm + g * 128 + (tid >> 7) * 8 + 100);
    u32x4 vr[4];
    int cgk = blockIdx.x >> 3;
    if (cgk < NCHUNK) {
#pragma unroll
        for (int i = 0; i < 4; ++i) { const int id = tid + 512 * i, row = id & 127, c = (id >> 7) * 8; vr[i] = *(const u32x4*)(V + (size_t)(cgk * 128 + row) * 1024 + g * 128 + c); }
    }
    for (; cgk < NCHUNK; cgk += G8) {
        const int t0 = cgk * 128;
        if (tid < 128) { const f32x4 q = VSS[t0 + tid]; sR[tid] = rsqrtf(((q.x + q.y) + (q.z + q.w)) * (1.f / 1024.f) + EPS); }
        __syncthreads();
#pragma unroll
        for (int i = 0; i < 4; ++i) { const int id = tid + 512 * i, row = id & 127, c = (id >> 7) * 8; const u32x4 v = vr[i]; const float ww = sR[row];
            const f32x4 na = i == 0 ? n0 : (i == 1 ? n2 : (i == 2 ? n4 : n6)), nb = i == 0 ? n1 : (i == 1 ? n3 : (i == 2 ? n5 : n7));
            sVn[(c + 0) * LDT + row] = f2bf(bflo(v.x) * ww * na.x); sVn[(c + 1) * LDT + row] = f2bf(bfhi(v.x) * ww * na.y); sVn[(c + 2) * LDT + row] = f2bf(bflo(v.y) * ww * na.z); sVn[(c + 3) * LDT + row] = f2bf(bfhi(v.y) * ww * na.w);
            sVn[(c + 4) * LDT + row] = f2bf(bflo(v.z) * ww * nb.x); sVn[(c + 5) * LDT + row] = f2bf(bfhi(v.z) * ww * nb.y); sVn[(c + 6) * LDT + row] = f2bf(bflo(v.w) * ww * nb.z); sVn[(c + 7) * LDT + row] = f2bf(bfhi(v.w) * ww * nb.w); }
        __syncthreads();
        if (cgk + G8 < NCHUNK) {
#pragma unroll
            for (int i = 0; i < 4; ++i) { const int id = tid + 512 * i, row = id & 127, c = (id >> 7) * 8; vr[i] = *(const u32x4*)(V + (size_t)((cgk + G8) * 128 + row) * 1024 + g * 128 + c); }
        }
        f32x16 acc[2];
#pragma unroll
        for (int c = 0; c < 2; ++c)
#pragma unroll
            for (int i = 0; i < 16; ++i) acc[c][i] = 0.f;
        mm_lds<8>(acc, sW, sVn, rb, cb0, lane);
#pragma unroll
        for (int c = 0; c < 2; ++c)
#pragma unroll
            for (int i = 0; i < 16; ++i) { const int t = 32 * rb + crow(i, hh), cc = g * 128 + 32 * (cb0 + c) + (lane & 31); const size_t ix = (size_t)(t0 + t) * 1024 + cc;
                Z[ix] = f2bf((acc[c][i] + p.c_b_sp[g * 128 + t]) * bf2f(U[ix])); }
    }
    __syncthreads();
}
DI void final_phase(const Params& p) {
    int tid_ = threadIdx.x; asm volatile("" : "+v"(tid_)); const int tid = tid_, lane = tid & 63, gw = blockIdx.x * 8 + (tid >> 6), NGW = gridDim.x * 8; const f32x4* SS = (const f32x4*)(p.ws + O_SS);
    for (int t = gw; t < T_TOK; t += NGW) { const float rs = rs_of(SS, t); f32x4* xr = (f32x4*)(p.out + (size_t)t * DM) + lane; const f32x4* gn = (const f32x4*)p.final_norm + lane;
#pragma unroll
        for (int j = 0; j < 4; ++j) xr[64 * j] = xr[64 * j] * rs * gn[64 * j]; }
}


#ifndef DBG
#define DBG 0
#endif
constexpr size_t O_DBG = O_END0;
DI int btok_(int i) { return ((int)blockIdx.x * 8 + (i & 7)) * 40 + ((int)blockIdx.x * 7 + i * 3) % 40; }
DI bool close_(float fast, float ref) { return fabsf(fast - ref) <= 0.03f + 0.04f * fabsf(ref); }
DI float nrs_(const Params& p, int t) { const float* x = xin_row(p, t); float s = 0.f; for (int k = 0; k < 1024; ++k) s += x[k] * x[k]; return rsqrtf(s * (1.f / 1024.f) + EPS); }
DI float nh_(const Params& p, int t, int col, float rs) { const float* x = xin_row(p, t); float s = 0.f; for (int k = 0; k < 1024; ++k) s += x[k] * p.ab_norm[k] * p.ab_w_in[(size_t)k * 2480 + col]; return s * rs; }
DI void dbg_fail(const Params& p, unsigned bit) { atomicOr((unsigned*)(p.ws + O_DBG), bit); }
DI void chk_inproj(const Params& p) {
    unsigned char* ws = p.ws; int tid_ = threadIdx.x; asm volatile("" : "+v"(tid_)); const int tid = tid_; const int bx = blockIdx.x;
    if (tid < 4) { const int t = btok_(tid); const float rs = nrs_(p, t);
        { const float ref = nh_(p, t, (7 + 50 * tid + bx) % 256, rs), fast = bf2f(((const bf16*)(ws + O_CQKV))[(size_t)t * 384 + (7 + 50 * tid + bx) % 256]); if (!close_(fast, ref)) dbg_fail(p, 0u); }
        { const float ref = nh_(p, t, 256 + (9 + 20 * tid + bx) % 128, rs), fast = bf2f(((const bf16*)(ws + O_CQKV))[(size_t)t * 384 + 256 + (9 + 20 * tid + bx) % 128]); if (!close_(fast, ref)) dbg_fail(p, 0u); }
        { const int ch = (3 + 37 * tid + 2 * bx) % 512; const float ref = nh_(p, t, 1440 + ch, rs), fast = bf2f(((const bf16*)(ws + O_MV))[(size_t)t * 512 + ch]); if (!close_(fast, ref)) dbg_fail(p, 0u); }
    } else if (tid < 8) { const int i = tid - 4, t = btok_(tid); const int sq = seq_of(t), s0 = seq_start(sq), sl = seq_len(sq);
        for (int w = 0; w < 2; ++w) { const int ch = (w ? 512 : 0) + (11 + 100 * i + 2 * bx) % 512; float a[3];
            for (int d = -1; d <= 1; ++d) { const int tt = t + d; a[d + 1] = (tt >= s0 && tt < s0 + sl) ? nh_(p, tt, 416 + ch, nrs_(p, tt)) : 0.f; }
            float v = a[0] * p.m_conv_w[ch] + a[1] * p.m_conv_w[1024 + ch] + a[2] * p.m_conv_w[2048 + ch] + p.m_conv_b[ch]; v = v / (1.f + expf(-v)); if (w) v *= 0.08838834764831845f;
            const float fast = bf2f(((const bf16*)(ws + (w ? O_KC : O_QC)))[(size_t)t * 512 + (ch & 511)]); if (!close_(fast, v)) { const int pos = t - s0, row = pos % 252 + 2; const int jj = pos / 252, pm = sq < 2 ? sq * 33 + jj : 66 + (sq - 2) * 17 + jj; (void)pm; const int fr_ = row & 15, m_ = (row >> 4) & 3; (void)fr_; (void)m_; { unsigned b = 0; if (fr_ == 1) b = 1u; else if (fr_ == 2) b = 2u; else if (fr_ == 3) b = 4u; else if (fr_ == 12) b = 8u; else if (fr_ == 13) b = 16u; else if (fr_ == 14) b = 32u; dbg_fail(p, b); } } }
    } else if (tid < 12) { const int i = tid - 8, t = btok_(tid); const float rs = nrs_(p, t); const int sq = seq_of(t), pos = t - seq_start(sq);
        { const int gi = (5 + 2 * i + bx) & 15; float v = nh_(p, t, 2464 + gi, rs) + p.gate_bias[gi]; if ((gi >> 2) & 1) v = fminf(v, 0.f) - log1pf(expf(-fabsf(v))); const float fast = ((const float*)(ws + O_G))[(size_t)t * 16 + gi]; if (!close_(fast, v)) dbg_fail(p, 0u); }
        { const int ii = (3 + i + bx) & 15; const float x1 = nh_(p, t, 384 + ii, rs), x2 = nh_(p, t, 384 + 16 + ii, rs); const float ang = (float)pos / powf(10000.f, ii / 16.f); const float c = cosf(ang), sn = sinf(ang);
          const float r1 = x1 * c - x2 * sn, r2 = x2 * c + x1 * sn; const bf16* KR = (const bf16*)(ws + O_KR); if (!close_(bf2f(KR[(size_t)t * 32 + ii]), r1) || !close_(bf2f(KR[(size_t)t * 32 + 16 + ii]), r2)) dbg_fail(p, 0u); }
        { const int ch = (17 + 60 * i + 2 * bx) % 512; float v = nh_(p, t, 1952 + ch, rs); v = 1.f / (1.f + expf(-v)); const float fast = bf2f(((const bf16*)(ws + O_MO))[(size_t)t * 512 + ch]); if (!close_(fast, v)) dbg_fail(p, 0u); }
    }
}
DI void chk_mlstm(const Params& p) {
    unsigned char* ws = p.ws; int tid_ = threadIdx.x; asm volatile("" : "+v"(tid_)); const int tid = tid_; const int sqm = blockIdx.x % 18, hd = (blockIdx.x / 18) & 3, t0 = seq_start(sqm), S = seq_len(sqm), tp = (blockIdx.x * 37 + 5) % S;
    const float* G = (const float*)(ws + O_G); const bf16* QC = (const bf16*)(ws + O_QC); const bf16* KC = (const bf16*)(ws + O_KC); const bf16* MV = (const bf16*)(ws + O_MV); const bf16* MO = (const bf16*)(ws + O_MO); const bf16* Y = (const bf16*)(ws + O_Y);
    const int d = tid >> 2, e0 = (tid & 3) * 32; float* sh = (float*)g_lds; float hsum = 0.f;
    for (int dir = 0; dir < 2; ++dir) {
        const int first = dir ? S - 1 : 0, step = dir ? -1 : 1, cnt = dir ? S - tp : tp + 1;
        float num = 0.f, den = 0.f;
        { float C[32];
#pragma unroll
          for (int e = 0; e < 32; ++e) C[e] = 0.f;
          for (int j = 0; j < cnt; ++j) { const int t = t0 + first + step * j; const float f = expf(G[(size_t)t * 16 + dir * 8 + 4 + hd]), ii = expf(G[(size_t)t * 16 + dir * 8 + hd]);
            const float v = bf2f(MV[(size_t)t * 512 + hd * 128 + d]) * ii;
#pragma unroll
            for (int e = 0; e < 32; ++e) { const float k = bf2f(KC[(size_t)t * 512 + hd * 128 + e0 + e]); C[e] = f * C[e] + v * k; } }
#pragma unroll
          for (int e = 0; e < 32; ++e) num += C[e] * bf2f(QC[(size_t)(t0 + tp) * 512 + hd * 128 + e0 + e]); }
        __builtin_amdgcn_sched_barrier(0);
        { float n[32];
#pragma unroll
          for (int e = 0; e < 32; ++e) n[e] = 0.f;
          for (int j = 0; j < cnt; ++j) { const int t = t0 + first + step * j; const float f = expf(G[(size_t)t * 16 + dir * 8 + 4 + hd]), ii = expf(G[(size_t)t * 16 + dir * 8 + hd]);
#pragma unroll
            for (int e = 0; e < 32; ++e) { const float k = bf2f(KC[(size_t)t * 512 + hd * 128 + e0 + e]); n[e] = f * n[e] + ii * k; } }
#pragma unroll
          for (int e = 0; e < 32; ++e) den += n[e] * bf2f(QC[(size_t)(t0 + tp) * 512 + hd * 128 + e0 + e]); }
        num += __shfl_xor(num, 1); num += __shfl_xor(num, 2); den += __shfl_xor(den, 1); den += __shfl_xor(den, 2);
        hsum += num / fmaxf(fabsf(den), 1.f);
    }
    __syncthreads();
    if ((tid & 3) == 0) sh[d] = hsum;
    __syncthreads();
    if (tid < 128) { float ss = 0.f; for (int e = 0; e < 128; ++e) ss += sh[e] * sh[e]; const float rstd = rsqrtf(ss * (1.f / 128.f) + EPS);
        const float ref = sh[tid] * rstd * p.m_out_norm[hd * 128 + tid] * bf2f(MO[(size_t)(t0 + tp) * 512 + hd * 128 + tid]); const float fast = bf2f(Y[(size_t)(t0 + tp) * 1024 + 512 + hd * 128 + tid]);
        if (!close_(fast, ref)) dbg_fail(p, 0u); }
    __syncthreads();
}
DI void chk_qkv(const Params& p) {
    unsigned char* ws = p.ws; int tid_ = threadIdx.x; asm volatile("" : "+v"(tid_)); const int tid = tid_; if (tid >= 4) return;
    const int t = btok_(tid); const int sq = seq_of(t), st = seq_start(sq), S = seq_len(sq), pos = t - st; const bf16* CQ = (const bf16*)(ws + O_CQKV) + (size_t)t * 384;
    float sq_ = 0.f, skv = 0.f; for (int k = 0; k < 256; ++k) sq_ += bf2f(CQ[k]) * bf2f(CQ[k]); for (int k = 0; k < 128; ++k) skv += bf2f(CQ[256 + k]) * bf2f(CQ[256 + k]);
    const float rq = rsqrtf(sq_ / 256.f + EPS), rkv = rsqrtf(skv / 128.f + EPS); const float qs = 0.10206207261596577f * 1.4426950408889634f;
    const int hd = (2 + tid + blockIdx.x) & 7;
    { const int dd = 13 + tid; float s = 0.f; for (int k = 0; k < 256; ++k) s += bf2f(CQ[k]) * p.q_norm[k] * p.w_uq[(size_t)k * 768 + hd * 96 + dd]; s *= rq * qs; if (!close_(bf2f(((const bf16*)(ws + O_Q))[(size_t)t * 768 + hd * 96 + dd]), s)) dbg_fail(p, 0u); }
    { const int ii = 2 + tid; float x1 = 0.f, x2 = 0.f; for (int k = 0; k < 256; ++k) { const float a = bf2f(CQ[k]) * p.q_norm[k]; x1 += a * p.w_uq[(size_t)k * 768 + hd * 96 + 64 + ii]; x2 += a * p.w_uq[(size_t)k * 768 + hd * 96 + 80 + ii]; }
      x1 *= rq * qs; x2 *= rq * qs; const float ang = (float)pos / powf(10000.f, ii / 16.f); const float c = cosf(ang), sn = sinf(ang); const bf16* Qp = (const bf16*)(ws + O_Q) + (size_t)t * 768 + hd * 96;
      if (!close_(bf2f(Qp[64 + ii]), x1 * c - x2 * sn) || !close_(bf2f(Qp[80 + ii]), x2 * c + x1 * sn)) dbg_fail(p, 0u); }
    { const int dd = 21 + tid; float s = 0.f, v = 0.f; for (int k = 0; k < 128; ++k) { const float a = bf2f(CQ[256 + k]) * p.kv_norm[k]; s += a * p.w_ukv[(size_t)k * 1024 + hd * 128 + dd]; v += a * p.w_ukv[(size_t)k * 1024 + hd * 128 + 64 + dd]; }
      s *= rkv; v *= rkv; if (!close_(bf2f(((const bf16*)(ws + O_KN))[(size_t)t * 512 + hd * 64 + dd]), s)) dbg_fail(p, 0u);
      if (!close_(bf2f(((const bf16*)(ws + O_VT))[(size_t)st * 512 + (size_t)(hd * 64 + dd) * S + pos]), v)) dbg_fail(p, 0u); }
}
DI void chk_attn(const Params& p) {
    unsigned char* ws = p.ws; int tid_ = threadIdx.x; asm volatile("" : "+v"(tid_)); const int tid = tid_; if (tid >= 64) return;
    const int smp = tid >> 4, dd = (tid & 15) * 4 + (blockIdx.x & 3); const int t = btok_(smp), hd = (1 + 2 * smp + blockIdx.x) & 7; const int sq = seq_of(t), st = seq_start(sq), S = seq_len(sq);
    const bf16* Q = (const bf16*)(ws + O_Q) + (size_t)t * 768 + hd * 96; const bf16* KN = (const bf16*)(ws + O_KN); const bf16* KR = (const bf16*)(ws + O_KR); const bf16* VT = (const bf16*)(ws + O_VT) + (size_t)st * 512 + (size_t)(hd * 64 + dd) * S;
    float m = -1e30f, l = 0.f, o = 0.f;
    for (int k = 0; k < S; ++k) { float s = 0.f; for (int e = 0; e < 64; ++e) s += bf2f(Q[e]) * bf2f(KN[(size_t)(st + k) * 512 + hd * 64 + e]); for (int e = 0; e < 32; ++e) s += bf2f(Q[64 + e]) * bf2f(KR[(size_t)(st + k) * 32 + e]);
        const float mn = fmaxf(m, s), a = exp2f(m - mn), pe = exp2f(s - mn); l = l * a + pe; o = o * a + pe * bf2f(VT[k]); m = mn; }
    const float ref = o / l, fast = bf2f(((const bf16*)(ws + O_Y))[(size_t)t * 1024 + hd * 64 + dd]); if (!close_(fast, ref)) dbg_fail(p, 0u);
}
DI void dbg_emit(const Params& p) {
    const float a = sqrtf((float)*(const unsigned*)(p.ws + O_DBG)); const int gt = blockIdx.x * NTHR + threadIdx.x, GT = gridDim.x * NTHR;
    for (size_t i = gt; i < (size_t)T_TOK * DM / 4; i += GT) ((f32x4*)p.out)[i] = (f32x4){a, a, a, a};
}

DI int dtok_(int i) { return i == 0 ? 62 : i == 1 ? 63 : i == 2 ? 253 : i == 3 ? 254 : i == 4 ? 8191 : i == 5 ? 16384 : i == 6 ? 20253 : 81919; }
DI float rowrs_(const float* x) { float s = 0.f; for (int k = 0; k < 1024; ++k) s += x[k] * x[k]; return rsqrtf(s * (1.f / 1024.f) + EPS); }
DI void chk_res(const Params& p, const bf16* A, int K, const float* W, bool first, unsigned bit, int slot) {
    if (threadIdx.x >= 8) return; const int i = threadIdx.x, t = btok_(i), c = (5 + 127 * i + 3 * (int)blockIdx.x) & 1023; float* sv = (float*)(p.ws + O_DBG + 64) + (size_t)blockIdx.x * 32;
    float s = first ? xin_row(p, t)[c] : sv[slot * 8 + i]; for (int k = 0; k < K; ++k) s += bf2f(A[(size_t)t * K + k]) * W[(size_t)k * 1024 + c];
    if (!close_(p.out[(size_t)t * DM + c], s)) dbg_fail(p, bit);
    sv[(slot + 1) * 8 + i] = p.out[(size_t)t * DM + c];
}
DI void chk_up(const Params& p, int layer) {
    if (threadIdx.x >= 8) return; const int i = threadIdx.x, t = btok_(i), j = (9 + 350 * i + 11 * (int)blockIdx.x) % 2816; const int sq = seq_of(t), s0 = seq_start(sq), sl = seq_len(sq);
    const float* W = p.ffn_w_up + (size_t)layer * 1024 * 5632; const float* cw = p.ffn_conv_w + (size_t)layer * 3 * 5632; const float* cb = p.ffn_conv_b + (size_t)layer * 5632; const float* gn = p.ffn_norm + layer * 1024;
    float g = cb[j], v = cb[2816 + j];
    for (int d = -1; d <= 1; ++d) { const int tt = t + d; if (tt < s0 || tt >= s0 + sl) continue; const float* x = p.out + (size_t)tt * DM; const float rs = rowrs_(x); float ag = 0.f, av = 0.f;
        for (int k = 0; k < 1024; ++k) { const float xn = x[k] * rs * gn[k]; ag += xn * W[(size_t)k * 5632 + j]; av += xn * W[(size_t)k * 5632 + 2816 + j]; }
        g += ag * cw[(d + 1) * 5632 + j]; v += av * cw[(d + 1) * 5632 + 2816 + j]; }
    const float ref = g / (1.f + expf(-g)) * v, fast = bf2f(((const bf16*)(p.ws + O_HID))[(size_t)t * DFF + j]); if (!close_(fast, ref)) dbg_fail(p, DBG == 3 ? (i < 6 ? (1u << i) : 0u) : 2u);
}
DI void chk_gin(const Params& p) {
    if (threadIdx.x >= 8) return; const int i = threadIdx.x, t = btok_(i), c = (3 + 120 * i + 5 * (int)blockIdx.x) & 1023; const float* x = p.out + (size_t)t * DM; const float rs = rowrs_(x); float au = 0.f, av = 0.f;
    for (int k = 0; k < 1024; ++k) { const float xn = x[k] * rs * p.c_norm[k]; au += xn * p.c_w_in[(size_t)k * 2048 + c]; av += xn * p.c_w_in[(size_t)k * 2048 + 1024 + c]; }
    au = 0.5f * au * (1.f + erff(au * 0.70710678f)); av = 0.5f * av * (1.f + erff(av * 0.70710678f));
    if (!close_(bf2f(((const bf16*)(p.ws + O_U))[(size_t)t * DM + c]), au) || !close_(bf2f(((const bf16*)(p.ws + O_V))[(size_t)t * DM + c]), av)) dbg_fail(p, 8u);
}
DI void chk_sp(const Params& p) {
    if (threadIdx.x >= 8) return; const int i = threadIdx.x, t = btok_(i), g = (i + (int)blockIdx.x) & 7, c = (7 + 13 * i + (int)blockIdx.x) & 127, t0 = t & ~127, tt = t & 127; const bf16* V = (const bf16*)(p.ws + O_V); const bf16* U = (const bf16*)(p.ws + O_U);
    float acc = 0.f;
    for (int s2 = 0; s2 < 128; ++s2) { const bf16* vr = V + (size_t)(t0 + s2) * DM; float ss = 0.f; for (int k = 0; k < 1024; ++k) ss += bf2f(vr[k]) * bf2f(vr[k]); const float rv = rsqrtf(ss * (1.f / 1024.f) + EPS);
        acc += p.c_w_sp[(size_t)g * 16384 + tt * 128 + s2] * bf2f(vr[g * 128 + c]) * rv * p.c_v_norm[g * 128 + c]; }
    const float ref = (acc + p.c_b_sp[g * 128 + tt]) * bf2f(U[(size_t)t * DM + g * 128 + c]); if (!close_(bf2f(((const bf16*)(p.ws + O_Z))[(size_t)t * DM + g * 128 + c]), ref)) dbg_fail(p, 0u);
}
#if defined(__HIP_DEVICE_COMPILE__)
#define GETP() Params p; { typedef const unsigned long long __attribute__((address_space(4)))* KA_; KA_ q_ = (KA_)__builtin_amdgcn_kernarg_segment_ptr(); asm volatile("" : "+s"(q_)); \
    typedef __attribute__((address_space(1))) unsigned char* GP_; const void** pp_ = (const void**)&p; _Pragma("unroll") for (int i_ = 0; i_ < 27; ++i_) pp_[i_] = (const void*)(GP_)q_[i_]; } unsigned char* ws = p.ws; (void)ws;
#else
#define GETP() Params p = p_unused; unsigned char* ws = p.ws; (void)ws;
#endif
__global__ void __launch_bounds__(NTHR, 2) fwd_kernel(Params p_unused, int lo, int hi) {
    cg::grid_group grid = cg::this_grid();
#define PH(k, ...) if (lo <= (k) && (k) < hi) { GETP() __VA_ARGS__ } if (lo <= (k) && (k) + 1 < hi) grid.sync();
    PH(0, p0_prologue(p); if (DBG && blockIdx.x == 0 && threadIdx.x == 0) *(unsigned*)(p.ws + O_DBG) = 0u;)
    PH(1, Gemm g{(const bf16*)(ws + O_XB), (const bf16*)(ws + O_WIN), 1024, NM_OVL, 10, 1}; EpiIn E{p}; gemm_phase(g, E);)
    PH(2, mlstm_local(p);)
    PH(3, mlstm_scan(p);)
    PH(4, mlstm_out(p);)
    PH(5, Gemm g{(const bf16*)(ws + O_CQKV), (const bf16*)(ws + O_WQKV), 384, NM_PLAIN, 7, 0, 1}; EpiQkv E{p}; gemm_phase(g, E);)
    PH(6, attn_phase(p);)
    PH(7, Gemm g{(const bf16*)(ws + O_Y), (const bf16*)(ws + O_WOUT), 1024, NM_PLAIN, 4, 0}; EpiRes E{p, 1}; gemm_phase<EpiRes, true>(g, E);)
    PH(8, Gemm g{(const bf16*)(ws + O_XB), (const bf16*)(ws + O_WUP), 1024, NM_OVL, 22, 1}; EpiUp E{p, 0}; gemm_phase<EpiUp, false>(g, E);)
    PH(9, Gemm g{(const bf16*)(ws + O_HID), (const bf16*)(ws + O_WDN), 2816, NM_PLAIN, 4, 0}; EpiRes E{p, 0}; gemm_phase<EpiRes, true>(g, E);)
    PH(10, Gemm g{(const bf16*)(ws + O_XB), (const bf16*)(ws + O_WCIN), 1024, NM_PLAIN, 8, 0}; EpiGin E{p}; gemm_phase<EpiGin, true>(g, E);)
    PH(11, spatial_phase(p);)
    PH(12, Gemm g{(const bf16*)(ws + O_Z), (const bf16*)(ws + O_WCOUT), 1024, NM_PLAIN, 4, 0}; EpiRes E{p, 0}; gemm_phase<EpiRes, true>(g, E);)
    PH(13, Gemm g{(const bf16*)(ws + O_XB), (const bf16*)(ws + O_WUP + AL((size_t)5632 * 1024 * 2)), 1024, NM_OVL, 22, 1}; EpiUp E{p, 1}; gemm_phase<EpiUp, false>(g, E);)
    PH(14, Gemm g{(const bf16*)(ws + O_HID), (const bf16*)(ws + O_WDN + AL((size_t)1024 * 2816 * 2)), 2816, NM_PLAIN, 4, 0}; EpiRes E{p, 0}; gemm_phase<EpiRes, true>(g, E);)
    PH(15, final_phase(p);)
}
#if DBG
__global__ void __launch_bounds__(NTHR) chk_kernel(Params p, int which) {
    unsigned char* ws = p.ws; (void)ws;
    if (which == 1) chk_inproj(p);
    else if (which == 4) chk_mlstm(p);
    else if (which == 5) chk_qkv(p);
    else if (which == 6) chk_attn(p);
    else if (which == 7) chk_res(p, (const bf16*)(ws + O_Y), 1024, p.ab_w_out, true, 1u, 0);
    else if (which == 8) chk_up(p, 0);
    else if (which == 9) chk_res(p, (const bf16*)(ws + O_HID), 2816, p.ffn_w_down, false, 4u, 1);
    else if (which == 10) chk_gin(p);
    else if (which == 11) chk_sp(p);
    else if (which == 12) chk_res(p, (const bf16*)(ws + O_Z), 1024, p.c_w_out, false, 32u, 2);
    else if (which == 13) chk_up(p, 1);
    else if (which == 99) dbg_emit(p);
}
#endif

extern "C" void kernel_launch(void* const* d_in, const int* in_sizes, int n_in, void* d_out, int out_size, void* d_ws, size_t ws_size, hipStream_t stream) {
    static int grid = 0;
    if (grid == 0) {
        if (n_in != 25 || ws_size < WS_NEED + 65536 || out_size != T_TOK * DM) { fprintf(stderr, "kernel_launch: unexpected problem: n_in %d out %d ws %zu (need %zu)\n", n_in, out_size, ws_size, (size_t)WS_NEED); grid = -1; return; }
        int dev = 0, cus = 0, per_cu = 0;
        hipGetDevice(&dev); hipDeviceGetAttribute(&cus, hipDeviceAttributeMultiprocessorCount, dev);
        if (hipFuncSetAttribute((const void*)fwd_kernel, hipFuncAttributeMaxDynamicSharedMemorySize, LDS_BYTES) != hipSuccess) { fprintf(stderr, "kernel_launch: hipFuncSetAttribute failed\n"); grid = -1; return; }
        hipOccupancyMaxActiveBlocksPerMultiprocessor(&per_cu, (const void*)fwd_kernel, NTHR, LDS_BYTES);
        if (per_cu < 1) { fprintf(stderr, "kernel_launch: occupancy query says %d blocks per CU\n", per_cu); per_cu = 1; }
        (void)hipGetLastError();
        grid = cus;
    }
    if (grid < 0) return;
    Params p{};
    const float** f = (const float**)&p;
    for (int i = 0; i < 25; ++i) f[i] = (const float*)d_in[i];
    p.out = (float*)d_out; p.ws = (unsigned char*)d_ws;
    auto run = [&](int lo, int hi) { void* args[] = {&p, &lo, &hi};
        hipError_t e = hipLaunchCooperativeKernel((const void*)fwd_kernel, dim3(grid), dim3(NTHR), args, LDS_BYTES, stream);
        if (e != hipSuccess) fprintf(stderr, "cooperative launch failed: %s (grid %d)\n", hipGetErrorString(e), grid); };
#if DBG == 0
    run(0, 16);
#else
    int cur = 0;
    auto upto = [&](int k) { run(cur, k + 1); cur = k + 1; };
    auto chk = [&](int which) { hipLaunchKernelGGL(chk_kernel, dim3(grid), dim3(NTHR), 4096, stream, p, which); };
#if DBG == 1
    upto(1); chk(1); upto(4); chk(4); upto(5); chk(5); upto(6); chk(6);
#else
    upto(7); chk(7); upto(8); chk(8); upto(9); chk(9); upto(10); chk(10); upto(11); chk(11); upto(12); chk(12);
#if DBG == 4
    upto(13); chk(13);
#endif
#endif
    chk(99);
#endif
}
```

```cpp
#include <hip/hip_runtime.h>
#include <hip/hip_cooperative_groups.h>
#include <cstdio>
#include <cstdint>
namespace cg = cooperative_groups;

typedef unsigned short bf16;
typedef short bf16x8 __attribute__((ext_vector_type(8)));
typedef short s16x4 __attribute__((ext_vector_type(4)));
typedef float f32x2 __attribute__((ext_vector_type(2)));
typedef float f32x4 __attribute__((ext_vector_type(4)));
typedef float f32x16 __attribute__((ext_vector_type(16)));
typedef unsigned u32x2 __attribute__((ext_vector_type(2)));
typedef unsigned u32x4 __attribute__((ext_vector_type(4)));
typedef __bf16 bf2_t __attribute__((ext_vector_type(2)));
#define DI __device__ __forceinline__
#define MFMA32(a, b, c) __builtin_amdgcn_mfma_f32_32x32x16_bf16((a), (b), (c), 0, 0, 0)

constexpr int NTHR = 512;
constexpr int T_TOK = 81920, TP = 16384, DM = 1024;
constexpr int NCHUNK = T_TOK / 128;
constexpr int DFF = 2816;
constexpr float EPS = 1e-6f;
constexpr int LDS_BYTES = 147456;

constexpr size_t AL(size_t x) { return (x + 255) & ~(size_t)255; }
constexpr size_t O_WIN = 0;
constexpr size_t O_WQKV = O_WIN + AL((size_t)2560 * 1024 * 2);
constexpr size_t O_WOUT = O_WQKV + AL((size_t)1792 * 384 * 2);
constexpr size_t O_WCIN = O_WOUT + AL((size_t)1024 * 1024 * 2);
constexpr size_t O_WCOUT = O_WCIN + AL((size_t)2048 * 1024 * 2);
constexpr size_t O_WUP = O_WCOUT + AL((size_t)1024 * 1024 * 2);
constexpr size_t O_WDN = O_WUP + 2 * AL((size_t)5632 * 1024 * 2);
constexpr size_t O_WSP = O_WDN + 2 * AL((size_t)1024 * 2816 * 2);
constexpr size_t O_ROPE = O_WSP + AL((size_t)8 * 128 * 128 * 2);
constexpr size_t O_SS = O_ROPE + AL((size_t)8192 * 32 * 4);
constexpr size_t O_VSS = O_SS + AL((size_t)T_TOK * 16);
constexpr size_t O_RQ = O_VSS + AL((size_t)T_TOK * 16);
constexpr size_t O_RKV = O_RQ + AL((size_t)T_TOK * 4);
constexpr size_t O_KR = O_RKV + AL((size_t)T_TOK * 4);
constexpr size_t O_G = O_KR + AL((size_t)T_TOK * 32 * 2);
constexpr size_t O_NS = O_G + AL((size_t)T_TOK * 16 * 4);
constexpr size_t O_ML = O_NS + AL((size_t)5120 * 128 * 4);
constexpr size_t O_BL = O_ML + AL((size_t)5120 * 4);
constexpr size_t O_MP = O_BL + AL((size_t)5120 * 4);
constexpr size_t O_XB = O_MP + AL((size_t)5120 * 4);
constexpr size_t O_AR = O_XB + AL((size_t)T_TOK * 1024 * 2);
constexpr size_t O_CQKV = O_AR;
constexpr size_t O_QC = O_CQKV + AL((size_t)T_TOK * 384 * 2);
constexpr size_t O_KC = O_QC + AL((size_t)T_TOK * 512 * 2);
constexpr size_t O_MV = O_KC + AL((size_t)T_TOK * 512 * 2);
constexpr size_t O_MO = O_MV + AL((size_t)T_TOK * 512 * 2);
constexpr size_t O_CS = O_MO + AL((size_t)T_TOK * 512 * 2);
constexpr size_t O_Y = O_CS + AL((size_t)5120 * 16384 * 2);
constexpr size_t O_END0 = O_Y + AL((size_t)T_TOK * 1024 * 2);
constexpr size_t O_Q = O_QC;
constexpr size_t O_KN = O_Q + AL((size_t)T_TOK * 768 * 2);
constexpr size_t O_VT = O_KN + AL((size_t)T_TOK * 512 * 2);
static_assert(O_VT + (size_t)T_TOK * 512 * 2 <= O_CS, "attention operands overlay");
constexpr size_t O_HID = O_AR;
constexpr size_t O_U = O_AR;
constexpr size_t O_V = O_U + AL((size_t)T_TOK * 1024 * 2);
constexpr size_t O_Z = O_V + AL((size_t)T_TOK * 1024 * 2);
constexpr size_t WS_NEED = O_END0;
static_assert(O_HID + (size_t)T_TOK * 2816 * 2 <= O_END0 && O_Z + (size_t)T_TOK * 2048 <= O_END0, "arena");

struct Params {
    const float* x_prompt; const float* x_sample;
    const float *ab_norm, *ab_w_in, *q_norm, *w_uq, *kv_norm, *w_ukv, *m_conv_w, *m_conv_b, *gate_bias, *m_out_norm, *ab_w_out;
    const float *c_norm, *c_w_in, *c_v_norm, *c_w_sp, *c_b_sp, *c_w_out;
    const float *ffn_norm, *ffn_w_up, *ffn_conv_w, *ffn_conv_b, *ffn_w_down, *final_norm;
    float* out; unsigned char* ws;
};

extern __shared__ __attribute__((aligned(16))) unsigned char g_lds[];

DI unsigned pk2(float lo, float hi) { f32x2 v = {lo, hi}; bf2_t b = __builtin_convertvector(v, bf2_t); return __builtin_bit_cast(unsigned, b); }
DI bf16 f2bf(float x) { return (bf16)(pk2(x, 0.f) & 0xffffu); }
DI float bf2f(bf16 x) { return __uint_as_float(((unsigned)x) << 16); }
DI float bflo(unsigned u) { return __uint_as_float(u << 16); }
DI float bfhi(unsigned u) { return __uint_as_float(u & 0xffff0000u); }
DI int seq_start(int sq) { return sq < 2 ? (sq << 13) : TP + ((sq - 2) << 12); }
DI int seq_len(int sq) { return sq < 2 ? 8192 : 4096; }
DI int seq_of(int t) { return t < TP ? (t >> 13) : 2 + ((t - TP) >> 12); }
DI float wave_sum(float v) {
#pragma unroll
    for (int o = 1; o < 64; o <<= 1) v += __shfl_xor(v, o);
    return v;
}
DI float frcp(float x) { return __builtin_amdgcn_rcpf(x); }
DI float sigmoidf_(float x) { return frcp(1.f + __builtin_amdgcn_exp2f(-1.4426950408889634f * x)); }
DI float siluf_(float x) { return x * frcp(1.f + __builtin_amdgcn_exp2f(-1.4426950408889634f * x)); }
DI float logsigmoidf_(float x) { return fminf(x, 0.f) - log1pf(__expf(-fabsf(x))); }
DI float geluf_(float v) {
    const float av = fabsf(v), t = frcp(1.f + 0.2316418882f * av);
    float q = t * 0.5307027145f + (-0.7265760135f); q = q * t + 0.7107068705f; q = q * t + (-0.142248368f); q = q * t + 0.127414796f; q = q * t;
    const float e = __builtin_amdgcn_exp2f(v * v * (-0.72134752044f));
    const float m = v * (q * e);
    return v < 0.f ? m : v - m;
}
DI f32x4 ld_ss(const f32x4* SS, int t) { return SS[t]; }
DI float rs_of(const f32x4* SS, int t) { f32x4 s = SS[t]; return rsqrtf(((s.x + s.y) + (s.z + s.w)) * (1.f / 1024.f) + EPS); }
DI const float* xin_row(const Params& p, int t) { return t < TP ? p.x_prompt + (size_t)t * DM : p.x_sample + (size_t)(t - TP) * DM; }

DI int srccol(int perm, int n) {
    if (perm == 1) { if (n < 416) return n; if (n < 432) return 2464 + (n - 416); if (n < 512) return -1; return n - 96; }
    if (perm == 2) { const int hd = (n & 511) >> 6, d = n & 63; return hd * 128 + (n >= 512 ? 64 : 0) + d; }
    if (perm == 3) { const int pn = n >> 8, c = n & 255; return c < 128 ? pn * 128 + c : 2816 + pn * 128 + (c - 128); }
    return n;
}
struct P0Job { const float* src; const float* gain; bf16* dst; int Nsrc, dld, dcol0, perm, k0, n0; };
DI void p0_job(const Params& p, int it, P0Job& J) {
    unsigned char* ws = p.ws; int r = it; int Nd;
    if (r < 640) { J.src = p.ab_w_in; J.Nsrc = 2480; Nd = 2560; J.dst = (bf16*)(ws + O_WIN); J.dld = 1024; J.dcol0 = 0; J.gain = p.ab_norm; J.perm = 1; }
    else if ((r -= 640) < 48) { J.src = p.w_uq; J.Nsrc = 768; Nd = 768; J.dst = (bf16*)(ws + O_WQKV); J.dld = 384; J.dcol0 = 0; J.gain = p.q_norm; J.perm = 0; }
    else if ((r -= 48) < 32) { J.src = p.w_ukv; J.Nsrc = 1024; Nd = 1024; J.dst = (bf16*)(ws + O_WQKV) + (size_t)768 * 384; J.dld = 384; J.dcol0 = 256; J.gain = p.kv_norm; J.perm = 2; }
    else if ((r -= 32) < 256) { J.src = p.ab_w_out; J.Nsrc = 1024; Nd = 1024; J.dst = (bf16*)(ws + O_WOUT); J.dld = 1024; J.dcol0 = 0; J.gain = nullptr; J.perm = 0; }
    else if ((r -= 256) < 512) { J.src = p.c_w_in; J.Nsrc = 2048; Nd = 2048; J.dst = (bf16*)(ws + O_WCIN); J.dld = 1024; J.dcol0 = 0; J.gain = p.c_norm; J.perm = 0; }
    else if ((r -= 512) < 256) { J.src = p.c_w_out; J.Nsrc = 1024; Nd = 1024; J.dst = (bf16*)(ws + O_WCOUT); J.dld = 1024; J.dcol0 = 0; J.gain = nullptr; J.perm = 0; }
    else if ((r -= 256) < 2816) { const int l = r / 1408; r -= l * 1408; J.src = p.ffn_w_up + (size_t)l * 1024 * 5632; J.Nsrc = 5632; Nd = 5632;
        J.dst = (bf16*)(ws + O_WUP + l * AL((size_t)5632 * 1024 * 2)); J.dld = 1024; J.dcol0 = 0; J.gain = p.ffn_norm + l * 1024; J.perm = 3; }
    else { r -= 2816; const int l = r / 704; r -= l * 704; J.src = p.ffn_w_down + (size_t)l * 2816 * 1024; J.Nsrc = 1024; Nd = 1024;
        J.dst = (bf16*)(ws + O_WDN + l * AL((size_t)1024 * 2816 * 2)); J.dld = 2816; J.dcol0 = 0; J.gain = nullptr; J.perm = 0; }
    const int nnt = Nd / 64; J.k0 = (r / nnt) * 64; J.n0 = (r % nnt) * 64;
}
DI void p0_load(const P0Job& J, int tid, float (&v)[8]) {
    const int j = tid & 63, sc = srccol(J.perm, J.n0 + j);
#pragma unroll
    for (int r = 0; r < 8; ++r) { const int k = J.k0 + (tid >> 6) + 8 * r; float x = 0.f; if (sc >= 0) { x = J.src[(size_t)k * J.Nsrc + sc]; if (J.gain) x *= J.gain[k]; } v[r] = x; }
}
DI void p0_row(const Params& p, int t, int lane) {
    bf16* XB = (bf16*)(p.ws + O_XB); f32x4* SS = (f32x4*)(p.ws + O_SS);
    const f32x4* xr = (const f32x4*)xin_row(p, t) + lane;
    f32x4 v[4]; float s = 0.f;
#pragma unroll
    for (int j = 0; j < 4; ++j) { v[j] = xr[64 * j]; s += (v[j].x * v[j].x + v[j].y * v[j].y) + (v[j].z * v[j].z + v[j].w * v[j].w); }
    s = wave_sum(s);
    u32x2* o = (u32x2*)(XB + (size_t)t * DM) + lane;
#pragma unroll
    for (int j = 0; j < 4; ++j) { u32x2 w; w.x = pk2(v[j].x, v[j].y); w.y = pk2(v[j].z, v[j].w); o[64 * j] = w; }
    if (lane == 0) { f32x4 q = {s, 0.f, 0.f, 0.f}; SS[t] = q; }
}
DI void p0_prologue(const Params& p) {
    unsigned char* ws = p.ws;
    int tid_ = threadIdx.x; asm volatile("" : "+v"(tid_)); const int tid = tid_;
    const int lane = tid & 63, NGW = gridDim.x * 8; int trow = blockIdx.x * 8 + (tid >> 6);
    constexpr int NJ = 5968;
    {
        float* tile = (float*)g_lds;
        P0Job J; float v[8]; int it = blockIdx.x;
        if (it < NJ) { p0_job(p, it, J); p0_load(J, tid, v); }
        for (; it < NJ; it += gridDim.x) {
#pragma unroll
            for (int r = 0; r < 8; ++r) tile[((tid >> 6) + 8 * r) * 65 + (tid & 63)] = v[r];
            __syncthreads();
            P0Job Jn = J; const int nit = it + gridDim.x;
            if (nit < NJ) { p0_job(p, nit, Jn); p0_load(Jn, tid, v); }
            const int n = tid >> 3, kc = (tid & 7) * 8;
            u32x4 o;
            o.x = pk2(tile[(kc + 0) * 65 + n], tile[(kc + 1) * 65 + n]); o.y = pk2(tile[(kc + 2) * 65 + n], tile[(kc + 3) * 65 + n]);
            o.z = pk2(tile[(kc + 4) * 65 + n], tile[(kc + 5) * 65 + n]); o.w = pk2(tile[(kc + 6) * 65 + n], tile[(kc + 7) * 65 + n]);
            *(u32x4*)(J.dst + (size_t)(J.n0 + n) * J.dld + J.dcol0 + J.k0 + kc) = o;
            if (trow < T_TOK) { p0_row(p, trow, lane); trow += NGW; }
            if (trow < T_TOK) { p0_row(p, trow, lane); trow += NGW; }
            __syncthreads();
            J = Jn;
        }
    }
    for (; trow < T_TOK; trow += NGW) p0_row(p, trow, lane);
    const int gt = blockIdx.x * NTHR + tid, GT = gridDim.x * NTHR;
    {
        bf16* W = (bf16*)(ws + O_WQKV); const u32x4 z = {0u, 0u, 0u, 0u};
        for (int v = gt; v < 768 * 16 + 1024 * 32; v += GT) {
            if (v < 768 * 16) { const int row = v >> 4, c = v & 15; *(u32x4*)(W + (size_t)row * 384 + 256 + c * 8) = z; }
            else { const int u = v - 768 * 16, row = 768 + (u >> 5), c = u & 31; *(u32x4*)(W + (size_t)row * 384 + c * 8) = z; }
        }
    }
    { bf16* W = (bf16*)(ws + O_WSP); for (int v = gt; v < 8 * 128 * 128; v += GT) W[v] = f2bf(p.c_w_sp[v]); }
    { float* RC = (float*)(ws + O_ROPE); float* RSN = RC + 8192 * 16;
      for (int v = gt; v < 8192 * 16; v += GT) { const int pos = v >> 4, i = v & 15; const float inv = 1.0f / powf(10000.f, (float)i * (1.f / 16.f)); const float ang = (float)pos * inv;
        float s, c; sincosf(ang, &s, &c); RC[v] = c; RSN[v] = s; } }
}

#define LAS __attribute__((address_space(3)))
constexpr int STAGE_BYTES = 131072;
constexpr int EPI_OFF = 131072;
DI int lds_byte(int r, int c) { const int st = (r >> 4) * 2 + (c >> 5), rr = r & 15, cc = c & 31, ob = rr * 64 + cc * 2; return st * 1024 + (ob ^ (((ob >> 9) & 1) << 5)); }
DI void stage_rc(int b, int& R, int& C) { const int st = b / 1024, sb = b % 1024, swz = sb ^ (((sb >> 9) & 1) << 5); R = (st >> 1) * 16 + swz / 64; C = (st & 1) * 32 + (swz % 64) / 2; }

struct Gemm { const bf16* A; const bf16* Bt; int K, nM, nN, overlap; int kmode = 0; };
typedef f32x4 Acc[2][2][4][2];
struct Unit { int pm, pn, tbase, kofs, nt; };

DI void tile_rows(int overlap, int pm, int& tbase, int& s0, int& slen) {
    s0 = 0; slen = T_TOK;
    if (!overlap) tbase = pm * 256; else tbase = 254 * pm - 1;
}
DI bool seq_first(int t) { return t < TP ? (t & 8191) == 0 : (t & 4095) == 0; }
DI bool tile_has_seam(int tbase) { const int nb = ((tbase + 1 + 4095) >> 12) << 12; return nb <= tbase + 255; }
constexpr int NM_PLAIN = 320, NM_OVL = 323;
DI bool next_unit(const Gemm& g, int i, Unit& u) {
    const int nM = g.nM, nN = g.nN, nwg = nM * nN; const long L = (long)i * gridDim.x + blockIdx.x; if (L >= nwg) return false;
    int wgid = (int)L; { const int q = nwg / 8, r = nwg % 8, xcd = wgid % 8, off = wgid / 8; wgid = (xcd < r ? xcd * (q + 1) : r * (q + 1) + (xcd - r) * q) + off; }
    const int nig = 8 * nN, gid = wgid / nig, fm = gid * 8, gsz = (nM - fm) < 8 ? (nM - fm) : 8;
    u.pm = fm + ((wgid % nig) % gsz); u.pn = (wgid % nig) / gsz;
    int s0, slen; tile_rows(g.overlap, u.pm, u.tbase, s0, slen);
    if (g.kmode) { u.kofs = u.pn < 3 ? 0 : 512; u.nt = u.pn < 3 ? 4 : 2; } else { u.kofs = 0; u.nt = g.K / 64; }
    return true;
}

#define DPP_ROR1(x) __builtin_bit_cast(float, __builtin_amdgcn_update_dpp(0, __builtin_bit_cast(int, (x)), 0x121, 0xf, 0xf, false))
#define DPP_ROL1(x) __builtin_bit_cast(float, __builtin_amdgcn_update_dpp(0, __builtin_bit_cast(int, (x)), 0x12F, 0xf, 0xf, false))

template <class F> DI void row_reduce(float (&part)[2][4], int wr, int wc, int fr, int fq, F&& f) {
    float* red = (float*)(g_lds + EPI_OFF);
#pragma unroll
    for (int ai = 0; ai < 2; ++ai)
#pragma unroll
        for (int m = 0; m < 4; ++m) { float v = part[ai][m]; v += __shfl_xor(v, 16); v += __shfl_xor(v, 32);
            if (fq == 0) red[(ai * 128 + wr * 64 + m * 16 + fr) * 4 + wc] = v; }
    __syncthreads();
    if (threadIdx.x < 256) { const f32x4 s = *(const f32x4*)(red + threadIdx.x * 4); f((int)threadIdx.x, (s.x + s.y) + (s.z + s.w)); }
    __syncthreads();
}
DI void conv_exchange(const Acc& acc, int wr, int wc, int fr, int fq) {
    float* bnd = (float*)(g_lds + EPI_OFF + 4096);
#pragma unroll
    for (int ai = 0; ai < 2; ++ai)
#pragma unroll
        for (int bj = 0; bj < 2; ++bj)
#pragma unroll
            for (int n = 0; n < 2; ++n) { const int colL = bj * 128 + wc * 32 + n * 16 + fq * 4, rb = ai * 2 + wr;
                if (fr == 0) *(f32x4*)(bnd + (0 * 4 + rb) * 256 + colL) = acc[ai][bj][0][n];
                if (fr == 15) *(f32x4*)(bnd + (1 * 4 + rb) * 256 + colL) = acc[ai][bj][3][n]; }
    __syncthreads();
}
#undef DPP_ROR1
#undef DPP_ROL1
#define DPP_ROR1(x) __builtin_bit_cast(float, __builtin_amdgcn_update_dpp(__builtin_bit_cast(int, (x)), __builtin_bit_cast(int, (x)), 0x121, 0xf, 0xf, false))
#define DPP_ROL1(x) __builtin_bit_cast(float, __builtin_amdgcn_update_dpp(__builtin_bit_cast(int, (x)), __builtin_bit_cast(int, (x)), 0x12F, 0xf, 0xf, false))
DI f32x4 ror4(const f32x4 v) { f32x4 r; asm volatile("s_nop 1\n\tv_mov_b32_dpp %0, %4 row_ror:1 row_mask:0xf bank_mask:0xf\n\tv_mov_b32_dpp %1, %5 row_ror:1 row_mask:0xf bank_mask:0xf\n\tv_mov_b32_dpp %2, %6 row_ror:1 row_mask:0xf bank_mask:0xf\n\tv_mov_b32_dpp %3, %7 row_ror:1 row_mask:0xf bank_mask:0xf"
    : "=&v"(r.x), "=&v"(r.y), "=&v"(r.z), "=&v"(r.w) : "v"(v.x), "v"(v.y), "v"(v.z), "v"(v.w)); return r; }
DI f32x4 rol4(const f32x4 v) { f32x4 r; asm volatile("s_nop 1\n\tv_mov_b32_dpp %0, %4 row_ror:15 row_mask:0xf bank_mask:0xf\n\tv_mov_b32_dpp %1, %5 row_ror:15 row_mask:0xf bank_mask:0xf\n\tv_mov_b32_dpp %2, %6 row_ror:15 row_mask:0xf bank_mask:0xf\n\tv_mov_b32_dpp %3, %7 row_ror:15 row_mask:0xf bank_mask:0xf"
    : "=&v"(r.x), "=&v"(r.y), "=&v"(r.z), "=&v"(r.w) : "v"(v.x), "v"(v.y), "v"(v.z), "v"(v.w)); return r; }
template <int BJ, int N, int AI, int M> DI f32x4 conv_row(const Acc& acc, const f32x4 w0, const f32x4 w1, const f32x4 w2, const f32x4 b, const f32x4 upB, const f32x4 dnB, int fr) {
    const f32x4 v = acc[AI][BJ][M][N];
    const f32x4 pu = M > 0 ? ror4(acc[AI][BJ][M > 0 ? M - 1 : 0][N]) : upB;
    const f32x4 nd = M < 3 ? rol4(acc[AI][BJ][M < 3 ? M + 1 : 3][N]) : dnB;
    const f32x4 rv_ = ror4(v), lv_ = rol4(v);
    const f32x4 up = fr > 0 ? rv_ : pu, dn = fr < 15 ? lv_ : nd;
    f32x4 r_ = w0 * up + w1 * v + w2 * dn + b;
    asm volatile("" : "+v"(r_.x), "+v"(r_.y), "+v"(r_.z), "+v"(r_.w));
    return r_;
}
template <int BJ, int N, int AI> DI void conv_bnd(int wr, int wc, int fq, f32x4& upB, f32x4& dnB) {
    const float* bnd = (const float*)(g_lds + EPI_OFF + 4096);
    const int colL = BJ * 128 + wc * 32 + N * 16 + fq * 4, rb = AI * 2 + wr; const f32x4 z4 = {0.f, 0.f, 0.f, 0.f};
    upB = rb > 0 ? *(const f32x4*)(bnd + (4 + rb - 1) * 256 + colL) : z4; dnB = rb < 3 ? *(const f32x4*)(bnd + (rb + 1) * 256 + colL) : z4;
}

template <int BJ, int N, int AI> DI void conv4(const Acc& acc, const f32x4 w0, const f32x4 w1, const f32x4 w2, const f32x4 b, const f32x4 upB, const f32x4 dnB, int fr, f32x4 (&out)[4]) {
    f32x4 rprev = upB, lcur = rol4(acc[AI][BJ][0][N]);
#pragma unroll
    for (int M = 0; M < 4; ++M) { const f32x4 v = acc[AI][BJ][M][N]; const f32x4 rv_ = ror4(v); f32x4 lnext = dnB; if (M < 3) lnext = rol4(acc[AI][BJ][M < 3 ? M + 1 : 3][N]);
        const f32x4 up = fr > 0 ? rv_ : rprev, dn = fr < 15 ? lcur : lnext;
        out[M] = w0 * up + w1 * v + w2 * dn + b; rprev = rv_; lcur = lnext; }
}
#define FOR_ROWS(...) _Pragma("unroll") for (int ai = 0; ai < 2; ++ai) _Pragma("unroll") for (int m = 0; m < 4; ++m) { \
    const int row = ai * 128 + wr * 64 + m * 16 + fr; const int tg = tbase + row; const bool ok = (tg >= s0) && (tg < s0 + slen) && (!OVL || (row >= 1 && row <= 254)); (void)ok; __VA_ARGS__ }
#define FOR_COLS(...) _Pragma("unroll") for (int bj = 0; bj < 2; ++bj) _Pragma("unroll") for (int n = 0; n < 2; ++n) { const int colL = bj * 128 + wc * 32 + n * 16 + fq * 4; (void)colL; __VA_ARGS__ }
DI void st_bf4(bf16* p, const f32x4 v) { u32x2 w; w.x = pk2(v.x, v.y); w.y = pk2(v.z, v.w); *(u32x2*)p = w; }
DI void st_bf8(bf16* p, const f32x4 a, const f32x4 b) { u32x4 w; w.x = pk2(a.x, a.y); w.y = pk2(a.z, a.w); w.z = pk2(b.x, b.y); w.w = pk2(b.z, b.w); *(u32x4*)p = w; }
DI float sq4(const f32x4 v) { return (v.x * v.x + v.y * v.y) + (v.z * v.z + v.w * v.w); }

struct EpiIn {
    Params p;
    DI void operator()(Acc& acc, const Unit& u, int wr, int wc, int fr, int fq) const {
        constexpr bool OVL = true; unsigned char* ws = p.ws; const int pn = u.pn; int tbase, s0, slen; tile_rows(1, u.pm, tbase, s0, slen); const bool hb_ = tile_has_seam(tbase); (void)hb_;
        const f32x4* SS = (const f32x4*)(ws + O_SS);
        FOR_ROWS({ const bool val = (tg >= s0) && (tg < s0 + slen); const float rs = val ? rs_of(SS, tg) : 0.f;
            _Pragma("unroll") for (int bj = 0; bj < 2; ++bj) _Pragma("unroll") for (int n = 0; n < 2; ++n) acc[ai][bj][m][n] = val ? acc[ai][bj][m][n] * rs : (f32x4){0.f, 0.f, 0.f, 0.f}; })
        if (pn == 0) {
            bf16* CQ = (bf16*)(ws + O_CQKV); float* RQ = (float*)(ws + O_RQ); float part[2][4];
            FOR_ROWS({ float s = 0.f; FOR_COLS({ const f32x4 v = acc[ai][bj][m][n]; s += sq4(v); if (ok) st_bf4(CQ + (size_t)tg * 384 + colL, v); }) part[ai][m] = s; })
            row_reduce(part, wr, wc, fr, fq, [&](int row, float ss) { const int tg = tbase + row; if (tg >= s0 && tg < s0 + slen && row >= 1 && row <= 254) RQ[tg] = rsqrtf(ss * (1.f / 256.f) + EPS); });
        } else if (pn == 1) {
            bf16* CQ = (bf16*)(ws + O_CQKV); float* RKV = (float*)(ws + O_RKV); float part[2][4];
            FOR_ROWS({ float s = 0.f; _Pragma("unroll") for (int n = 0; n < 2; ++n) { const f32x4 v = acc[ai][0][m][n]; s += sq4(v); if (ok) st_bf4(CQ + (size_t)tg * 384 + 256 + wc * 32 + n * 16 + fq * 4, v); } part[ai][m] = s; })
            row_reduce(part, wr, wc, fr, fq, [&](int row, float ss) { const int tg = tbase + row; if (tg >= s0 && tg < s0 + slen && row >= 1 && row <= 254) RKV[tg] = rsqrtf(ss * (1.f / 128.f) + EPS); });
            if (wc == 0) {
                const float* RC = (const float*)(ws + O_ROPE); const float* RSN = RC + 8192 * 16; bf16* KR = (bf16*)(ws + O_KR);
                FOR_ROWS({ if (ok) { const int pos = tg - seq_start(seq_of(tg)); const f32x4 c = *(const f32x4*)(RC + pos * 16 + fq * 4), s = *(const f32x4*)(RSN + pos * 16 + fq * 4); const f32x4 x1 = acc[ai][1][m][0], x2 = acc[ai][1][m][1];
                    st_bf4(KR + (size_t)tg * 32 + fq * 4, x1 * c - x2 * s); st_bf4(KR + (size_t)tg * 32 + 16 + fq * 4, x2 * c + x1 * s); } })
            } else if (wc == 1) {
                float* G = (float*)(ws + O_G); const f32x4 gb = *(const f32x4*)(p.gate_bias + fq * 4); const bool isf = fq & 1;
                FOR_ROWS({ if (ok) { f32x4 v = acc[ai][1][m][0] + gb; if (isf) { v.x = logsigmoidf_(v.x); v.y = logsigmoidf_(v.y); v.z = logsigmoidf_(v.z); v.w = logsigmoidf_(v.w); } *(f32x4*)(G + (size_t)tg * 16 + fq * 4) = v; } })
            }
        } else if (pn < 6) {
            conv_exchange(acc, wr, wc, fr, fq);
            const float* cw = p.m_conv_w; const float* cb = p.m_conv_b; const int chb = (pn - 2) * 256 + wc * 32 + fq * 4;
            const bool isK = pn >= 4; bf16* dst = (bf16*)(ws + (isK ? O_KC : O_QC)); const float sc = isK ? 0.08838834764831845f : 1.f; const int cb0 = (pn - (isK ? 4 : 2)) * 256;
#define CA_(BJ, N, AI) { f32x4 upB, dnB; conv_bnd<BJ, N, AI>(wr, wc, fq, upB, dnB); f32x4 rp_ = upB, lc_ = rol4(acc[AI][BJ][0][N]); \
        _Pragma("unroll") for (int M = 0; M < 4; ++M) { const int row = AI * 128 + wr * 64 + M * 16 + fr, tg = tbase + row; const f32x4 a_ = acc[AI][BJ][M][N]; const f32x4 ra_ = ror4(a_); f32x4 ln_ = dnB; if (M < 3) ln_ = rol4(acc[AI][BJ][M < 3 ? M + 1 : 3][N]); \
            f32x4 up_ = fr > 0 ? ra_ : rp_, dn_ = fr < 15 ? lc_ : ln_; if (hb_) { const f32x4 z_ = {0.f, 0.f, 0.f, 0.f}; if (seq_first(tg)) up_ = z_; if (seq_first(tg + 1)) dn_ = z_; } const f32x4 v = w0 * up_ + w1 * a_ + w2 * dn_ + bb; rp_ = ra_; lc_ = ln_; \
            if ((tg >= s0) && (tg < s0 + slen) && row >= 1 && row <= 254) st_bf4(dst + (size_t)tg * 512 + cb0 + BJ * 128 + wc * 32 + N * 16 + fq * 4, (f32x4){siluf_(v.x) * sc, siluf_(v.y) * sc, siluf_(v.z) * sc, siluf_(v.w) * sc}); __builtin_amdgcn_sched_barrier(0); } }
#define CS_(BJ, N) { const int ch = chb + BJ * 128 + N * 16; const f32x4 w0 = *(const f32x4*)(cw + ch), w1 = *(const f32x4*)(cw + 1024 + ch), w2 = *(const f32x4*)(cw + 2048 + ch), bb = *(const f32x4*)(cb + ch); CA_(BJ, N, 0) CA_(BJ, N, 1) }
            CS_(0, 0) CS_(0, 1) CS_(1, 0) CS_(1, 1)
#undef CS_
#undef CA_
        } else if (pn < 8) {
            bf16* MV = (bf16*)(ws + O_MV); const int cb0 = (pn - 6) * 256;
            FOR_ROWS({ if (ok) { FOR_COLS({ st_bf4(MV + (size_t)tg * 512 + cb0 + colL, acc[ai][bj][m][n]); }) } })
        } else {
            bf16* MO = (bf16*)(ws + O_MO); const int cb0 = (pn - 8) * 256;
            FOR_ROWS({ if (ok) { FOR_COLS({ const f32x4 v = acc[ai][bj][m][n]; st_bf4(MO + (size_t)tg * 512 + cb0 + colL, (f32x4){sigmoidf_(v.x), sigmoidf_(v.y), sigmoidf_(v.z), sigmoidf_(v.w)}); }) } })
        }
    }
};
struct EpiQkv {
    Params p;
    DI void operator()(Acc& acc, const Unit& u, int wr, int wc, int fr, int fq) const {
        constexpr bool OVL = false; const int s0 = 0, slen = T_TOK, tbase = u.tbase, pn = u.pn; unsigned char* ws = p.ws;
        const float* RS = (const float*)(ws + (pn < 3 ? O_RQ : O_RKV));
        if (pn < 3) {
            bf16* Q = (bf16*)(ws + O_Q); const float* RC = (const float*)(ws + O_ROPE); const float* RSN = RC + 8192 * 16;
            const float qs = 0.10206207261596577f * 1.4426950408889634f;
            FOR_ROWS({ const float rs = RS[tg] * qs; const int sq = seq_of(tg), pos = tg - seq_start(sq);
                _Pragma("unroll") for (int bj = 0; bj < 2; ++bj) { const int base32 = pn * 256 + bj * 128 + wc * 32; const f32x4 v0 = acc[ai][bj][m][0] * rs, v1 = acc[ai][bj][m][1] * rs;
                    f32x4 o0 = v0, o1 = v1;
                    if (base32 % 96 == 64) { const f32x4 c = *(const f32x4*)(RC + pos * 16 + fq * 4), s = *(const f32x4*)(RSN + pos * 16 + fq * 4); o0 = v0 * c - v1 * s; o1 = v1 * c + v0 * s; }
                    st_bf4(Q + (size_t)tg * 768 + base32 + fq * 4, o0); st_bf4(Q + (size_t)tg * 768 + base32 + 16 + fq * 4, o1); } })
        } else if (pn < 5) {
            bf16* KN = (bf16*)(ws + O_KN); const int cb0 = (pn - 3) * 256;
            FOR_ROWS({ const float rs = RS[tg]; FOR_COLS({ st_bf4(KN + (size_t)tg * 512 + cb0 + colL, acc[ai][bj][m][n] * rs); }) })
        } else {
            bf16* VT = (bf16*)(ws + O_VT); const int cb0 = (pn - 5) * 256;
            FOR_ROWS({ const float rs = RS[tg]; const int sq = seq_of(tg), st = seq_start(sq), S = seq_len(sq), pos = tg - st; bf16* base = VT + (size_t)st * 512 + pos;
                FOR_COLS({ const int c = cb0 + colL; const f32x4 v = acc[ai][bj][m][n] * rs;
                    base[(size_t)c * S] = f2bf(v.x); base[(size_t)(c + 1) * S] = f2bf(v.y); base[(size_t)(c + 2) * S] = f2bf(v.z); base[(size_t)(c + 3) * S] = f2bf(v.w); }) })
        }
    }
};
struct EpiRes {
    Params p; int first, nobf;
    DI void operator()(Acc& acc, const Unit& u, int wr, int wc, int fr, int fq) const {
        const int tbase = u.tbase, pn = u.pn; unsigned char* ws = p.ws;
        bf16* XB = (bf16*)(ws + O_XB); float* SS = (float*)(ws + O_SS); float part[2][4];
#pragma unroll
        for (int ai = 0; ai < 2; ++ai) { f32x4 res[4][2][2];
#pragma unroll
            for (int m = 0; m < 4; ++m) { const int tg = tbase + ai * 128 + wr * 64 + m * 16 + fr; const float* rr = (first ? xin_row(p, tg) : p.out + (size_t)tg * DM) + pn * 256 + wc * 32 + 8 * fq;
#pragma unroll
                for (int bj = 0; bj < 2; ++bj) { res[m][bj][0] = *(const f32x4*)(rr + bj * 128); res[m][bj][1] = *(const f32x4*)(rr + bj * 128 + 4); } }
#pragma unroll
            for (int m = 0; m < 4; ++m) { const int tg = tbase + ai * 128 + wr * 64 + m * 16 + fr; const int c0 = pn * 256 + wc * 32 + 8 * fq; float* orow = p.out + (size_t)tg * DM + c0; bf16* xrow = XB + (size_t)tg * DM + c0; float s = 0.f;
#pragma unroll
                for (int bj = 0; bj < 2; ++bj) { const f32x4 v0 = res[m][bj][0] + acc[ai][bj][m][0], v1 = res[m][bj][1] + acc[ai][bj][m][1];
                    *(f32x4*)(orow + bj * 128) = v0; *(f32x4*)(orow + bj * 128 + 4) = v1; if (!nobf) st_bf8(xrow + bj * 128, v0, v1); s += sq4(v0) + sq4(v1); }
                part[ai][m] = s; } }
        row_reduce(part, wr, wc, fr, fq, [&](int row, float ss) { SS[(size_t)(tbase + row) * 4 + pn] = ss; });
    }
};
struct EpiUp {
    Params p; int layer;
    DI void operator()(Acc& acc, const Unit& u, int wr, int wc, int fr, int fq) const {
        constexpr bool OVL = true; unsigned char* ws = p.ws; const int pn = u.pn; int tbase, s0, slen; tile_rows(1, u.pm, tbase, s0, slen); const bool hb_ = tile_has_seam(tbase); (void)hb_;
        const f32x4* SS = (const f32x4*)(ws + O_SS);
        FOR_ROWS({ const bool val = (tg >= s0) && (tg < s0 + slen); const float rs = val ? rs_of(SS, tg) : 0.f;
            _Pragma("unroll") for (int bj = 0; bj < 2; ++bj) _Pragma("unroll") for (int n = 0; n < 2; ++n) acc[ai][bj][m][n] = val ? acc[ai][bj][m][n] * rs : (f32x4){0.f, 0.f, 0.f, 0.f}; })
        conv_exchange(acc, wr, wc, fr, fq);
        const float* cw = p.ffn_conv_w + (size_t)layer * 3 * 5632; const float* cb = p.ffn_conv_b + (size_t)layer * 5632; const int chb = pn * 128 + wc * 32 + fq * 4;
        bf16* HID = (bf16*)(ws + O_HID);
#define CA_(N, AI) { f32x4 upG, dnG, upV, dnV; conv_bnd<0, N, AI>(wr, wc, fq, upG, dnG); conv_bnd<1, N, AI>(wr, wc, fq, upV, dnV); \
        f32x4 rpg_ = upG, lcg_ = rol4(acc[AI][0][0][N]), rpv_ = upV, lcv_ = rol4(acc[AI][1][0][N]); \
        _Pragma("unroll") for (int M = 0; M < 4; ++M) { const int row = AI * 128 + wr * 64 + M * 16 + fr, tg = tbase + row; const f32x4 a_ = acc[AI][0][M][N], b_ = acc[AI][1][M][N]; const f32x4 rga_ = ror4(a_), rvb_ = ror4(b_); \
            f32x4 lng_ = dnG, lnv_ = dnV; if (M < 3) { lng_ = rol4(acc[AI][0][M < 3 ? M + 1 : 3][N]); lnv_ = rol4(acc[AI][1][M < 3 ? M + 1 : 3][N]); } \
            f32x4 ug_ = fr > 0 ? rga_ : rpg_, dg_ = fr < 15 ? lcg_ : lng_, uv_ = fr > 0 ? rvb_ : rpv_, dv_ = fr < 15 ? lcv_ : lnv_; if (hb_) { const f32x4 z_ = {0.f, 0.f, 0.f, 0.f}; if (seq_first(tg)) { ug_ = z_; uv_ = z_; } if (seq_first(tg + 1)) { dg_ = z_; dv_ = z_; } } const f32x4 g = g0 * ug_ + g1 * a_ + g2 * dg_ + gb, v = v0 * uv_ + v1 * b_ + v2 * dv_ + vb; rpg_ = rga_; lcg_ = lng_; rpv_ = rvb_; lcv_ = lnv_; \
            if ((tg >= s0) && (tg < s0 + slen) && row >= 1 && row <= 254) st_bf4(HID + (size_t)tg * DFF + chb + N * 16, (f32x4){siluf_(g.x) * v.x, siluf_(g.y) * v.y, siluf_(g.z) * v.z, siluf_(g.w) * v.w}); __builtin_amdgcn_sched_barrier(0); } }
#define CS_(N) { const int cg_ = chb + N * 16, cv2_ = 2816 + chb + N * 16; \
        const f32x4 g0 = *(const f32x4*)(cw + cg_), g1 = *(const f32x4*)(cw + 5632 + cg_), g2 = *(const f32x4*)(cw + 11264 + cg_), gb = *(const f32x4*)(cb + cg_); \
        const f32x4 v0 = *(const f32x4*)(cw + cv2_), v1 = *(const f32x4*)(cw + 5632 + cv2_), v2 = *(const f32x4*)(cw + 11264 + cv2_), vb = *(const f32x4*)(cb + cv2_); CA_(N, 0) CA_(N, 1) }
        CS_(0) CS_(1)
#undef CS_
#undef CA_
    }
};
struct EpiGin {
    Params p;
    DI void operator()(Acc& acc, const Unit& u, int wr, int wc, int fr, int fq) const {
        constexpr bool OVL = false; const int s0 = 0, slen = T_TOK, tbase = u.tbase, pn = u.pn; unsigned char* ws = p.ws;
        const f32x4* SS = (const f32x4*)(ws + O_SS);
        bf16* dst = (bf16*)(ws + (pn < 4 ? O_U : O_V)); const int cb0 = (pn & 3) * 256 + wc * 32 + 8 * fq; float part[2][4];
        float rsv[2][4]; FOR_ROWS({ rsv[ai][m] = rs_of(SS, tg); })
        FOR_ROWS({ const float rs = rsv[ai][m]; float s = 0.f;
            _Pragma("unroll") for (int bj = 0; bj < 2; ++bj) { f32x4 v0 = acc[ai][bj][m][0] * rs, v1 = acc[ai][bj][m][1] * rs;
                v0.x = geluf_(v0.x); v0.y = geluf_(v0.y); v0.z = geluf_(v0.z); v0.w = geluf_(v0.w); v1.x = geluf_(v1.x); v1.y = geluf_(v1.y); v1.z = geluf_(v1.z); v1.w = geluf_(v1.w);
                s += sq4(v0) + sq4(v1); st_bf8(dst + (size_t)tg * DM + cb0 + bj * 128, v0, v1); } part[ai][m] = s; })
        if (pn >= 4) { float* VSS = (float*)(ws + O_VSS); row_reduce(part, wr, wc, fr, fq, [&](int row, float ss) { VSS[(size_t)(tbase + row) * 4 + (pn - 4)] = ss; }); }
    }
};

DI int perm32(int rho) { const int n = rho >> 4, i = rho & 15; return 8 * (i >> 2) + 4 * n + (i & 3); }
template <class Epi, bool PERM = false> DI void gemm_phase(const Gemm g, const Epi& E) {
    LAS unsigned char* lds = (LAS unsigned char*)g_lds;
    int tid_ = threadIdx.x; asm volatile("" : "+v"(tid_));
    const int tid = tid_, wid = __builtin_amdgcn_readfirstlane(tid >> 6), lane = tid & 63, wr = wid >> 2, wc = wid & 3, fr = lane & 15, fq = lane >> 4;
    const int K = g.K;
    unsigned voff[2], voffB[2];
#pragma unroll
    for (int i = 0; i < 2; ++i) { int R, C; stage_rc(tid * 16 + i * 8192, R, C); voff[i] = (unsigned)(R * K + C) * 2u; const int Rb = PERM ? ((R & ~31) + perm32(R & 31)) : R; voffB[i] = (unsigned)(Rb * K + C) * 2u; }
    const size_t kstep = 128, hstep = (size_t)128 * K * 2, tstep = 2 * hstep;
    const unsigned ldsw = (unsigned)wid * 1024u;
    const int aoff = lds_byte(wr * 64 + fr, fq * 8), boff = lds_byte(wc * 32 + fr, fq * 8);
#define PG8_SA(b, h) (((b) * 2 + (h)) * 16384)
#define PG8_SB(b, h) ((4 + (b) * 2 + (h)) * 16384)
#define PG8_STAGEX(bufoff, gbase, vo) do { _Pragma("unroll") for (int _i = 0; _i < 2; ++_i) \
        __builtin_amdgcn_global_load_lds((const unsigned*)((const char*)(gbase) + vo[_i]), (LAS unsigned*)(lds + (bufoff) + ldsw + _i * 8192), 16, 0, 0); } while (0)
#define PG8_LDA(dst, b, h) do { _Pragma("unroll") for (int m = 0; m < 4; ++m) _Pragma("unroll") for (int k = 0; k < 2; ++k) dst[m][k] = *(const LAS bf16x8*)(lds + PG8_SA(b, h) + aoff + m * 2048 + k * 1024); } while (0)
#define PG8_LDB(dst, b, h) do { _Pragma("unroll") for (int n = 0; n < 2; ++n) _Pragma("unroll") for (int k = 0; k < 2; ++k) dst[n][k] = *(const LAS bf16x8*)(lds + PG8_SB(b, h) + boff + n * 2048 + k * 1024); } while (0)
#define PG8_MMA(ai, bj, At, Bt) do { __builtin_amdgcn_s_setprio(1); _Pragma("unroll") for (int m = 0; m < 4; ++m) _Pragma("unroll") for (int n = 0; n < 2; ++n) _Pragma("unroll") for (int k = 0; k < 2; ++k) \
        acc[ai][bj][m][n] = __builtin_amdgcn_mfma_f32_16x16x32_bf16(Bt[n][k], At[m][k], acc[ai][bj][m][n], 0, 0, 0); __builtin_amdgcn_s_setprio(0); } while (0)
#define PG8_WAIT_V(n) asm volatile("s_waitcnt vmcnt(" #n ")" ::: "memory")
#define PG8_WAIT_L(n) asm volatile("s_waitcnt lgkmcnt(" #n ")" ::: "memory")
#define PG8_BAR __builtin_amdgcn_s_barrier()
#define PG8_SCHED __builtin_amdgcn_sched_barrier(0)
    Unit cur, nxt; int ui = 0;
    if (!next_unit(g, 0, cur)) return;
    Acc acc;
#pragma unroll
    for (int a = 0; a < 2; ++a)
#pragma unroll
        for (int b = 0; b < 2; ++b)
#pragma unroll
            for (int m = 0; m < 4; ++m)
#pragma unroll
                for (int n = 0; n < 2; ++n) acc[a][b][m][n] = (f32x4){0.f, 0.f, 0.f, 0.f};
    bf16x8 At[4][2], B0[2][2], B1[2][2];
    const char* cA = (const char*)g.A + (ptrdiff_t)cur.tbase * (ptrdiff_t)(K * 2) + cur.kofs; const char* cB = (const char*)g.Bt + (size_t)cur.pn * tstep + cur.kofs;
    PG8_STAGEX(PG8_SB(0, 0), cB, voffB); PG8_STAGEX(PG8_SB(0, 1), cB + hstep, voffB); PG8_STAGEX(PG8_SA(0, 0), cA, voff); PG8_STAGEX(PG8_SA(0, 1), cA + hstep, voff);
    if (wr == 1) PG8_BAR;
    PG8_WAIT_V(2); PG8_BAR;
    PG8_STAGEX(PG8_SB(1, 0), cB + kstep, voffB); PG8_STAGEX(PG8_SA(1, 0), cA + kstep, voff); PG8_STAGEX(PG8_SB(1, 1), cB + hstep + kstep, voffB);
    PG8_WAIT_V(6); PG8_BAR;
    for (;;) {
        const bool has_next = next_unit(g, ui + 1, nxt);
        const char* nA = has_next ? (const char*)g.A + (ptrdiff_t)nxt.tbase * (ptrdiff_t)(K * 2) + nxt.kofs : cA; const char* nB = has_next ? (const char*)g.Bt + (size_t)nxt.pn * tstep + nxt.kofs : cB;
        const int nt = cur.nt;
        for (int t = 0; t < nt; t += 2) {
            const bool last = (t == nt - 2);
            const char* a1 = cA + (size_t)(t + 1) * kstep;
            const char* a2 = last ? nA : cA + (size_t)(t + 2) * kstep; const char* b2 = last ? nB : cB + (size_t)(t + 2) * kstep;
            const char* a3 = a2 + kstep; const char* b3 = b2 + kstep;
            PG8_LDB(B0, 0, 0); PG8_LDB(B1, 0, 1); PG8_SCHED; PG8_LDA(At, 0, 0); PG8_STAGEX(PG8_SA(1, 1), a1 + hstep, voff);
            PG8_WAIT_V(8); PG8_WAIT_L(0); PG8_BAR; PG8_MMA(0, 0, At, B0); PG8_MMA(0, 1, At, B1); PG8_BAR; PG8_SCHED;
            PG8_LDA(At, 0, 1); PG8_STAGEX(PG8_SB(0, 0), b2, voffB); PG8_STAGEX(PG8_SB(0, 1), b2 + hstep, voffB); PG8_STAGEX(PG8_SA(0, 0), a2, voff);
            PG8_WAIT_V(8); PG8_WAIT_L(0); PG8_BAR; PG8_MMA(1, 0, At, B0); PG8_MMA(1, 1, At, B1); PG8_BAR; PG8_SCHED;
            PG8_LDB(B0, 1, 0); PG8_LDB(B1, 1, 1); PG8_SCHED; PG8_LDA(At, 1, 0); PG8_STAGEX(PG8_SA(0, 1), a2 + hstep, voff);
            PG8_WAIT_V(8); PG8_WAIT_L(0); PG8_BAR; PG8_MMA(0, 0, At, B0); PG8_MMA(0, 1, At, B1); PG8_BAR; PG8_SCHED;
            PG8_LDA(At, 1, 1); PG8_STAGEX(PG8_SB(1, 0), b3, voffB); PG8_STAGEX(PG8_SB(1, 1), b3 + hstep, voffB); PG8_STAGEX(PG8_SA(1, 0), a3, voff);
            PG8_WAIT_V(8); PG8_WAIT_L(0); PG8_BAR; PG8_MMA(1, 0, At, B0); PG8_MMA(1, 1, At, B1); PG8_BAR; PG8_SCHED;
        }
        if (wr == 0) PG8_BAR;
        { int fr2 = fr, fq2 = fq; asm volatile("" : "+v"(fr2), "+v"(fq2)); E(acc, cur, wr, wc, fr2, fq2); }
        if (!has_next) break;
#pragma unroll
        for (int a = 0; a < 2; ++a)
#pragma unroll
            for (int b = 0; b < 2; ++b)
#pragma unroll
                for (int m = 0; m < 4; ++m)
#pragma unroll
                    for (int n = 0; n < 2; ++n) acc[a][b][m][n] = (f32x4){0.f, 0.f, 0.f, 0.f};
        cur = nxt; cA = nA; cB = nB; ++ui;
        if (wr == 1) PG8_BAR;
    }
    PG8_WAIT_V(0);
    PG8_BAR;
    __syncthreads();
}

constexpr int LDT = 136;
constexpr int TILE_B = 128 * LDT * 2;
DI int crow(int i, int h) { return (i & 3) + 8 * (i >> 2) + 4 * h; }
template <int KS> DI void mm_lds(f32x16 (&acc)[2], const bf16* sA, const bf16* sB, int rb, int cb0, int lane) {
    const int r = lane & 31, h = lane >> 5;
#pragma unroll
    for (int ks = 0; ks < KS; ++ks) {
        const bf16x8 a = *(const bf16x8*)(sA + (32 * rb + r) * LDT + 16 * ks + 8 * h);
#pragma unroll
        for (int c = 0; c < 2; ++c) { const bf16x8 b = *(const bf16x8*)(sB + (32 * (cb0 + c) + r) * LDT + 16 * ks + 8 * h); acc[c] = MFMA32(a, b, acc[c]); }
    }
}
DI float scan_add(float v, int lane) {
#pragma unroll
    for (int o = 1; o < 64; o <<= 1) { const float t = __shfl_up(v, o); if (lane >= o) v += t; }
    return v;
}
DI float scan_max(float v, int lane) {
#pragma unroll
    for (int o = 1; o < 64; o <<= 1) { const float t = __shfl_up(v, o); if (lane >= o) v = fmaxf(v, t); }
    return v;
}
DI float wave_max(float v) {
#pragma unroll
    for (int o = 1; o < 64; o <<= 1) v = fmaxf(v, __shfl_xor(v, o));
    return v;
}
DI void load_tile_nat(bf16* sT, const bf16* g, int gld, int tid) {
#pragma unroll
    for (int i = 0; i < 4; ++i) { const int id = tid + 512 * i, row = id >> 4, c = (id & 15) * 8; *(u32x4*)(sT + row * LDT + c) = *(const u32x4*)(g + (size_t)row * gld + c); }
}
DI void load_tile_tr(bf16* sT, const bf16* g, int gld, const float* w, int tid) {
#pragma unroll
    for (int i = 0; i < 4; ++i) { const int id = tid + 512 * i, row = id & 127, c = (id >> 7) * 8; const u32x4 v = *(const u32x4*)(g + (size_t)row * gld + c); const float ww = w ? w[row] : 1.f;
        const unsigned uu[4] = {v.x, v.y, v.z, v.w};
#pragma unroll
        for (int e = 0; e < 4; ++e) { sT[(c + 2 * e) * LDT + row] = f2bf(bflo(uu[e]) * ww); sT[(c + 2 * e + 1) * LDT + row] = f2bf(bfhi(uu[e]) * ww); } }
}

DI void write_tile_tr(bf16* sT, const u32x4 (&v)[4], const float* w, int tid) {
#pragma unroll
    for (int i = 0; i < 4; ++i) { const int id = tid + 512 * i, row = id & 127, c = (id >> 7) * 8; const float ww = w ? w[row] : 1.f;
        const unsigned uu[4] = {v[i].x, v[i].y, v[i].z, v[i].w};
#pragma unroll
        for (int e = 0; e < 4; ++e) { sT[(c + 2 * e) * LDT + row] = f2bf(bflo(uu[e]) * ww); sT[(c + 2 * e + 1) * LDT + row] = f2bf(bfhi(uu[e]) * ww); } }
}
DI void mlstm_local(const Params& p) {
    unsigned char* ws = p.ws; int tid_ = threadIdx.x; asm volatile("" : "+v"(tid_)); const int tid = tid_, lane = tid & 63, wid = tid >> 6;
    bf16* sV = (bf16*)g_lds; bf16* sK = (bf16*)(g_lds + TILE_B); float* sW = (float*)(g_lds + 2 * TILE_B);
    const float* G = (const float*)(ws + O_G); const bf16* MV = (const bf16*)(ws + O_MV); const bf16* KC = (const bf16*)(ws + O_KC);
    bf16* CS = (bf16*)(ws + O_CS); float* NS = (float*)(ws + O_NS); float* ML = (float*)(ws + O_ML); float* BL = (float*)(ws + O_BL);
    const int rb = wid & 3, cb0 = (wid >> 2) * 2;
    for (int it2 = blockIdx.x; it2 < 2560; it2 += gridDim.x) {
        const int cgk = it2 >> 2, h = it2 & 3, t0 = cgk * 128;
        u32x4 vr[4], kr[4];
#pragma unroll
        for (int i = 0; i < 4; ++i) { const int id = tid + 512 * i, row = id & 127, c = (id >> 7) * 8; vr[i] = *(const u32x4*)(MV + (size_t)(t0 + row) * 512 + h * 128 + c); kr[i] = *(const u32x4*)(KC + (size_t)(t0 + row) * 512 + h * 128 + c); }
        if (wid < 2) { const int dir = wid, item = it2 * 2 + dir;
            const int o0 = dir ? 127 - lane : lane, o1 = dir ? 63 - lane : lane + 64;
            const float lf0 = G[(size_t)(t0 + o0) * 16 + dir * 8 + 4 + h], li0 = G[(size_t)(t0 + o0) * 16 + dir * 8 + h];
            const float lf1 = G[(size_t)(t0 + o1) * 16 + dir * 8 + 4 + h], li1 = G[(size_t)(t0 + o1) * 16 + dir * 8 + h];
            const float b0 = scan_add(lf0, lane), tot0 = __shfl(b0, 63), b1 = scan_add(lf1, lane) + tot0, bL = __shfl(b1, 63);
            const float g0 = bL - b0 + li0, g1 = bL - b1 + li1, ml = wave_max(fmaxf(g0, g1));
            sW[dir * 128 + o0] = __expf(g0 - ml); sW[dir * 128 + o1] = __expf(g1 - ml);
            if (lane == 0) { ML[item] = ml; BL[item] = bL; }
        }
        write_tile_tr(sK, kr, nullptr, tid);
        __syncthreads();
#pragma unroll 1
        for (int dir = 0; dir < 2; ++dir) { const int item = it2 * 2 + dir; const float* sWd = sW + dir * 128;
            write_tile_tr(sV, vr, sWd, tid);
            __syncthreads();
            if (tid < 128) { float s = 0.f;
#pragma unroll 4
                for (int l = 0; l < 128; l += 8) { const u32x4 kk = *(const u32x4*)(sK + tid * LDT + l); const f32x4 wa = *(const f32x4*)(sWd + l), wb = *(const f32x4*)(sWd + l + 4);
                    s += (wa.x * bflo(kk.x) + wa.y * bfhi(kk.x)) + (wa.z * bflo(kk.y) + wa.w * bfhi(kk.y)) + (wb.x * bflo(kk.z) + wb.y * bfhi(kk.z)) + (wb.z * bflo(kk.w) + wb.w * bfhi(kk.w)); }
                NS[(size_t)item * 128 + tid] = s; }
            f32x16 acc[2];
#pragma unroll
            for (int c = 0; c < 2; ++c)
#pragma unroll
                for (int i = 0; i < 16; ++i) acc[c][i] = 0.f;
            mm_lds<8>(acc, sV, sK, rb, cb0, lane);
            bf16* Co = CS + (size_t)item * 16384;
#pragma unroll
            for (int c = 0; c < 2; ++c)
#pragma unroll
                for (int i = 0; i < 16; ++i) Co[(32 * rb + crow(i, lane >> 5)) * 128 + 32 * (cb0 + c) + (lane & 31)] = f2bf(acc[c][i]);
            __syncthreads();
        }
    }
}
DI void mlstm_scan(const Params& p) {
    unsigned char* ws = p.ws; int tid_ = threadIdx.x; asm volatile("" : "+v"(tid_)); const int gt = blockIdx.x * NTHR + tid_, GT = gridDim.x * NTHR;
    bf16* CS = (bf16*)(ws + O_CS); float* NS = (float*)(ws + O_NS); const float* ML = (const float*)(ws + O_ML); const float* BL = (const float*)(ws + O_BL); float* MP = (float*)(ws + O_MP);
    for (int u = gt; u < 144 * 2080; u += GT) {
        const int st = u / 2080, v = u % 2080, sq = st >> 3, h = (st >> 1) & 3, dir = st & 1, nc = seq_len(sq) >> 7, c0 = seq_start(sq) >> 7;
        float m = 0.f;
        if (v < 2048) {
            float C[8];
#pragma unroll
            for (int e = 0; e < 8; ++e) C[e] = 0.f;
            for (int j = 0; j < nc; j += 4) {
                u32x4 t[4]; float bl[4], mlv[4]; int itm[4];
#pragma unroll
                for (int q = 0; q < 4; ++q) { const int n = dir ? nc - 1 - (j + q) : j + q; itm[q] = ((c0 + n) * 4 + h) * 2 + dir; t[q] = *(const u32x4*)(CS + (size_t)itm[q] * 16384 + v * 8); bl[q] = BL[itm[q]]; mlv[q] = ML[itm[q]]; }
#pragma unroll
                for (int q = 0; q < 4; ++q) { u32x4 o; o.x = pk2(C[0], C[1]); o.y = pk2(C[2], C[3]); o.z = pk2(C[4], C[5]); o.w = pk2(C[6], C[7]); *(u32x4*)(CS + (size_t)itm[q] * 16384 + v * 8) = o;
                    if (v == 0) MP[itm[q]] = m;
                    const float mn = fmaxf(bl[q] + m, mlv[q]), a = __expf(bl[q] + m - mn), c = __expf(mlv[q] - mn);
                    C[0] = a * C[0] + c * bflo(t[q].x); C[1] = a * C[1] + c * bfhi(t[q].x); C[2] = a * C[2] + c * bflo(t[q].y); C[3] = a * C[3] + c * bfhi(t[q].y);
                    C[4] = a * C[4] + c * bflo(t[q].z); C[5] = a * C[5] + c * bfhi(t[q].z); C[6] = a * C[6] + c * bflo(t[q].w); C[7] = a * C[7] + c * bfhi(t[q].w); m = mn; }
            }
        } else {
            f32x4 N = {0.f, 0.f, 0.f, 0.f};
            for (int j = 0; j < nc; j += 4) {
                f32x4 t[4]; float bl[4], mlv[4]; int itm[4];
#pragma unroll
                for (int q = 0; q < 4; ++q) { const int n = dir ? nc - 1 - (j + q) : j + q; itm[q] = ((c0 + n) * 4 + h) * 2 + dir; t[q] = *(const f32x4*)(NS + (size_t)itm[q] * 128 + (v - 2048) * 4); bl[q] = BL[itm[q]]; mlv[q] = ML[itm[q]]; }
#pragma unroll
                for (int q = 0; q < 4; ++q) { *(f32x4*)(NS + (size_t)itm[q] * 128 + (v - 2048) * 4) = N;
                    const float mn = fmaxf(bl[q] + m, mlv[q]), a = __expf(bl[q] + m - mn), c = __expf(mlv[q] - mn); N = a * N + c * t[q]; m = mn; }
            }
        }
    }
}
DI void mlstm_out(const Params& p) {
    unsigned char* ws = p.ws; int tid_ = threadIdx.x; asm volatile("" : "+v"(tid_)); const int tid = tid_, lane = tid & 63, wid = tid >> 6, hh = lane >> 5;
    bf16* sQ = (bf16*)g_lds; bf16* sK = (bf16*)(g_lds + TILE_B); bf16* sVT = (bf16*)(g_lds + 2 * TILE_B); bf16* sC = (bf16*)(g_lds + 3 * TILE_B); bf16* sP = sK;
    float* sBv2 = (float*)(g_lds + 4 * TILE_B); float* sLi2 = sBv2 + 256; float* sMt2 = sBv2 + 512; float* sInter2 = sBv2 + 768; float* sInv = sBv2 + 1024; float* sN = sBv2 + 1152;
    float* sH = (float*)g_lds;
    const float* G = (const float*)(ws + O_G); const bf16* QC = (const bf16*)(ws + O_QC); const bf16* KC = (const bf16*)(ws + O_KC); const bf16* MV = (const bf16*)(ws + O_MV); const bf16* MO = (const bf16*)(ws + O_MO);
    const bf16* CS = (const bf16*)(ws + O_CS); const float* NS = (const float*)(ws + O_NS); const float* MP = (const float*)(ws + O_MP); bf16* Y = (bf16*)(ws + O_Y);
    const int rb = wid & 3, cb0 = (wid >> 2) * 2;
    for (int item = blockIdx.x; item < 2560; item += gridDim.x) {
        const int cgk = item >> 2, h = item & 3, t0 = cgk * 128;
        load_tile_nat(sQ, QC + (size_t)t0 * 512 + h * 128, 512, tid);
        load_tile_nat(sK, KC + (size_t)t0 * 512 + h * 128, 512, tid);
        load_tile_tr(sVT, MV + (size_t)t0 * 512 + h * 128, 512, nullptr, tid);
        if (wid < 2) {
            const int dir = wid, itemd = (cgk * 4 + h) * 2 + dir; const float mprev = MP[itemd];
            const int o0 = dir ? 127 - lane : lane, o1 = dir ? 63 - lane : lane + 64;
            const float lf0 = G[(size_t)(t0 + o0) * 16 + dir * 8 + 4 + h], li0 = G[(size_t)(t0 + o0) * 16 + dir * 8 + h];
            const float lf1 = G[(size_t)(t0 + o1) * 16 + dir * 8 + 4 + h], li1 = G[(size_t)(t0 + o1) * 16 + dir * 8 + h];
            const float b0 = scan_add(lf0, lane), tot0 = __shfl(b0, 63), b1 = scan_add(lf1, lane) + tot0;
            const float pm0 = scan_max(li0 - b0, lane), mx0 = __shfl(pm0, 63), pm1 = fmaxf(scan_max(li1 - b1, lane), mx0);
            const float a0 = b0 + mprev, a1 = b1 + mprev, mt0 = fmaxf(a0, b0 + pm0), mt1 = fmaxf(a1, b1 + pm1);
            float* B_ = sBv2 + dir * 128; float* L_ = sLi2 + dir * 128; float* M_ = sMt2 + dir * 128; float* I_ = sInter2 + dir * 128;
            B_[o0] = b0; B_[o1] = b1; L_[o0] = li0; L_[o1] = li1; M_[o0] = mt0; M_[o1] = mt1; I_[o0] = __expf(a0 - mt0); I_[o1] = __expf(a1 - mt1);
        }
        __syncthreads();
        f32x16 S[2], hs[2];
#pragma unroll
        for (int c = 0; c < 2; ++c)
#pragma unroll
            for (int i = 0; i < 16; ++i) { S[c][i] = 0.f; hs[c][i] = 0.f; }
        mm_lds<8>(S, sQ, sK, rb, cb0, lane);
#pragma unroll 1
        for (int dir = 0; dir < 2; ++dir) {
            __syncthreads();
            const int itemd = (cgk * 4 + h) * 2 + dir;
            const float* sBv = sBv2 + dir * 128; const float* sLi = sLi2 + dir * 128; const float* sMt = sMt2 + dir * 128; const float* sInter = sInter2 + dir * 128;
            load_tile_nat(sC, CS + (size_t)itemd * 16384, 128, tid);
            if (tid >= 64 && tid < 96) *(f32x4*)(sN + (tid - 64) * 4) = *(const f32x4*)(NS + (size_t)itemd * 128 + (tid - 64) * 4);
            __syncthreads();
#pragma unroll
            for (int c = 0; c < 2; ++c) { const int s = 32 * (cb0 + c) + (lane & 31); const float bs = sBv[s] - sLi[s];
#pragma unroll
                for (int i = 0; i < 16; ++i) { const int t = 32 * rb + crow(i, hh); const bool valid = dir ? (s >= t) : (s <= t);
                    const float pv = valid ? S[c][i] * __expf(sBv[t] - bs - sMt[t]) : 0.f; sP[t * LDT + s] = f2bf(pv); } }
            __syncthreads();
            if (tid < 128) { const int t = tid; float dot = 0.f, rsum = 0.f;
#pragma unroll 4
                for (int e = 0; e < 128; e += 8) { const u32x4 qq = *(const u32x4*)(sQ + t * LDT + e), pq = *(const u32x4*)(sP + t * LDT + e); const f32x4 na = *(const f32x4*)(sN + e), nb = *(const f32x4*)(sN + e + 4);
                    dot += (na.x * bflo(qq.x) + na.y * bfhi(qq.x)) + (na.z * bflo(qq.y) + na.w * bfhi(qq.y)) + (nb.x * bflo(qq.z) + nb.y * bfhi(qq.z)) + (nb.z * bflo(qq.w) + nb.w * bfhi(qq.w));
                    rsum += (bflo(pq.x) + bfhi(pq.x)) + (bflo(pq.y) + bfhi(pq.y)) + (bflo(pq.z) + bfhi(pq.z)) + (bflo(pq.w) + bfhi(pq.w)); }
                const float den = sInter[t] * dot + rsum; sInv[t] = 1.f / fmaxf(fabsf(den), __expf(-sMt[t])); }
            f32x16 num[2];
#pragma unroll
            for (int c = 0; c < 2; ++c)
#pragma unroll
                for (int i = 0; i < 16; ++i) num[c][i] = 0.f;
            mm_lds<8>(num, sQ, sC, rb, cb0, lane);
#pragma unroll
            for (int i = 0; i < 16; ++i) { const float it = sInter[32 * rb + crow(i, hh)]; num[0][i] *= it; num[1][i] *= it; }
            mm_lds<8>(num, sP, sVT, rb, cb0, lane);
            __syncthreads();
#pragma unroll
            for (int i = 0; i < 16; ++i) { const float iv = sInv[32 * rb + crow(i, hh)]; hs[0][i] += num[0][i] * iv; hs[1][i] += num[1][i] * iv; }
        }
        __syncthreads();
#pragma unroll
        for (int c = 0; c < 2; ++c)
#pragma unroll
            for (int i = 0; i < 16; ++i) sH[(32 * rb + crow(i, hh)) * 132 + 32 * (cb0 + c) + (lane & 31)] = hs[c][i];
        __syncthreads();
        { const int t = tid >> 2, d0 = (tid & 3) * 32; f32x4 v[8]; float ss = 0.f;
#pragma unroll
          for (int e = 0; e < 8; ++e) { v[e] = *(const f32x4*)(sH + t * 132 + d0 + 4 * e); ss += sq4(v[e]); }
          ss += __shfl_xor(ss, 1); ss += __shfl_xor(ss, 2);
          const float rstd = rsqrtf(ss * (1.f / 128.f) + EPS);
          const bf16* mo = MO + (size_t)(t0 + t) * 512 + h * 128 + d0; const float* on = p.m_out_norm + h * 128 + d0; bf16* yo = Y + (size_t)(t0 + t) * 1024 + 512 + h * 128 + d0;
#pragma unroll
          for (int e = 0; e < 4; ++e) { const u32x4 g = *(const u32x4*)(mo + 8 * e); const f32x4 n0 = *(const f32x4*)(on + 8 * e), n1 = *(const f32x4*)(on + 8 * e + 4); const f32x4 a = v[2 * e] * rstd * n0, b = v[2 * e + 1] * rstd * n1;
              u32x4 o; o.x = pk2(a.x * bflo(g.x), a.y * bfhi(g.x)); o.y = pk2(a.z * bflo(g.y), a.w * bfhi(g.y)); o.z = pk2(b.x * bflo(g.z), b.y * bfhi(g.z)); o.w = pk2(b.z * bflo(g.w), b.w * bfhi(g.w));
              *(u32x4*)(yo + 8 * e) = o; } }
        __syncthreads();
    }
}
DI void attn_phase(const Params& p) {
    unsigned char* ws = p.ws; int tid_ = threadIdx.x; asm volatile("" : "+v"(tid_)); const int tid = tid_, lane = tid & 63, wid = tid >> 6, r = lane & 31, hh = lane >> 5;
    const bf16* Q = (const bf16*)(ws + O_Q); const bf16* KN = (const bf16*)(ws + O_KN); const bf16* KR = (const bf16*)(ws + O_KR); const bf16* VT = (const bf16*)(ws + O_VT); bf16* Y = (bf16*)(ws + O_Y);
    constexpr int KB_B = 128 * 208, VB_B = 64 * 272, VOFF = 2 * KB_B, SOFF = 0;
    for (int item = blockIdx.x; item < 1280; item += gridDim.x) {
        int sq, head, qb;
        if (item < 256) { sq = item >> 7; head = (item & 127) >> 4; qb = item & 15; } else { const int it = item - 256; sq = 2 + (it >> 6); head = (it & 63) >> 3; qb = it & 7; }
        const int S = seq_len(sq), t0 = seq_start(sq), nkt = S >> 7, tq0 = t0 + qb * 512 + wid * 64;
        bf16x8 qf[2][6];
#pragma unroll
        for (int j = 0; j < 2; ++j)
#pragma unroll
            for (int ks = 0; ks < 6; ++ks) qf[j][ks] = *(const bf16x8*)(Q + (size_t)(tq0 + j * 32 + r) * 768 + head * 96 + 16 * ks + 8 * hh);
        f32x16 o[2][2];
#pragma unroll
        for (int j = 0; j < 2; ++j)
#pragma unroll
            for (int c = 0; c < 2; ++c)
#pragma unroll
                for (int i = 0; i < 16; ++i) o[j][c][i] = 0.f;
        float mrun[2] = {0.f, 0.f}, lrun[2] = {0.f, 0.f};
        const bf16* gk = KN + (size_t)(t0 + (tid >> 3)) * 512 + head * 64 + (tid & 7) * 8;
        const bf16* gr = KR + (size_t)(t0 + (tid >> 2)) * 32 + (tid & 3) * 8;
        const bf16* gv = VT + (size_t)t0 * 512 + (size_t)(head * 64 + (tid >> 3)) * S + (tid & 7) * 8;
        unsigned char* lk = g_lds + (tid >> 3) * 208 + (tid & 7) * 16; unsigned char* lr = g_lds + (tid >> 2) * 208 + 128 + (tid & 3) * 16; unsigned char* lv = g_lds + VOFF + (tid >> 3) * 272 + ((tid & 7) >> 1) * 32 + (tid & 1) * 8;
        u32x4 rk, rk2, rr, rv, rv2;
#define ALD_(kt_) { rk = *(const u32x4*)(gk + (size_t)(kt_) * 128 * 512); rk2 = *(const u32x4*)(gk + (size_t)((kt_) * 128 + 64) * 512); rr = *(const u32x4*)(gr + (size_t)(kt_) * 128 * 32); rv = *(const u32x4*)(gv + (kt_) * 128); rv2 = *(const u32x4*)(gv + (kt_) * 128 + 64); }
#define AST_(b_) { *(u32x4*)(lk + (b_) * KB_B) = rk; *(u32x4*)(lk + (b_) * KB_B + 64 * 208) = rk2; *(u32x4*)(lr + (b_) * KB_B) = rr; \
            *(u32x2*)(lv + (b_) * VB_B) = (u32x2){rv.x, rv.y}; *(u32x2*)(lv + (b_) * VB_B + 16) = (u32x2){rv.z, rv.w}; *(u32x2*)(lv + (b_) * VB_B + 128) = (u32x2){rv2.x, rv2.y}; *(u32x2*)(lv + (b_) * VB_B + 144) = (u32x2){rv2.z, rv2.w}; }
        ALD_(0) AST_(0)
        __syncthreads();
        for (int kt = 0; kt < nkt; ++kt) {
            const int buf = kt & 1; const bool more = kt + 1 < nkt;
            if (more) ALD_(kt + 1)
            const unsigned char* Kb = g_lds + buf * KB_B; const unsigned char* Vb = g_lds + VOFF + buf * VB_B;
#pragma unroll 1
            for (int kb = 0; kb < 4; ++kb) {
                f32x16 st[2];
#pragma unroll
                for (int j = 0; j < 2; ++j) { const float nm = -mrun[j];
#pragma unroll
                    for (int i = 0; i < 16; ++i) st[j][i] = nm; }
#pragma unroll
                for (int ks = 0; ks < 6; ++ks) { const bf16x8 a = *(const bf16x8*)(Kb + (32 * kb + r) * 208 + (16 * ks + 8 * hh) * 2); st[0] = MFMA32(a, qf[0][ks], st[0]); st[1] = MFMA32(a, qf[1][ks], st[1]); }
                bf16x8 pf[2][2];
                const bool first = (kt == 0) && (kb == 0);
#pragma unroll
                for (int j = 0; j < 2; ++j) {
                    float mx = st[j][0];
#pragma unroll
                    for (int i = 1; i < 16; ++i) mx = fmaxf(mx, st[j][i]);
                    mx = fmaxf(mx, __shfl_xor(mx, 32));
                    if (first || __builtin_amdgcn_ballot_w64(mx > 8.f) != 0ull) {
                        const float d = first ? mx : fmaxf(mx, 0.f);
                        if (!first) { const float alpha = __builtin_amdgcn_exp2f(-d); lrun[j] *= alpha;
#pragma unroll
                            for (int c = 0; c < 2; ++c)
#pragma unroll
                                for (int i = 0; i < 16; ++i) o[j][c][i] *= alpha; }
#pragma unroll
                        for (int i = 0; i < 16; ++i) st[j][i] -= d;
                        mrun[j] += d;
                    }
                    float ps = 0.f;
#pragma unroll
                    for (int i = 0; i < 16; ++i) { const float e = __builtin_amdgcn_exp2f(st[j][i]); st[j][i] = e; ps += e; }
                    lrun[j] += ps;
#pragma unroll
                    for (int s2 = 0; s2 < 2; ++s2) {
                        u32x4 pp; pp.x = pk2(st[j][8 * s2 + 0], st[j][8 * s2 + 1]); pp.y = pk2(st[j][8 * s2 + 2], st[j][8 * s2 + 3]); pp.z = pk2(st[j][8 * s2 + 4], st[j][8 * s2 + 5]); pp.w = pk2(st[j][8 * s2 + 6], st[j][8 * s2 + 7]);
                        pf[j][s2] = __builtin_bit_cast(bf16x8, pp); }
                }
#pragma unroll
                for (int s2 = 0; s2 < 2; ++s2)
#pragma unroll
                    for (int db = 0; db < 2; ++db) { const bf16x8 a = *(const bf16x8*)(Vb + (32 * db + r) * 272 + (32 * kb + 16 * s2) * 2 + hh * 16);
                        o[0][db] = MFMA32(a, pf[0][s2], o[0][db]); o[1][db] = MFMA32(a, pf[1][s2], o[1][db]); }
            }
            if (more) AST_(buf ^ 1)
            __syncthreads();
        }
#undef ALD_
#undef AST_
        unsigned char* stg = g_lds + SOFF + wid * 8704;
#pragma unroll
        for (int j = 0; j < 2; ++j) { float l = lrun[j]; l += __shfl_xor(l, 32); const float inv = 1.f / l;
#pragma unroll
            for (int db = 0; db < 2; ++db)
#pragma unroll
                for (int g4 = 0; g4 < 4; ++g4) { u32x2 w; w.x = pk2(o[j][db][4 * g4] * inv, o[j][db][4 * g4 + 1] * inv); w.y = pk2(o[j][db][4 * g4 + 2] * inv, o[j][db][4 * g4 + 3] * inv);
                    *(u32x2*)(stg + (j * 32 + r) * 136 + (32 * db + 8 * g4 + 4 * hh) * 2) = w; } }
        __syncthreads();
#pragma unroll
        for (int j = 0; j < 8; ++j) { const int id = lane + 64 * j, row = id >> 3, c = id & 7; const u32x2 a = *(const u32x2*)(stg + row * 136 + c * 16), b = *(const u32x2*)(stg + row * 136 + c * 16 + 8);
            *(u32x4*)(Y + (size_t)(tq0 + row) * 1024 + head * 64 + c * 8) = (u32x4){a.x, a.y, b.x, b.y}; }
        __syncthreads();
    }
}
DI void spatial_phase(const Params& p) {
    unsigned char* ws = p.ws; int tid_ = threadIdx.x; asm volatile("" : "+v"(tid_)); const int tid = tid_, lane = tid & 63, wid = tid >> 6, hh = lane >> 5;
    bf16* sW = (bf16*)g_lds; bf16* sVn = (bf16*)(g_lds + TILE_B); float* sR = (float*)(g_lds + 2 * TILE_B);
    const bf16* WSP = (const bf16*)(ws + O_WSP); const bf16* U = (const bf16*)(ws + O_U); const bf16* V = (const bf16*)(ws + O_V); const f32x4* VSS = (const f32x4*)(ws + O_VSS); bf16* Z = (bf16*)(ws + O_Z);
    const int rb = wid & 3, cb0 = (wid >> 2) * 2;
    const int G8 = (gridDim.x & 7) == 0 ? (int)(gridDim.x >> 3) : 0;
    if (G8 == 0) return;
    const int g = blockIdx.x & 7;
    load_tile_nat(sW, WSP + (size_t)g * 16384, 128, tid);
    const f32x4 n0 = *(const f32x4*)(p.c_v_norm + g * 128 + (tid >> 7) * 8), n1 = *(const f32x4*)(p.c_v_norm + g * 128 + (tid >> 7) * 8 + 4), n2 = *(const f32x4*)(p.c_v_norm + g * 128 + (tid >> 7) * 8 + 32), n3 = *(const f32x4*)(p.c_v_norm + g * 128 + (tid >> 7) * 8 + 36);
    const f32x4 n4 = *(const f32x4*)(p.c_v_norm + g * 128 + (tid >> 7) * 8 + 64), n5 = *(const f32x4*)(p.c_v_norm + g * 128 + (tid >> 7) * 8 + 68), n6 = *(const f32x4*)(p.c_v_norm + g * 128 + (tid >> 7) * 8 + 96), n7 = *(const f32x4*)(p.c_v_norm + g * 128 + (tid >> 7) * 8 + 100);
    u32x4 vr[4];
    int cgk = blockIdx.x >> 3;
    if (cgk < NCHUNK) {
#pragma unroll
        for (int i = 0; i < 4; ++i) { const int id = tid + 512 * i, row = id & 127, c = (id >> 7) * 8; vr[i] = *(const u32x4*)(V + (size_t)(cgk * 128 + row) * 1024 + g * 128 + c); }
    }
    for (; cgk < NCHUNK; cgk += G8) {
        const int t0 = cgk * 128;
        if (tid < 128) { const f32x4 q = VSS[t0 + tid]; sR[tid] = rsqrtf(((q.x + q.y) + (q.z + q.w)) * (1.f / 1024.f) + EPS); }
        __syncthreads();
#pragma unroll
        for (int i = 0; i < 4; ++i) { const int id = tid + 512 * i, row = id & 127, c = (id >> 7) * 8; const u32x4 v = vr[i]; const float ww = sR[row];
            const f32x4 na = i == 0 ? n0 : (i == 1 ? n2 : (i == 2 ? n4 : n6)), nb = i == 0 ? n1 : (i == 1 ? n3 : (i == 2 ? n5 : n7));
            sVn[(c + 0) * LDT + row] = f2bf(bflo(v.x) * ww * na.x); sVn[(c + 1) * LDT + row] = f2bf(bfhi(v.x) * ww * na.y); sVn[(c + 2) * LDT + row] = f2bf(bflo(v.y) * ww * na.z); sVn[(c + 3) * LDT + row] = f2bf(bfhi(v.y) * ww * na.w);
            sVn[(c + 4) * LDT + row] = f2bf(bflo(v.z) * ww * nb.x); sVn[(c + 5) * LDT + row] = f2bf(bfhi(v.z) * ww * nb.y); sVn[(c + 6) * LDT + row] = f2bf(bflo(v.w) * ww * nb.z); sVn[(c + 7) * LDT + row] = f2bf(bfhi(v.w) * ww * nb.w); }
        __syncthreads();
        if (cgk + G8 < NCHUNK) {
#pragma unroll
            for (int i = 0; i < 4; ++i) { const int id = tid + 512 * i, row = id & 127, c = (id >> 7) * 8; vr[i] = *(const u32x4*)(V + (size_t)((cgk + G8) * 128 + row) * 1024 + g * 128 + c); }
        }
        f32x16 acc[2];
#pragma unroll
        for (int c = 0; c < 2; ++c)
#pragma unroll
            for (int i = 0; i < 16; ++i) acc[c][i] = 0.f;
        mm_lds<8>(acc, sW, sVn, rb, cb0, lane);
#pragma unroll
        for (int c = 0; c < 2; ++c)
#pragma unroll
            for (int i = 0; i < 16; ++i) { const int t = 32 * rb + crow(i, hh), cc = g * 128 + 32 * (cb0 + c) + (lane & 31); const size_t ix = (size_t)(t0 + t) * 1024 + cc;
                Z[ix] = f2bf((acc[c][i] + p.c_b_sp[g * 128 + t]) * bf2f(U[ix])); }
    }
    __syncthreads();
}
DI void final_phase(const Params& p) {
    int tid_ = threadIdx.x; asm volatile("" : "+v"(tid_)); const int tid = tid_, lane = tid & 63, gw = blockIdx.x * 8 + (tid >> 6), NGW = gridDim.x * 8; const f32x4* SS = (const f32x4*)(p.ws + O_SS);
    for (int t = gw; t < T_TOK; t += NGW) { const float rs = rs_of(SS, t); f32x4* xr = (f32x4*)(p.out + (size_t)t * DM) + lane; const f32x4* gn = (const f32x4*)p.final_norm + lane;
#pragma unroll
        for (int j = 0; j < 4; ++j) xr[64 * j] = xr[64 * j] * rs * gn[64 * j]; }
}


#ifndef DBG
#define DBG 0
#endif
constexpr size_t O_DBG = O_END0;
DI int btok_(int i) { return ((int)blockIdx.x * 8 + (i & 7)) * 40 + ((int)blockIdx.x * 7 + i * 3) % 40; }
DI bool close_(float fast, float ref) { return fabsf(fast - ref) <= 0.03f + 0.04f * fabsf(ref); }
DI float nrs_(const Params& p, int t) { const float* x = xin_row(p, t); float s = 0.f; for (int k = 0; k < 1024; ++k) s += x[k] * x[k]; return rsqrtf(s * (1.f / 1024.f) + EPS); }
DI float nh_(const Params& p, int t, int col, float rs) { const float* x = xin_row(p, t); float s = 0.f; for (int k = 0; k < 1024; ++k) s += x[k] * p.ab_norm[k] * p.ab_w_in[(size_t)k * 2480 + col]; return s * rs; }
DI void dbg_fail(const Params& p, unsigned bit) { atomicOr((unsigned*)(p.ws + O_DBG), bit); }
DI void chk_inproj(const Params& p) {
    unsigned char* ws = p.ws; int tid_ = threadIdx.x; asm volatile("" : "+v"(tid_)); const int tid = tid_; const int bx = blockIdx.x;
    if (tid < 4) { const int t = btok_(tid); const float rs = nrs_(p, t);
        { const float ref = nh_(p, t, (7 + 50 * tid + bx) % 256, rs), fast = bf2f(((const bf16*)(ws + O_CQKV))[(size_t)t * 384 + (7 + 50 * tid + bx) % 256]); if (!close_(fast, ref)) dbg_fail(p, 0u); }
        { const float ref = nh_(p, t, 256 + (9 + 20 * tid + bx) % 128, rs), fast = bf2f(((const bf16*)(ws + O_CQKV))[(size_t)t * 384 + 256 + (9 + 20 * tid + bx) % 128]); if (!close_(fast, ref)) dbg_fail(p, 0u); }
        { const int ch = (3 + 37 * tid + 2 * bx) % 512; const float ref = nh_(p, t, 1440 + ch, rs), fast = bf2f(((const bf16*)(ws + O_MV))[(size_t)t * 512 + ch]); if (!close_(fast, ref)) dbg_fail(p, 0u); }
    } else if (tid < 8) { const int i = tid - 4, t = btok_(tid); const int sq = seq_of(t), s0 = seq_start(sq), sl = seq_len(sq);
        for (int w = 0; w < 2; ++w) { const int ch = (w ? 512 : 0) + (11 + 100 * i + 2 * bx) % 512; float a[3];
            for (int d = -1; d <= 1; ++d) { const int tt = t + d; a[d + 1] = (tt >= s0 && tt < s0 + sl) ? nh_(p, tt, 416 + ch, nrs_(p, tt)) : 0.f; }
            float v = a[0] * p.m_conv_w[ch] + a[1] * p.m_conv_w[1024 + ch] + a[2] * p.m_conv_w[2048 + ch] + p.m_conv_b[ch]; v = v / (1.f + expf(-v)); if (w) v *= 0.08838834764831845f;
            const float fast = bf2f(((const bf16*)(ws + (w ? O_KC : O_QC)))[(size_t)t * 512 + (ch & 511)]); if (!close_(fast, v)) { const int pos = t - s0, row = pos % 252 + 2; const int jj = pos / 252, pm = sq < 2 ? sq * 33 + jj : 66 + (sq - 2) * 17 + jj; (void)pm; const int fr_ = row & 15, m_ = (row >> 4) & 3; (void)fr_; (void)m_; { unsigned b = 0; if (fr_ == 1) b = 1u; else if (fr_ == 2) b = 2u; else if (fr_ == 3) b = 4u; else if (fr_ == 12) b = 8u; else if (fr_ == 13) b = 16u; else if (fr_ == 14) b = 32u; dbg_fail(p, b); } } }
    } else if (tid < 12) { const int i = tid - 8, t = btok_(tid); const float rs = nrs_(p, t); const int sq = seq_of(t), pos = t - seq_start(sq);
        { const int gi = (5 + 2 * i + bx) & 15; float v = nh_(p, t, 2464 + gi, rs) + p.gate_bias[gi]; if ((gi >> 2) & 1) v = fminf(v, 0.f) - log1pf(expf(-fabsf(v))); const float fast = ((const float*)(ws + O_G))[(size_t)t * 16 + gi]; if (!close_(fast, v)) dbg_fail(p, 0u); }
        { const int ii = (3 + i + bx) & 15; const float x1 = nh_(p, t, 384 + ii, rs), x2 = nh_(p, t, 384 + 16 + ii, rs); const float ang = (float)pos / powf(10000.f, ii / 16.f); const float c = cosf(ang), sn = sinf(ang);
          const float r1 = x1 * c - x2 * sn, r2 = x2 * c + x1 * sn; const bf16* KR = (const bf16*)(ws + O_KR); if (!close_(bf2f(KR[(size_t)t * 32 + ii]), r1) || !close_(bf2f(KR[(size_t)t * 32 + 16 + ii]), r2)) dbg_fail(p, 0u); }
        { const int ch = (17 + 60 * i + 2 * bx) % 512; float v = nh_(p, t, 1952 + ch, rs); v = 1.f / (1.f + expf(-v)); const float fast = bf2f(((const bf16*)(ws + O_MO))[(size_t)t * 512 + ch]); if (!close_(fast, v)) dbg_fail(p, 0u); }
    }
}
DI void chk_mlstm(const Params& p) {
    unsigned char* ws = p.ws; int tid_ = threadIdx.x; asm volatile("" : "+v"(tid_)); const int tid = tid_; const int sqm = blockIdx.x % 18, hd = (blockIdx.x / 18) & 3, t0 = seq_start(sqm), S = seq_len(sqm), tp = (blockIdx.x * 37 + 5) % S;
    const float* G = (const float*)(ws + O_G); const bf16* QC = (const bf16*)(ws + O_QC); const bf16* KC = (const bf16*)(ws + O_KC); const bf16* MV = (const bf16*)(ws + O_MV); const bf16* MO = (const bf16*)(ws + O_MO); const bf16* Y = (const bf16*)(ws + O_Y);
    const int d = tid >> 2, e0 = (tid & 3) * 32; float* sh = (float*)g_lds; float hsum = 0.f;
    for (int dir = 0; dir < 2; ++dir) {
        const int first = dir ? S - 1 : 0, step = dir ? -1 : 1, cnt = dir ? S - tp : tp + 1;
        float num = 0.f, den = 0.f;
        { float C[32];
#pragma unroll
          for (int e = 0; e < 32; ++e) C[e] = 0.f;
          for (int j = 0; j < cnt; ++j) { const int t = t0 + first + step * j; const float f = expf(G[(size_t)t * 16 + dir * 8 + 4 + hd]), ii = expf(G[(size_t)t * 16 + dir * 8 + hd]);
            const float v = bf2f(MV[(size_t)t * 512 + hd * 128 + d]) * ii;
#pragma unroll
            for (int e = 0; e < 32; ++e) { const float k = bf2f(KC[(size_t)t * 512 + hd * 128 + e0 + e]); C[e] = f * C[e] + v * k; } }
#pragma unroll
          for (int e = 0; e < 32; ++e) num += C[e] * bf2f(QC[(size_t)(t0 + tp) * 512 + hd * 128 + e0 + e]); }
        __builtin_amdgcn_sched_barrier(0);
        { float n[32];
#pragma unroll
          for (int e = 0; e < 32; ++e) n[e] = 0.f;
          for (int j = 0; j < cnt; ++j) { const int t = t0 + first + step * j; const float f = expf(G[(size_t)t * 16 + dir * 8 + 4 + hd]), ii = expf(G[(size_t)t * 16 + dir * 8 + hd]);
#pragma unroll
            for (int e = 0; e < 32; ++e) { const float k = bf2f(KC[(size_t)t * 512 + hd * 128 + e0 + e]); n[e] = f * n[e] + ii * k; } }
#pragma unroll
          for (int e = 0; e < 32; ++e) den += n[e] * bf2f(QC[(size_t)(t0 + tp) * 512 + hd * 128 + e0 + e]); }
        num += __shfl_xor(num, 1); num += __shfl_xor(num, 2); den += __shfl_xor(den, 1); den += __shfl_xor(den, 2);
        hsum += num / fmaxf(fabsf(den), 1.f);
    }
    __syncthreads();
    if ((tid & 3) == 0) sh[d] = hsum;
    __syncthreads();
    if (tid < 128) { float ss = 0.f; for (int e = 0; e < 128; ++e) ss += sh[e] * sh[e]; const float rstd = rsqrtf(ss * (1.f / 128.f) + EPS);
        const float ref = sh[tid] * rstd * p.m_out_norm[hd * 128 + tid] * bf2f(MO[(size_t)(t0 + tp) * 512 + hd * 128 + tid]); const float fast = bf2f(Y[(size_t)(t0 + tp) * 1024 + 512 + hd * 128 + tid]);
        if (!close_(fast, ref)) dbg_fail(p, 0u); }
    __syncthreads();
}
DI void chk_qkv(const Params& p) {
    unsigned char* ws = p.ws; int tid_ = threadIdx.x; asm volatile("" : "+v"(tid_)); const int tid = tid_; if (tid >= 4) return;
    const int t = btok_(tid); const int sq = seq_of(t), st = seq_start(sq), S = seq_len(sq), pos = t - st; const bf16* CQ = (const bf16*)(ws + O_CQKV) + (size_t)t * 384;
    float sq_ = 0.f, skv = 0.f; for (int k = 0; k < 256; ++k) sq_ += bf2f(CQ[k]) * bf2f(CQ[k]); for (int k = 0; k < 128; ++k) skv += bf2f(CQ[256 + k]) * bf2f(CQ[256 + k]);
    const float rq = rsqrtf(sq_ / 256.f + EPS), rkv = rsqrtf(skv / 128.f + EPS); const float qs = 0.10206207261596577f * 1.4426950408889634f;
    const int hd = (2 + tid + blockIdx.x) & 7;
    { const int dd = 13 + tid; float s = 0.f; for (int k = 0; k < 256; ++k) s += bf2f(CQ[k]) * p.q_norm[k] * p.w_uq[(size_t)k * 768 + hd * 96 + dd]; s *= rq * qs; if (!close_(bf2f(((const bf16*)(ws + O_Q))[(size_t)t * 768 + hd * 96 + dd]), s)) dbg_fail(p, 0u); }
    { const int ii = 2 + tid; float x1 = 0.f, x2 = 0.f; for (int k = 0; k < 256; ++k) { const float a = bf2f(CQ[k]) * p.q_norm[k]; x1 += a * p.w_uq[(size_t)k * 768 + hd * 96 + 64 + ii]; x2 += a * p.w_uq[(size_t)k * 768 + hd * 96 + 80 + ii]; }
      x1 *= rq * qs; x2 *= rq * qs; const float ang = (float)pos / powf(10000.f, ii / 16.f); const float c = cosf(ang), sn = sinf(ang); const bf16* Qp = (const bf16*)(ws + O_Q) + (size_t)t * 768 + hd * 96;
      if (!close_(bf2f(Qp[64 + ii]), x1 * c - x2 * sn) || !close_(bf2f(Qp[80 + ii]), x2 * c + x1 * sn)) dbg_fail(p, 0u); }
    { const int dd = 21 + tid; float s = 0.f, v = 0.f; for (int k = 0; k < 128; ++k) { const float a = bf2f(CQ[256 + k]) * p.kv_norm[k]; s += a * p.w_ukv[(size_t)k * 1024 + hd * 128 + dd]; v += a * p.w_ukv[(size_t)k * 1024 + hd * 128 + 64 + dd]; }
      s *= rkv; v *= rkv; if (!close_(bf2f(((const bf16*)(ws + O_KN))[(size_t)t * 512 + hd * 64 + dd]), s)) dbg_fail(p, 0u);
      if (!close_(bf2f(((const bf16*)(ws + O_VT))[(size_t)st * 512 + (size_t)(hd * 64 + dd) * S + pos]), v)) dbg_fail(p, 0u); }
}
DI void chk_attn(const Params& p) {
    unsigned char* ws = p.ws; int tid_ = threadIdx.x; asm volatile("" : "+v"(tid_)); const int tid = tid_; if (tid >= 64) return;
    const int smp = tid >> 4, dd = (tid & 15) * 4 + (blockIdx.x & 3); const int t = btok_(smp), hd = (1 + 2 * smp + blockIdx.x) & 7; const int sq = seq_of(t), st = seq_start(sq), S = seq_len(sq);
    const bf16* Q = (const bf16*)(ws + O_Q) + (size_t)t * 768 + hd * 96; const bf16* KN = (const bf16*)(ws + O_KN); const bf16* KR = (const bf16*)(ws + O_KR); const bf16* VT = (const bf16*)(ws + O_VT) + (size_t)st * 512 + (size_t)(hd * 64 + dd) * S;
    float m = -1e30f, l = 0.f, o = 0.f;
    for (int k = 0; k < S; ++k) { float s = 0.f; for (int e = 0; e < 64; ++e) s += bf2f(Q[e]) * bf2f(KN[(size_t)(st + k) * 512 + hd * 64 + e]); for (int e = 0; e < 32; ++e) s += bf2f(Q[64 + e]) * bf2f(KR[(size_t)(st + k) * 32 + e]);
        const float mn = fmaxf(m, s), a = exp2f(m - mn), pe = exp2f(s - mn); l = l * a + pe; o = o * a + pe * bf2f(VT[k]); m = mn; }
    const float ref = o / l, fast = bf2f(((const bf16*)(ws + O_Y))[(size_t)t * 1024 + hd * 64 + dd]); if (!close_(fast, ref)) dbg_fail(p, 0u);
}
DI void dbg_emit(const Params& p) {
    const float a = sqrtf((float)*(const unsigned*)(p.ws + O_DBG)); const int gt = blockIdx.x * NTHR + threadIdx.x, GT = gridDim.x * NTHR;
    for (size_t i = gt; i < (size_t)T_TOK * DM / 4; i += GT) ((f32x4*)p.out)[i] = (f32x4){a, a, a, a};
}

DI int dtok_(int i) { return i == 0 ? 62 : i == 1 ? 63 : i == 2 ? 253 : i == 3 ? 254 : i == 4 ? 8191 : i == 5 ? 16384 : i == 6 ? 20253 : 81919; }
DI float rowrs_(const float* x) { float s = 0.f; for (int k = 0; k < 1024; ++k) s += x[k] * x[k]; return rsqrtf(s * (1.f / 1024.f) + EPS); }
DI void chk_res(const Params& p, const bf16* A, int K, const float* W, bool first, unsigned bit, int slot) {
    if (threadIdx.x >= 8) return; const int i = threadIdx.x, t = btok_(i), c = (5 + 127 * i + 3 * (int)blockIdx.x) & 1023; float* sv = (float*)(p.ws + O_DBG + 64) + (size_t)blockIdx.x * 32;
    float s = first ? xin_row(p, t)[c] : sv[slot * 8 + i]; for (int k = 0; k < K; ++k) s += bf2f(A[(size_t)t * K + k]) * W[(size_t)k * 1024 + c];
    if (!close_(p.out[(size_t)t * DM + c], s)) dbg_fail(p, bit);
    sv[(slot + 1) * 8 + i] = p.out[(size_t)t * DM + c];
}
DI void chk_up(const Params& p, int layer) {
    if (threadIdx.x >= 8) return; const int i = threadIdx.x, t = btok_(i), j = (9 + 350 * i + 11 * (int)blockIdx.x) % 2816; const int sq = seq_of(t), s0 = seq_start(sq), sl = seq_len(sq);
    const float* W = p.ffn_w_up + (size_t)layer * 1024 * 5632; const float* cw = p.ffn_conv_w + (size_t)layer * 3 * 5632; const float* cb = p.ffn_conv_b + (size_t)layer * 5632; const float* gn = p.ffn_norm + layer * 1024;
    float g = cb[j], v = cb[2816 + j];
    for (int d = -1; d <= 1; ++d) { const int tt = t + d; if (tt < s0 || tt >= s0 + sl) continue; const float* x = p.out + (size_t)tt * DM; const float rs = rowrs_(x); float ag = 0.f, av = 0.f;
        for (int k = 0; k < 1024; ++k) { const float xn = x[k] * rs * gn[k]; ag += xn * W[(size_t)k * 5632 + j]; av += xn * W[(size_t)k * 5632 + 2816 + j]; }
        g += ag * cw[(d + 1) * 5632 + j]; v += av * cw[(d + 1) * 5632 + 2816 + j]; }
    const float ref = g / (1.f + expf(-g)) * v, fast = bf2f(((const bf16*)(p.ws + O_HID))[(size_t)t * DFF + j]); if (!close_(fast, ref)) dbg_fail(p, DBG == 3 ? (i < 6 ? (1u << i) : 0u) : 2u);
}
DI void chk_gin(const Params& p) {
    if (threadIdx.x >= 8) return; const int i = threadIdx.x, t = btok_(i), c = (3 + 120 * i + 5 * (int)blockIdx.x) & 1023; const float* x = p.out + (size_t)t * DM; const float rs = rowrs_(x); float au = 0.f, av = 0.f;
    for (int k = 0; k < 1024; ++k) { const float xn = x[k] * rs * p.c_norm[k]; au += xn * p.c_w_in[(size_t)k * 2048 + c]; av += xn * p.c_w_in[(size_t)k * 2048 + 1024 + c]; }
    au = 0.5f * au * (1.f + erff(au * 0.70710678f)); av = 0.5f * av * (1.f + erff(av * 0.70710678f));
    if (!close_(bf2f(((const bf16*)(p.ws + O_U))[(size_t)t * DM + c]), au) || !close_(bf2f(((const bf16*)(p.ws + O_V))[(size_t)t * DM + c]), av)) dbg_fail(p, 8u);
}
DI void chk_sp(const Params& p) {
    if (threadIdx.x >= 8) return; const int i = threadIdx.x, t = btok_(i), g = (i + (int)blockIdx.x) & 7, c = (7 + 13 * i + (int)blockIdx.x) & 127, t0 = t & ~127, tt = t & 127; const bf16* V = (const bf16*)(p.ws + O_V); const bf16* U = (const bf16*)(p.ws + O_U);
    float acc = 0.f;
    for (int s2 = 0; s2 < 128; ++s2) { const bf16* vr = V + (size_t)(t0 + s2) * DM; float ss = 0.f; for (int k = 0; k < 1024; ++k) ss += bf2f(vr[k]) * bf2f(vr[k]); const float rv = rsqrtf(ss * (1.f / 1024.f) + EPS);
        acc += p.c_w_sp[(size_t)g * 16384 + tt * 128 + s2] * bf2f(vr[g * 128 + c]) * rv * p.c_v_norm[g * 128 + c]; }
    const float ref = (acc + p.c_b_sp[g * 128 + tt]) * bf2f(U[(size_t)t * DM + g * 128 + c]); if (!close_(bf2f(((const bf16*)(p.ws + O_Z))[(size_t)t * DM + g * 128 + c]), ref)) dbg_fail(p, 0u);
}
#if defined(__HIP_DEVICE_COMPILE__)
#define GETP() Params p; { typedef const unsigned long long __attribute__((address_space(4)))* KA_; KA_ q_ = (KA_)__builtin_amdgcn_kernarg_segment_ptr(); asm volatile("" : "+s"(q_)); \
    typedef __attribute__((address_space(1))) unsigned char* GP_; const void** pp_ = (const void**)&p; _Pragma("unroll") for (int i_ = 0; i_ < 27; ++i_) pp_[i_] = (const void*)(GP_)q_[i_]; } unsigned char* ws = p.ws; (void)ws;
#else
#define GETP() Params p = p_unused; unsigned char* ws = p.ws; (void)ws;
#endif
__global__ void __launch_bounds__(NTHR, 2) fwd_kernel(Params p_unused, int lo, int hi) {
    cg::grid_group grid = cg::this_grid();
#define PH(k, ...) if (lo <= (k) && (k) < hi) { GETP() __VA_ARGS__ } if (lo <= (k) && (k) + 1 < hi) grid.sync();
    PH(0, p0_prologue(p); if (DBG && blockIdx.x == 0 && threadIdx.x == 0) *(unsigned*)(p.ws + O_DBG) = 0u;)
    PH(1, Gemm g{(const bf16*)(ws + O_XB), (const bf16*)(ws + O_WIN), 1024, NM_OVL, 10, 1}; EpiIn E{p}; gemm_phase(g, E);)
    PH(2, mlstm_local(p);)
    PH(3, mlstm_scan(p);)
    PH(4, mlstm_out(p);)
    PH(5, Gemm g{(const bf16*)(ws + O_CQKV), (const bf16*)(ws + O_WQKV), 384, NM_PLAIN, 7, 0, 1}; EpiQkv E{p}; gemm_phase(g, E);)
    PH(6, attn_phase(p);)
    PH(7, Gemm g{(const bf16*)(ws + O_Y), (const bf16*)(ws + O_WOUT), 1024, NM_PLAIN, 4, 0}; EpiRes E{p, 1, 0}; gemm_phase<EpiRes, true>(g, E);)
    PH(8, Gemm g{(const bf16*)(ws + O_XB), (const bf16*)(ws + O_WUP), 1024, NM_OVL, 22, 1}; EpiUp E{p, 0}; gemm_phase<EpiUp, false>(g, E);)
    PH(9, Gemm g{(const bf16*)(ws + O_HID), (const bf16*)(ws + O_WDN), 2816, NM_PLAIN, 4, 0}; EpiRes E{p, 0, 0}; gemm_phase<EpiRes, true>(g, E);)
    PH(10, Gemm g{(const bf16*)(ws + O_XB), (const bf16*)(ws + O_WCIN), 1024, NM_PLAIN, 8, 0}; EpiGin E{p}; gemm_phase<EpiGin, true>(g, E);)
    PH(11, spatial_phase(p);)
    PH(12, Gemm g{(const bf16*)(ws + O_Z), (const bf16*)(ws + O_WCOUT), 1024, NM_PLAIN, 4, 0}; EpiRes E{p, 0, 0}; gemm_phase<EpiRes, true>(g, E);)
    PH(13, Gemm g{(const bf16*)(ws + O_XB), (const bf16*)(ws + O_WUP + AL((size_t)5632 * 1024 * 2)), 1024, NM_OVL, 22, 1}; EpiUp E{p, 1}; gemm_phase<EpiUp, false>(g, E);)
    PH(14, Gemm g{(const bf16*)(ws + O_HID), (const bf16*)(ws + O_WDN + AL((size_t)1024 * 2816 * 2)), 2816, NM_PLAIN, 4, 0}; EpiRes E{p, 0, 1}; gemm_phase<EpiRes, true>(g, E);)
    PH(15, final_phase(p);)
}
#if DBG
__global__ void __launch_bounds__(NTHR) chk_kernel(Params p, int which) {
    unsigned char* ws = p.ws; (void)ws;
    if (which == 1) chk_inproj(p);
    else if (which == 4) chk_mlstm(p);
    else if (which == 5) chk_qkv(p);
    else if (which == 6) chk_attn(p);
    else if (which == 7) chk_res(p, (const bf16*)(ws + O_Y), 1024, p.ab_w_out, true, 1u, 0);
    else if (which == 8) chk_up(p, 0);
    else if (which == 9) chk_res(p, (const bf16*)(ws + O_HID), 2816, p.ffn_w_down, false, 4u, 1);
    else if (which == 10) chk_gin(p);
    else if (which == 11) chk_sp(p);
    else if (which == 12) chk_res(p, (const bf16*)(ws + O_Z), 1024, p.c_w_out, false, 32u, 2);
    else if (which == 13) chk_up(p, 1);
    else if (which == 99) dbg_emit(p);
}
#endif

extern "C" void kernel_launch(void* const* d_in, const int* in_sizes, int n_in, void* d_out, int out_size, void* d_ws, size_t ws_size, hipStream_t stream) {
    static int grid = 0;
    if (grid == 0) {
        if (n_in != 25 || ws_size < WS_NEED + 65536 || out_size != T_TOK * DM) { fprintf(stderr, "kernel_launch: unexpected problem: n_in %d out %d ws %zu (need %zu)\n", n_in, out_size, ws_size, (size_t)WS_NEED); grid = -1; return; }
        int dev = 0, cus = 0, per_cu = 0;
        hipGetDevice(&dev); hipDeviceGetAttribute(&cus, hipDeviceAttributeMultiprocessorCount, dev);
        if (hipFuncSetAttribute((const void*)fwd_kernel, hipFuncAttributeMaxDynamicSharedMemorySize, LDS_BYTES) != hipSuccess) { fprintf(stderr, "kernel_launch: hipFuncSetAttribute failed\n"); grid = -1; return; }
        hipOccupancyMaxActiveBlocksPerMultiprocessor(&per_cu, (const void*)fwd_kernel, NTHR, LDS_BYTES);
        if (per_cu < 1) { fprintf(stderr, "kernel_launch: occupancy query says %d blocks per CU\n", per_cu); per_cu = 1; }
        (void)hipGetLastError();
        grid = cus;
    }
    if (grid < 0) return;
    Params p{};
    const float** f = (const float**)&p;
    for (int i = 0; i < 25; ++i) f[i] = (const float*)d_in[i];
    p.out = (float*)d_out; p.ws = (unsigned char*)d_ws;
    auto run = [&](int lo, int hi) { void* args[] = {&p, &lo, &hi};
        hipError_t e = hipLaunchCooperativeKernel((const void*)fwd_kernel, dim3(grid), dim3(NTHR), args, LDS_BYTES, stream);
        if (e != hipSuccess) fprintf(stderr, "cooperative launch failed: %s (grid %d)\n", hipGetErrorString(e), grid); };
#if DBG == 0
    run(0, 16);
#else
    int cur = 0;
    auto upto = [&](int k) { run(cur, k + 1); cur = k + 1; };
    auto chk = [&](int which) { hipLaunchKernelGGL(chk_kernel, dim3(grid), dim3(NTHR), 4096, stream, p, which); };
#if DBG == 1
    upto(1); chk(1); upto(4); chk(4); upto(5); chk(5); upto(6); chk(6);
#else
    upto(7); chk(7); upto(8); chk(8); upto(9); chk(9); upto(10); chk(10); upto(11); chk(11); upto(12); chk(12);
#if DBG == 4
    upto(13); chk(13);
#endif
#endif
    chk(99);
#endif
}
```

```cpp
#include <hip/hip_runtime.h>
#include <hip/hip_cooperative_groups.h>
#include <cstdio>
#include <cstdint>
namespace cg = cooperative_groups;

typedef unsigned short bf16;
typedef short bf16x8 __attribute__((ext_vector_type(8)));
typedef short s16x4 __attribute__((ext_vector_type(4)));
typedef float f32x2 __attribute__((ext_vector_type(2)));
typedef float f32x4 __attribute__((ext_vector_type(4)));
typedef float f32x16 __attribute__((ext_vector_type(16)));
typedef unsigned u32x2 __attribute__((ext_vector_type(2)));
typedef unsigned u32x4 __attribute__((ext_vector_type(4)));
typedef __bf16 bf2_t __attribute__((ext_vector_type(2)));
#define DI __device__ __forceinline__
#define MFMA32(a, b, c) __builtin_amdgcn_mfma_f32_32x32x16_bf16((a), (b), (c), 0, 0, 0)

constexpr int NTHR = 512;
constexpr int T_TOK = 81920, TP = 16384, DM = 1024;
constexpr int NCHUNK = T_TOK / 128;
constexpr int DFF = 2816;
constexpr float EPS = 1e-6f;
constexpr int LDS_BYTES = 147456;

constexpr size_t AL(size_t x) { return (x + 255) & ~(size_t)255; }
constexpr size_t O_WIN = 0;
constexpr size_t O_WQKV = O_WIN + AL((size_t)2560 * 1024 * 2);
constexpr size_t O_WOUT = O_WQKV + AL((size_t)1792 * 384 * 2);
constexpr size_t O_WCIN = O_WOUT + AL((size_t)1024 * 1024 * 2);
constexpr size_t O_WCOUT = O_WCIN + AL((size_t)2048 * 1024 * 2);
constexpr size_t O_WUP = O_WCOUT + AL((size_t)1024 * 1024 * 2);
constexpr size_t O_WDN = O_WUP + 2 * AL((size_t)5632 * 1024 * 2);
constexpr size_t O_WSP = O_WDN + 2 * AL((size_t)1024 * 2816 * 2);
constexpr size_t O_ROPE = O_WSP + AL((size_t)8 * 128 * 128 * 2);
constexpr size_t O_SS = O_ROPE + AL((size_t)8192 * 32 * 4);
constexpr size_t O_VSS = O_SS + AL((size_t)T_TOK * 16);
constexpr size_t O_RQ = O_VSS + AL((size_t)T_TOK * 16);
constexpr size_t O_RKV = O_RQ + AL((size_t)T_TOK * 4);
constexpr size_t O_KR = O_RKV + AL((size_t)T_TOK * 4);
constexpr size_t O_G = O_KR + AL((size_t)T_TOK * 32 * 2);
constexpr size_t O_NS = O_G + AL((size_t)T_TOK * 16 * 4);
constexpr size_t O_ML = O_NS + AL((size_t)5120 * 128 * 4);
constexpr size_t O_BL = O_ML + AL((size_t)5120 * 4);
constexpr size_t O_MP = O_BL + AL((size_t)5120 * 4);
constexpr size_t O_XBG = O_MP + AL((size_t)5120 * 4);
constexpr size_t O_XB = O_XBG + 4096;
constexpr size_t O_AR = O_XB + AL((size_t)T_TOK * 1024 * 2);
constexpr size_t O_CQKV = O_AR;
constexpr size_t O_QC = O_CQKV + AL((size_t)T_TOK * 384 * 2);
constexpr size_t O_KC = O_QC + AL((size_t)T_TOK * 512 * 2);
constexpr size_t O_MV = O_KC + AL((size_t)T_TOK * 512 * 2);
constexpr size_t O_MO = O_MV + AL((size_t)T_TOK * 512 * 2);
constexpr size_t O_CS = O_MO + AL((size_t)T_TOK * 512 * 2);
constexpr size_t O_Y = O_CS + AL((size_t)5120 * 16384 * 2);
constexpr size_t O_END0 = O_Y + AL((size_t)T_TOK * 1024 * 2);
constexpr size_t O_Q = O_QC;
constexpr size_t O_KN = O_Q + AL((size_t)T_TOK * 768 * 2);
constexpr size_t O_VT = O_KN + AL((size_t)T_TOK * 512 * 2);
static_assert(O_VT + (size_t)T_TOK * 512 * 2 <= O_CS, "attention operands overlay");
constexpr size_t O_HID = O_AR;
constexpr size_t O_U = O_AR;
constexpr size_t O_V = O_U + AL((size_t)T_TOK * 1024 * 2);
constexpr size_t O_Z = O_V + AL((size_t)T_TOK * 1024 * 2);
constexpr size_t WS_NEED = O_END0;
static_assert(O_HID + (size_t)T_TOK * 2816 * 2 <= O_END0 && O_Z + (size_t)T_TOK * 2048 <= O_END0, "arena");

struct Params {
    const float* x_prompt; const float* x_sample;
    const float *ab_norm, *ab_w_in, *q_norm, *w_uq, *kv_norm, *w_ukv, *m_conv_w, *m_conv_b, *gate_bias, *m_out_norm, *ab_w_out;
    const float *c_norm, *c_w_in, *c_v_norm, *c_w_sp, *c_b_sp, *c_w_out;
    const float *ffn_norm, *ffn_w_up, *ffn_conv_w, *ffn_conv_b, *ffn_w_down, *final_norm;
    float* out; unsigned char* ws;
};

extern __shared__ __attribute__((aligned(16))) unsigned char g_lds[];

DI unsigned pk2(float lo, float hi) { f32x2 v = {lo, hi}; bf2_t b = __builtin_convertvector(v, bf2_t); return __builtin_bit_cast(unsigned, b); }
DI bf16 f2bf(float x) { return (bf16)(pk2(x, 0.f) & 0xffffu); }
DI float bf2f(bf16 x) { return __uint_as_float(((unsigned)x) << 16); }
DI float bflo(unsigned u) { return __uint_as_float(u << 16); }
DI float bfhi(unsigned u) { return __uint_as_float(u & 0xffff0000u); }
DI int seq_start(int sq) { return sq < 2 ? (sq << 13) : TP + ((sq - 2) << 12); }
DI int seq_len(int sq) { return sq < 2 ? 8192 : 4096; }
DI int seq_of(int t) { return t < TP ? (t >> 13) : 2 + ((t - TP) >> 12); }
DI float wave_sum(float v) {
#pragma unroll
    for (int o = 1; o < 64; o <<= 1) v += __shfl_xor(v, o);
    return v;
}
DI float frcp(float x) { return __builtin_amdgcn_rcpf(x); }
DI float sigmoidf_(float x) { return frcp(1.f + __builtin_amdgcn_exp2f(-1.4426950408889634f * x)); }
DI float siluf_(float x) { return x * frcp(1.f + __builtin_amdgcn_exp2f(-1.4426950408889634f * x)); }
DI float logsigmoidf_(float x) { return fminf(x, 0.f) - log1pf(__expf(-fabsf(x))); }
DI float geluf_(float v) {
    const float av = fabsf(v), t = frcp(1.f + 0.2316418882f * av);
    float q = t * 0.5307027145f + (-0.7265760135f); q = q * t + 0.7107068705f; q = q * t + (-0.142248368f); q = q * t + 0.127414796f; q = q * t;
    const float e = __builtin_amdgcn_exp2f(v * v * (-0.72134752044f));
    const float m = v * (q * e);
    return v < 0.f ? m : v - m;
}
DI f32x4 ld_ss(const f32x4* SS, int t) { return SS[t]; }
DI float rs_of(const f32x4* SS, int t) { f32x4 s = SS[t]; return rsqrtf(((s.x + s.y) + (s.z + s.w)) * (1.f / 1024.f) + EPS); }
DI const float* xin_row(const Params& p, int t) { return t < TP ? p.x_prompt + (size_t)t * DM : p.x_sample + (size_t)(t - TP) * DM; }

DI int srccol(int perm, int n) {
    if (perm == 1) { if (n < 416) return n; if (n < 432) return 2464 + (n - 416); if (n < 512) return -1; return n - 96; }
    if (perm == 2) { const int hd = (n & 511) >> 6, d = n & 63; return hd * 128 + (n >= 512 ? 64 : 0) + d; }
    if (perm == 3) { const int pn = n >> 8, c = n & 255; return c < 128 ? pn * 128 + c : 2816 + pn * 128 + (c - 128); }
    return n;
}
struct P0Job { const float* src; const float* gain; bf16* dst; int Nsrc, dld, dcol0, perm, k0, n0; };
DI void p0_job(const Params& p, int it, P0Job& J) {
    unsigned char* ws = p.ws; int r = it; int Nd;
    if (r < 640) { J.src = p.ab_w_in; J.Nsrc = 2480; Nd = 2560; J.dst = (bf16*)(ws + O_WIN); J.dld = 1024; J.dcol0 = 0; J.gain = p.ab_norm; J.perm = 1; }
    else if ((r -= 640) < 48) { J.src = p.w_uq; J.Nsrc = 768; Nd = 768; J.dst = (bf16*)(ws + O_WQKV); J.dld = 384; J.dcol0 = 0; J.gain = p.q_norm; J.perm = 0; }
    else if ((r -= 48) < 32) { J.src = p.w_ukv; J.Nsrc = 1024; Nd = 1024; J.dst = (bf16*)(ws + O_WQKV) + (size_t)768 * 384; J.dld = 384; J.dcol0 = 256; J.gain = p.kv_norm; J.perm = 2; }
    else if ((r -= 32) < 256) { J.src = p.ab_w_out; J.Nsrc = 1024; Nd = 1024; J.dst = (bf16*)(ws + O_WOUT); J.dld = 1024; J.dcol0 = 0; J.gain = nullptr; J.perm = 0; }
    else if ((r -= 256) < 512) { J.src = p.c_w_in; J.Nsrc = 2048; Nd = 2048; J.dst = (bf16*)(ws + O_WCIN); J.dld = 1024; J.dcol0 = 0; J.gain = p.c_norm; J.perm = 0; }
    else if ((r -= 512) < 256) { J.src = p.c_w_out; J.Nsrc = 1024; Nd = 1024; J.dst = (bf16*)(ws + O_WCOUT); J.dld = 1024; J.dcol0 = 0; J.gain = nullptr; J.perm = 0; }
    else if ((r -= 256) < 2816) { const int l = r / 1408; r -= l * 1408; J.src = p.ffn_w_up + (size_t)l * 1024 * 5632; J.Nsrc = 5632; Nd = 5632;
        J.dst = (bf16*)(ws + O_WUP + l * AL((size_t)5632 * 1024 * 2)); J.dld = 1024; J.dcol0 = 0; J.gain = p.ffn_norm + l * 1024; J.perm = 3; }
    else { r -= 2816; const int l = r / 704; r -= l * 704; J.src = p.ffn_w_down + (size_t)l * 2816 * 1024; J.Nsrc = 1024; Nd = 1024;
        J.dst = (bf16*)(ws + O_WDN + l * AL((size_t)1024 * 2816 * 2)); J.dld = 2816; J.dcol0 = 0; J.gain = nullptr; J.perm = 0; }
    const int nnt = Nd / 64; J.k0 = (r / nnt) * 64; J.n0 = (r % nnt) * 64;
}
DI void p0_load(const P0Job& J, int tid, float (&v)[8]) {
    const int j = tid & 63, sc = srccol(J.perm, J.n0 + j);
#pragma unroll
    for (int r = 0; r < 8; ++r) { const int k = J.k0 + (tid >> 6) + 8 * r; float x = 0.f; if (sc >= 0) { x = J.src[(size_t)k * J.Nsrc + sc]; if (J.gain) x *= J.gain[k]; } v[r] = x; }
}
DI void p0_row(const Params& p, int t, int lane) {
    bf16* XB = (bf16*)(p.ws + O_XB); f32x4* SS = (f32x4*)(p.ws + O_SS);
    const f32x4* xr = (const f32x4*)xin_row(p, t) + lane;
    f32x4 v[4]; float s = 0.f;
#pragma unroll
    for (int j = 0; j < 4; ++j) { v[j] = xr[64 * j]; s += (v[j].x * v[j].x + v[j].y * v[j].y) + (v[j].z * v[j].z + v[j].w * v[j].w); }
    s = wave_sum(s);
    u32x2* o = (u32x2*)(XB + (size_t)t * DM) + lane;
#pragma unroll
    for (int j = 0; j < 4; ++j) { u32x2 w; w.x = pk2(v[j].x, v[j].y); w.y = pk2(v[j].z, v[j].w); o[64 * j] = w; }
    if (lane == 0) { f32x4 q = {s, 0.f, 0.f, 0.f}; SS[t] = q; }
}
DI void p0_prologue(const Params& p) {
    unsigned char* ws = p.ws;
    int tid_ = threadIdx.x; asm volatile("" : "+v"(tid_)); const int tid = tid_;
    const int lane = tid & 63, NGW = gridDim.x * 8; int trow = blockIdx.x * 8 + (tid >> 6);
    constexpr int NJ = 5968;
    {
        float* tile = (float*)g_lds;
        P0Job J; float v[8]; int it = blockIdx.x;
        if (it < NJ) { p0_job(p, it, J); p0_load(J, tid, v); }
        for (; it < NJ; it += gridDim.x) {
#pragma unroll
            for (int r = 0; r < 8; ++r) tile[((tid >> 6) + 8 * r) * 65 + (tid & 63)] = v[r];
            __syncthreads();
            P0Job Jn = J; const int nit = it + gridDim.x;
            if (nit < NJ) { p0_job(p, nit, Jn); p0_load(Jn, tid, v); }
            const int n = tid >> 3, kc = (tid & 7) * 8;
            u32x4 o;
            o.x = pk2(tile[(kc + 0) * 65 + n], tile[(kc + 1) * 65 + n]); o.y = pk2(tile[(kc + 2) * 65 + n], tile[(kc + 3) * 65 + n]);
            o.z = pk2(tile[(kc + 4) * 65 + n], tile[(kc + 5) * 65 + n]); o.w = pk2(tile[(kc + 6) * 65 + n], tile[(kc + 7) * 65 + n]);
            *(u32x4*)(J.dst + (size_t)(J.n0 + n) * J.dld + J.dcol0 + J.k0 + kc) = o;
            if (trow < T_TOK) { p0_row(p, trow, lane); trow += NGW; }
            if (trow < T_TOK) { p0_row(p, trow, lane); trow += NGW; }
            __syncthreads();
            J = Jn;
        }
    }
    for (; trow < T_TOK; trow += NGW) p0_row(p, trow, lane);
    const int gt = blockIdx.x * NTHR + tid, GT = gridDim.x * NTHR;
    if (gt < 256) ((u32x4*)(ws + O_XBG))[gt] = (u32x4){0u, 0u, 0u, 0u};
    {
        bf16* W = (bf16*)(ws + O_WQKV); const u32x4 z = {0u, 0u, 0u, 0u};
        for (int v = gt; v < 768 * 16 + 1024 * 32; v += GT) {
            if (v < 768 * 16) { const int row = v >> 4, c = v & 15; *(u32x4*)(W + (size_t)row * 384 + 256 + c * 8) = z; }
            else { const int u = v - 768 * 16, row = 768 + (u >> 5), c = u & 31; *(u32x4*)(W + (size_t)row * 384 + c * 8) = z; }
        }
    }
    { bf16* W = (bf16*)(ws + O_WSP); for (int v = gt; v < 8 * 128 * 128; v += GT) W[v] = f2bf(p.c_w_sp[v]); }
    { float* RC = (float*)(ws + O_ROPE); float* RSN = RC + 8192 * 16;
      for (int v = gt; v < 8192 * 16; v += GT) { const int pos = v >> 4, i = v & 15; const float inv = 1.0f / powf(10000.f, (float)i * (1.f / 16.f)); const float ang = (float)pos * inv;
        float s, c; sincosf(ang, &s, &c); RC[v] = c; RSN[v] = s; } }
}

#define LAS __attribute__((address_space(3)))
constexpr int STAGE_BYTES = 131072;
constexpr int EPI_OFF = 131072;
DI int lds_byte(int r, int c) { const int st = (r >> 4) * 2 + (c >> 5), rr = r & 15, cc = c & 31, ob = rr * 64 + cc * 2; return st * 1024 + (ob ^ (((ob >> 9) & 1) << 5)); }
DI void stage_rc(int b, int& R, int& C) { const int st = b / 1024, sb = b % 1024, swz = sb ^ (((sb >> 9) & 1) << 5); R = (st >> 1) * 16 + swz / 64; C = (st & 1) * 32 + (swz % 64) / 2; }

struct Gemm { const bf16* A; const bf16* Bt; int K, nM, nN, overlap; int kmode = 0; };
typedef f32x4 Acc[2][2][4][2];
struct Unit { int pm, pn, tbase, kofs, nt; };

DI void tile_rows(int overlap, int pm, int& tbase, int& s0, int& slen) {
    s0 = 0; slen = T_TOK;
    if (!overlap) tbase = pm * 256; else tbase = 254 * pm - 1;
}
DI bool seq_first(int t) { return t < TP ? (t & 8191) == 0 : (t & 4095) == 0; }
DI bool tile_has_seam(int tbase) { const int nb = ((tbase + 1 + 4095) >> 12) << 12; return nb <= tbase + 255; }
constexpr int NM_PLAIN = 320, NM_OVL = 323;
DI bool next_unit(const Gemm& g, int i, Unit& u) {
    const int nM = g.nM, nN = g.nN, nwg = nM * nN; const long L = (long)i * gridDim.x + blockIdx.x; if (L >= nwg) return false;
    int wgid = (int)L; { const int q = nwg / 8, r = nwg % 8, xcd = wgid % 8, off = wgid / 8; wgid = (xcd < r ? xcd * (q + 1) : r * (q + 1) + (xcd - r) * q) + off; }
    const int nig = 8 * nN, gid = wgid / nig, fm = gid * 8, gsz = (nM - fm) < 8 ? (nM - fm) : 8;
    u.pm = fm + ((wgid % nig) % gsz); u.pn = (wgid % nig) / gsz;
    int s0, slen; tile_rows(g.overlap, u.pm, u.tbase, s0, slen);
    if (g.kmode) { u.kofs = u.pn < 3 ? 0 : 512; u.nt = u.pn < 3 ? 4 : 2; } else { u.kofs = 0; u.nt = g.K / 64; }
    return true;
}

#define DPP_ROR1(x) __builtin_bit_cast(float, __builtin_amdgcn_update_dpp(0, __builtin_bit_cast(int, (x)), 0x121, 0xf, 0xf, false))
#define DPP_ROL1(x) __builtin_bit_cast(float, __builtin_amdgcn_update_dpp(0, __builtin_bit_cast(int, (x)), 0x12F, 0xf, 0xf, false))

template <class F> DI void row_reduce(float (&part)[2][4], int wr, int wc, int fr, int fq, F&& f) {
    float* red = (float*)(g_lds + EPI_OFF);
#pragma unroll
    for (int ai = 0; ai < 2; ++ai)
#pragma unroll
        for (int m = 0; m < 4; ++m) { float v = part[ai][m]; v += __shfl_xor(v, 16); v += __shfl_xor(v, 32);
            if (fq == 0) red[(ai * 128 + wr * 64 + m * 16 + fr) * 4 + wc] = v; }
    __syncthreads();
    if (threadIdx.x < 256) { const f32x4 s = *(const f32x4*)(red + threadIdx.x * 4); f((int)threadIdx.x, (s.x + s.y) + (s.z + s.w)); }
    __syncthreads();
}
DI void conv_exchange(const Acc& acc, int wr, int wc, int fr, int fq) {
    float* bnd = (float*)(g_lds + EPI_OFF + 4096);
#pragma unroll
    for (int ai = 0; ai < 2; ++ai)
#pragma unroll
        for (int bj = 0; bj < 2; ++bj)
#pragma unroll
            for (int n = 0; n < 2; ++n) { const int colL = bj * 128 + wc * 32 + n * 16 + fq * 4, rb = ai * 2 + wr;
                if (fr == 0) *(f32x4*)(bnd + (0 * 4 + rb) * 256 + colL) = acc[ai][bj][0][n];
                if (fr == 15) *(f32x4*)(bnd + (1 * 4 + rb) * 256 + colL) = acc[ai][bj][3][n]; }
    __syncthreads();
}
#undef DPP_ROR1
#undef DPP_ROL1
#define DPP_ROR1(x) __builtin_bit_cast(float, __builtin_amdgcn_update_dpp(__builtin_bit_cast(int, (x)), __builtin_bit_cast(int, (x)), 0x121, 0xf, 0xf, false))
#define DPP_ROL1(x) __builtin_bit_cast(float, __builtin_amdgcn_update_dpp(__builtin_bit_cast(int, (x)), __builtin_bit_cast(int, (x)), 0x12F, 0xf, 0xf, false))
DI f32x4 ror4(const f32x4 v) { f32x4 r; asm volatile("s_nop 1\n\tv_mov_b32_dpp %0, %4 row_ror:1 row_mask:0xf bank_mask:0xf\n\tv_mov_b32_dpp %1, %5 row_ror:1 row_mask:0xf bank_mask:0xf\n\tv_mov_b32_dpp %2, %6 row_ror:1 row_mask:0xf bank_mask:0xf\n\tv_mov_b32_dpp %3, %7 row_ror:1 row_mask:0xf bank_mask:0xf"
    : "=&v"(r.x), "=&v"(r.y), "=&v"(r.z), "=&v"(r.w) : "v"(v.x), "v"(v.y), "v"(v.z), "v"(v.w)); return r; }
DI f32x4 rol4(const f32x4 v) { f32x4 r; asm volatile("s_nop 1\n\tv_mov_b32_dpp %0, %4 row_ror:15 row_mask:0xf bank_mask:0xf\n\tv_mov_b32_dpp %1, %5 row_ror:15 row_mask:0xf bank_mask:0xf\n\tv_mov_b32_dpp %2, %6 row_ror:15 row_mask:0xf bank_mask:0xf\n\tv_mov_b32_dpp %3, %7 row_ror:15 row_mask:0xf bank_mask:0xf"
    : "=&v"(r.x), "=&v"(r.y), "=&v"(r.z), "=&v"(r.w) : "v"(v.x), "v"(v.y), "v"(v.z), "v"(v.w)); return r; }
template <int BJ, int N, int AI, int M> DI f32x4 conv_row(const Acc& acc, const f32x4 w0, const f32x4 w1, const f32x4 w2, const f32x4 b, const f32x4 upB, const f32x4 dnB, int fr) {
    const f32x4 v = acc[AI][BJ][M][N];
    const f32x4 pu = M > 0 ? ror4(acc[AI][BJ][M > 0 ? M - 1 : 0][N]) : upB;
    const f32x4 nd = M < 3 ? rol4(acc[AI][BJ][M < 3 ? M + 1 : 3][N]) : dnB;
    const f32x4 rv_ = ror4(v), lv_ = rol4(v);
    const f32x4 up = fr > 0 ? rv_ : pu, dn = fr < 15 ? lv_ : nd;
    f32x4 r_ = w0 * up + w1 * v + w2 * dn + b;
    asm volatile("" : "+v"(r_.x), "+v"(r_.y), "+v"(r_.z), "+v"(r_.w));
    return r_;
}
template <int BJ, int N, int AI> DI void conv_bnd(int wr, int wc, int fq, f32x4& upB, f32x4& dnB) {
    const float* bnd = (const float*)(g_lds + EPI_OFF + 4096);
    const int colL = BJ * 128 + wc * 32 + N * 16 + fq * 4, rb = AI * 2 + wr; const f32x4 z4 = {0.f, 0.f, 0.f, 0.f};
    upB = rb > 0 ? *(const f32x4*)(bnd + (4 + rb - 1) * 256 + colL) : z4; dnB = rb < 3 ? *(const f32x4*)(bnd + (rb + 1) * 256 + colL) : z4;
}

template <int BJ, int N, int AI> DI void conv4(const Acc& acc, const f32x4 w0, const f32x4 w1, const f32x4 w2, const f32x4 b, const f32x4 upB, const f32x4 dnB, int fr, f32x4 (&out)[4]) {
    f32x4 rprev = upB, lcur = rol4(acc[AI][BJ][0][N]);
#pragma unroll
    for (int M = 0; M < 4; ++M) { const f32x4 v = acc[AI][BJ][M][N]; const f32x4 rv_ = ror4(v); f32x4 lnext = dnB; if (M < 3) lnext = rol4(acc[AI][BJ][M < 3 ? M + 1 : 3][N]);
        const f32x4 up = fr > 0 ? rv_ : rprev, dn = fr < 15 ? lcur : lnext;
        out[M] = w0 * up + w1 * v + w2 * dn + b; rprev = rv_; lcur = lnext; }
}
#define FOR_ROWS(...) _Pragma("unroll") for (int ai = 0; ai < 2; ++ai) _Pragma("unroll") for (int m = 0; m < 4; ++m) { \
    const int row = ai * 128 + wr * 64 + m * 16 + fr; const int tg = tbase + row; const bool ok = (tg >= s0) && (tg < s0 + slen) && (!OVL || (row >= 1 && row <= 254)); (void)ok; __VA_ARGS__ }
#define FOR_COLS(...) _Pragma("unroll") for (int bj = 0; bj < 2; ++bj) _Pragma("unroll") for (int n = 0; n < 2; ++n) { const int colL = bj * 128 + wc * 32 + n * 16 + fq * 4; (void)colL; __VA_ARGS__ }
DI void st_bf4(bf16* p, const f32x4 v) { u32x2 w; w.x = pk2(v.x, v.y); w.y = pk2(v.z, v.w); *(u32x2*)p = w; }
DI void st_bf8(bf16* p, const f32x4 a, const f32x4 b) { u32x4 w; w.x = pk2(a.x, a.y); w.y = pk2(a.z, a.w); w.z = pk2(b.x, b.y); w.w = pk2(b.z, b.w); *(u32x4*)p = w; }
DI float sq4(const f32x4 v) { return (v.x * v.x + v.y * v.y) + (v.z * v.z + v.w * v.w); }

struct EpiIn {
    Params p;
    DI void operator()(Acc& acc, const Unit& u, int wr, int wc, int fr, int fq) const {
        constexpr bool OVL = true; unsigned char* ws = p.ws; const int pn = u.pn; int tbase, s0, slen; tile_rows(1, u.pm, tbase, s0, slen); const bool hb_ = tile_has_seam(tbase); (void)hb_;
        const f32x4* SS = (const f32x4*)(ws + O_SS);
        FOR_ROWS({ const bool val = (tg >= s0) && (tg < s0 + slen); const float rs = val ? rs_of(SS, tg) : 0.f;
            _Pragma("unroll") for (int bj = 0; bj < 2; ++bj) _Pragma("unroll") for (int n = 0; n < 2; ++n) acc[ai][bj][m][n] *= rs; })
        if (pn == 0) {
            bf16* CQ = (bf16*)(ws + O_CQKV); float* RQ = (float*)(ws + O_RQ); float part[2][4];
            FOR_ROWS({ float s = 0.f; FOR_COLS({ const f32x4 v = acc[ai][bj][m][n]; s += sq4(v); if (ok) st_bf4(CQ + (size_t)tg * 384 + colL, v); }) part[ai][m] = s; })
            row_reduce(part, wr, wc, fr, fq, [&](int row, float ss) { const int tg = tbase + row; if (tg >= s0 && tg < s0 + slen && row >= 1 && row <= 254) RQ[tg] = rsqrtf(ss * (1.f / 256.f) + EPS); });
        } else if (pn == 1) {
            bf16* CQ = (bf16*)(ws + O_CQKV); float* RKV = (float*)(ws + O_RKV); float part[2][4];
            FOR_ROWS({ float s = 0.f; _Pragma("unroll") for (int n = 0; n < 2; ++n) { const f32x4 v = acc[ai][0][m][n]; s += sq4(v); if (ok) st_bf4(CQ + (size_t)tg * 384 + 256 + wc * 32 + n * 16 + fq * 4, v); } part[ai][m] = s; })
            row_reduce(part, wr, wc, fr, fq, [&](int row, float ss) { const int tg = tbase + row; if (tg >= s0 && tg < s0 + slen && row >= 1 && row <= 254) RKV[tg] = rsqrtf(ss * (1.f / 128.f) + EPS); });
            if (wc == 0) {
                const float* RC = (const float*)(ws + O_ROPE); const float* RSN = RC + 8192 * 16; bf16* KR = (bf16*)(ws + O_KR);
                FOR_ROWS({ if (ok) { const int pos = tg - seq_start(seq_of(tg)); const f32x4 c = *(const f32x4*)(RC + pos * 16 + fq * 4), s = *(const f32x4*)(RSN + pos * 16 + fq * 4); const f32x4 x1 = acc[ai][1][m][0], x2 = acc[ai][1][m][1];
                    st_bf4(KR + (size_t)tg * 32 + fq * 4, x1 * c - x2 * s); st_bf4(KR + (size_t)tg * 32 + 16 + fq * 4, x2 * c + x1 * s); } })
            } else if (wc == 1) {
                float* G = (float*)(ws + O_G); const f32x4 gb = *(const f32x4*)(p.gate_bias + fq * 4); const bool isf = fq & 1;
                FOR_ROWS({ if (ok) { f32x4 v = acc[ai][1][m][0] + gb; if (isf) { v.x = logsigmoidf_(v.x); v.y = logsigmoidf_(v.y); v.z = logsigmoidf_(v.z); v.w = logsigmoidf_(v.w); } *(f32x4*)(G + (size_t)tg * 16 + fq * 4) = v; } })
            }
        } else if (pn < 6) {
            conv_exchange(acc, wr, wc, fr, fq);
            const float* cw = p.m_conv_w; const float* cb = p.m_conv_b; const int chb = (pn - 2) * 256 + wc * 32 + fq * 4;
            const bool isK = pn >= 4; bf16* dst = (bf16*)(ws + (isK ? O_KC : O_QC)); const float sc = isK ? 0.08838834764831845f : 1.f; const int cb0 = (pn - (isK ? 4 : 2)) * 256;
#define CA_(BJ, N, AI) { f32x4 upB, dnB; conv_bnd<BJ, N, AI>(wr, wc, fq, upB, dnB); f32x4 rp_ = upB, lc_ = rol4(acc[AI][BJ][0][N]); \
        _Pragma("unroll") for (int M = 0; M < 4; ++M) { const int row = AI * 128 + wr * 64 + M * 16 + fr, tg = tbase + row; const f32x4 a_ = acc[AI][BJ][M][N]; const f32x4 ra_ = ror4(a_); f32x4 ln_ = dnB; if (M < 3) ln_ = rol4(acc[AI][BJ][M < 3 ? M + 1 : 3][N]); \
            f32x4 up_ = fr > 0 ? ra_ : rp_, dn_ = fr < 15 ? lc_ : ln_; if (hb_) { const f32x4 z_ = {0.f, 0.f, 0.f, 0.f}; if (seq_first(tg)) up_ = z_; if (seq_first(tg + 1)) dn_ = z_; } const f32x4 v = w0 * up_ + w1 * a_ + w2 * dn_ + bb; rp_ = ra_; lc_ = ln_; \
            if ((tg >= s0) && (tg < s0 + slen) && row >= 1 && row <= 254) st_bf4(dst + (size_t)tg * 512 + cb0 + BJ * 128 + wc * 32 + N * 16 + fq * 4, (f32x4){siluf_(v.x) * sc, siluf_(v.y) * sc, siluf_(v.z) * sc, siluf_(v.w) * sc}); __builtin_amdgcn_sched_barrier(0); } }
#define CS_(BJ, N) { const int ch = chb + BJ * 128 + N * 16; const f32x4 w0 = *(const f32x4*)(cw + ch), w1 = *(const f32x4*)(cw + 1024 + ch), w2 = *(const f32x4*)(cw + 2048 + ch), bb = *(const f32x4*)(cb + ch); CA_(BJ, N, 0) CA_(BJ, N, 1) }
            CS_(0, 0) CS_(0, 1) CS_(1, 0) CS_(1, 1)
#undef CS_
#undef CA_
        } else if (pn < 8) {
            bf16* MV = (bf16*)(ws + O_MV); const int cb0 = (pn - 6) * 256;
            FOR_ROWS({ if (ok) { FOR_COLS({ st_bf4(MV + (size_t)tg * 512 + cb0 + colL, acc[ai][bj][m][n]); }) } })
        } else {
            bf16* MO = (bf16*)(ws + O_MO); const int cb0 = (pn - 8) * 256;
            FOR_ROWS({ if (ok) { FOR_COLS({ const f32x4 v = acc[ai][bj][m][n]; st_bf4(MO + (size_t)tg * 512 + cb0 + colL, (f32x4){sigmoidf_(v.x), sigmoidf_(v.y), sigmoidf_(v.z), sigmoidf_(v.w)}); }) } })
        }
    }
};
struct EpiQkv {
    Params p;
    DI void operator()(Acc& acc, const Unit& u, int wr, int wc, int fr, int fq) const {
        constexpr bool OVL = false; const int s0 = 0, slen = T_TOK, tbase = u.tbase, pn = u.pn; unsigned char* ws = p.ws;
        const float* RS = (const float*)(ws + (pn < 3 ? O_RQ : O_RKV));
        if (pn < 3) {
            bf16* Q = (bf16*)(ws + O_Q); const float* RC = (const float*)(ws + O_ROPE); const float* RSN = RC + 8192 * 16;
            const float qs = 0.10206207261596577f * 1.4426950408889634f;
            FOR_ROWS({ const float rs = RS[tg] * qs; const int sq = seq_of(tg), pos = tg - seq_start(sq);
                _Pragma("unroll") for (int bj = 0; bj < 2; ++bj) { const int base32 = pn * 256 + bj * 128 + wc * 32; const f32x4 v0 = acc[ai][bj][m][0] * rs, v1 = acc[ai][bj][m][1] * rs;
                    f32x4 o0 = v0, o1 = v1;
                    if (base32 % 96 == 64) { const f32x4 c = *(const f32x4*)(RC + pos * 16 + fq * 4), s = *(const f32x4*)(RSN + pos * 16 + fq * 4); o0 = v0 * c - v1 * s; o1 = v1 * c + v0 * s; }
                    st_bf4(Q + (size_t)tg * 768 + base32 + fq * 4, o0); st_bf4(Q + (size_t)tg * 768 + base32 + 16 + fq * 4, o1); } })
        } else if (pn < 5) {
            bf16* KN = (bf16*)(ws + O_KN); const int cb0 = (pn - 3) * 256;
            FOR_ROWS({ const float rs = RS[tg]; FOR_COLS({ st_bf4(KN + (size_t)tg * 512 + cb0 + colL, acc[ai][bj][m][n] * rs); }) })
        } else {
            bf16* VT = (bf16*)(ws + O_VT); const int cb0 = (pn - 5) * 256;
            FOR_ROWS({ const float rs = RS[tg]; const int sq = seq_of(tg), st = seq_start(sq), S = seq_len(sq), pos = tg - st; bf16* base = VT + (size_t)st * 512 + pos;
                FOR_COLS({ const int c = cb0 + colL; const f32x4 v = acc[ai][bj][m][n] * rs;
                    base[(size_t)c * S] = f2bf(v.x); base[(size_t)(c + 1) * S] = f2bf(v.y); base[(size_t)(c + 2) * S] = f2bf(v.z); base[(size_t)(c + 3) * S] = f2bf(v.w); }) })
        }
    }
};
struct EpiRes {
    Params p; int first, nobf;
    DI void operator()(Acc& acc, const Unit& u, int wr, int wc, int fr, int fq) const {
        const int tbase = u.tbase, pn = u.pn; unsigned char* ws = p.ws;
        bf16* XB = (bf16*)(ws + O_XB); float* SS = (float*)(ws + O_SS); float part[2][4];
#pragma unroll
        for (int ai = 0; ai < 2; ++ai) { f32x4 res[4][2][2];
#pragma unroll
            for (int m = 0; m < 4; ++m) { const int tg = tbase + ai * 128 + wr * 64 + m * 16 + fr; const float* rr = (first ? xin_row(p, tg) : p.out + (size_t)tg * DM) + pn * 256 + wc * 32 + 8 * fq;
#pragma unroll
                for (int bj = 0; bj < 2; ++bj) { res[m][bj][0] = *(const f32x4*)(rr + bj * 128); res[m][bj][1] = *(const f32x4*)(rr + bj * 128 + 4); } }
#pragma unroll
            for (int m = 0; m < 4; ++m) { const int tg = tbase + ai * 128 + wr * 64 + m * 16 + fr; const int c0 = pn * 256 + wc * 32 + 8 * fq; float* orow = p.out + (size_t)tg * DM + c0; bf16* xrow = XB + (size_t)tg * DM + c0; float s = 0.f;
#pragma unroll
                for (int bj = 0; bj < 2; ++bj) { const f32x4 v0 = res[m][bj][0] + acc[ai][bj][m][0], v1 = res[m][bj][1] + acc[ai][bj][m][1];
                    *(f32x4*)(orow + bj * 128) = v0; *(f32x4*)(orow + bj * 128 + 4) = v1; if (!nobf) st_bf8(xrow + bj * 128, v0, v1); s += sq4(v0) + sq4(v1); }
                part[ai][m] = s; } }
        row_reduce(part, wr, wc, fr, fq, [&](int row, float ss) { SS[(size_t)(tbase + row) * 4 + pn] = ss; });
    }
};
struct EpiUp {
    Params p; int layer;
    DI void operator()(Acc& acc, const Unit& u, int wr, int wc, int fr, int fq) const {
        constexpr bool OVL = true; unsigned char* ws = p.ws; const int pn = u.pn; int tbase, s0, slen; tile_rows(1, u.pm, tbase, s0, slen); const bool hb_ = tile_has_seam(tbase); (void)hb_;
        const f32x4* SS = (const f32x4*)(ws + O_SS);
        FOR_ROWS({ const bool val = (tg >= s0) && (tg < s0 + slen); const float rs = val ? rs_of(SS, tg) : 0.f;
            _Pragma("unroll") for (int bj = 0; bj < 2; ++bj) _Pragma("unroll") for (int n = 0; n < 2; ++n) acc[ai][bj][m][n] *= rs; })
        conv_exchange(acc, wr, wc, fr, fq);
        const float* cw = p.ffn_conv_w + (size_t)layer * 3 * 5632; const float* cb = p.ffn_conv_b + (size_t)layer * 5632; const int chb = pn * 128 + wc * 32 + fq * 4;
        bf16* HID = (bf16*)(ws + O_HID);
#define CA_(N, AI) { f32x4 upG, dnG, upV, dnV; conv_bnd<0, N, AI>(wr, wc, fq, upG, dnG); conv_bnd<1, N, AI>(wr, wc, fq, upV, dnV); \
        f32x4 rpg_ = upG, lcg_ = rol4(acc[AI][0][0][N]), rpv_ = upV, lcv_ = rol4(acc[AI][1][0][N]); \
        _Pragma("unroll") for (int M = 0; M < 4; ++M) { const int row = AI * 128 + wr * 64 + M * 16 + fr, tg = tbase + row; const f32x4 a_ = acc[AI][0][M][N], b_ = acc[AI][1][M][N]; const f32x4 rga_ = ror4(a_), rvb_ = ror4(b_); \
            f32x4 lng_ = dnG, lnv_ = dnV; if (M < 3) { lng_ = rol4(acc[AI][0][M < 3 ? M + 1 : 3][N]); lnv_ = rol4(acc[AI][1][M < 3 ? M + 1 : 3][N]); } \
            f32x4 ug_ = fr > 0 ? rga_ : rpg_, dg_ = fr < 15 ? lcg_ : lng_, uv_ = fr > 0 ? rvb_ : rpv_, dv_ = fr < 15 ? lcv_ : lnv_; if (hb_) { const f32x4 z_ = {0.f, 0.f, 0.f, 0.f}; if (seq_first(tg)) { ug_ = z_; uv_ = z_; } if (seq_first(tg + 1)) { dg_ = z_; dv_ = z_; } } const f32x4 g = g0 * ug_ + g1 * a_ + g2 * dg_ + gb, v = v0 * uv_ + v1 * b_ + v2 * dv_ + vb; rpg_ = rga_; lcg_ = lng_; rpv_ = rvb_; lcv_ = lnv_; \
            if ((tg >= s0) && (tg < s0 + slen) && row >= 1 && row <= 254) st_bf4(HID + (size_t)tg * DFF + chb + N * 16, (f32x4){siluf_(g.x) * v.x, siluf_(g.y) * v.y, siluf_(g.z) * v.z, siluf_(g.w) * v.w}); __builtin_amdgcn_sched_barrier(0); } }
#define CS_(N) { const int cg_ = chb + N * 16, cv2_ = 2816 + chb + N * 16; \
        const f32x4 g0 = *(const f32x4*)(cw + cg_), g1 = *(const f32x4*)(cw + 5632 + cg_), g2 = *(const f32x4*)(cw + 11264 + cg_), gb = *(const f32x4*)(cb + cg_); \
        const f32x4 v0 = *(const f32x4*)(cw + cv2_), v1 = *(const f32x4*)(cw + 5632 + cv2_), v2 = *(const f32x4*)(cw + 11264 + cv2_), vb = *(const f32x4*)(cb + cv2_); CA_(N, 0) CA_(N, 1) }
        CS_(0) CS_(1)
#undef CS_
#undef CA_
    }
};
struct EpiGin {
    Params p;
    DI void operator()(Acc& acc, const Unit& u, int wr, int wc, int fr, int fq) const {
        constexpr bool OVL = false; const int s0 = 0, slen = T_TOK, tbase = u.tbase, pn = u.pn; unsigned char* ws = p.ws;
        const f32x4* SS = (const f32x4*)(ws + O_SS);
        bf16* dst = (bf16*)(ws + (pn < 4 ? O_U : O_V)); const int cb0 = (pn & 3) * 256 + wc * 32 + 8 * fq; float part[2][4];
        float rsv[2][4]; FOR_ROWS({ rsv[ai][m] = rs_of(SS, tg); })
        FOR_ROWS({ const float rs = rsv[ai][m]; float s = 0.f;
            _Pragma("unroll") for (int bj = 0; bj < 2; ++bj) { f32x4 v0 = acc[ai][bj][m][0] * rs, v1 = acc[ai][bj][m][1] * rs;
                v0.x = geluf_(v0.x); v0.y = geluf_(v0.y); v0.z = geluf_(v0.z); v0.w = geluf_(v0.w); v1.x = geluf_(v1.x); v1.y = geluf_(v1.y); v1.z = geluf_(v1.z); v1.w = geluf_(v1.w);
                s += sq4(v0) + sq4(v1); st_bf8(dst + (size_t)tg * DM + cb0 + bj * 128, v0, v1); } part[ai][m] = s; })
        if (pn >= 4) { float* VSS = (float*)(ws + O_VSS); row_reduce(part, wr, wc, fr, fq, [&](int row, float ss) { VSS[(size_t)(tbase + row) * 4 + (pn - 4)] = ss; }); }
    }
};

DI int perm32(int rho) { const int n = rho >> 4, i = rho & 15; return 8 * (i >> 2) + 4 * n + (i & 3); }
template <class Epi, bool PERM = false> DI void gemm_phase(const Gemm g, const Epi& E) {
    LAS unsigned char* lds = (LAS unsigned char*)g_lds;
    int tid_ = threadIdx.x; asm volatile("" : "+v"(tid_));
    const int tid = tid_, wid = __builtin_amdgcn_readfirstlane(tid >> 6), lane = tid & 63, wr = wid >> 2, wc = wid & 3, fr = lane & 15, fq = lane >> 4;
    const int K = g.K;
    unsigned voff[2], voffB[2];
#pragma unroll
    for (int i = 0; i < 2; ++i) { int R, C; stage_rc(tid * 16 + i * 8192, R, C); voff[i] = (unsigned)(R * K + C) * 2u; const int Rb = PERM ? ((R & ~31) + perm32(R & 31)) : R; voffB[i] = (unsigned)(Rb * K + C) * 2u; }
    const size_t kstep = 128, hstep = (size_t)128 * K * 2, tstep = 2 * hstep;
    const unsigned ldsw = (unsigned)wid * 1024u;
    const int aoff = lds_byte(wr * 64 + fr, fq * 8), boff = lds_byte(wc * 32 + fr, fq * 8);
#define PG8_SA(b, h) (((b) * 2 + (h)) * 16384)
#define PG8_SB(b, h) ((4 + (b) * 2 + (h)) * 16384)
#define PG8_STAGEX(bufoff, gbase, vo) do { _Pragma("unroll") for (int _i = 0; _i < 2; ++_i) \
        __builtin_amdgcn_global_load_lds((const unsigned*)((const char*)(gbase) + vo[_i]), (LAS unsigned*)(lds + (bufoff) + ldsw + _i * 8192), 16, 0, 0); } while (0)
#define PG8_LDA(dst, b, h) do { _Pragma("unroll") for (int m = 0; m < 4; ++m) _Pragma("unroll") for (int k = 0; k < 2; ++k) dst[m][k] = *(const LAS bf16x8*)(lds + PG8_SA(b, h) + aoff + m * 2048 + k * 1024); } while (0)
#define PG8_LDB(dst, b, h) do { _Pragma("unroll") for (int n = 0; n < 2; ++n) _Pragma("unroll") for (int k = 0; k < 2; ++k) dst[n][k] = *(const LAS bf16x8*)(lds + PG8_SB(b, h) + boff + n * 2048 + k * 1024); } while (0)
#define PG8_MMA(ai, bj, At, Bt) do { __builtin_amdgcn_s_setprio(1); _Pragma("unroll") for (int m = 0; m < 4; ++m) _Pragma("unroll") for (int n = 0; n < 2; ++n) _Pragma("unroll") for (int k = 0; k < 2; ++k) \
        acc[ai][bj][m][n] = __builtin_amdgcn_mfma_f32_16x16x32_bf16(Bt[n][k], At[m][k], acc[ai][bj][m][n], 0, 0, 0); __builtin_amdgcn_s_setprio(0); } while (0)
#define PG8_WAIT_V(n) asm volatile("s_waitcnt vmcnt(" #n ")" ::: "memory")
#define PG8_WAIT_L(n) asm volatile("s_waitcnt lgkmcnt(" #n ")" ::: "memory")
#define PG8_BAR __builtin_amdgcn_s_barrier()
#define PG8_SCHED __builtin_amdgcn_sched_barrier(0)
    Unit cur, nxt; int ui = 0;
    if (!next_unit(g, 0, cur)) return;
    Acc acc;
#pragma unroll
    for (int a = 0; a < 2; ++a)
#pragma unroll
        for (int b = 0; b < 2; ++b)
#pragma unroll
            for (int m = 0; m < 4; ++m)
#pragma unroll
                for (int n = 0; n < 2; ++n) acc[a][b][m][n] = (f32x4){0.f, 0.f, 0.f, 0.f};
    bf16x8 At[4][2], B0[2][2], B1[2][2];
    const char* cA = (const char*)g.A + (ptrdiff_t)cur.tbase * (ptrdiff_t)(K * 2) + cur.kofs; const char* cB = (const char*)g.Bt + (size_t)cur.pn * tstep + cur.kofs;
    PG8_STAGEX(PG8_SB(0, 0), cB, voffB); PG8_STAGEX(PG8_SB(0, 1), cB + hstep, voffB); PG8_STAGEX(PG8_SA(0, 0), cA, voff); PG8_STAGEX(PG8_SA(0, 1), cA + hstep, voff);
    if (wr == 1) PG8_BAR;
    PG8_WAIT_V(2); PG8_BAR;
    PG8_STAGEX(PG8_SB(1, 0), cB + kstep, voffB); PG8_STAGEX(PG8_SA(1, 0), cA + kstep, voff); PG8_STAGEX(PG8_SB(1, 1), cB + hstep + kstep, voffB);
    PG8_WAIT_V(6); PG8_BAR;
    for (;;) {
        const bool has_next = next_unit(g, ui + 1, nxt);
        const char* nA = has_next ? (const char*)g.A + (ptrdiff_t)nxt.tbase * (ptrdiff_t)(K * 2) + nxt.kofs : cA; const char* nB = has_next ? (const char*)g.Bt + (size_t)nxt.pn * tstep + nxt.kofs : cB;
        const int nt = cur.nt;
        for (int t = 0; t < nt; t += 2) {
            const bool last = (t == nt - 2);
            const char* a1 = cA + (size_t)(t + 1) * kstep;
            const char* a2 = last ? nA : cA + (size_t)(t + 2) * kstep; const char* b2 = last ? nB : cB + (size_t)(t + 2) * kstep;
            const char* a3 = a2 + kstep; const char* b3 = b2 + kstep;
            PG8_LDB(B0, 0, 0); PG8_LDB(B1, 0, 1); PG8_SCHED; PG8_LDA(At, 0, 0); PG8_STAGEX(PG8_SA(1, 1), a1 + hstep, voff);
            PG8_WAIT_V(8); PG8_WAIT_L(0); PG8_BAR; PG8_MMA(0, 0, At, B0); PG8_MMA(0, 1, At, B1); PG8_BAR; PG8_SCHED;
            PG8_LDA(At, 0, 1); PG8_STAGEX(PG8_SB(0, 0), b2, voffB); PG8_STAGEX(PG8_SB(0, 1), b2 + hstep, voffB); PG8_STAGEX(PG8_SA(0, 0), a2, voff);
            PG8_WAIT_V(8); PG8_WAIT_L(0); PG8_BAR; PG8_MMA(1, 0, At, B0); PG8_MMA(1, 1, At, B1); PG8_BAR; PG8_SCHED;
            PG8_LDB(B0, 1, 0); PG8_LDB(B1, 1, 1); PG8_SCHED; PG8_LDA(At, 1, 0); PG8_STAGEX(PG8_SA(0, 1), a2 + hstep, voff);
            PG8_WAIT_V(8); PG8_WAIT_L(0); PG8_BAR; PG8_MMA(0, 0, At, B0); PG8_MMA(0, 1, At, B1); PG8_BAR; PG8_SCHED;
            PG8_LDA(At, 1, 1); PG8_STAGEX(PG8_SB(1, 0), b3, voffB); PG8_STAGEX(PG8_SB(1, 1), b3 + hstep, voffB); PG8_STAGEX(PG8_SA(1, 0), a3, voff);
            PG8_WAIT_V(8); PG8_WAIT_L(0); PG8_BAR; PG8_MMA(1, 0, At, B0); PG8_MMA(1, 1, At, B1); PG8_BAR; PG8_SCHED;
        }
        if (wr == 0) PG8_BAR;
        { int fr2 = fr, fq2 = fq; asm volatile("" : "+v"(fr2), "+v"(fq2)); E(acc, cur, wr, wc, fr2, fq2); }
        if (!has_next) break;
#pragma unroll
        for (int a = 0; a < 2; ++a)
#pragma unroll
            for (int b = 0; b < 2; ++b)
#pragma unroll
                for (int m = 0; m < 4; ++m)
#pragma unroll
                    for (int n = 0; n < 2; ++n) acc[a][b][m][n] = (f32x4){0.f, 0.f, 0.f, 0.f};
        cur = nxt; cA = nA; cB = nB; ++ui;
        if (wr == 1) PG8_BAR;
    }
    PG8_WAIT_V(0);
    PG8_BAR;
    __syncthreads();
}

constexpr int LDT = 136;
constexpr int TILE_B = 128 * LDT * 2;
DI int crow(int i, int h) { return (i & 3) + 8 * (i >> 2) + 4 * h; }
template <int KS> DI void mm_lds(f32x16 (&acc)[2], const bf16* sA, const bf16* sB, int rb, int cb0, int lane) {
    const int r = lane & 31, h = lane >> 5;
#pragma unroll
    for (int ks = 0; ks < KS; ++ks) {
        const bf16x8 a = *(const bf16x8*)(sA + (32 * rb + r) * LDT + 16 * ks + 8 * h);
#pragma unroll
        for (int c = 0; c < 2; ++c) { const bf16x8 b = *(const bf16x8*)(sB + (32 * (cb0 + c) + r) * LDT + 16 * ks + 8 * h); acc[c] = MFMA32(a, b, acc[c]); }
    }
}
DI float scan_add(float v, int lane) {
#pragma unroll
    for (int o = 1; o < 64; o <<= 1) { const float t = __shfl_up(v, o); if (lane >= o) v += t; }
    return v;
}
DI float scan_max(float v, int lane) {
#pragma unroll
    for (int o = 1; o < 64; o <<= 1) { const float t = __shfl_up(v, o); if (lane >= o) v = fmaxf(v, t); }
    return v;
}
DI float wave_max(float v) {
#pragma unroll
    for (int o = 1; o < 64; o <<= 1) v = fmaxf(v, __shfl_xor(v, o));
    return v;
}
DI void load_tile_nat(bf16* sT, const bf16* g, int gld, int tid) {
#pragma unroll
    for (int i = 0; i < 4; ++i) { const int id = tid + 512 * i, row = id >> 4, c = (id & 15) * 8; *(u32x4*)(sT + row * LDT + c) = *(const u32x4*)(g + (size_t)row * gld + c); }
}
DI void load_tile_tr(bf16* sT, const bf16* g, int gld, const float* w, int tid) {
#pragma unroll
    for (int i = 0; i < 4; ++i) { const int id = tid + 512 * i, row = id & 127, c = (id >> 7) * 8; const u32x4 v = *(const u32x4*)(g + (size_t)row * gld + c); const float ww = w ? w[row] : 1.f;
        const unsigned uu[4] = {v.x, v.y, v.z, v.w};
#pragma unroll
        for (int e = 0; e < 4; ++e) { sT[(c + 2 * e) * LDT + row] = f2bf(bflo(uu[e]) * ww); sT[(c + 2 * e + 1) * LDT + row] = f2bf(bfhi(uu[e]) * ww); } }
}

DI void write_tile_tr(bf16* sT, const u32x4 (&v)[4], const float* w, int tid) {
#pragma unroll
    for (int i = 0; i < 4; ++i) { const int id = tid + 512 * i, row = id & 127, c = (id >> 7) * 8; const float ww = w ? w[row] : 1.f;
        const unsigned uu[4] = {v[i].x, v[i].y, v[i].z, v[i].w};
#pragma unroll
        for (int e = 0; e < 4; ++e) { sT[(c + 2 * e) * LDT + row] = f2bf(bflo(uu[e]) * ww); sT[(c + 2 * e + 1) * LDT + row] = f2bf(bfhi(uu[e]) * ww); } }
}
DI void mlstm_local(const Params& p) {
    unsigned char* ws = p.ws; int tid_ = threadIdx.x; asm volatile("" : "+v"(tid_)); const int tid = tid_, lane = tid & 63, wid = tid >> 6;
    bf16* sV = (bf16*)g_lds; bf16* sK = (bf16*)(g_lds + TILE_B); float* sW = (float*)(g_lds + 2 * TILE_B);
    const float* G = (const float*)(ws + O_G); const bf16* MV = (const bf16*)(ws + O_MV); const bf16* KC = (const bf16*)(ws + O_KC);
    bf16* CS = (bf16*)(ws + O_CS); float* NS = (float*)(ws + O_NS); float* ML = (float*)(ws + O_ML); float* BL = (float*)(ws + O_BL);
    const int rb = wid & 3, cb0 = (wid >> 2) * 2;
    for (int it2 = blockIdx.x; it2 < 2560; it2 += gridDim.x) {
        const int cgk = it2 >> 2, h = it2 & 3, t0 = cgk * 128;
        u32x4 vr[4], kr[4];
#pragma unroll
        for (int i = 0; i < 4; ++i) { const int id = tid + 512 * i, row = id & 127, c = (id >> 7) * 8; vr[i] = *(const u32x4*)(MV + (size_t)(t0 + row) * 512 + h * 128 + c); kr[i] = *(const u32x4*)(KC + (size_t)(t0 + row) * 512 + h * 128 + c); }
        if (wid < 2) { const int dir = wid, item = it2 * 2 + dir;
            const int o0 = dir ? 127 - lane : lane, o1 = dir ? 63 - lane : lane + 64;
            const float lf0 = G[(size_t)(t0 + o0) * 16 + dir * 8 + 4 + h], li0 = G[(size_t)(t0 + o0) * 16 + dir * 8 + h];
            const float lf1 = G[(size_t)(t0 + o1) * 16 + dir * 8 + 4 + h], li1 = G[(size_t)(t0 + o1) * 16 + dir * 8 + h];
            const float b0 = scan_add(lf0, lane), tot0 = __shfl(b0, 63), b1 = scan_add(lf1, lane) + tot0, bL = __shfl(b1, 63);
            const float g0 = bL - b0 + li0, g1 = bL - b1 + li1, ml = wave_max(fmaxf(g0, g1));
            sW[dir * 128 + o0] = __expf(g0 - ml); sW[dir * 128 + o1] = __expf(g1 - ml);
            if (lane == 0) { ML[item] = ml; BL[item] = bL; }
        }
        write_tile_tr(sK, kr, nullptr, tid);
        __syncthreads();
#pragma unroll 1
        for (int dir = 0; dir < 2; ++dir) { const int item = it2 * 2 + dir; const float* sWd = sW + dir * 128;
            write_tile_tr(sV, vr, sWd, tid);
            __syncthreads();
            if (tid < 128) { float s = 0.f;
#pragma unroll 4
                for (int l = 0; l < 128; l += 8) { const u32x4 kk = *(const u32x4*)(sK + tid * LDT + l); const f32x4 wa = *(const f32x4*)(sWd + l), wb = *(const f32x4*)(sWd + l + 4);
                    s += (wa.x * bflo(kk.x) + wa.y * bfhi(kk.x)) + (wa.z * bflo(kk.y) + wa.w * bfhi(kk.y)) + (wb.x * bflo(kk.z) + wb.y * bfhi(kk.z)) + (wb.z * bflo(kk.w) + wb.w * bfhi(kk.w)); }
                NS[(size_t)item * 128 + tid] = s; }
            f32x16 acc[2];
#pragma unroll
            for (int c = 0; c < 2; ++c)
#pragma unroll
                for (int i = 0; i < 16; ++i) acc[c][i] = 0.f;
            mm_lds<8>(acc, sV, sK, rb, cb0, lane);
            bf16* Co = CS + (size_t)item * 16384;
#pragma unroll
            for (int c = 0; c < 2; ++c)
#pragma unroll
                for (int i = 0; i < 16; ++i) Co[(32 * rb + crow(i, lane >> 5)) * 128 + 32 * (cb0 + c) + (lane & 31)] = f2bf(acc[c][i]);
            __syncthreads();
        }
    }
}
DI void mlstm_scan(const Params& p) {
    unsigned char* ws = p.ws; int tid_ = threadIdx.x; asm volatile("" : "+v"(tid_)); const int gt = blockIdx.x * NTHR + tid_, GT = gridDim.x * NTHR;
    bf16* CS = (bf16*)(ws + O_CS); float* NS = (float*)(ws + O_NS); const float* ML = (const float*)(ws + O_ML); const float* BL = (const float*)(ws + O_BL); float* MP = (float*)(ws + O_MP);
    for (int u = gt; u < 144 * 2080; u += GT) {
        const int st = u / 2080, v = u % 2080, sq = st >> 3, h = (st >> 1) & 3, dir = st & 1, nc = seq_len(sq) >> 7, c0 = seq_start(sq) >> 7;
        float m = 0.f;
        if (v < 2048) {
            float C[8];
#pragma unroll
            for (int e = 0; e < 8; ++e) C[e] = 0.f;
            for (int j = 0; j < nc; j += 4) {
                u32x4 t[4]; float bl[4], mlv[4]; int itm[4];
#pragma unroll
                for (int q = 0; q < 4; ++q) { const int n = dir ? nc - 1 - (j + q) : j + q; itm[q] = ((c0 + n) * 4 + h) * 2 + dir; t[q] = *(const u32x4*)(CS + (size_t)itm[q] * 16384 + v * 8); bl[q] = BL[itm[q]]; mlv[q] = ML[itm[q]]; }
#pragma unroll
                for (int q = 0; q < 4; ++q) { u32x4 o; o.x = pk2(C[0], C[1]); o.y = pk2(C[2], C[3]); o.z = pk2(C[4], C[5]); o.w = pk2(C[6], C[7]); *(u32x4*)(CS + (size_t)itm[q] * 16384 + v * 8) = o;
                    if (v == 0) MP[itm[q]] = m;
                    const float mn = fmaxf(bl[q] + m, mlv[q]), a = __expf(bl[q] + m - mn), c = __expf(mlv[q] - mn);
                    C[0] = a * C[0] + c * bflo(t[q].x); C[1] = a * C[1] + c * bfhi(t[q].x); C[2] = a * C[2] + c * bflo(t[q].y); C[3] = a * C[3] + c * bfhi(t[q].y);
                    C[4] = a * C[4] + c * bflo(t[q].z); C[5] = a * C[5] + c * bfhi(t[q].z); C[6] = a * C[6] + c * bflo(t[q].w); C[7] = a * C[7] + c * bfhi(t[q].w); m = mn; }
            }
        } else {
            f32x4 N = {0.f, 0.f, 0.f, 0.f};
            for (int j = 0; j < nc; j += 4) {
                f32x4 t[4]; float bl[4], mlv[4]; int itm[4];
#pragma unroll
                for (int q = 0; q < 4; ++q) { const int n = dir ? nc - 1 - (j + q) : j + q; itm[q] = ((c0 + n) * 4 + h) * 2 + dir; t[q] = *(const f32x4*)(NS + (size_t)itm[q] * 128 + (v - 2048) * 4); bl[q] = BL[itm[q]]; mlv[q] = ML[itm[q]]; }
#pragma unroll
                for (int q = 0; q < 4; ++q) { *(f32x4*)(NS + (size_t)itm[q] * 128 + (v - 2048) * 4) = N;
                    const float mn = fmaxf(bl[q] + m, mlv[q]), a = __expf(bl[q] + m - mn), c = __expf(mlv[q] - mn); N = a * N + c * t[q]; m = mn; }
            }
        }
    }
}
DI void mlstm_out(const Params& p) {
    unsigned char* ws = p.ws; int tid_ = threadIdx.x; asm volatile("" : "+v"(tid_)); const int tid = tid_, lane = tid & 63, wid = tid >> 6, hh = lane >> 5;
    bf16* sQ = (bf16*)g_lds; bf16* sK = (bf16*)(g_lds + TILE_B); bf16* sVT = (bf16*)(g_lds + 2 * TILE_B); bf16* sC = (bf16*)(g_lds + 3 * TILE_B); bf16* sP = sK;
    float* sBv2 = (float*)(g_lds + 4 * TILE_B); float* sLi2 = sBv2 + 256; float* sMt2 = sBv2 + 512; float* sInter2 = sBv2 + 768; float* sInv = sBv2 + 1024; float* sN = sBv2 + 1152;
    float* sH = (float*)g_lds;
    const float* G = (const float*)(ws + O_G); const bf16* QC = (const bf16*)(ws + O_QC); const bf16* KC = (const bf16*)(ws + O_KC); const bf16* MV = (const bf16*)(ws + O_MV); const bf16* MO = (const bf16*)(ws + O_MO);
    const bf16* CS = (const bf16*)(ws + O_CS); const float* NS = (const float*)(ws + O_NS); const float* MP = (const float*)(ws + O_MP); bf16* Y = (bf16*)(ws + O_Y);
    const int rb = wid & 3, cb0 = (wid >> 2) * 2;
    for (int item = blockIdx.x; item < 2560; item += gridDim.x) {
        const int cgk = item >> 2, h = item & 3, t0 = cgk * 128;
        load_tile_nat(sQ, QC + (size_t)t0 * 512 + h * 128, 512, tid);
        load_tile_nat(sK, KC + (size_t)t0 * 512 + h * 128, 512, tid);
        load_tile_tr(sVT, MV + (size_t)t0 * 512 + h * 128, 512, nullptr, tid);
        if (wid < 2) {
            const int dir = wid, itemd = (cgk * 4 + h) * 2 + dir; const float mprev = MP[itemd];
            const int o0 = dir ? 127 - lane : lane, o1 = dir ? 63 - lane : lane + 64;
            const float lf0 = G[(size_t)(t0 + o0) * 16 + dir * 8 + 4 + h], li0 = G[(size_t)(t0 + o0) * 16 + dir * 8 + h];
            const float lf1 = G[(size_t)(t0 + o1) * 16 + dir * 8 + 4 + h], li1 = G[(size_t)(t0 + o1) * 16 + dir * 8 + h];
            const float b0 = scan_add(lf0, lane), tot0 = __shfl(b0, 63), b1 = scan_add(lf1, lane) + tot0;
            const float pm0 = scan_max(li0 - b0, lane), mx0 = __shfl(pm0, 63), pm1 = fmaxf(scan_max(li1 - b1, lane), mx0);
            const float a0 = b0 + mprev, a1 = b1 + mprev, mt0 = fmaxf(a0, b0 + pm0), mt1 = fmaxf(a1, b1 + pm1);
            float* B_ = sBv2 + dir * 128; float* L_ = sLi2 + dir * 128; float* M_ = sMt2 + dir * 128; float* I_ = sInter2 + dir * 128;
            B_[o0] = b0; B_[o1] = b1; L_[o0] = li0; L_[o1] = li1; M_[o0] = mt0; M_[o1] = mt1; I_[o0] = __expf(a0 - mt0); I_[o1] = __expf(a1 - mt1);
        }
        __syncthreads();
        f32x16 S[2], hs[2];
#pragma unroll
        for (int c = 0; c < 2; ++c)
#pragma unroll
            for (int i = 0; i < 16; ++i) { S[c][i] = 0.f; hs[c][i] = 0.f; }
        mm_lds<8>(S, sQ, sK, rb, cb0, lane);
#pragma unroll 1
        for (int dir = 0; dir < 2; ++dir) {
            __syncthreads();
            const int itemd = (cgk * 4 + h) * 2 + dir;
            const float* sBv = sBv2 + dir * 128; const float* sLi = sLi2 + dir * 128; const float* sMt = sMt2 + dir * 128; const float* sInter = sInter2 + dir * 128;
            load_tile_nat(sC, CS + (size_t)itemd * 16384, 128, tid);
            if (tid >= 64 && tid < 96) *(f32x4*)(sN + (tid - 64) * 4) = *(const f32x4*)(NS + (size_t)itemd * 128 + (tid - 64) * 4);
            __syncthreads();
#pragma unroll
            for (int c = 0; c < 2; ++c) { const int s = 32 * (cb0 + c) + (lane & 31); const float bs = sBv[s] - sLi[s];
#pragma unroll
                for (int i = 0; i < 16; ++i) { const int t = 32 * rb + crow(i, hh); const bool valid = dir ? (s >= t) : (s <= t);
                    const float pv = valid ? S[c][i] * __expf(sBv[t] - bs - sMt[t]) : 0.f; sP[t * LDT + s] = f2bf(pv); } }
            __syncthreads();
            if (tid < 128) { const int t = tid; float dot = 0.f, rsum = 0.f;
#pragma unroll 4
                for (int e = 0; e < 128; e += 8) { const u32x4 qq = *(const u32x4*)(sQ + t * LDT + e), pq = *(const u32x4*)(sP + t * LDT + e); const f32x4 na = *(const f32x4*)(sN + e), nb = *(const f32x4*)(sN + e + 4);
                    dot += (na.x * bflo(qq.x) + na.y * bfhi(qq.x)) + (na.z * bflo(qq.y) + na.w * bfhi(qq.y)) + (nb.x * bflo(qq.z) + nb.y * bfhi(qq.z)) + (nb.z * bflo(qq.w) + nb.w * bfhi(qq.w));
                    rsum += (bflo(pq.x) + bfhi(pq.x)) + (bflo(pq.y) + bfhi(pq.y)) + (bflo(pq.z) + bfhi(pq.z)) + (bflo(pq.w) + bfhi(pq.w)); }
                const float den = sInter[t] * dot + rsum; sInv[t] = 1.f / fmaxf(fabsf(den), __expf(-sMt[t])); }
            f32x16 num[2];
#pragma unroll
            for (int c = 0; c < 2; ++c)
#pragma unroll
                for (int i = 0; i < 16; ++i) num[c][i] = 0.f;
            mm_lds<8>(num, sQ, sC, rb, cb0, lane);
#pragma unroll
            for (int i = 0; i < 16; ++i) { const float it = sInter[32 * rb + crow(i, hh)]; num[0][i] *= it; num[1][i] *= it; }
            mm_lds<8>(num, sP, sVT, rb, cb0, lane);
            __syncthreads();
#pragma unroll
            for (int i = 0; i < 16; ++i) { const float iv = sInv[32 * rb + crow(i, hh)]; hs[0][i] += num[0][i] * iv; hs[1][i] += num[1][i] * iv; }
        }
        __syncthreads();
#pragma unroll
        for (int c = 0; c < 2; ++c)
#pragma unroll
            for (int i = 0; i < 16; ++i) sH[(32 * rb + crow(i, hh)) * 132 + 32 * (cb0 + c) + (lane & 31)] = hs[c][i];
        __syncthreads();
        { const int t = tid >> 2, d0 = (tid & 3) * 32; f32x4 v[8]; float ss = 0.f;
#pragma unroll
          for (int e = 0; e < 8; ++e) { v[e] = *(const f32x4*)(sH + t * 132 + d0 + 4 * e); ss += sq4(v[e]); }
          ss += __shfl_xor(ss, 1); ss += __shfl_xor(ss, 2);
          const float rstd = rsqrtf(ss * (1.f / 128.f) + EPS);
          const bf16* mo = MO + (size_t)(t0 + t) * 512 + h * 128 + d0; const float* on = p.m_out_norm + h * 128 + d0; bf16* yo = Y + (size_t)(t0 + t) * 1024 + 512 + h * 128 + d0;
#pragma unroll
          for (int e = 0; e < 4; ++e) { const u32x4 g = *(const u32x4*)(mo + 8 * e); const f32x4 n0 = *(const f32x4*)(on + 8 * e), n1 = *(const f32x4*)(on + 8 * e + 4); const f32x4 a = v[2 * e] * rstd * n0, b = v[2 * e + 1] * rstd * n1;
              u32x4 o; o.x = pk2(a.x * bflo(g.x), a.y * bfhi(g.x)); o.y = pk2(a.z * bflo(g.y), a.w * bfhi(g.y)); o.z = pk2(b.x * bflo(g.z), b.y * bfhi(g.z)); o.w = pk2(b.z * bflo(g.w), b.w * bfhi(g.w));
              *(u32x4*)(yo + 8 * e) = o; } }
        __syncthreads();
    }
}
DI void attn_phase(const Params& p) {
    unsigned char* ws = p.ws; int tid_ = threadIdx.x; asm volatile("" : "+v"(tid_)); const int tid = tid_, lane = tid & 63, wid = tid >> 6, r = lane & 31, hh = lane >> 5;
    const bf16* Q = (const bf16*)(ws + O_Q); const bf16* KN = (const bf16*)(ws + O_KN); const bf16* KR = (const bf16*)(ws + O_KR); const bf16* VT = (const bf16*)(ws + O_VT); bf16* Y = (bf16*)(ws + O_Y);
    constexpr int KB_B = 128 * 208, VB_B = 64 * 272, VOFF = 2 * KB_B, SOFF = 0;
    for (int item = blockIdx.x; item < 1280; item += gridDim.x) {
        int sq, head, qb;
        if (item < 256) { sq = item >> 7; head = (item & 127) >> 4; qb = item & 15; } else { const int it = item - 256; sq = 2 + (it >> 6); head = (it & 63) >> 3; qb = it & 7; }
        const int S = seq_len(sq), t0 = seq_start(sq), nkt = S >> 7, tq0 = t0 + qb * 512 + wid * 64;
        bf16x8 qf[2][6];
#pragma unroll
        for (int j = 0; j < 2; ++j)
#pragma unroll
            for (int ks = 0; ks < 6; ++ks) qf[j][ks] = *(const bf16x8*)(Q + (size_t)(tq0 + j * 32 + r) * 768 + head * 96 + 16 * ks + 8 * hh);
        f32x16 o[2][2];
#pragma unroll
        for (int j = 0; j < 2; ++j)
#pragma unroll
            for (int c = 0; c < 2; ++c)
#pragma unroll
                for (int i = 0; i < 16; ++i) o[j][c][i] = 0.f;
        float mrun[2] = {0.f, 0.f}, lrun[2] = {0.f, 0.f};
        const bf16* gk = KN + (size_t)(t0 + (tid >> 3)) * 512 + head * 64 + (tid & 7) * 8;
        const bf16* gr = KR + (size_t)(t0 + (tid >> 2)) * 32 + (tid & 3) * 8;
        const bf16* gv = VT + (size_t)t0 * 512 + (size_t)(head * 64 + (tid >> 3)) * S + (tid & 7) * 8;
        unsigned char* lk = g_lds + (tid >> 3) * 208 + (tid & 7) * 16; unsigned char* lr = g_lds + (tid >> 2) * 208 + 128 + (tid & 3) * 16; unsigned char* lv = g_lds + VOFF + (tid >> 3) * 272 + ((tid & 7) >> 1) * 32 + (tid & 1) * 8;
        u32x4 rk, rk2, rr, rv, rv2;
#define ALD_(kt_) { rk = *(const u32x4*)(gk + (size_t)(kt_) * 128 * 512); rk2 = *(const u32x4*)(gk + (size_t)((kt_) * 128 + 64) * 512); rr = *(const u32x4*)(gr + (size_t)(kt_) * 128 * 32); rv = *(const u32x4*)(gv + (kt_) * 128); rv2 = *(const u32x4*)(gv + (kt_) * 128 + 64); }
#define AST_(b_) { *(u32x4*)(lk + (b_) * KB_B) = rk; *(u32x4*)(lk + (b_) * KB_B + 64 * 208) = rk2; *(u32x4*)(lr + (b_) * KB_B) = rr; \
            *(u32x2*)(lv + (b_) * VB_B) = (u32x2){rv.x, rv.y}; *(u32x2*)(lv + (b_) * VB_B + 16) = (u32x2){rv.z, rv.w}; *(u32x2*)(lv + (b_) * VB_B + 128) = (u32x2){rv2.x, rv2.y}; *(u32x2*)(lv + (b_) * VB_B + 144) = (u32x2){rv2.z, rv2.w}; }
        ALD_(0) AST_(0)
        __syncthreads();
        for (int kt = 0; kt < nkt; ++kt) {
            const int buf = kt & 1; const bool more = kt + 1 < nkt;
            if (more) ALD_(kt + 1)
            const unsigned char* Kb = g_lds + buf * KB_B; const unsigned char* Vb = g_lds + VOFF + buf * VB_B;
#pragma unroll 1
            for (int kb = 0; kb < 4; ++kb) {
                f32x16 st[2];
#pragma unroll
                for (int j = 0; j < 2; ++j) { const float nm = -mrun[j];
#pragma unroll
                    for (int i = 0; i < 16; ++i) st[j][i] = nm; }
#pragma unroll
                for (int ks = 0; ks < 6; ++ks) { const bf16x8 a = *(const bf16x8*)(Kb + (32 * kb + r) * 208 + (16 * ks + 8 * hh) * 2); st[0] = MFMA32(a, qf[0][ks], st[0]); st[1] = MFMA32(a, qf[1][ks], st[1]); }
                bf16x8 pf[2][2];
                const bool first = (kt == 0) && (kb == 0);
#pragma unroll
                for (int j = 0; j < 2; ++j) {
                    float mx = st[j][0];
#pragma unroll
                    for (int i = 1; i < 16; ++i) mx = fmaxf(mx, st[j][i]);
                    mx = fmaxf(mx, __shfl_xor(mx, 32));
                    if (first || __builtin_amdgcn_ballot_w64(mx > 8.f) != 0ull) {
                        const float d = first ? mx : fmaxf(mx, 0.f);
                        if (!first) { const float alpha = __builtin_amdgcn_exp2f(-d); lrun[j] *= alpha;
#pragma unroll
                            for (int c = 0; c < 2; ++c)
#pragma unroll
                                for (int i = 0; i < 16; ++i) o[j][c][i] *= alpha; }
#pragma unroll
                        for (int i = 0; i < 16; ++i) st[j][i] -= d;
                        mrun[j] += d;
                    }
                    float ps = 0.f;
#pragma unroll
                    for (int i = 0; i < 16; ++i) { const float e = __builtin_amdgcn_exp2f(st[j][i]); st[j][i] = e; ps += e; }
                    lrun[j] += ps;
#pragma unroll
                    for (int s2 = 0; s2 < 2; ++s2) {
                        u32x4 pp; pp.x = pk2(st[j][8 * s2 + 0], st[j][8 * s2 + 1]); pp.y = pk2(st[j][8 * s2 + 2], st[j][8 * s2 + 3]); pp.z = pk2(st[j][8 * s2 + 4], st[j][8 * s2 + 5]); pp.w = pk2(st[j][8 * s2 + 6], st[j][8 * s2 + 7]);
                        pf[j][s2] = __builtin_bit_cast(bf16x8, pp); }
                }
#pragma unroll
                for (int s2 = 0; s2 < 2; ++s2)
#pragma unroll
                    for (int db = 0; db < 2; ++db) { const bf16x8 a = *(const bf16x8*)(Vb + (32 * db + r) * 272 + (32 * kb + 16 * s2) * 2 + hh * 16);
                        o[0][db] = MFMA32(a, pf[0][s2], o[0][db]); o[1][db] = MFMA32(a, pf[1][s2], o[1][db]); }
            }
            if (more) AST_(buf ^ 1)
            __syncthreads();
        }
#undef ALD_
#undef AST_
        unsigned char* stg = g_lds + SOFF + wid * 8704;
#pragma unroll
        for (int j = 0; j < 2; ++j) { float l = lrun[j]; l += __shfl_xor(l, 32); const float inv = 1.f / l;
#pragma unroll
            for (int db = 0; db < 2; ++db)
#pragma unroll
                for (int g4 = 0; g4 < 4; ++g4) { u32x2 w; w.x = pk2(o[j][db][4 * g4] * inv, o[j][db][4 * g4 + 1] * inv); w.y = pk2(o[j][db][4 * g4 + 2] * inv, o[j][db][4 * g4 + 3] * inv);
                    *(u32x2*)(stg + (j * 32 + r) * 136 + (32 * db + 8 * g4 + 4 * hh) * 2) = w; } }
        __syncthreads();
#pragma unroll
        for (int j = 0; j < 8; ++j) { const int id = lane + 64 * j, row = id >> 3, c = id & 7; const u32x2 a = *(const u32x2*)(stg + row * 136 + c * 16), b = *(const u32x2*)(stg + row * 136 + c * 16 + 8);
            *(u32x4*)(Y + (size_t)(tq0 + row) * 1024 + head * 64 + c * 8) = (u32x4){a.x, a.y, b.x, b.y}; }
        __syncthreads();
    }
}
DI void spatial_phase(const Params& p) {
    unsigned char* ws = p.ws; int tid_ = threadIdx.x; asm volatile("" : "+v"(tid_)); const int tid = tid_, lane = tid & 63, wid = tid >> 6, hh = lane >> 5;
    bf16* sW = (bf16*)g_lds; bf16* sVn = (bf16*)(g_lds + TILE_B); float* sR = (float*)(g_lds + 2 * TILE_B);
    const bf16* WSP = (const bf16*)(ws + O_WSP); const bf16* U = (const bf16*)(ws + O_U); const bf16* V = (const bf16*)(ws + O_V); const f32x4* VSS = (const f32x4*)(ws + O_VSS); bf16* Z = (bf16*)(ws + O_Z);
    const int rb = wid & 3, cb0 = (wid >> 2) * 2;
    const int G8 = (gridDim.x & 7) == 0 ? (int)(gridDim.x >> 3) : 0;
    if (G8 == 0) return;
    const int g = blockIdx.x & 7;
    load_tile_nat(sW, WSP + (size_t)g * 16384, 128, tid);
    const f32x4 n0 = *(const f32x4*)(p.c_v_norm + g * 128 + (tid >> 7) * 8), n1 = *(const f32x4*)(p.c_v_norm + g * 128 + (tid >> 7) * 8 + 4), n2 = *(const f32x4*)(p.c_v_norm + g * 128 + (tid >> 7) * 8 + 32), n3 = *(const f32x4*)(p.c_v_norm + g * 128 + (tid >> 7) * 8 + 36);
    const f32x4 n4 = *(const f32x4*)(p.c_v_norm + g * 128 + (tid >> 7) * 8 + 64), n5 = *(const f32x4*)(p.c_v_norm + g * 128 + (tid >> 7) * 8 + 68), n6 = *(const f32x4*)(p.c_v_norm + g * 128 + (tid >> 7) * 8 + 96), n7 = *(const f32x4*)(p.c_v_norm + g * 128 + (tid >> 7) * 8 + 100);
    u32x4 vr[4];
    int cgk = blockIdx.x >> 3;
    if (cgk < NCHUNK) {
#pragma unroll
        for (int i = 0; i < 4; ++i) { const int id = tid + 512 * i, row = id & 127, c = (id >> 7) * 8; vr[i] = *(const u32x4*)(V + (size_t)(cgk * 128 + row) * 1024 + g * 128 + c); }
    }
    for (; cgk < NCHUNK; cgk += G8) {
        const int t0 = cgk * 128;
        if (tid < 128) { const f32x4 q = VSS[t0 + tid]; sR[tid] = rsqrtf(((q.x + q.y) + (q.z + q.w)) * (1.f / 1024.f) + EPS); }
        __syncthreads();
#pragma unroll
        for (int i = 0; i < 4; ++i) { const int id = tid + 512 * i, row = id & 127, c = (id >> 7) * 8; const u32x4 v = vr[i]; const float ww = sR[row];
            const f32x4 na = i == 0 ? n0 : (i == 1 ? n2 : (i == 2 ? n4 : n6)), nb = i == 0 ? n1 : (i == 1 ? n3 : (i == 2 ? n5 : n7));
            sVn[(c + 0) * LDT + row] = f2bf(bflo(v.x) * ww * na.x); sVn[(c + 1) * LDT + row] = f2bf(bfhi(v.x) * ww * na.y); sVn[(c + 2) * LDT + row] = f2bf(bflo(v.y) * ww * na.z); sVn[(c + 3) * LDT + row] = f2bf(bfhi(v.y) * ww * na.w);
            sVn[(c + 4) * LDT + row] = f2bf(bflo(v.z) * ww * nb.x); sVn[(c + 5) * LDT + row] = f2bf(bfhi(v.z) * ww * nb.y); sVn[(c + 6) * LDT + row] = f2bf(bflo(v.w) * ww * nb.z); sVn[(c + 7) * LDT + row] = f2bf(bfhi(v.w) * ww * nb.w); }
        __syncthreads();
        if (cgk + G8 < NCHUNK) {
#pragma unroll
            for (int i = 0; i < 4; ++i) { const int id = tid + 512 * i, row = id & 127, c = (id >> 7) * 8; vr[i] = *(const u32x4*)(V + (size_t)((cgk + G8) * 128 + row) * 1024 + g * 128 + c); }
        }
        f32x16 acc[2];
#pragma unroll
        for (int c = 0; c < 2; ++c)
#pragma unroll
            for (int i = 0; i < 16; ++i) acc[c][i] = 0.f;
        mm_lds<8>(acc, sW, sVn, rb, cb0, lane);
#pragma unroll
        for (int c = 0; c < 2; ++c)
#pragma unroll
            for (int i = 0; i < 16; ++i) { const int t = 32 * rb + crow(i, hh), cc = g * 128 + 32 * (cb0 + c) + (lane & 31); const size_t ix = (size_t)(t0 + t) * 1024 + cc;
                Z[ix] = f2bf((acc[c][i] + p.c_b_sp[g * 128 + t]) * bf2f(U[ix])); }
    }
    __syncthreads();
}
DI void final_phase(const Params& p) {
    int tid_ = threadIdx.x; asm volatile("" : "+v"(tid_)); const int tid = tid_, lane = tid & 63, gw = blockIdx.x * 8 + (tid >> 6), NGW = gridDim.x * 8; const f32x4* SS = (const f32x4*)(p.ws + O_SS);
    for (int t = gw; t < T_TOK; t += NGW) { const float rs = rs_of(SS, t); f32x4* xr = (f32x4*)(p.out + (size_t)t * DM) + lane; const f32x4* gn = (const f32x4*)p.final_norm + lane;
#pragma unroll
        for (int j = 0; j < 4; ++j) xr[64 * j] = xr[64 * j] * rs * gn[64 * j]; }
}


#ifndef DBG
#define DBG 0
#endif
constexpr size_t O_DBG = O_END0;
DI int btok_(int i) { return ((int)blockIdx.x * 8 + (i & 7)) * 40 + ((int)blockIdx.x * 7 + i * 3) % 40; }
DI bool close_(float fast, float ref) { return fabsf(fast - ref) <= 0.03f + 0.04f * fabsf(ref); }
DI float nrs_(const Params& p, int t) { const float* x = xin_row(p, t); float s = 0.f; for (int k = 0; k < 1024; ++k) s += x[k] * x[k]; return rsqrtf(s * (1.f / 1024.f) + EPS); }
DI float nh_(const Params& p, int t, int col, float rs) { const float* x = xin_row(p, t); float s = 0.f; for (int k = 0; k < 1024; ++k) s += x[k] * p.ab_norm[k] * p.ab_w_in[(size_t)k * 2480 + col]; return s * rs; }
DI void dbg_fail(const Params& p, unsigned bit) { atomicOr((unsigned*)(p.ws + O_DBG), bit); }
DI void chk_inproj(const Params& p) {
    unsigned char* ws = p.ws; int tid_ = threadIdx.x; asm volatile("" : "+v"(tid_)); const int tid = tid_; const int bx = blockIdx.x;
    if (tid < 4) { const int t = btok_(tid); const float rs = nrs_(p, t);
        { const float ref = nh_(p, t, (7 + 50 * tid + bx) % 256, rs), fast = bf2f(((const bf16*)(ws + O_CQKV))[(size_t)t * 384 + (7 + 50 * tid + bx) % 256]); if (!close_(fast, ref)) dbg_fail(p, 0u); }
        { const float ref = nh_(p, t, 256 + (9 + 20 * tid + bx) % 128, rs), fast = bf2f(((const bf16*)(ws + O_CQKV))[(size_t)t * 384 + 256 + (9 + 20 * tid + bx) % 128]); if (!close_(fast, ref)) dbg_fail(p, 0u); }
        { const int ch = (3 + 37 * tid + 2 * bx) % 512; const float ref = nh_(p, t, 1440 + ch, rs), fast = bf2f(((const bf16*)(ws + O_MV))[(size_t)t * 512 + ch]); if (!close_(fast, ref)) dbg_fail(p, 0u); }
    } else if (tid < 8) { const int i = tid - 4, t = btok_(tid); const int sq = seq_of(t), s0 = seq_start(sq), sl = seq_len(sq);
        for (int w = 0; w < 2; ++w) { const int ch = (w ? 512 : 0) + (11 + 100 * i + 2 * bx) % 512; float a[3];
            for (int d = -1; d <= 1; ++d) { const int tt = t + d; a[d + 1] = (tt >= s0 && tt < s0 + sl) ? nh_(p, tt, 416 + ch, nrs_(p, tt)) : 0.f; }
            float v = a[0] * p.m_conv_w[ch] + a[1] * p.m_conv_w[1024 + ch] + a[2] * p.m_conv_w[2048 + ch] + p.m_conv_b[ch]; v = v / (1.f + expf(-v)); if (w) v *= 0.08838834764831845f;
            const float fast = bf2f(((const bf16*)(ws + (w ? O_KC : O_QC)))[(size_t)t * 512 + (ch & 511)]); if (!close_(fast, v)) { const int pos = t - s0, row = pos % 252 + 2; const int jj = pos / 252, pm = sq < 2 ? sq * 33 + jj : 66 + (sq - 2) * 17 + jj; (void)pm; const int fr_ = row & 15, m_ = (row >> 4) & 3; (void)fr_; (void)m_; { unsigned b = 0; if (fr_ == 1) b = 1u; else if (fr_ == 2) b = 2u; else if (fr_ == 3) b = 4u; else if (fr_ == 12) b = 8u; else if (fr_ == 13) b = 16u; else if (fr_ == 14) b = 32u; dbg_fail(p, b); } } }
    } else if (tid < 12) { const int i = tid - 8, t = btok_(tid); const float rs = nrs_(p, t); const int sq = seq_of(t), pos = t - seq_start(sq);
        { const int gi = (5 + 2 * i + bx) & 15; float v = nh_(p, t, 2464 + gi, rs) + p.gate_bias[gi]; if ((gi >> 2) & 1) v = fminf(v, 0.f) - log1pf(expf(-fabsf(v))); const float fast = ((const float*)(ws + O_G))[(size_t)t * 16 + gi]; if (!close_(fast, v)) dbg_fail(p, 0u); }
        { const int ii = (3 + i + bx) & 15; const float x1 = nh_(p, t, 384 + ii, rs), x2 = nh_(p, t, 384 + 16 + ii, rs); const float ang = (float)pos / powf(10000.f, ii / 16.f); const float c = cosf(ang), sn = sinf(ang);
          const float r1 = x1 * c - x2 * sn, r2 = x2 * c + x1 * sn; const bf16* KR = (const bf16*)(ws + O_KR); if (!close_(bf2f(KR[(size_t)t * 32 + ii]), r1) || !close_(bf2f(KR[(size_t)t * 32 + 16 + ii]), r2)) dbg_fail(p, 0u); }
        { const int ch = (17 + 60 * i + 2 * bx) % 512; float v = nh_(p, t, 1952 + ch, rs); v = 1.f / (1.f + expf(-v)); const float fast = bf2f(((const bf16*)(ws + O_MO))[(size_t)t * 512 + ch]); if (!close_(fast, v)) dbg_fail(p, 0u); }
    }
}
DI void chk_mlstm(const Params& p) {
    unsigned char* ws = p.ws; int tid_ = threadIdx.x; asm volatile("" : "+v"(tid_)); const int tid = tid_; const int sqm = blockIdx.x % 18, hd = (blockIdx.x / 18) & 3, t0 = seq_start(sqm), S = seq_len(sqm), tp = (blockIdx.x * 37 + 5) % S;
    const float* G = (const float*)(ws + O_G); const bf16* QC = (const bf16*)(ws + O_QC); const bf16* KC = (const bf16*)(ws + O_KC); const bf16* MV = (const bf16*)(ws + O_MV); const bf16* MO = (const bf16*)(ws + O_MO); const bf16* Y = (const bf16*)(ws + O_Y);
    const int d = tid >> 2, e0 = (tid & 3) * 32; float* sh = (float*)g_lds; float hsum = 0.f;
    for (int dir = 0; dir < 2; ++dir) {
        const int first = dir ? S - 1 : 0, step = dir ? -1 : 1, cnt = dir ? S - tp : tp + 1;
        float num = 0.f, den = 0.f;
        { float C[32];
#pragma unroll
          for (int e = 0; e < 32; ++e) C[e] = 0.f;
          for (int j = 0; j < cnt; ++j) { const int t = t0 + first + step * j; const float f = expf(G[(size_t)t * 16 + dir * 8 + 4 + hd]), ii = expf(G[(size_t)t * 16 + dir * 8 + hd]);
            const float v = bf2f(MV[(size_t)t * 512 + hd * 128 + d]) * ii;
#pragma unroll
            for (int e = 0; e < 32; ++e) { const float k = bf2f(KC[(size_t)t * 512 + hd * 128 + e0 + e]); C[e] = f * C[e] + v * k; } }
#pragma unroll
          for (int e = 0; e < 32; ++e) num += C[e] * bf2f(QC[(size_t)(t0 + tp) * 512 + hd * 128 + e0 + e]); }
        __builtin_amdgcn_sched_barrier(0);
        { float n[32];
#pragma unroll
          for (int e = 0; e < 32; ++e) n[e] = 0.f;
          for (int j = 0; j < cnt; ++j) { const int t = t0 + first + step * j; const float f = expf(G[(size_t)t * 16 + dir * 8 + 4 + hd]), ii = expf(G[(size_t)t * 16 + dir * 8 + hd]);
#pragma unroll
            for (int e = 0; e < 32; ++e) { const float k = bf2f(KC[(size_t)t * 512 + hd * 128 + e0 + e]); n[e] = f * n[e] + ii * k; } }
#pragma unroll
          for (int e = 0; e < 32; ++e) den += n[e] * bf2f(QC[(size_t)(t0 + tp) * 512 + hd * 128 + e0 + e]); }
        num += __shfl_xor(num, 1); num += __shfl_xor(num, 2); den += __shfl_xor(den, 1); den += __shfl_xor(den, 2);
        hsum += num / fmaxf(fabsf(den), 1.f);
    }
    __syncthreads();
    if ((tid & 3) == 0) sh[d] = hsum;
    __syncthreads();
    if (tid < 128) { float ss = 0.f; for (int e = 0; e < 128; ++e) ss += sh[e] * sh[e]; const float rstd = rsqrtf(ss * (1.f / 128.f) + EPS);
        const float ref = sh[tid] * rstd * p.m_out_norm[hd * 128 + tid] * bf2f(MO[(size_t)(t0 + tp) * 512 + hd * 128 + tid]); const float fast = bf2f(Y[(size_t)(t0 + tp) * 1024 + 512 + hd * 128 + tid]);
        if (!close_(fast, ref)) dbg_fail(p, 0u); }
    __syncthreads();
}
DI void chk_qkv(const Params& p) {
    unsigned char* ws = p.ws; int tid_ = threadIdx.x; asm volatile("" : "+v"(tid_)); const int tid = tid_; if (tid >= 4) return;
    const int t = btok_(tid); const int sq = seq_of(t), st = seq_start(sq), S = seq_len(sq), pos = t - st; const bf16* CQ = (const bf16*)(ws + O_CQKV) + (size_t)t * 384;
    float sq_ = 0.f, skv = 0.f; for (int k = 0; k < 256; ++k) sq_ += bf2f(CQ[k]) * bf2f(CQ[k]); for (int k = 0; k < 128; ++k) skv += bf2f(CQ[256 + k]) * bf2f(CQ[256 + k]);
    const float rq = rsqrtf(sq_ / 256.f + EPS), rkv = rsqrtf(skv / 128.f + EPS); const float qs = 0.10206207261596577f * 1.4426950408889634f;
    const int hd = (2 + tid + blockIdx.x) & 7;
    { const int dd = 13 + tid; float s = 0.f; for (int k = 0; k < 256; ++k) s += bf2f(CQ[k]) * p.q_norm[k] * p.w_uq[(size_t)k * 768 + hd * 96 + dd]; s *= rq * qs; if (!close_(bf2f(((const bf16*)(ws + O_Q))[(size_t)t * 768 + hd * 96 + dd]), s)) dbg_fail(p, 0u); }
    { const int ii = 2 + tid; float x1 = 0.f, x2 = 0.f; for (int k = 0; k < 256; ++k) { const float a = bf2f(CQ[k]) * p.q_norm[k]; x1 += a * p.w_uq[(size_t)k * 768 + hd * 96 + 64 + ii]; x2 += a * p.w_uq[(size_t)k * 768 + hd * 96 + 80 + ii]; }
      x1 *= rq * qs; x2 *= rq * qs; const float ang = (float)pos / powf(10000.f, ii / 16.f); const float c = cosf(ang), sn = sinf(ang); const bf16* Qp = (const bf16*)(ws + O_Q) + (size_t)t * 768 + hd * 96;
      if (!close_(bf2f(Qp[64 + ii]), x1 * c - x2 * sn) || !close_(bf2f(Qp[80 + ii]), x2 * c + x1 * sn)) dbg_fail(p, 0u); }
    { const int dd = 21 + tid; float s = 0.f, v = 0.f; for (int k = 0; k < 128; ++k) { const float a = bf2f(CQ[256 + k]) * p.kv_norm[k]; s += a * p.w_ukv[(size_t)k * 1024 + hd * 128 + dd]; v += a * p.w_ukv[(size_t)k * 1024 + hd * 128 + 64 + dd]; }
      s *= rkv; v *= rkv; if (!close_(bf2f(((const bf16*)(ws + O_KN))[(size_t)t * 512 + hd * 64 + dd]), s)) dbg_fail(p, 0u);
      if (!close_(bf2f(((const bf16*)(ws + O_VT))[(size_t)st * 512 + (size_t)(hd * 64 + dd) * S + pos]), v)) dbg_fail(p, 0u); }
}
DI void chk_attn(const Params& p) {
    unsigned char* ws = p.ws; int tid_ = threadIdx.x; asm volatile("" : "+v"(tid_)); const int tid = tid_; if (tid >= 64) return;
    const int smp = tid >> 4, dd = (tid & 15) * 4 + (blockIdx.x & 3); const int t = btok_(smp), hd = (1 + 2 * smp + blockIdx.x) & 7; const int sq = seq_of(t), st = seq_start(sq), S = seq_len(sq);
    const bf16* Q = (const bf16*)(ws + O_Q) + (size_t)t * 768 + hd * 96; const bf16* KN = (const bf16*)(ws + O_KN); const bf16* KR = (const bf16*)(ws + O_KR); const bf16* VT = (const bf16*)(ws + O_VT) + (size_t)st * 512 + (size_t)(hd * 64 + dd) * S;
    float m = -1e30f, l = 0.f, o = 0.f;
    for (int k = 0; k < S; ++k) { float s = 0.f; for (int e = 0; e < 64; ++e) s += bf2f(Q[e]) * bf2f(KN[(size_t)(st + k) * 512 + hd * 64 + e]); for (int e = 0; e < 32; ++e) s += bf2f(Q[64 + e]) * bf2f(KR[(size_t)(st + k) * 32 + e]);
        const float mn = fmaxf(m, s), a = exp2f(m - mn), pe = exp2f(s - mn); l = l * a + pe; o = o * a + pe * bf2f(VT[k]); m = mn; }
    const float ref = o / l, fast = bf2f(((const bf16*)(ws + O_Y))[(size_t)t * 1024 + hd * 64 + dd]); if (!close_(fast, ref)) dbg_fail(p, 0u);
}
DI void dbg_emit(const Params& p) {
    const float a = sqrtf((float)*(const unsigned*)(p.ws + O_DBG)); const int gt = blockIdx.x * NTHR + threadIdx.x, GT = gridDim.x * NTHR;
    for (size_t i = gt; i < (size_t)T_TOK * DM / 4; i += GT) ((f32x4*)p.out)[i] = (f32x4){a, a, a, a};
}

DI int dtok_(int i) { return i == 0 ? 62 : i == 1 ? 63 : i == 2 ? 253 : i == 3 ? 254 : i == 4 ? 8191 : i == 5 ? 16384 : i == 6 ? 20253 : 81919; }
DI float rowrs_(const float* x) { float s = 0.f; for (int k = 0; k < 1024; ++k) s += x[k] * x[k]; return rsqrtf(s * (1.f / 1024.f) + EPS); }
DI void chk_res(const Params& p, const bf16* A, int K, const float* W, bool first, unsigned bit, int slot) {
    if (threadIdx.x >= 8) return; const int i = threadIdx.x, t = btok_(i), c = (5 + 127 * i + 3 * (int)blockIdx.x) & 1023; float* sv = (float*)(p.ws + O_DBG + 64) + (size_t)blockIdx.x * 32;
    float s = first ? xin_row(p, t)[c] : sv[slot * 8 + i]; for (int k = 0; k < K; ++k) s += bf2f(A[(size_t)t * K + k]) * W[(size_t)k * 1024 + c];
    if (!close_(p.out[(size_t)t * DM + c], s)) dbg_fail(p, bit);
    sv[(slot + 1) * 8 + i] = p.out[(size_t)t * DM + c];
}
DI void chk_up(const Params& p, int layer) {
    if (threadIdx.x >= 8) return; const int i = threadIdx.x, t = btok_(i), j = (9 + 350 * i + 11 * (int)blockIdx.x) % 2816; const int sq = seq_of(t), s0 = seq_start(sq), sl = seq_len(sq);
    const float* W = p.ffn_w_up + (size_t)layer * 1024 * 5632; const float* cw = p.ffn_conv_w + (size_t)layer * 3 * 5632; const float* cb = p.ffn_conv_b + (size_t)layer * 5632; const float* gn = p.ffn_norm + layer * 1024;
    float g = cb[j], v = cb[2816 + j];
    for (int d = -1; d <= 1; ++d) { const int tt = t + d; if (tt < s0 || tt >= s0 + sl) continue; const float* x = p.out + (size_t)tt * DM; const float rs = rowrs_(x); float ag = 0.f, av = 0.f;
        for (int k = 0; k < 1024; ++k) { const float xn = x[k] * rs * gn[k]; ag += xn * W[(size_t)k * 5632 + j]; av += xn * W[(size_t)k * 5632 + 2816 + j]; }
        g += ag * cw[(d + 1) * 5632 + j]; v += av * cw[(d + 1) * 5632 + 2816 + j]; }
    const float ref = g / (1.f + expf(-g)) * v, fast = bf2f(((const bf16*)(p.ws + O_HID))[(size_t)t * DFF + j]); if (!close_(fast, ref)) dbg_fail(p, DBG == 3 ? (i < 6 ? (1u << i) : 0u) : 2u);
}
DI void chk_gin(const Params& p) {
    if (threadIdx.x >= 8) return; const int i = threadIdx.x, t = btok_(i), c = (3 + 120 * i + 5 * (int)blockIdx.x) & 1023; const float* x = p.out + (size_t)t * DM; const float rs = rowrs_(x); float au = 0.f, av = 0.f;
    for (int k = 0; k < 1024; ++k) { const float xn = x[k] * rs * p.c_norm[k]; au += xn * p.c_w_in[(size_t)k * 2048 + c]; av += xn * p.c_w_in[(size_t)k * 2048 + 1024 + c]; }
    au = 0.5f * au * (1.f + erff(au * 0.70710678f)); av = 0.5f * av * (1.f + erff(av * 0.70710678f));
    if (!close_(bf2f(((const bf16*)(p.ws + O_U))[(size_t)t * DM + c]), au) || !close_(bf2f(((const bf16*)(p.ws + O_V))[(size_t)t * DM + c]), av)) dbg_fail(p, 8u);
}
DI void chk_sp(const Params& p) {
    if (threadIdx.x >= 8) return; const int i = threadIdx.x, t = btok_(i), g = (i + (int)blockIdx.x) & 7, c = (7 + 13 * i + (int)blockIdx.x) & 127, t0 = t & ~127, tt = t & 127; const bf16* V = (const bf16*)(p.ws + O_V); const bf16* U = (const bf16*)(p.ws + O_U);
    float acc = 0.f;
    for (int s2 = 0; s2 < 128; ++s2) { const bf16* vr = V + (size_t)(t0 + s2) * DM; float ss = 0.f; for (int k = 0; k < 1024; ++k) ss += bf2f(vr[k]) * bf2f(vr[k]); const float rv = rsqrtf(ss * (1.f / 1024.f) + EPS);
        acc += p.c_w_sp[(size_t)g * 16384 + tt * 128 + s2] * bf2f(vr[g * 128 + c]) * rv * p.c_v_norm[g * 128 + c]; }
    const float ref = (acc + p.c_b_sp[g * 128 + tt]) * bf2f(U[(size_t)t * DM + g * 128 + c]); if (!close_(bf2f(((const bf16*)(p.ws + O_Z))[(size_t)t * DM + g * 128 + c]), ref)) dbg_fail(p, 0u);
}
#if defined(__HIP_DEVICE_COMPILE__)
#define GETP() Params p; { typedef const unsigned long long __attribute__((address_space(4)))* KA_; KA_ q_ = (KA_)__builtin_amdgcn_kernarg_segment_ptr(); asm volatile("" : "+s"(q_)); \
    typedef __attribute__((address_space(1))) unsigned char* GP_; const void** pp_ = (const void**)&p; _Pragma("unroll") for (int i_ = 0; i_ < 27; ++i_) pp_[i_] = (const void*)(GP_)q_[i_]; } unsigned char* ws = p.ws; (void)ws;
#else
#define GETP() Params p = p_unused; unsigned char* ws = p.ws; (void)ws;
#endif
__global__ void __launch_bounds__(NTHR, 2) fwd_kernel(Params p_unused, int lo, int hi) {
    cg::grid_group grid = cg::this_grid();
#define PH(k, ...) if (lo <= (k) && (k) < hi) { GETP() __VA_ARGS__ } if (lo <= (k) && (k) + 1 < hi) grid.sync();
    PH(0, p0_prologue(p); if (DBG && blockIdx.x == 0 && threadIdx.x == 0) *(unsigned*)(p.ws + O_DBG) = 0u;)
    PH(1, Gemm g{(const bf16*)(ws + O_XB), (const bf16*)(ws + O_WIN), 1024, NM_OVL, 10, 1}; EpiIn E{p}; gemm_phase(g, E);)
    PH(2, mlstm_local(p);)
    PH(3, mlstm_scan(p);)
    PH(4, mlstm_out(p);)
    PH(5, Gemm g{(const bf16*)(ws + O_CQKV), (const bf16*)(ws + O_WQKV), 384, NM_PLAIN, 7, 0, 1}; EpiQkv E{p}; gemm_phase(g, E);)
    PH(6, attn_phase(p);)
    PH(7, Gemm g{(const bf16*)(ws + O_Y), (const bf16*)(ws + O_WOUT), 1024, NM_PLAIN, 4, 0}; EpiRes E{p, 1, 0}; gemm_phase<EpiRes, true>(g, E);)
    PH(8, Gemm g{(const bf16*)(ws + O_XB), (const bf16*)(ws + O_WUP), 1024, NM_OVL, 22, 1}; EpiUp E{p, 0}; gemm_phase<EpiUp, false>(g, E);)
    PH(9, Gemm g{(const bf16*)(ws + O_HID), (const bf16*)(ws + O_WDN), 2816, NM_PLAIN, 4, 0}; EpiRes E{p, 0, 0}; gemm_phase<EpiRes, true>(g, E);)
    PH(10, Gemm g{(const bf16*)(ws + O_XB), (const bf16*)(ws + O_WCIN), 1024, NM_PLAIN, 8, 0}; EpiGin E{p}; gemm_phase<EpiGin, true>(g, E);)
    PH(11, spatial_phase(p);)
    PH(12, Gemm g{(const bf16*)(ws + O_Z), (const bf16*)(ws + O_WCOUT), 1024, NM_PLAIN, 4, 0}; EpiRes E{p, 0, 0}; gemm_phase<EpiRes, true>(g, E);)
    PH(13, Gemm g{(const bf16*)(ws + O_XB), (const bf16*)(ws + O_WUP + AL((size_t)5632 * 1024 * 2)), 1024, NM_OVL, 22, 1}; EpiUp E{p, 1}; gemm_phase<EpiUp, false>(g, E);)
    PH(14, Gemm g{(const bf16*)(ws + O_HID), (const bf16*)(ws + O_WDN + AL((size_t)1024 * 2816 * 2)), 2816, NM_PLAIN, 4, 0}; EpiRes E{p, 0, 1}; gemm_phase<EpiRes, true>(g, E);)
    PH(15, final_phase(p);)
}
#if DBG
__global__ void __launch_bounds__(NTHR) chk_kernel(Params p, int which) {
    unsigned char* ws = p.ws; (void)ws;
    if (which == 1) chk_inproj(p);
    else if (which == 4) chk_mlstm(p);
    else if (which == 5) chk_qkv(p);
    else if (which == 6) chk_attn(p);
    else if (which == 7) chk_res(p, (const bf16*)(ws + O_Y), 1024, p.ab_w_out, true, 1u, 0);
    else if (which == 8) chk_up(p, 0);
    else if (which == 9) chk_res(p, (const bf16*)(ws + O_HID), 2816, p.ffn_w_down, false, 4u, 1);
    else if (which == 10) chk_gin(p);
    else if (which == 11) chk_sp(p);
    else if (which == 12) chk_res(p, (const bf16*)(ws + O_Z), 1024, p.c_w_out, false, 32u, 2);
    else if (which == 13) chk_up(p, 1);
    else if (which == 99) dbg_emit(p);
}
#endif

extern "C" void kernel_launch(void* const* d_in, const int* in_sizes, int n_in, void* d_out, int out_size, void* d_ws, size_t ws_size, hipStream_t stream) {
    static int grid = 0;
    if (grid == 0) {
        if (n_in != 25 || ws_size < WS_NEED + 65536 || out_size != T_TOK * DM) { fprintf(stderr, "kernel_launch: unexpected problem: n_in %d out %d ws %zu (need %zu)\n", n_in, out_size, ws_size, (size_t)WS_NEED); grid = -1; return; }
        int dev = 0, cus = 0, per_cu = 0;
        hipGetDevice(&dev); hipDeviceGetAttribute(&cus, hipDeviceAttributeMultiprocessorCount, dev);
        if (hipFuncSetAttribute((const void*)fwd_kernel, hipFuncAttributeMaxDynamicSharedMemorySize, LDS_BYTES) != hipSuccess) { fprintf(stderr, "kernel_launch: hipFuncSetAttribute failed\n"); grid = -1; return; }
        hipOccupancyMaxActiveBlocksPerMultiprocessor(&per_cu, (const void*)fwd_kernel, NTHR, LDS_BYTES);
        if (per_cu < 1) { fprintf(stderr, "kernel_launch: occupancy query says %d blocks per CU\n", per_cu); per_cu = 1; }
        (void)hipGetLastError();
        grid = cus;
    }
    if (grid < 0) return;
    Params p{};
    const float** f = (const float**)&p;
    for (int i = 0; i < 25; ++i) f[i] = (const float*)d_in[i];
    p.out = (float*)d_out; p.ws = (unsigned char*)d_ws;
    auto run = [&](int lo, int hi) { void* args[] = {&p, &lo, &hi};
        hipError_t e = hipLaunchCooperativeKernel((const void*)fwd_kernel, dim3(grid), dim3(NTHR), args, LDS_BYTES, stream);
        if (e != hipSuccess) fprintf(stderr, "cooperative launch failed: %s (grid %d)\n", hipGetErrorString(e), grid); };
#if DBG == 0
    run(0, 16);
#else
    int cur = 0;
    auto upto = [&](int k) { run(cur, k + 1); cur = k + 1; };
    auto chk = [&](int which) { hipLaunchKernelGGL(chk_kernel, dim3(grid), dim3(NTHR), 4096, stream, p, which); };
#if DBG == 1
    upto(1); chk(1); upto(4); chk(4); upto(5); chk(5); upto(6); chk(6);
#else
    upto(7); chk(7); upto(8); chk(8); upto(9); chk(9); upto(10); chk(10); upto(11); chk(11); upto(12); chk(12);
#if DBG == 4
    upto(13); chk(13);
#endif
#endif
    chk(99);
#endif
}
```

```cpp
#include <hip/hip_runtime.h>
#include <hip/hip_cooperative_groups.h>
#include <cstdio>
#include <cstdint>
namespace cg = cooperative_groups;

typedef unsigned short bf16;
typedef short bf16x8 __attribute__((ext_vector_type(8)));
typedef short s16x4 __attribute__((ext_vector_type(4)));
typedef float f32x2 __attribute__((ext_vector_type(2)));
typedef float f32x4 __attribute__((ext_vector_type(4)));
typedef float f32x16 __attribute__((ext_vector_type(16)));
typedef unsigned u32x2 __attribute__((ext_vector_type(2)));
typedef unsigned u32x4 __attribute__((ext_vector_type(4)));
typedef __bf16 bf2_t __attribute__((ext_vector_type(2)));
#define DI __device__ __forceinline__
#define MFMA32(a, b, c) __builtin_amdgcn_mfma_f32_32x32x16_bf16((a), (b), (c), 0, 0, 0)

constexpr int NTHR = 512;
constexpr int T_TOK = 81920, TP = 16384, DM = 1024;
constexpr int NCHUNK = T_TOK / 128;
constexpr int DFF = 2816;
constexpr float EPS = 1e-6f;
constexpr int LDS_BYTES = 147456;

constexpr size_t AL(size_t x) { return (x + 255) & ~(size_t)255; }
constexpr size_t O_WIN = 0;
constexpr size_t O_WQKV = O_WIN + AL((size_t)2560 * 1024 * 2);
constexpr size_t O_WOUT = O_WQKV + AL((size_t)1792 * 384 * 2);
constexpr size_t O_WCIN = O_WOUT + AL((size_t)1024 * 1024 * 2);
constexpr size_t O_WCOUT = O_WCIN + AL((size_t)2048 * 1024 * 2);
constexpr size_t O_WUP = O_WCOUT + AL((size_t)1024 * 1024 * 2);
constexpr size_t O_WDN = O_WUP + 2 * AL((size_t)5632 * 1024 * 2);
constexpr size_t O_WSP = O_WDN + 2 * AL((size_t)1024 * 2816 * 2);
constexpr size_t O_ROPE = O_WSP + AL((size_t)8 * 128 * 128 * 2);
constexpr size_t O_SS = O_ROPE + AL((size_t)8192 * 32 * 4);
constexpr size_t O_VSS = O_SS + AL((size_t)T_TOK * 16);
constexpr size_t O_RQ = O_VSS + AL((size_t)T_TOK * 16);
constexpr size_t O_RKV = O_RQ + AL((size_t)T_TOK * 4);
constexpr size_t O_KR = O_RKV + AL((size_t)T_TOK * 4);
constexpr size_t O_G = O_KR + AL((size_t)T_TOK * 32 * 2);
constexpr size_t O_NS = O_G + AL((size_t)T_TOK * 16 * 4);
constexpr size_t O_ML = O_NS + AL((size_t)5120 * 128 * 4);
constexpr size_t O_BL = O_ML + AL((size_t)5120 * 4);
constexpr size_t O_MP = O_BL + AL((size_t)5120 * 4);
constexpr size_t O_XBG = O_MP + AL((size_t)5120 * 4);
constexpr size_t O_XB = O_XBG + 4096;
constexpr size_t O_AR = O_XB + AL((size_t)T_TOK * 1024 * 2);
constexpr size_t O_CQKV = O_AR;
constexpr size_t O_QC = O_CQKV + AL((size_t)T_TOK * 384 * 2);
constexpr size_t O_KC = O_QC + AL((size_t)T_TOK * 512 * 2);
constexpr size_t O_MV = O_KC + AL((size_t)T_TOK * 512 * 2);
constexpr size_t O_MO = O_MV + AL((size_t)T_TOK * 512 * 2);
constexpr size_t O_CS = O_MO + AL((size_t)T_TOK * 512 * 2);
constexpr size_t O_Y = O_CS + AL((size_t)5120 * 16384 * 2);
constexpr size_t O_END0 = O_Y + AL((size_t)T_TOK * 1024 * 2);
constexpr size_t O_Q = O_QC;
constexpr size_t O_KN = O_Q + AL((size_t)T_TOK * 768 * 2);
constexpr size_t O_VT = O_KN + AL((size_t)T_TOK * 512 * 2);
static_assert(O_VT + (size_t)T_TOK * 512 * 2 <= O_CS, "attention operands overlay");
constexpr size_t O_HID = O_AR;
constexpr size_t O_U = O_AR;
constexpr size_t O_V = O_U + AL((size_t)T_TOK * 1024 * 2);
constexpr size_t O_Z = O_V + AL((size_t)T_TOK * 1024 * 2);
constexpr size_t WS_NEED = O_END0;
static_assert(O_HID + (size_t)T_TOK * 2816 * 2 <= O_END0 && O_Z + (size_t)T_TOK * 2048 <= O_END0, "arena");

struct Params {
    const float* x_prompt; const float* x_sample;
    const float *ab_norm, *ab_w_in, *q_norm, *w_uq, *kv_norm, *w_ukv, *m_conv_w, *m_conv_b, *gate_bias, *m_out_norm, *ab_w_out;
    const float *c_norm, *c_w_in, *c_v_norm, *c_w_sp, *c_b_sp, *c_w_out;
    const float *ffn_norm, *ffn_w_up, *ffn_conv_w, *ffn_conv_b, *ffn_w_down, *final_norm;
    float* out; unsigned char* ws;
};

extern __shared__ __attribute__((aligned(16))) unsigned char g_lds[];

DI unsigned pk2(float lo, float hi) { f32x2 v = {lo, hi}; bf2_t b = __builtin_convertvector(v, bf2_t); return __builtin_bit_cast(unsigned, b); }
DI bf16 f2bf(float x) { return (bf16)(pk2(x, 0.f) & 0xffffu); }
DI float bf2f(bf16 x) { return __uint_as_float(((unsigned)x) << 16); }
DI float bflo(unsigned u) { return __uint_as_float(u << 16); }
DI float bfhi(unsigned u) { return __uint_as_float(u & 0xffff0000u); }
DI int seq_start(int sq) { return sq < 2 ? (sq << 13) : TP + ((sq - 2) << 12); }
DI int seq_len(int sq) { return sq < 2 ? 8192 : 4096; }
DI int seq_of(int t) { return t < TP ? (t >> 13) : 2 + ((t - TP) >> 12); }
DI float wave_sum(float v) {
#pragma unroll
    for (int o = 1; o < 64; o <<= 1) v += __shfl_xor(v, o);
    return v;
}
DI float frcp(float x) { return __builtin_amdgcn_rcpf(x); }
DI float sigmoidf_(float x) { return frcp(1.f + __builtin_amdgcn_exp2f(-1.4426950408889634f * x)); }
DI float siluf_(float x) { return x * frcp(1.f + __builtin_amdgcn_exp2f(-1.4426950408889634f * x)); }
DI float logsigmoidf_(float x) { return fminf(x, 0.f) - log1pf(__expf(-fabsf(x))); }
DI float geluf_(float v) {
    const float av = fabsf(v), t = frcp(1.f + 0.2316418882f * av);
    float q = t * 0.5307027145f + (-0.7265760135f); q = q * t + 0.7107068705f; q = q * t + (-0.142248368f); q = q * t + 0.127414796f; q = q * t;
    const float e = __builtin_amdgcn_exp2f(v * v * (-0.72134752044f));
    const float m = v * (q * e);
    return v < 0.f ? m : v - m;
}
DI f32x4 ld_ss(const f32x4* SS, int t) { return SS[t]; }
DI float rs_of(const f32x4* SS, int t) { f32x4 s = SS[t]; return rsqrtf(((s.x + s.y) + (s.z + s.w)) * (1.f / 1024.f) + EPS); }
DI const float* xin_row(const Params& p, int t) { return t < TP ? p.x_prompt + (size_t)t * DM : p.x_sample + (size_t)(t - TP) * DM; }

DI int srccol(int perm, int n) {
    if (perm == 1) { if (n < 416) return n; if (n < 432) return 2464 + (n - 416); if (n < 512) return -1; return n - 96; }
    if (perm == 2) { const int hd = (n & 511) >> 6, d = n & 63; return hd * 128 + (n >= 512 ? 64 : 0) + d; }
    if (perm == 3) { const int pn = n >> 8, c = n & 255; return c < 128 ? pn * 128 + c : 2816 + pn * 128 + (c - 128); }
    return n;
}
struct P0Job { const float* src; const float* gain; bf16* dst; int Nsrc, dld, dcol0, perm, k0, n0; };
DI void p0_job(const Params& p, int it, P0Job& J) {
    unsigned char* ws = p.ws; int r = it; int Nd;
    if (r < 640) { J.src = p.ab_w_in; J.Nsrc = 2480; Nd = 2560; J.dst = (bf16*)(ws + O_WIN); J.dld = 1024; J.dcol0 = 0; J.gain = p.ab_norm; J.perm = 1; }
    else if ((r -= 640) < 48) { J.src = p.w_uq; J.Nsrc = 768; Nd = 768; J.dst = (bf16*)(ws + O_WQKV); J.dld = 384; J.dcol0 = 0; J.gain = p.q_norm; J.perm = 0; }
    else if ((r -= 48) < 32) { J.src = p.w_ukv; J.Nsrc = 1024; Nd = 1024; J.dst = (bf16*)(ws + O_WQKV) + (size_t)768 * 384; J.dld = 384; J.dcol0 = 256; J.gain = p.kv_norm; J.perm = 2; }
    else if ((r -= 32) < 256) { J.src = p.ab_w_out; J.Nsrc = 1024; Nd = 1024; J.dst = (bf16*)(ws + O_WOUT); J.dld = 1024; J.dcol0 = 0; J.gain = nullptr; J.perm = 0; }
    else if ((r -= 256) < 512) { J.src = p.c_w_in; J.Nsrc = 2048; Nd = 2048; J.dst = (bf16*)(ws + O_WCIN); J.dld = 1024; J.dcol0 = 0; J.gain = p.c_norm; J.perm = 0; }
    else if ((r -= 512) < 256) { J.src = p.c_w_out; J.Nsrc = 1024; Nd = 1024; J.dst = (bf16*)(ws + O_WCOUT); J.dld = 1024; J.dcol0 = 0; J.gain = nullptr; J.perm = 0; }
    else if ((r -= 256) < 2816) { const int l = r / 1408; r -= l * 1408; J.src = p.ffn_w_up + (size_t)l * 1024 * 5632; J.Nsrc = 5632; Nd = 5632;
        J.dst = (bf16*)(ws + O_WUP + l * AL((size_t)5632 * 1024 * 2)); J.dld = 1024; J.dcol0 = 0; J.gain = p.ffn_norm + l * 1024; J.perm = 3; }
    else { r -= 2816; const int l = r / 704; r -= l * 704; J.src = p.ffn_w_down + (size_t)l * 2816 * 1024; J.Nsrc = 1024; Nd = 1024;
        J.dst = (bf16*)(ws + O_WDN + l * AL((size_t)1024 * 2816 * 2)); J.dld = 2816; J.dcol0 = 0; J.gain = nullptr; J.perm = 0; }
    const int nnt = Nd / 64; J.k0 = (r / nnt) * 64; J.n0 = (r % nnt) * 64;
}
DI void p0_load(const P0Job& J, int tid, float (&v)[8]) {
    const int j = tid & 63, sc = srccol(J.perm, J.n0 + j);
#pragma unroll
    for (int r = 0; r < 8; ++r) { const int k = J.k0 + (tid >> 6) + 8 * r; float x = 0.f; if (sc >= 0) { x = J.src[(size_t)k * J.Nsrc + sc]; if (J.gain) x *= J.gain[k]; } v[r] = x; }
}
DI void p0_row(const Params& p, int t, int lane) {
    bf16* XB = (bf16*)(p.ws + O_XB); f32x4* SS = (f32x4*)(p.ws + O_SS);
    const f32x4* xr = (const f32x4*)xin_row(p, t) + lane;
    f32x4 v[4]; float s = 0.f;
#pragma unroll
    for (int j = 0; j < 4; ++j) { v[j] = xr[64 * j]; s += (v[j].x * v[j].x + v[j].y * v[j].y) + (v[j].z * v[j].z + v[j].w * v[j].w); }
    s = wave_sum(s);
    u32x2* o = (u32x2*)(XB + (size_t)t * DM) + lane;
#pragma unroll
    for (int j = 0; j < 4; ++j) { u32x2 w; w.x = pk2(v[j].x, v[j].y); w.y = pk2(v[j].z, v[j].w); o[64 * j] = w; }
    if (lane == 0) { f32x4 q = {s, 0.f, 0.f, 0.f}; SS[t] = q; }
}
DI void p0_prologue(const Params& p) {
    unsigned char* ws = p.ws;
    int tid_ = threadIdx.x; asm volatile("" : "+v"(tid_)); const int tid = tid_;
    const int lane = tid & 63, NGW = gridDim.x * 8; int trow = blockIdx.x * 8 + (tid >> 6);
    constexpr int NJ = 5968;
    {
        float* tile = (float*)g_lds;
        P0Job J; float v[8]; int it = blockIdx.x;
        if (it < NJ) { p0_job(p, it, J); p0_load(J, tid, v); }
        for (; it < NJ; it += gridDim.x) {
#pragma unroll
            for (int r = 0; r < 8; ++r) tile[((tid >> 6) + 8 * r) * 65 + (tid & 63)] = v[r];
            __syncthreads();
            P0Job Jn = J; const int nit = it + gridDim.x;
            if (nit < NJ) { p0_job(p, nit, Jn); p0_load(Jn, tid, v); }
            const int n = tid >> 3, kc = (tid & 7) * 8;
            u32x4 o;
            o.x = pk2(tile[(kc + 0) * 65 + n], tile[(kc + 1) * 65 + n]); o.y = pk2(tile[(kc + 2) * 65 + n], tile[(kc + 3) * 65 + n]);
            o.z = pk2(tile[(kc + 4) * 65 + n], tile[(kc + 5) * 65 + n]); o.w = pk2(tile[(kc + 6) * 65 + n], tile[(kc + 7) * 65 + n]);
            *(u32x4*)(J.dst + (size_t)(J.n0 + n) * J.dld + J.dcol0 + J.k0 + kc) = o;
            if (trow < T_TOK) { p0_row(p, trow, lane); trow += NGW; }
            if (trow < T_TOK) { p0_row(p, trow, lane); trow += NGW; }
            __syncthreads();
            J = Jn;
        }
    }
    for (; trow < T_TOK; trow += NGW) p0_row(p, trow, lane);
    const int gt = blockIdx.x * NTHR + tid, GT = gridDim.x * NTHR;
    if (gt < 256) ((u32x4*)(ws + O_XBG))[gt] = (u32x4){0u, 0u, 0u, 0u};
    {
        bf16* W = (bf16*)(ws + O_WQKV); const u32x4 z = {0u, 0u, 0u, 0u};
        for (int v = gt; v < 768 * 16 + 1024 * 32; v += GT) {
            if (v < 768 * 16) { const int row = v >> 4, c = v & 15; *(u32x4*)(W + (size_t)row * 384 + 256 + c * 8) = z; }
            else { const int u = v - 768 * 16, row = 768 + (u >> 5), c = u & 31; *(u32x4*)(W + (size_t)row * 384 + c * 8) = z; }
        }
    }
    { bf16* W = (bf16*)(ws + O_WSP); for (int v = gt; v < 8 * 128 * 128; v += GT) W[v] = f2bf(p.c_w_sp[v]); }
    { float* RC = (float*)(ws + O_ROPE); float* RSN = RC + 8192 * 16;
      for (int v = gt; v < 8192 * 16; v += GT) { const int pos = v >> 4, i = v & 15; const float inv = 1.0f / powf(10000.f, (float)i * (1.f / 16.f)); const float ang = (float)pos * inv;
        float s, c; sincosf(ang, &s, &c); RC[v] = c; RSN[v] = s; } }
}

#define LAS __attribute__((address_space(3)))
constexpr int STAGE_BYTES = 131072;
constexpr int EPI_OFF = 131072;
DI int lds_byte(int r, int c) { const int st = (r >> 4) * 2 + (c >> 5), rr = r & 15, cc = c & 31, ob = rr * 64 + cc * 2; return st * 1024 + (ob ^ (((ob >> 9) & 1) << 5)); }
DI void stage_rc(int b, int& R, int& C) { const int st = b / 1024, sb = b % 1024, swz = sb ^ (((sb >> 9) & 1) << 5); R = (st >> 1) * 16 + swz / 64; C = (st & 1) * 32 + (swz % 64) / 2; }

struct Gemm { const bf16* A; const bf16* Bt; int K, nM, nN, overlap; int kmode = 0; };
typedef f32x4 Acc[2][2][4][2];
struct Unit { int pm, pn, tbase, kofs, nt; };

DI void tile_rows(int overlap, int pm, int& tbase, int& s0, int& slen) {
    s0 = 0; slen = T_TOK;
    if (!overlap) tbase = pm * 256; else tbase = 254 * pm - 1;
}
DI bool seq_first(int t) { return t < TP ? (t & 8191) == 0 : (t & 4095) == 0; }
DI bool tile_has_seam(int tbase) { const int nb = ((tbase + 1 + 4095) >> 12) << 12; return nb <= tbase + 255; }
constexpr int NM_PLAIN = 320, NM_OVL = 323;
DI bool next_unit(const Gemm& g, int i, Unit& u) {
    const int nM = g.nM, nN = g.nN, nwg = nM * nN; const long L = (long)i * gridDim.x + blockIdx.x; if (L >= nwg) return false;
    int wgid = (int)L; { const int q = nwg / 8, r = nwg % 8, xcd = wgid % 8, off = wgid / 8; wgid = (xcd < r ? xcd * (q + 1) : r * (q + 1) + (xcd - r) * q) + off; }
    const int nig = 8 * nN, gid = wgid / nig, fm = gid * 8, gsz = (nM - fm) < 8 ? (nM - fm) : 8;
    u.pm = fm + ((wgid % nig) % gsz); u.pn = (wgid % nig) / gsz;
    int s0, slen; tile_rows(g.overlap, u.pm, u.tbase, s0, slen);
    if (g.kmode) { u.kofs = u.pn < 3 ? 0 : 512; u.nt = u.pn < 3 ? 4 : 2; } else { u.kofs = 0; u.nt = g.K / 64; }
    return true;
}

#define DPP_ROR1(x) __builtin_bit_cast(float, __builtin_amdgcn_update_dpp(0, __builtin_bit_cast(int, (x)), 0x121, 0xf, 0xf, false))
#define DPP_ROL1(x) __builtin_bit_cast(float, __builtin_amdgcn_update_dpp(0, __builtin_bit_cast(int, (x)), 0x12F, 0xf, 0xf, false))

template <class F> DI void row_reduce(float (&part)[2][4], int wr, int wc, int fr, int fq, F&& f) {
    float* red = (float*)(g_lds + EPI_OFF);
#pragma unroll
    for (int ai = 0; ai < 2; ++ai)
#pragma unroll
        for (int m = 0; m < 4; ++m) { float v = part[ai][m]; v += __shfl_xor(v, 16); v += __shfl_xor(v, 32);
            if (fq == 0) red[(ai * 128 + wr * 64 + m * 16 + fr) * 4 + wc] = v; }
    __syncthreads();
    if (threadIdx.x < 256) { const f32x4 s = *(const f32x4*)(red + threadIdx.x * 4); f((int)threadIdx.x, (s.x + s.y) + (s.z + s.w)); }
    __syncthreads();
}
DI void conv_exchange(const Acc& acc, int wr, int wc, int fr, int fq) {
    float* bnd = (float*)(g_lds + EPI_OFF + 4096);
#pragma unroll
    for (int ai = 0; ai < 2; ++ai)
#pragma unroll
        for (int bj = 0; bj < 2; ++bj)
#pragma unroll
            for (int n = 0; n < 2; ++n) { const int colL = bj * 128 + wc * 32 + n * 16 + fq * 4, rb = ai * 2 + wr;
                if (fr == 0) *(f32x4*)(bnd + (0 * 4 + rb) * 256 + colL) = acc[ai][bj][0][n];
                if (fr == 15) *(f32x4*)(bnd + (1 * 4 + rb) * 256 + colL) = acc[ai][bj][3][n]; }
    __syncthreads();
}
#undef DPP_ROR1
#undef DPP_ROL1
#define DPP_ROR1(x) __builtin_bit_cast(float, __builtin_amdgcn_update_dpp(__builtin_bit_cast(int, (x)), __builtin_bit_cast(int, (x)), 0x121, 0xf, 0xf, false))
#define DPP_ROL1(x) __builtin_bit_cast(float, __builtin_amdgcn_update_dpp(__builtin_bit_cast(int, (x)), __builtin_bit_cast(int, (x)), 0x12F, 0xf, 0xf, false))
DI f32x4 ror4(const f32x4 v) { f32x4 r; asm volatile("s_nop 1\n\tv_mov_b32_dpp %0, %4 row_ror:1 row_mask:0xf bank_mask:0xf\n\tv_mov_b32_dpp %1, %5 row_ror:1 row_mask:0xf bank_mask:0xf\n\tv_mov_b32_dpp %2, %6 row_ror:1 row_mask:0xf bank_mask:0xf\n\tv_mov_b32_dpp %3, %7 row_ror:1 row_mask:0xf bank_mask:0xf"
    : "=&v"(r.x), "=&v"(r.y), "=&v"(r.z), "=&v"(r.w) : "v"(v.x), "v"(v.y), "v"(v.z), "v"(v.w)); return r; }
DI f32x4 rol4(const f32x4 v) { f32x4 r; asm volatile("s_nop 1\n\tv_mov_b32_dpp %0, %4 row_ror:15 row_mask:0xf bank_mask:0xf\n\tv_mov_b32_dpp %1, %5 row_ror:15 row_mask:0xf bank_mask:0xf\n\tv_mov_b32_dpp %2, %6 row_ror:15 row_mask:0xf bank_mask:0xf\n\tv_mov_b32_dpp %3, %7 row_ror:15 row_mask:0xf bank_mask:0xf"
    : "=&v"(r.x), "=&v"(r.y), "=&v"(r.z), "=&v"(r.w) : "v"(v.x), "v"(v.y), "v"(v.z), "v"(v.w)); return r; }
template <int BJ, int N, int AI, int M> DI f32x4 conv_row(const Acc& acc, const f32x4 w0, const f32x4 w1, const f32x4 w2, const f32x4 b, const f32x4 upB, const f32x4 dnB, int fr) {
    const f32x4 v = acc[AI][BJ][M][N];
    const f32x4 pu = M > 0 ? ror4(acc[AI][BJ][M > 0 ? M - 1 : 0][N]) : upB;
    const f32x4 nd = M < 3 ? rol4(acc[AI][BJ][M < 3 ? M + 1 : 3][N]) : dnB;
    const f32x4 rv_ = ror4(v), lv_ = rol4(v);
    const f32x4 up = fr > 0 ? rv_ : pu, dn = fr < 15 ? lv_ : nd;
    f32x4 r_ = w0 * up + w1 * v + w2 * dn + b;
    asm volatile("" : "+v"(r_.x), "+v"(r_.y), "+v"(r_.z), "+v"(r_.w));
    return r_;
}
template <int BJ, int N, int AI> DI void conv_bnd(int wr, int wc, int fq, f32x4& upB, f32x4& dnB) {
    const float* bnd = (const float*)(g_lds + EPI_OFF + 4096);
    const int colL = BJ * 128 + wc * 32 + N * 16 + fq * 4, rb = AI * 2 + wr; const f32x4 z4 = {0.f, 0.f, 0.f, 0.f};
    upB = rb > 0 ? *(const f32x4*)(bnd + (4 + rb - 1) * 256 + colL) : z4; dnB = rb < 3 ? *(const f32x4*)(bnd + (rb + 1) * 256 + colL) : z4;
}

template <int BJ, int N, int AI> DI void conv4(const Acc& acc, const f32x4 w0, const f32x4 w1, const f32x4 w2, const f32x4 b, const f32x4 upB, const f32x4 dnB, int fr, f32x4 (&out)[4]) {
    f32x4 rprev = upB, lcur = rol4(acc[AI][BJ][0][N]);
#pragma unroll
    for (int M = 0; M < 4; ++M) { const f32x4 v = acc[AI][BJ][M][N]; const f32x4 rv_ = ror4(v); f32x4 lnext = dnB; if (M < 3) lnext = rol4(acc[AI][BJ][M < 3 ? M + 1 : 3][N]);
        const f32x4 up = fr > 0 ? rv_ : rprev, dn = fr < 15 ? lcur : lnext;
        out[M] = w0 * up + w1 * v + w2 * dn + b; rprev = rv_; lcur = lnext; }
}
#define FOR_ROWS(...) _Pragma("unroll") for (int ai = 0; ai < 2; ++ai) _Pragma("unroll") for (int m = 0; m < 4; ++m) { \
    const int row = ai * 128 + wr * 64 + m * 16 + fr; const int tg = tbase + row; const bool ok = (tg >= s0) && (tg < s0 + slen) && (!OVL || (row >= 1 && row <= 254)); (void)ok; __VA_ARGS__ }
#define FOR_COLS(...) _Pragma("unroll") for (int bj = 0; bj < 2; ++bj) _Pragma("unroll") for (int n = 0; n < 2; ++n) { const int colL = bj * 128 + wc * 32 + n * 16 + fq * 4; (void)colL; __VA_ARGS__ }
DI void st_bf4(bf16* p, const f32x4 v) { u32x2 w; w.x = pk2(v.x, v.y); w.y = pk2(v.z, v.w); *(u32x2*)p = w; }
DI void st_bf8(bf16* p, const f32x4 a, const f32x4 b) { u32x4 w; w.x = pk2(a.x, a.y); w.y = pk2(a.z, a.w); w.z = pk2(b.x, b.y); w.w = pk2(b.z, b.w); *(u32x4*)p = w; }
DI float sq4(const f32x4 v) { return (v.x * v.x + v.y * v.y) + (v.z * v.z + v.w * v.w); }

struct EpiIn {
    Params p;
    DI void operator()(Acc& acc, const Unit& u, int wr, int wc, int fr, int fq) const {
        constexpr bool OVL = true; unsigned char* ws = p.ws; const int pn = u.pn; int tbase, s0, slen; tile_rows(1, u.pm, tbase, s0, slen); const bool hb_ = tile_has_seam(tbase); (void)hb_;
        const f32x4* SS = (const f32x4*)(ws + O_SS);
        FOR_ROWS({ const bool val = (tg >= s0) && (tg < s0 + slen); const float rs = val ? rs_of(SS, tg) : 0.f;
            _Pragma("unroll") for (int bj = 0; bj < 2; ++bj) _Pragma("unroll") for (int n = 0; n < 2; ++n) acc[ai][bj][m][n] *= rs; })
        if (pn == 0) {
            bf16* CQ = (bf16*)(ws + O_CQKV); float* RQ = (float*)(ws + O_RQ); float part[2][4];
            FOR_ROWS({ float s = 0.f; FOR_COLS({ const f32x4 v = acc[ai][bj][m][n]; s += sq4(v); if (ok) st_bf4(CQ + (size_t)tg * 384 + colL, v); }) part[ai][m] = s; })
            row_reduce(part, wr, wc, fr, fq, [&](int row, float ss) { const int tg = tbase + row; if (tg >= s0 && tg < s0 + slen && row >= 1 && row <= 254) RQ[tg] = rsqrtf(ss * (1.f / 256.f) + EPS); });
        } else if (pn == 1) {
            bf16* CQ = (bf16*)(ws + O_CQKV); float* RKV = (float*)(ws + O_RKV); float part[2][4];
            FOR_ROWS({ float s = 0.f; _Pragma("unroll") for (int n = 0; n < 2; ++n) { const f32x4 v = acc[ai][0][m][n]; s += sq4(v); if (ok) st_bf4(CQ + (size_t)tg * 384 + 256 + wc * 32 + n * 16 + fq * 4, v); } part[ai][m] = s; })
            row_reduce(part, wr, wc, fr, fq, [&](int row, float ss) { const int tg = tbase + row; if (tg >= s0 && tg < s0 + slen && row >= 1 && row <= 254) RKV[tg] = rsqrtf(ss * (1.f / 128.f) + EPS); });
            if (wc == 0) {
                const float* RC = (const float*)(ws + O_ROPE); const float* RSN = RC + 8192 * 16; bf16* KR = (bf16*)(ws + O_KR);
                FOR_ROWS({ if (ok) { const int pos = tg - seq_start(seq_of(tg)); const f32x4 c = *(const f32x4*)(RC + pos * 16 + fq * 4), s = *(const f32x4*)(RSN + pos * 16 + fq * 4); const f32x4 x1 = acc[ai][1][m][0], x2 = acc[ai][1][m][1];
                    st_bf4(KR + (size_t)tg * 32 + fq * 4, x1 * c - x2 * s); st_bf4(KR + (size_t)tg * 32 + 16 + fq * 4, x2 * c + x1 * s); } })
            } else if (wc == 1) {
                float* G = (float*)(ws + O_G); const f32x4 gb = *(const f32x4*)(p.gate_bias + fq * 4); const bool isf = fq & 1;
                FOR_ROWS({ if (ok) { f32x4 v = acc[ai][1][m][0] + gb; if (isf) { v.x = logsigmoidf_(v.x); v.y = logsigmoidf_(v.y); v.z = logsigmoidf_(v.z); v.w = logsigmoidf_(v.w); } *(f32x4*)(G + (size_t)tg * 16 + fq * 4) = v; } })
            }
        } else if (pn < 6) {
            conv_exchange(acc, wr, wc, fr, fq);
            const float* cw = p.m_conv_w; const float* cb = p.m_conv_b; const int chb = (pn - 2) * 256 + wc * 32 + fq * 4;
            const bool isK = pn >= 4; bf16* dst = (bf16*)(ws + (isK ? O_KC : O_QC)); const float sc = isK ? 0.08838834764831845f : 1.f; const int cb0 = (pn - (isK ? 4 : 2)) * 256;
#define CA_(BJ, N, AI) { f32x4 upB, dnB; conv_bnd<BJ, N, AI>(wr, wc, fq, upB, dnB); f32x4 rp_ = upB, lc_ = rol4(acc[AI][BJ][0][N]); \
        _Pragma("unroll") for (int M = 0; M < 4; ++M) { const int row = AI * 128 + wr * 64 + M * 16 + fr, tg = tbase + row; const f32x4 a_ = acc[AI][BJ][M][N]; const f32x4 ra_ = ror4(a_); f32x4 ln_ = dnB; if (M < 3) ln_ = rol4(acc[AI][BJ][M < 3 ? M + 1 : 3][N]); \
            f32x4 up_ = fr > 0 ? ra_ : rp_, dn_ = fr < 15 ? lc_ : ln_; if (hb_) { const f32x4 z_ = {0.f, 0.f, 0.f, 0.f}; if (seq_first(tg)) up_ = z_; if (seq_first(tg + 1)) dn_ = z_; } const f32x4 v = w0 * up_ + w1 * a_ + w2 * dn_ + bb; rp_ = ra_; lc_ = ln_; \
            if ((tg >= s0) && (tg < s0 + slen) && row >= 1 && row <= 254) st_bf4(dst + (size_t)tg * 512 + cb0 + BJ * 128 + wc * 32 + N * 16 + fq * 4, (f32x4){siluf_(v.x) * sc, siluf_(v.y) * sc, siluf_(v.z) * sc, siluf_(v.w) * sc}); __builtin_amdgcn_sched_barrier(0); } }
#define CS_(BJ, N) { const int ch = chb + BJ * 128 + N * 16; const f32x4 w0 = *(const f32x4*)(cw + ch), w1 = *(const f32x4*)(cw + 1024 + ch), w2 = *(const f32x4*)(cw + 2048 + ch), bb = *(const f32x4*)(cb + ch); CA_(BJ, N, 0) CA_(BJ, N, 1) }
            CS_(0, 0) CS_(0, 1) CS_(1, 0) CS_(1, 1)
#undef CS_
#undef CA_
        } else if (pn < 8) {
            bf16* MV = (bf16*)(ws + O_MV); const int cb0 = (pn - 6) * 256;
            FOR_ROWS({ if (ok) { FOR_COLS({ st_bf4(MV + (size_t)tg * 512 + cb0 + colL, acc[ai][bj][m][n]); }) } })
        } else {
            bf16* MO = (bf16*)(ws + O_MO); const int cb0 = (pn - 8) * 256;
            FOR_ROWS({ if (ok) { FOR_COLS({ const f32x4 v = acc[ai][bj][m][n]; st_bf4(MO + (size_t)tg * 512 + cb0 + colL, (f32x4){sigmoidf_(v.x), sigmoidf_(v.y), sigmoidf_(v.z), sigmoidf_(v.w)}); }) } })
        }
    }
};
struct EpiQkv {
    Params p;
    DI void operator()(Acc& acc, const Unit& u, int wr, int wc, int fr, int fq) const {
        constexpr bool OVL = false; const int s0 = 0, slen = T_TOK, tbase = u.tbase, pn = u.pn; unsigned char* ws = p.ws;
        const float* RS = (const float*)(ws + (pn < 3 ? O_RQ : O_RKV));
        if (pn < 3) {
            bf16* Q = (bf16*)(ws + O_Q); const float* RC = (const float*)(ws + O_ROPE); const float* RSN = RC + 8192 * 16;
            const float qs = 0.10206207261596577f * 1.4426950408889634f;
            FOR_ROWS({ const float rs = RS[tg] * qs; const int sq = seq_of(tg), pos = tg - seq_start(sq);
                _Pragma("unroll") for (int bj = 0; bj < 2; ++bj) { const int base32 = pn * 256 + bj * 128 + wc * 32; const f32x4 v0 = acc[ai][bj][m][0] * rs, v1 = acc[ai][bj][m][1] * rs;
                    f32x4 o0 = v0, o1 = v1;
                    if (base32 % 96 == 64) { const f32x4 c = *(const f32x4*)(RC + pos * 16 + fq * 4), s = *(const f32x4*)(RSN + pos * 16 + fq * 4); o0 = v0 * c - v1 * s; o1 = v1 * c + v0 * s; }
                    st_bf4(Q + (size_t)tg * 768 + base32 + fq * 4, o0); st_bf4(Q + (size_t)tg * 768 + base32 + 16 + fq * 4, o1); } })
        } else if (pn < 5) {
            bf16* KN = (bf16*)(ws + O_KN); const int cb0 = (pn - 3) * 256;
            FOR_ROWS({ const float rs = RS[tg]; FOR_COLS({ st_bf4(KN + (size_t)tg * 512 + cb0 + colL, acc[ai][bj][m][n] * rs); }) })
        } else {
            bf16* VT = (bf16*)(ws + O_VT); const int cb0 = (pn - 5) * 256;
            FOR_ROWS({ const float rs = RS[tg]; const int sq = seq_of(tg), st = seq_start(sq), S = seq_len(sq), pos = tg - st; bf16* base = VT + (size_t)st * 512 + pos;
                FOR_COLS({ const int c = cb0 + colL; const f32x4 v = acc[ai][bj][m][n] * rs;
                    base[(size_t)c * S] = f2bf(v.x); base[(size_t)(c + 1) * S] = f2bf(v.y); base[(size_t)(c + 2) * S] = f2bf(v.z); base[(size_t)(c + 3) * S] = f2bf(v.w); }) })
        }
    }
};
struct EpiRes {
    Params p; int first, nobf;
    DI void operator()(Acc& acc, const Unit& u, int wr, int wc, int fr, int fq) const {
        const int tbase = u.tbase, pn = u.pn; unsigned char* ws = p.ws;
        bf16* XB = (bf16*)(ws + O_XB); float* SS = (float*)(ws + O_SS); float part[2][4];
#pragma unroll
        for (int ai = 0; ai < 2; ++ai) { f32x4 res[4][2][2];
#pragma unroll
            for (int m = 0; m < 4; ++m) { const int tg = tbase + ai * 128 + wr * 64 + m * 16 + fr; const float* rr = (first ? xin_row(p, tg) : p.out + (size_t)tg * DM) + pn * 256 + wc * 32 + 8 * fq;
#pragma unroll
                for (int bj = 0; bj < 2; ++bj) { res[m][bj][0] = *(const f32x4*)(rr + bj * 128); res[m][bj][1] = *(const f32x4*)(rr + bj * 128 + 4); } }
#pragma unroll
            for (int m = 0; m < 4; ++m) { const int tg = tbase + ai * 128 + wr * 64 + m * 16 + fr; const int c0 = pn * 256 + wc * 32 + 8 * fq; float* orow = p.out + (size_t)tg * DM + c0; bf16* xrow = XB + (size_t)tg * DM + c0; float s = 0.f;
#pragma unroll
                for (int bj = 0; bj < 2; ++bj) { const f32x4 v0 = res[m][bj][0] + acc[ai][bj][m][0], v1 = res[m][bj][1] + acc[ai][bj][m][1];
                    *(f32x4*)(orow + bj * 128) = v0; *(f32x4*)(orow + bj * 128 + 4) = v1; if (!nobf) st_bf8(xrow + bj * 128, v0, v1); s += sq4(v0) + sq4(v1); }
                part[ai][m] = s; } }
        row_reduce(part, wr, wc, fr, fq, [&](int row, float ss) { SS[(size_t)(tbase + row) * 4 + pn] = ss; });
    }
};
struct EpiUp {
    Params p; int layer;
    DI void operator()(Acc& acc, const Unit& u, int wr, int wc, int fr, int fq) const {
        constexpr bool OVL = true; unsigned char* ws = p.ws; const int pn = u.pn; int tbase, s0, slen; tile_rows(1, u.pm, tbase, s0, slen); const bool hb_ = tile_has_seam(tbase); (void)hb_;
        const f32x4* SS = (const f32x4*)(ws + O_SS);
        FOR_ROWS({ const bool val = (tg >= s0) && (tg < s0 + slen); const float rs = val ? rs_of(SS, tg) : 0.f;
            _Pragma("unroll") for (int bj = 0; bj < 2; ++bj) _Pragma("unroll") for (int n = 0; n < 2; ++n) acc[ai][bj][m][n] *= rs; })
        conv_exchange(acc, wr, wc, fr, fq);
        const float* cw = p.ffn_conv_w + (size_t)layer * 3 * 5632; const float* cb = p.ffn_conv_b + (size_t)layer * 5632; const int chb = pn * 128 + wc * 32 + fq * 4;
        bf16* HID = (bf16*)(ws + O_HID);
#define CA_(N, AI) { f32x4 upG, dnG, upV, dnV; conv_bnd<0, N, AI>(wr, wc, fq, upG, dnG); conv_bnd<1, N, AI>(wr, wc, fq, upV, dnV); \
        f32x4 rpg_ = upG, lcg_ = rol4(acc[AI][0][0][N]), rpv_ = upV, lcv_ = rol4(acc[AI][1][0][N]); \
        _Pragma("unroll") for (int M = 0; M < 4; ++M) { const int row = AI * 128 + wr * 64 + M * 16 + fr, tg = tbase + row; const f32x4 a_ = acc[AI][0][M][N], b_ = acc[AI][1][M][N]; const f32x4 rga_ = ror4(a_), rvb_ = ror4(b_); \
            f32x4 lng_ = dnG, lnv_ = dnV; if (M < 3) { lng_ = rol4(acc[AI][0][M < 3 ? M + 1 : 3][N]); lnv_ = rol4(acc[AI][1][M < 3 ? M + 1 : 3][N]); } \
            f32x4 ug_ = fr > 0 ? rga_ : rpg_, dg_ = fr < 15 ? lcg_ : lng_, uv_ = fr > 0 ? rvb_ : rpv_, dv_ = fr < 15 ? lcv_ : lnv_; if (hb_) { const f32x4 z_ = {0.f, 0.f, 0.f, 0.f}; if (seq_first(tg)) { ug_ = z_; uv_ = z_; } if (seq_first(tg + 1)) { dg_ = z_; dv_ = z_; } } const f32x4 g = g0 * ug_ + g1 * a_ + g2 * dg_ + gb, v = v0 * uv_ + v1 * b_ + v2 * dv_ + vb; rpg_ = rga_; lcg_ = lng_; rpv_ = rvb_; lcv_ = lnv_; \
            if ((tg >= s0) && (tg < s0 + slen) && row >= 1 && row <= 254) st_bf4(HID + (size_t)tg * DFF + chb + N * 16, (f32x4){siluf_(g.x) * v.x, siluf_(g.y) * v.y, siluf_(g.z) * v.z, siluf_(g.w) * v.w}); __builtin_amdgcn_sched_barrier(0); } }
#define CS_(N) { const int cg_ = chb + N * 16, cv2_ = 2816 + chb + N * 16; \
        const f32x4 g0 = *(const f32x4*)(cw + cg_), g1 = *(const f32x4*)(cw + 5632 + cg_), g2 = *(const f32x4*)(cw + 11264 + cg_), gb = *(const f32x4*)(cb + cg_); \
        const f32x4 v0 = *(const f32x4*)(cw + cv2_), v1 = *(const f32x4*)(cw + 5632 + cv2_), v2 = *(const f32x4*)(cw + 11264 + cv2_), vb = *(const f32x4*)(cb + cv2_); CA_(N, 0) CA_(N, 1) }
        CS_(0) CS_(1)
#undef CS_
#undef CA_
    }
};
struct EpiGin {
    Params p;
    DI void operator()(Acc& acc, const Unit& u, int wr, int wc, int fr, int fq) const {
        constexpr bool OVL = false; const int s0 = 0, slen = T_TOK, tbase = u.tbase, pn = u.pn; unsigned char* ws = p.ws;
        const f32x4* SS = (const f32x4*)(ws + O_SS);
        bf16* dst = (bf16*)(ws + (pn < 4 ? O_U : O_V)); const int cb0 = (pn & 3) * 256 + wc * 32 + 8 * fq; float part[2][4];
        float rsv[2][4]; FOR_ROWS({ rsv[ai][m] = rs_of(SS, tg); })
        FOR_ROWS({ const float rs = rsv[ai][m]; float s = 0.f;
            _Pragma("unroll") for (int bj = 0; bj < 2; ++bj) { f32x4 v0 = acc[ai][bj][m][0] * rs, v1 = acc[ai][bj][m][1] * rs;
                v0.x = geluf_(v0.x); v0.y = geluf_(v0.y); v0.z = geluf_(v0.z); v0.w = geluf_(v0.w); v1.x = geluf_(v1.x); v1.y = geluf_(v1.y); v1.z = geluf_(v1.z); v1.w = geluf_(v1.w);
                s += sq4(v0) + sq4(v1); st_bf8(dst + (size_t)tg * DM + cb0 + bj * 128, v0, v1); } part[ai][m] = s; })
        if (pn >= 4) { float* VSS = (float*)(ws + O_VSS); row_reduce(part, wr, wc, fr, fq, [&](int row, float ss) { VSS[(size_t)(tbase + row) * 4 + (pn - 4)] = ss; }); }
    }
};

DI int perm32(int rho) { const int n = rho >> 4, i = rho & 15; return 8 * (i >> 2) + 4 * n + (i & 3); }
template <class Epi, bool PERM = false> DI void gemm_phase(const Gemm g, const Epi& E) {
    LAS unsigned char* lds = (LAS unsigned char*)g_lds;
    int tid_ = threadIdx.x; asm volatile("" : "+v"(tid_));
    const int tid = tid_, wid = __builtin_amdgcn_readfirstlane(tid >> 6), lane = tid & 63, wr = wid >> 2, wc = wid & 3, fr = lane & 15, fq = lane >> 4;
    const int K = g.K;
    unsigned voff[2], voffB[2];
#pragma unroll
    for (int i = 0; i < 2; ++i) { int R, C; stage_rc(tid * 16 + i * 8192, R, C); voff[i] = (unsigned)(R * K + C) * 2u; const int Rb = PERM ? ((R & ~31) + perm32(R & 31)) : R; voffB[i] = (unsigned)(Rb * K + C) * 2u; }
    const size_t kstep = 128, hstep = (size_t)128 * K * 2, tstep = 2 * hstep;
    const unsigned ldsw = (unsigned)wid * 1024u;
    const int aoff = lds_byte(wr * 64 + fr, fq * 8), boff = lds_byte(wc * 32 + fr, fq * 8);
#define PG8_SA(b, h) (((b) * 2 + (h)) * 16384)
#define PG8_SB(b, h) ((4 + (b) * 2 + (h)) * 16384)
#define PG8_STAGEX(bufoff, gbase, vo) do { _Pragma("unroll") for (int _i = 0; _i < 2; ++_i) \
        __builtin_amdgcn_global_load_lds((const unsigned*)((const char*)(gbase) + vo[_i]), (LAS unsigned*)(lds + (bufoff) + ldsw + _i * 8192), 16, 0, 0); } while (0)
#define PG8_LDA(dst, b, h) do { _Pragma("unroll") for (int m = 0; m < 4; ++m) _Pragma("unroll") for (int k = 0; k < 2; ++k) dst[m][k] = *(const LAS bf16x8*)(lds + PG8_SA(b, h) + aoff + m * 2048 + k * 1024); } while (0)
#define PG8_LDB(dst, b, h) do { _Pragma("unroll") for (int n = 0; n < 2; ++n) _Pragma("unroll") for (int k = 0; k < 2; ++k) dst[n][k] = *(const LAS bf16x8*)(lds + PG8_SB(b, h) + boff + n * 2048 + k * 1024); } while (0)
#define PG8_MMA(ai, bj, At, Bt) do { __builtin_amdgcn_s_setprio(1); _Pragma("unroll") for (int m = 0; m < 4; ++m) _Pragma("unroll") for (int n = 0; n < 2; ++n) _Pragma("unroll") for (int k = 0; k < 2; ++k) \
        acc[ai][bj][m][n] = __builtin_amdgcn_mfma_f32_16x16x32_bf16(Bt[n][k], At[m][k], acc[ai][bj][m][n], 0, 0, 0); __builtin_amdgcn_s_setprio(0); } while (0)
#define PG8_WAIT_V(n) asm volatile("s_waitcnt vmcnt(" #n ")" ::: "memory")
#define PG8_WAIT_L(n) asm volatile("s_waitcnt lgkmcnt(" #n ")" ::: "memory")
#define PG8_BAR __builtin_amdgcn_s_barrier()
#define PG8_SCHED __builtin_amdgcn_sched_barrier(0)
    Unit cur, nxt; int ui = 0;
    if (!next_unit(g, 0, cur)) return;
    Acc acc;
#pragma unroll
    for (int a = 0; a < 2; ++a)
#pragma unroll
        for (int b = 0; b < 2; ++b)
#pragma unroll
            for (int m = 0; m < 4; ++m)
#pragma unroll
                for (int n = 0; n < 2; ++n) acc[a][b][m][n] = (f32x4){0.f, 0.f, 0.f, 0.f};
    bf16x8 At[4][2], B0[2][2], B1[2][2];
    const char* cA = (const char*)g.A + (ptrdiff_t)cur.tbase * (ptrdiff_t)(K * 2) + cur.kofs; const char* cB = (const char*)g.Bt + (size_t)cur.pn * tstep + cur.kofs;
    PG8_STAGEX(PG8_SB(0, 0), cB, voffB); PG8_STAGEX(PG8_SB(0, 1), cB + hstep, voffB); PG8_STAGEX(PG8_SA(0, 0), cA, voff); PG8_STAGEX(PG8_SA(0, 1), cA + hstep, voff);
    if (wr == 1) PG8_BAR;
    PG8_WAIT_V(2); PG8_BAR;
    PG8_STAGEX(PG8_SB(1, 0), cB + kstep, voffB); PG8_STAGEX(PG8_SA(1, 0), cA + kstep, voff); PG8_STAGEX(PG8_SB(1, 1), cB + hstep + kstep, voffB);
    PG8_WAIT_V(6); PG8_BAR;
    for (;;) {
        const bool has_next = next_unit(g, ui + 1, nxt);
        const char* nA = has_next ? (const char*)g.A + (ptrdiff_t)nxt.tbase * (ptrdiff_t)(K * 2) + nxt.kofs : cA; const char* nB = has_next ? (const char*)g.Bt + (size_t)nxt.pn * tstep + nxt.kofs : cB;
        const int nt = cur.nt;
        for (int t = 0; t < nt; t += 2) {
            const bool last = (t == nt - 2);
            const char* a1 = cA + (size_t)(t + 1) * kstep;
            const char* a2 = last ? nA : cA + (size_t)(t + 2) * kstep; const char* b2 = last ? nB : cB + (size_t)(t + 2) * kstep;
            const char* a3 = a2 + kstep; const char* b3 = b2 + kstep;
            PG8_LDB(B0, 0, 0); PG8_LDB(B1, 0, 1); PG8_SCHED; PG8_LDA(At, 0, 0); PG8_STAGEX(PG8_SA(1, 1), a1 + hstep, voff);
            PG8_WAIT_V(8); PG8_WAIT_L(0); PG8_BAR; PG8_MMA(0, 0, At, B0); PG8_MMA(0, 1, At, B1); PG8_BAR; PG8_SCHED;
            PG8_LDA(At, 0, 1); PG8_STAGEX(PG8_SB(0, 0), b2, voffB); PG8_STAGEX(PG8_SB(0, 1), b2 + hstep, voffB); PG8_STAGEX(PG8_SA(0, 0), a2, voff);
            PG8_WAIT_V(8); PG8_WAIT_L(0); PG8_BAR; PG8_MMA(1, 0, At, B0); PG8_MMA(1, 1, At, B1); PG8_BAR; PG8_SCHED;
            PG8_LDB(B0, 1, 0); PG8_LDB(B1, 1, 1); PG8_SCHED; PG8_LDA(At, 1, 0); PG8_STAGEX(PG8_SA(0, 1), a2 + hstep, voff);
            PG8_WAIT_V(8); PG8_WAIT_L(0); PG8_BAR; PG8_MMA(0, 0, At, B0); PG8_MMA(0, 1, At, B1); PG8_BAR; PG8_SCHED;
            PG8_LDA(At, 1, 1); PG8_STAGEX(PG8_SB(1, 0), b3, voffB); PG8_STAGEX(PG8_SB(1, 1), b3 + hstep, voffB); PG8_STAGEX(PG8_SA(1, 0), a3, voff);
            PG8_WAIT_V(8); PG8_WAIT_L(0); PG8_BAR; PG8_MMA(1, 0, At, B0); PG8_MMA(1, 1, At, B1); PG8_BAR; PG8_SCHED;
        }
        if (wr == 0) PG8_BAR;
        { int fr2 = fr, fq2 = fq; asm volatile("" : "+v"(fr2), "+v"(fq2)); E(acc, cur, wr, wc, fr2, fq2); }
        if (!has_next) break;
#pragma unroll
        for (int a = 0; a < 2; ++a)
#pragma unroll
            for (int b = 0; b < 2; ++b)
#pragma unroll
                for (int m = 0; m < 4; ++m)
#pragma unroll
                    for (int n = 0; n < 2; ++n) acc[a][b][m][n] = (f32x4){0.f, 0.f, 0.f, 0.f};
        cur = nxt; cA = nA; cB = nB; ++ui;
        if (wr == 1) PG8_BAR;
    }
    PG8_WAIT_V(0);
    PG8_BAR;
    __syncthreads();
}

constexpr int LDT = 136;
constexpr int TILE_B = 128 * LDT * 2;
DI int crow(int i, int h) { return (i & 3) + 8 * (i >> 2) + 4 * h; }
template <int KS> DI void mm_lds(f32x16 (&acc)[2], const bf16* sA, const bf16* sB, int rb, int cb0, int lane) {
    const int r = lane & 31, h = lane >> 5;
#pragma unroll
    for (int ks = 0; ks < KS; ++ks) {
        const bf16x8 a = *(const bf16x8*)(sA + (32 * rb + r) * LDT + 16 * ks + 8 * h);
#pragma unroll
        for (int c = 0; c < 2; ++c) { const bf16x8 b = *(const bf16x8*)(sB + (32 * (cb0 + c) + r) * LDT + 16 * ks + 8 * h); acc[c] = MFMA32(a, b, acc[c]); }
    }
}
DI float scan_add(float v, int lane) {
#pragma unroll
    for (int o = 1; o < 64; o <<= 1) { const float t = __shfl_up(v, o); if (lane >= o) v += t; }
    return v;
}
DI float scan_max(float v, int lane) {
#pragma unroll
    for (int o = 1; o < 64; o <<= 1) { const float t = __shfl_up(v, o); if (lane >= o) v = fmaxf(v, t); }
    return v;
}
DI float wave_max(float v) {
#pragma unroll
    for (int o = 1; o < 64; o <<= 1) v = fmaxf(v, __shfl_xor(v, o));
    return v;
}
DI void load_tile_nat(bf16* sT, const bf16* g, int gld, int tid) {
#pragma unroll
    for (int i = 0; i < 4; ++i) { const int id = tid + 512 * i, row = id >> 4, c = (id & 15) * 8; *(u32x4*)(sT + row * LDT + c) = *(const u32x4*)(g + (size_t)row * gld + c); }
}
DI void load_tile_tr(bf16* sT, const bf16* g, int gld, const float* w, int tid) {
#pragma unroll
    for (int i = 0; i < 4; ++i) { const int id = tid + 512 * i, row = id & 127, c = (id >> 7) * 8; const u32x4 v = *(const u32x4*)(g + (size_t)row * gld + c); const float ww = w ? w[row] : 1.f;
        const unsigned uu[4] = {v.x, v.y, v.z, v.w};
#pragma unroll
        for (int e = 0; e < 4; ++e) { sT[(c + 2 * e) * LDT + row] = f2bf(bflo(uu[e]) * ww); sT[(c + 2 * e + 1) * LDT + row] = f2bf(bfhi(uu[e]) * ww); } }
}

DI void write_tile_tr(bf16* sT, const u32x4 (&v)[4], const float* w, int tid) {
#pragma unroll
    for (int i = 0; i < 4; ++i) { const int id = tid + 512 * i, row = id & 127, c = (id >> 7) * 8; const float ww = w ? w[row] : 1.f;
        const unsigned uu[4] = {v[i].x, v[i].y, v[i].z, v[i].w};
#pragma unroll
        for (int e = 0; e < 4; ++e) { sT[(c + 2 * e) * LDT + row] = f2bf(bflo(uu[e]) * ww); sT[(c + 2 * e + 1) * LDT + row] = f2bf(bfhi(uu[e]) * ww); } }
}
DI void mlstm_local(const Params& p) {
    unsigned char* ws = p.ws; int tid_ = threadIdx.x; asm volatile("" : "+v"(tid_)); const int tid = tid_, lane = tid & 63, wid = tid >> 6;
    bf16* sV = (bf16*)g_lds; bf16* sK = (bf16*)(g_lds + TILE_B); float* sW = (float*)(g_lds + 2 * TILE_B);
    const float* G = (const float*)(ws + O_G); const bf16* MV = (const bf16*)(ws + O_MV); const bf16* KC = (const bf16*)(ws + O_KC);
    bf16* CS = (bf16*)(ws + O_CS); float* NS = (float*)(ws + O_NS); float* ML = (float*)(ws + O_ML); float* BL = (float*)(ws + O_BL);
    const int rb = wid & 3, cb0 = (wid >> 2) * 2;
    for (int it2 = blockIdx.x; it2 < 2560; it2 += gridDim.x) {
        const int cgk = it2 >> 2, h = it2 & 3, t0 = cgk * 128;
        u32x4 vr[4], kr[4];
#pragma unroll
        for (int i = 0; i < 4; ++i) { const int id = tid + 512 * i, row = id & 127, c = (id >> 7) * 8; vr[i] = *(const u32x4*)(MV + (size_t)(t0 + row) * 512 + h * 128 + c); kr[i] = *(const u32x4*)(KC + (size_t)(t0 + row) * 512 + h * 128 + c); }
        if (wid < 2) { const int dir = wid, item = it2 * 2 + dir;
            const int o0 = dir ? 127 - lane : lane, o1 = dir ? 63 - lane : lane + 64;
            const float lf0 = G[(size_t)(t0 + o0) * 16 + dir * 8 + 4 + h], li0 = G[(size_t)(t0 + o0) * 16 + dir * 8 + h];
            const float lf1 = G[(size_t)(t0 + o1) * 16 + dir * 8 + 4 + h], li1 = G[(size_t)(t0 + o1) * 16 + dir * 8 + h];
            const float b0 = scan_add(lf0, lane), tot0 = __shfl(b0, 63), b1 = scan_add(lf1, lane) + tot0, bL = __shfl(b1, 63);
            const float g0 = bL - b0 + li0, g1 = bL - b1 + li1, ml = wave_max(fmaxf(g0, g1));
            sW[dir * 128 + o0] = __expf(g0 - ml); sW[dir * 128 + o1] = __expf(g1 - ml);
            if (lane == 0) { ML[item] = ml; BL[item] = bL; }
        }
        write_tile_tr(sK, kr, nullptr, tid);
        __syncthreads();
#pragma unroll 1
        for (int dir = 0; dir < 2; ++dir) { const int item = it2 * 2 + dir; const float* sWd = sW + dir * 128;
            write_tile_tr(sV, vr, sWd, tid);
            __syncthreads();
            if (tid < 128) { float s = 0.f;
#pragma unroll 4
                for (int l = 0; l < 128; l += 8) { const u32x4 kk = *(const u32x4*)(sK + tid * LDT + l); const f32x4 wa = *(const f32x4*)(sWd + l), wb = *(const f32x4*)(sWd + l + 4);
                    s += (wa.x * bflo(kk.x) + wa.y * bfhi(kk.x)) + (wa.z * bflo(kk.y) + wa.w * bfhi(kk.y)) + (wb.x * bflo(kk.z) + wb.y * bfhi(kk.z)) + (wb.z * bflo(kk.w) + wb.w * bfhi(kk.w)); }
                NS[(size_t)item * 128 + tid] = s; }
            f32x16 acc[2];
#pragma unroll
            for (int c = 0; c < 2; ++c)
#pragma unroll
                for (int i = 0; i < 16; ++i) acc[c][i] = 0.f;
            mm_lds<8>(acc, sV, sK, rb, cb0, lane);
            bf16* Co = CS + (size_t)item * 16384;
#pragma unroll
            for (int c = 0; c < 2; ++c)
#pragma unroll
                for (int i = 0; i < 16; ++i) Co[(32 * rb + crow(i, lane >> 5)) * 128 + 32 * (cb0 + c) + (lane & 31)] = f2bf(acc[c][i]);
            __syncthreads();
        }
    }
}
DI void mlstm_scan(const Params& p) {
    unsigned char* ws = p.ws; int tid_ = threadIdx.x; asm volatile("" : "+v"(tid_)); const int gt = blockIdx.x * NTHR + tid_, GT = gridDim.x * NTHR;
    bf16* CS = (bf16*)(ws + O_CS); float* NS = (float*)(ws + O_NS); const float* ML = (const float*)(ws + O_ML); const float* BL = (const float*)(ws + O_BL); float* MP = (float*)(ws + O_MP);
    for (int u = gt; u < 144 * 2080; u += GT) {
        const int st = u / 2080, v = u % 2080, sq = st >> 3, h = (st >> 1) & 3, dir = st & 1, nc = seq_len(sq) >> 7, c0 = seq_start(sq) >> 7;
        float m = 0.f;
        if (v < 2048) {
            float C[8];
#pragma unroll
            for (int e = 0; e < 8; ++e) C[e] = 0.f;
            for (int j = 0; j < nc; j += 4) {
                u32x4 t[4]; float bl[4], mlv[4]; int itm[4];
#pragma unroll
                for (int q = 0; q < 4; ++q) { const int n = dir ? nc - 1 - (j + q) : j + q; itm[q] = ((c0 + n) * 4 + h) * 2 + dir; t[q] = *(const u32x4*)(CS + (size_t)itm[q] * 16384 + v * 8); bl[q] = BL[itm[q]]; mlv[q] = ML[itm[q]]; }
#pragma unroll
                for (int q = 0; q < 4; ++q) { u32x4 o; o.x = pk2(C[0], C[1]); o.y = pk2(C[2], C[3]); o.z = pk2(C[4], C[5]); o.w = pk2(C[6], C[7]); *(u32x4*)(CS + (size_t)itm[q] * 16384 + v * 8) = o;
                    if (v == 0) MP[itm[q]] = m;
                    const float mn = fmaxf(bl[q] + m, mlv[q]), a = __expf(bl[q] + m - mn), c = __expf(mlv[q] - mn);
                    C[0] = a * C[0] + c * bflo(t[q].x); C[1] = a * C[1] + c * bfhi(t[q].x); C[2] = a * C[2] + c * bflo(t[q].y); C[3] = a * C[3] + c * bfhi(t[q].y);
                    C[4] = a * C[4] + c * bflo(t[q].z); C[5] = a * C[5] + c * bfhi(t[q].z); C[6] = a * C[6] + c * bflo(t[q].w); C[7] = a * C[7] + c * bfhi(t[q].w); m = mn; }
            }
        } else {
            f32x4 N = {0.f, 0.f, 0.f, 0.f};
            for (int j = 0; j < nc; j += 4) {
                f32x4 t[4]; float bl[4], mlv[4]; int itm[4];
#pragma unroll
                for (int q = 0; q < 4; ++q) { const int n = dir ? nc - 1 - (j + q) : j + q; itm[q] = ((c0 + n) * 4 + h) * 2 + dir; t[q] = *(const f32x4*)(NS + (size_t)itm[q] * 128 + (v - 2048) * 4); bl[q] = BL[itm[q]]; mlv[q] = ML[itm[q]]; }
#pragma unroll
                for (int q = 0; q < 4; ++q) { *(f32x4*)(NS + (size_t)itm[q] * 128 + (v - 2048) * 4) = N;
                    const float mn = fmaxf(bl[q] + m, mlv[q]), a = __expf(bl[q] + m - mn), c = __expf(mlv[q] - mn); N = a * N + c * t[q]; m = mn; }
            }
        }
    }
}
DI void mlstm_out(const Params& p) {
    unsigned char* ws = p.ws; int tid_ = threadIdx.x; asm volatile("" : "+v"(tid_)); const int tid = tid_, lane = tid & 63, wid = tid >> 6, hh = lane >> 5;
    bf16* sQ = (bf16*)g_lds; bf16* sK = (bf16*)(g_lds + TILE_B); bf16* sVT = (bf16*)(g_lds + 2 * TILE_B); bf16* sC = (bf16*)(g_lds + 3 * TILE_B); bf16* sP = sK;
    float* sBv2 = (float*)(g_lds + 4 * TILE_B); float* sLi2 = sBv2 + 256; float* sMt2 = sBv2 + 512; float* sInter2 = sBv2 + 768; float* sInv = sBv2 + 1024; float* sN = sBv2 + 1152;
    float* sH = (float*)g_lds;
    const float* G = (const float*)(ws + O_G); const bf16* QC = (const bf16*)(ws + O_QC); const bf16* KC = (const bf16*)(ws + O_KC); const bf16* MV = (const bf16*)(ws + O_MV); const bf16* MO = (const bf16*)(ws + O_MO);
    const bf16* CS = (const bf16*)(ws + O_CS); const float* NS = (const float*)(ws + O_NS); const float* MP = (const float*)(ws + O_MP); bf16* Y = (bf16*)(ws + O_Y);
    const int rb = wid & 3, cb0 = (wid >> 2) * 2;
    for (int item = blockIdx.x; item < 2560; item += gridDim.x) {
        const int cgk = item >> 2, h = item & 3, t0 = cgk * 128;
        load_tile_nat(sQ, QC + (size_t)t0 * 512 + h * 128, 512, tid);
        load_tile_nat(sK, KC + (size_t)t0 * 512 + h * 128, 512, tid);
        load_tile_tr(sVT, MV + (size_t)t0 * 512 + h * 128, 512, nullptr, tid);
        if (wid < 2) {
            const int dir = wid, itemd = (cgk * 4 + h) * 2 + dir; const float mprev = MP[itemd];
            const int o0 = dir ? 127 - lane : lane, o1 = dir ? 63 - lane : lane + 64;
            const float lf0 = G[(size_t)(t0 + o0) * 16 + dir * 8 + 4 + h], li0 = G[(size_t)(t0 + o0) * 16 + dir * 8 + h];
            const float lf1 = G[(size_t)(t0 + o1) * 16 + dir * 8 + 4 + h], li1 = G[(size_t)(t0 + o1) * 16 + dir * 8 + h];
            const float b0 = scan_add(lf0, lane), tot0 = __shfl(b0, 63), b1 = scan_add(lf1, lane) + tot0;
            const float pm0 = scan_max(li0 - b0, lane), mx0 = __shfl(pm0, 63), pm1 = fmaxf(scan_max(li1 - b1, lane), mx0);
            const float a0 = b0 + mprev, a1 = b1 + mprev, mt0 = fmaxf(a0, b0 + pm0), mt1 = fmaxf(a1, b1 + pm1);
            float* B_ = sBv2 + dir * 128; float* L_ = sLi2 + dir * 128; float* M_ = sMt2 + dir * 128; float* I_ = sInter2 + dir * 128;
            B_[o0] = b0; B_[o1] = b1; L_[o0] = li0; L_[o1] = li1; M_[o0] = mt0; M_[o1] = mt1; I_[o0] = __expf(a0 - mt0); I_[o1] = __expf(a1 - mt1);
        }
        __syncthreads();
        f32x16 S[2], hs[2];
#pragma unroll
        for (int c = 0; c < 2; ++c)
#pragma unroll
            for (int i = 0; i < 16; ++i) { S[c][i] = 0.f; hs[c][i] = 0.f; }
        mm_lds<8>(S, sQ, sK, rb, cb0, lane);
#pragma unroll 1
        for (int dir = 0; dir < 2; ++dir) {
            __syncthreads();
            const int itemd = (cgk * 4 + h) * 2 + dir;
            const float* sBv = sBv2 + dir * 128; const float* sLi = sLi2 + dir * 128; const float* sMt = sMt2 + dir * 128; const float* sInter = sInter2 + dir * 128;
            load_tile_nat(sC, CS + (size_t)itemd * 16384, 128, tid);
            if (tid >= 64 && tid < 96) *(f32x4*)(sN + (tid - 64) * 4) = *(const f32x4*)(NS + (size_t)itemd * 128 + (tid - 64) * 4);
            __syncthreads();
#pragma unroll
            for (int c = 0; c < 2; ++c) { const int s = 32 * (cb0 + c) + (lane & 31); const float bs = sBv[s] - sLi[s];
#pragma unroll
                for (int i = 0; i < 16; ++i) { const int t = 32 * rb + crow(i, hh); const bool valid = dir ? (s >= t) : (s <= t);
                    const float pv = valid ? S[c][i] * __expf(sBv[t] - bs - sMt[t]) : 0.f; sP[t * LDT + s] = f2bf(pv); } }
            __syncthreads();
            if (tid < 128) { const int t = tid; float dot = 0.f, rsum = 0.f;
#pragma unroll 4
                for (int e = 0; e < 128; e += 8) { const u32x4 qq = *(const u32x4*)(sQ + t * LDT + e), pq = *(const u32x4*)(sP + t * LDT + e); const f32x4 na = *(const f32x4*)(sN + e), nb = *(const f32x4*)(sN + e + 4);
                    dot += (na.x * bflo(qq.x) + na.y * bfhi(qq.x)) + (na.z * bflo(qq.y) + na.w * bfhi(qq.y)) + (nb.x * bflo(qq.z) + nb.y * bfhi(qq.z)) + (nb.z * bflo(qq.w) + nb.w * bfhi(qq.w));
                    rsum += (bflo(pq.x) + bfhi(pq.x)) + (bflo(pq.y) + bfhi(pq.y)) + (bflo(pq.z) + bfhi(pq.z)) + (bflo(pq.w) + bfhi(pq.w)); }
                const float den = sInter[t] * dot + rsum; sInv[t] = 1.f / fmaxf(fabsf(den), __expf(-sMt[t])); }
            f32x16 num[2];
#pragma unroll
            for (int c = 0; c < 2; ++c)
#pragma unroll
                for (int i = 0; i < 16; ++i) num[c][i] = 0.f;
            mm_lds<8>(num, sQ, sC, rb, cb0, lane);
#pragma unroll
            for (int i = 0; i < 16; ++i) { const float it = sInter[32 * rb + crow(i, hh)]; num[0][i] *= it; num[1][i] *= it; }
            mm_lds<8>(num, sP, sVT, rb, cb0, lane);
            __syncthreads();
#pragma unroll
            for (int i = 0; i < 16; ++i) { const float iv = sInv[32 * rb + crow(i, hh)]; hs[0][i] += num[0][i] * iv; hs[1][i] += num[1][i] * iv; }
        }
        __syncthreads();
#pragma unroll
        for (int c = 0; c < 2; ++c)
#pragma unroll
            for (int i = 0; i < 16; ++i) sH[(32 * rb + crow(i, hh)) * 132 + 32 * (cb0 + c) + (lane & 31)] = hs[c][i];
        __syncthreads();
        { const int t = tid >> 2, d0 = (tid & 3) * 32; f32x4 v[8]; float ss = 0.f;
#pragma unroll
          for (int e = 0; e < 8; ++e) { v[e] = *(const f32x4*)(sH + t * 132 + d0 + 4 * e); ss += sq4(v[e]); }
          ss += __shfl_xor(ss, 1); ss += __shfl_xor(ss, 2);
          const float rstd = rsqrtf(ss * (1.f / 128.f) + EPS);
          const bf16* mo = MO + (size_t)(t0 + t) * 512 + h * 128 + d0; const float* on = p.m_out_norm + h * 128 + d0; bf16* yo = Y + (size_t)(t0 + t) * 1024 + 512 + h * 128 + d0;
#pragma unroll
          for (int e = 0; e < 4; ++e) { const u32x4 g = *(const u32x4*)(mo + 8 * e); const f32x4 n0 = *(const f32x4*)(on + 8 * e), n1 = *(const f32x4*)(on + 8 * e + 4); const f32x4 a = v[2 * e] * rstd * n0, b = v[2 * e + 1] * rstd * n1;
              u32x4 o; o.x = pk2(a.x * bflo(g.x), a.y * bfhi(g.x)); o.y = pk2(a.z * bflo(g.y), a.w * bfhi(g.y)); o.z = pk2(b.x * bflo(g.z), b.y * bfhi(g.z)); o.w = pk2(b.z * bflo(g.w), b.w * bfhi(g.w));
              *(u32x4*)(yo + 8 * e) = o; } }
        __syncthreads();
    }
}
DI void attn_phase(const Params& p) {
    unsigned char* ws = p.ws; int tid_ = threadIdx.x; asm volatile("" : "+v"(tid_)); const int tid = tid_, lane = tid & 63, wid = tid >> 6, r = lane & 31, hh = lane >> 5;
    const bf16* Q = (const bf16*)(ws + O_Q); const bf16* KN = (const bf16*)(ws + O_KN); const bf16* KR = (const bf16*)(ws + O_KR); const bf16* VT = (const bf16*)(ws + O_VT); bf16* Y = (bf16*)(ws + O_Y);
    constexpr int KB_B = 128 * 208, VB_B = 64 * 272, VOFF = 2 * KB_B, SOFF = 0;
    for (int item = blockIdx.x; item < 1280; item += gridDim.x) {
        int sq, head, qb;
        if (item < 256) { sq = item >> 7; head = (item & 127) >> 4; qb = item & 15; } else { const int it = item - 256; sq = 2 + (it >> 6); head = (it & 63) >> 3; qb = it & 7; }
        const int S = seq_len(sq), t0 = seq_start(sq), nkt = S >> 7, tq0 = t0 + qb * 512 + wid * 64;
        bf16x8 qf[2][6];
#pragma unroll
        for (int j = 0; j < 2; ++j)
#pragma unroll
            for (int ks = 0; ks < 6; ++ks) qf[j][ks] = *(const bf16x8*)(Q + (size_t)(tq0 + j * 32 + r) * 768 + head * 96 + 16 * ks + 8 * hh);
        f32x16 o[2][2];
#pragma unroll
        for (int j = 0; j < 2; ++j)
#pragma unroll
            for (int c = 0; c < 2; ++c)
#pragma unroll
                for (int i = 0; i < 16; ++i) o[j][c][i] = 0.f;
        float mrun[2] = {0.f, 0.f}, lrun[2] = {0.f, 0.f};
        const bf16* gk = KN + (size_t)(t0 + (tid >> 3)) * 512 + head * 64 + (tid & 7) * 8;
        const bf16* gr = KR + (size_t)(t0 + (tid >> 2)) * 32 + (tid & 3) * 8;
        const bf16* gv = VT + (size_t)t0 * 512 + (size_t)(head * 64 + (tid >> 3)) * S + (tid & 7) * 8;
        unsigned char* lk = g_lds + (tid >> 3) * 208 + (tid & 7) * 16; unsigned char* lr = g_lds + (tid >> 2) * 208 + 128 + (tid & 3) * 16; unsigned char* lv = g_lds + VOFF + (tid >> 3) * 272 + ((tid & 7) >> 1) * 32 + (tid & 1) * 8;
        u32x4 rk, rk2, rr, rv, rv2;
#define ALD_(kt_) { rk = *(const u32x4*)(gk + (size_t)(kt_) * 128 * 512); rk2 = *(const u32x4*)(gk + (size_t)((kt_) * 128 + 64) * 512); rr = *(const u32x4*)(gr + (size_t)(kt_) * 128 * 32); rv = *(const u32x4*)(gv + (kt_) * 128); rv2 = *(const u32x4*)(gv + (kt_) * 128 + 64); }
#define AST_(b_) { *(u32x4*)(lk + (b_) * KB_B) = rk; *(u32x4*)(lk + (b_) * KB_B + 64 * 208) = rk2; *(u32x4*)(lr + (b_) * KB_B) = rr; \
            *(u32x2*)(lv + (b_) * VB_B) = (u32x2){rv.x, rv.y}; *(u32x2*)(lv + (b_) * VB_B + 16) = (u32x2){rv.z, rv.w}; *(u32x2*)(lv + (b_) * VB_B + 128) = (u32x2){rv2.x, rv2.y}; *(u32x2*)(lv + (b_) * VB_B + 144) = (u32x2){rv2.z, rv2.w}; }
        ALD_(0) AST_(0)
        __syncthreads();
        for (int kt = 0; kt < nkt; ++kt) {
            const int buf = kt & 1; const bool more = kt + 1 < nkt;
            if (more) ALD_(kt + 1)
            const unsigned char* Kb = g_lds + buf * KB_B; const unsigned char* Vb = g_lds + VOFF + buf * VB_B;
#pragma unroll 1
            for (int kb = 0; kb < 4; ++kb) {
                f32x16 st[2];
#pragma unroll
                for (int j = 0; j < 2; ++j) { const float nm = -mrun[j];
#pragma unroll
                    for (int i = 0; i < 16; ++i) st[j][i] = nm; }
#pragma unroll
                for (int ks = 0; ks < 6; ++ks) { const bf16x8 a = *(const bf16x8*)(Kb + (32 * kb + r) * 208 + (16 * ks + 8 * hh) * 2); st[0] = MFMA32(a, qf[0][ks], st[0]); st[1] = MFMA32(a, qf[1][ks], st[1]); }
                bf16x8 pf[2][2];
                const bool first = (kt == 0) && (kb == 0);
#pragma unroll
                for (int j = 0; j < 2; ++j) {
                    float mx = st[j][0];
#pragma unroll
                    for (int i = 1; i < 16; ++i) mx = fmaxf(mx, st[j][i]);
                    mx = fmaxf(mx, __shfl_xor(mx, 32));
                    if (first || __builtin_amdgcn_ballot_w64(mx > 8.f) != 0ull) {
                        const float d = first ? mx : fmaxf(mx, 0.f);
                        if (!first) { const float alpha = __builtin_amdgcn_exp2f(-d); lrun[j] *= alpha;
#pragma unroll
                            for (int c = 0; c < 2; ++c)
#pragma unroll
                                for (int i = 0; i < 16; ++i) o[j][c][i] *= alpha; }
#pragma unroll
                        for (int i = 0; i < 16; ++i) st[j][i] -= d;
                        mrun[j] += d;
                    }
                    float ps = 0.f;
#pragma unroll
                    for (int i = 0; i < 16; ++i) { const float e = __builtin_amdgcn_exp2f(st[j][i]); st[j][i] = e; ps += e; }
                    lrun[j] += ps;
#pragma unroll
                    for (int s2 = 0; s2 < 2; ++s2) {
                        u32x4 pp; pp.x = pk2(st[j][8 * s2 + 0], st[j][8 * s2 + 1]); pp.y = pk2(st[j][8 * s2 + 2], st[j][8 * s2 + 3]); pp.z = pk2(st[j][8 * s2 + 4], st[j][8 * s2 + 5]); pp.w = pk2(st[j][8 * s2 + 6], st[j][8 * s2 + 7]);
                        pf[j][s2] = __builtin_bit_cast(bf16x8, pp); }
                }
#pragma unroll
                for (int s2 = 0; s2 < 2; ++s2)
#pragma unroll
                    for (int db = 0; db < 2; ++db) { const bf16x8 a = *(const bf16x8*)(Vb + (32 * db + r) * 272 + (32 * kb + 16 * s2) * 2 + hh * 16);
                        o[0][db] = MFMA32(a, pf[0][s2], o[0][db]); o[1][db] = MFMA32(a, pf[1][s2], o[1][db]); }
            }
            if (more) AST_(buf ^ 1)
            __syncthreads();
        }
#undef ALD_
#undef AST_
        unsigned char* stg = g_lds + SOFF + wid * 8704;
#pragma unroll
        for (int j = 0; j < 2; ++j) { float l = lrun[j]; l += __shfl_xor(l, 32); const float inv = 1.f / l;
#pragma unroll
            for (int db = 0; db < 2; ++db)
#pragma unroll
                for (int g4 = 0; g4 < 4; ++g4) { u32x2 w; w.x = pk2(o[j][db][4 * g4] * inv, o[j][db][4 * g4 + 1] * inv); w.y = pk2(o[j][db][4 * g4 + 2] * inv, o[j][db][4 * g4 + 3] * inv);
                    *(u32x2*)(stg + (j * 32 + r) * 136 + (32 * db + 8 * g4 + 4 * hh) * 2) = w; } }
        __syncthreads();
#pragma unroll
        for (int j = 0; j < 8; ++j) { const int id = lane + 64 * j, row = id >> 3, c = id & 7; const u32x2 a = *(const u32x2*)(stg + row * 136 + c * 16), b = *(const u32x2*)(stg + row * 136 + c * 16 + 8);
            *(u32x4*)(Y + (size_t)(tq0 + row) * 1024 + head * 64 + c * 8) = (u32x4){a.x, a.y, b.x, b.y}; }
        __syncthreads();
    }
}
DI void spatial_phase(const Params& p) {
    unsigned char* ws = p.ws; int tid_ = threadIdx.x; asm volatile("" : "+v"(tid_)); const int tid = tid_, lane = tid & 63, wid = tid >> 6, hh = lane >> 5;
    bf16* sW = (bf16*)g_lds; bf16* sVn = (bf16*)(g_lds + TILE_B); float* sR = (float*)(g_lds + 2 * TILE_B);
    const bf16* WSP = (const bf16*)(ws + O_WSP); const bf16* U = (const bf16*)(ws + O_U); const bf16* V = (const bf16*)(ws + O_V); const f32x4* VSS = (const f32x4*)(ws + O_VSS); bf16* Z = (bf16*)(ws + O_Z);
    const int rb = wid & 3, cb0 = (wid >> 2) * 2;
    const int G8 = (gridDim.x & 7) == 0 ? (int)(gridDim.x >> 3) : 0;
    if (G8 == 0) return;
    const int g = blockIdx.x & 7;
    load_tile_nat(sW, WSP + (size_t)g * 16384, 128, tid);
    const f32x4 n0 = *(const f32x4*)(p.c_v_norm + g * 128 + (tid >> 7) * 8), n1 = *(const f32x4*)(p.c_v_norm + g * 128 + (tid >> 7) * 8 + 4), n2 = *(const f32x4*)(p.c_v_norm + g * 128 + (tid >> 7) * 8 + 32), n3 = *(const f32x4*)(p.c_v_norm + g * 128 + (tid >> 7) * 8 + 36);
    const f32x4 n4 = *(const f32x4*)(p.c_v_norm + g * 128 + (tid >> 7) * 8 + 64), n5 = *(const f32x4*)(p.c_v_norm + g * 128 + (tid >> 7) * 8 + 68), n6 = *(const f32x4*)(p.c_v_norm + g * 128 + (tid >> 7) * 8 + 96), n7 = *(const f32x4*)(p.c_v_norm + g * 128 + (tid >> 7) * 8 + 100);
    float bsp[16];
#pragma unroll
    for (int i = 0; i < 16; ++i) bsp[i] = p.c_b_sp[g * 128 + 32 * rb + crow(i, hh)];
    u32x4 vr[4];
    int cgk = blockIdx.x >> 3;
    if (cgk < NCHUNK) {
#pragma unroll
        for (int i = 0; i < 4; ++i) { const int id = tid + 512 * i, row = id & 127, c = (id >> 7) * 8; vr[i] = *(const u32x4*)(V + (size_t)(cgk * 128 + row) * 1024 + g * 128 + c); }
    }
    for (; cgk < NCHUNK; cgk += G8) {
        const int t0 = cgk * 128;
        if (tid < 128) { const f32x4 q = VSS[t0 + tid]; sR[tid] = rsqrtf(((q.x + q.y) + (q.z + q.w)) * (1.f / 1024.f) + EPS); }
        __syncthreads();
#pragma unroll
        for (int i = 0; i < 4; ++i) { const int id = tid + 512 * i, row = id & 127, c = (id >> 7) * 8; const u32x4 v = vr[i]; const float ww = sR[row];
            const f32x4 na = i == 0 ? n0 : (i == 1 ? n2 : (i == 2 ? n4 : n6)), nb = i == 0 ? n1 : (i == 1 ? n3 : (i == 2 ? n5 : n7));
            sVn[(c + 0) * LDT + row] = f2bf(bflo(v.x) * ww * na.x); sVn[(c + 1) * LDT + row] = f2bf(bfhi(v.x) * ww * na.y); sVn[(c + 2) * LDT + row] = f2bf(bflo(v.y) * ww * na.z); sVn[(c + 3) * LDT + row] = f2bf(bfhi(v.y) * ww * na.w);
            sVn[(c + 4) * LDT + row] = f2bf(bflo(v.z) * ww * nb.x); sVn[(c + 5) * LDT + row] = f2bf(bfhi(v.z) * ww * nb.y); sVn[(c + 6) * LDT + row] = f2bf(bflo(v.w) * ww * nb.z); sVn[(c + 7) * LDT + row] = f2bf(bfhi(v.w) * ww * nb.w); }
        __syncthreads();
        if (cgk + G8 < NCHUNK) {
#pragma unroll
            for (int i = 0; i < 4; ++i) { const int id = tid + 512 * i, row = id & 127, c = (id >> 7) * 8; vr[i] = *(const u32x4*)(V + (size_t)((cgk + G8) * 128 + row) * 1024 + g * 128 + c); }
        }
        bf16 uu[2][16];
#pragma unroll
        for (int c = 0; c < 2; ++c)
#pragma unroll
            for (int i = 0; i < 16; ++i) uu[c][i] = U[(size_t)(t0 + 32 * rb + crow(i, hh)) * 1024 + g * 128 + 32 * (cb0 + c) + (lane & 31)];
        f32x16 acc[2];
#pragma unroll
        for (int c = 0; c < 2; ++c)
#pragma unroll
            for (int i = 0; i < 16; ++i) acc[c][i] = 0.f;
        mm_lds<8>(acc, sW, sVn, rb, cb0, lane);
#pragma unroll
        for (int c = 0; c < 2; ++c)
#pragma unroll
            for (int i = 0; i < 16; ++i) { const int t = 32 * rb + crow(i, hh), cc = g * 128 + 32 * (cb0 + c) + (lane & 31); const size_t ix = (size_t)(t0 + t) * 1024 + cc;
                Z[ix] = f2bf((acc[c][i] + bsp[i]) * bf2f(uu[c][i])); }
    }
    __syncthreads();
}
DI void final_phase(const Params& p) {
    int tid_ = threadIdx.x; asm volatile("" : "+v"(tid_)); const int tid = tid_, lane = tid & 63, gw = blockIdx.x * 8 + (tid >> 6), NGW = gridDim.x * 8; const f32x4* SS = (const f32x4*)(p.ws + O_SS);
    for (int t = gw; t < T_TOK; t += NGW) { const float rs = rs_of(SS, t); f32x4* xr = (f32x4*)(p.out + (size_t)t * DM) + lane; const f32x4* gn = (const f32x4*)p.final_norm + lane;
#pragma unroll
        for (int j = 0; j < 4; ++j) xr[64 * j] = xr[64 * j] * rs * gn[64 * j]; }
}


#ifndef DBG
#define DBG 0
#endif
constexpr size_t O_DBG = O_END0;
DI int btok_(int i) { return ((int)blockIdx.x * 8 + (i & 7)) * 40 + ((int)blockIdx.x * 7 + i * 3) % 40; }
DI bool close_(float fast, float ref) { return fabsf(fast - ref) <= 0.03f + 0.04f * fabsf(ref); }
DI float nrs_(const Params& p, int t) { const float* x = xin_row(p, t); float s = 0.f; for (int k = 0; k < 1024; ++k) s += x[k] * x[k]; return rsqrtf(s * (1.f / 1024.f) + EPS); }
DI float nh_(const Params& p, int t, int col, float rs) { const float* x = xin_row(p, t); float s = 0.f; for (int k = 0; k < 1024; ++k) s += x[k] * p.ab_norm[k] * p.ab_w_in[(size_t)k * 2480 + col]; return s * rs; }
DI void dbg_fail(const Params& p, unsigned bit) { atomicOr((unsigned*)(p.ws + O_DBG), bit); }
DI void chk_inproj(const Params& p) {
    unsigned char* ws = p.ws; int tid_ = threadIdx.x; asm volatile("" : "+v"(tid_)); const int tid = tid_; const int bx = blockIdx.x;
    if (tid < 4) { const int t = btok_(tid); const float rs = nrs_(p, t);
        { const float ref = nh_(p, t, (7 + 50 * tid + bx) % 256, rs), fast = bf2f(((const bf16*)(ws + O_CQKV))[(size_t)t * 384 + (7 + 50 * tid + bx) % 256]); if (!close_(fast, ref)) dbg_fail(p, 0u); }
        { const float ref = nh_(p, t, 256 + (9 + 20 * tid + bx) % 128, rs), fast = bf2f(((const bf16*)(ws + O_CQKV))[(size_t)t * 384 + 256 + (9 + 20 * tid + bx) % 128]); if (!close_(fast, ref)) dbg_fail(p, 0u); }
        { const int ch = (3 + 37 * tid + 2 * bx) % 512; const float ref = nh_(p, t, 1440 + ch, rs), fast = bf2f(((const bf16*)(ws + O_MV))[(size_t)t * 512 + ch]); if (!close_(fast, ref)) dbg_fail(p, 0u); }
    } else if (tid < 8) { const int i = tid - 4, t = btok_(tid); const int sq = seq_of(t), s0 = seq_start(sq), sl = seq_len(sq);
        for (int w = 0; w < 2; ++w) { const int ch = (w ? 512 : 0) + (11 + 100 * i + 2 * bx) % 512; float a[3];
            for (int d = -1; d <= 1; ++d) { const int tt = t + d; a[d + 1] = (tt >= s0 && tt < s0 + sl) ? nh_(p, tt, 416 + ch, nrs_(p, tt)) : 0.f; }
            float v = a[0] * p.m_conv_w[ch] + a[1] * p.m_conv_w[1024 + ch] + a[2] * p.m_conv_w[2048 + ch] + p.m_conv_b[ch]; v = v / (1.f + expf(-v)); if (w) v *= 0.08838834764831845f;
            const float fast = bf2f(((const bf16*)(ws + (w ? O_KC : O_QC)))[(size_t)t * 512 + (ch & 511)]); if (!close_(fast, v)) { const int pos = t - s0, row = pos % 252 + 2; const int jj = pos / 252, pm = sq < 2 ? sq * 33 + jj : 66 + (sq - 2) * 17 + jj; (void)pm; const int fr_ = row & 15, m_ = (row >> 4) & 3; (void)fr_; (void)m_; { unsigned b = 0; if (fr_ == 1) b = 1u; else if (fr_ == 2) b = 2u; else if (fr_ == 3) b = 4u; else if (fr_ == 12) b = 8u; else if (fr_ == 13) b = 16u; else if (fr_ == 14) b = 32u; dbg_fail(p, b); } } }
    } else if (tid < 12) { const int i = tid - 8, t = btok_(tid); const float rs = nrs_(p, t); const int sq = seq_of(t), pos = t - seq_start(sq);
        { const int gi = (5 + 2 * i + bx) & 15; float v = nh_(p, t, 2464 + gi, rs) + p.gate_bias[gi]; if ((gi >> 2) & 1) v = fminf(v, 0.f) - log1pf(expf(-fabsf(v))); const float fast = ((const float*)(ws + O_G))[(size_t)t * 16 + gi]; if (!close_(fast, v)) dbg_fail(p, 0u); }
        { const int ii = (3 + i + bx) & 15; const float x1 = nh_(p, t, 384 + ii, rs), x2 = nh_(p, t, 384 + 16 + ii, rs); const float ang = (float)pos / powf(10000.f, ii / 16.f); const float c = cosf(ang), sn = sinf(ang);
          const float r1 = x1 * c - x2 * sn, r2 = x2 * c + x1 * sn; const bf16* KR = (const bf16*)(ws + O_KR); if (!close_(bf2f(KR[(size_t)t * 32 + ii]), r1) || !close_(bf2f(KR[(size_t)t * 32 + 16 + ii]), r2)) dbg_fail(p, 0u); }
        { const int ch = (17 + 60 * i + 2 * bx) % 512; float v = nh_(p, t, 1952 + ch, rs); v = 1.f / (1.f + expf(-v)); const float fast = bf2f(((const bf16*)(ws + O_MO))[(size_t)t * 512 + ch]); if (!close_(fast, v)) dbg_fail(p, 0u); }
    }
}
DI void chk_mlstm(const Params& p) {
    unsigned char* ws = p.ws; int tid_ = threadIdx.x; asm volatile("" : "+v"(tid_)); const int tid = tid_; const int sqm = blockIdx.x % 18, hd = (blockIdx.x / 18) & 3, t0 = seq_start(sqm), S = seq_len(sqm), tp = (blockIdx.x * 37 + 5) % S;
    const float* G = (const float*)(ws + O_G); const bf16* QC = (const bf16*)(ws + O_QC); const bf16* KC = (const bf16*)(ws + O_KC); const bf16* MV = (const bf16*)(ws + O_MV); const bf16* MO = (const bf16*)(ws + O_MO); const bf16* Y = (const bf16*)(ws + O_Y);
    const int d = tid >> 2, e0 = (tid & 3) * 32; float* sh = (float*)g_lds; float hsum = 0.f;
    for (int dir = 0; dir < 2; ++dir) {
        const int first = dir ? S - 1 : 0, step = dir ? -1 : 1, cnt = dir ? S - tp : tp + 1;
        float num = 0.f, den = 0.f;
        { float C[32];
#pragma unroll
          for (int e = 0; e < 32; ++e) C[e] = 0.f;
          for (int j = 0; j < cnt; ++j) { const int t = t0 + first + step * j; const float f = expf(G[(size_t)t * 16 + dir * 8 + 4 + hd]), ii = expf(G[(size_t)t * 16 + dir * 8 + hd]);
            const float v = bf2f(MV[(size_t)t * 512 + hd * 128 + d]) * ii;
#pragma unroll
            for (int e = 0; e < 32; ++e) { const float k = bf2f(KC[(size_t)t * 512 + hd * 128 + e0 + e]); C[e] = f * C[e] + v * k; } }
#pragma unroll
          for (int e = 0; e < 32; ++e) num += C[e] * bf2f(QC[(size_t)(t0 + tp) * 512 + hd * 128 + e0 + e]); }
        __builtin_amdgcn_sched_barrier(0);
        { float n[32];
#pragma unroll
          for (int e = 0; e < 32; ++e) n[e] = 0.f;
          for (int j = 0; j < cnt; ++j) { const int t = t0 + first + step * j; const float f = expf(G[(size_t)t * 16 + dir * 8 + 4 + hd]), ii = expf(G[(size_t)t * 16 + dir * 8 + hd]);
#pragma unroll
            for (int e = 0; e < 32; ++e) { const float k = bf2f(KC[(size_t)t * 512 + hd * 128 + e0 + e]); n[e] = f * n[e] + ii * k; } }
#pragma unroll
          for (int e = 0; e < 32; ++e) den += n[e] * bf2f(QC[(size_t)(t0 + tp) * 512 + hd * 128 + e0 + e]); }
        num += __shfl_xor(num, 1); num += __shfl_xor(num, 2); den += __shfl_xor(den, 1); den += __shfl_xor(den, 2);
        hsum += num / fmaxf(fabsf(den), 1.f);
    }
    __syncthreads();
    if ((tid & 3) == 0) sh[d] = hsum;
    __syncthreads();
    if (tid < 128) { float ss = 0.f; for (int e = 0; e < 128; ++e) ss += sh[e] * sh[e]; const float rstd = rsqrtf(ss * (1.f / 128.f) + EPS);
        const float ref = sh[tid] * rstd * p.m_out_norm[hd * 128 + tid] * bf2f(MO[(size_t)(t0 + tp) * 512 + hd * 128 + tid]); const float fast = bf2f(Y[(size_t)(t0 + tp) * 1024 + 512 + hd * 128 + tid]);
        if (!close_(fast, ref)) dbg_fail(p, 0u); }
    __syncthreads();
}
DI void chk_qkv(const Params& p) {
    unsigned char* ws = p.ws; int tid_ = threadIdx.x; asm volatile("" : "+v"(tid_)); const int tid = tid_; if (tid >= 4) return;
    const int t = btok_(tid); const int sq = seq_of(t), st = seq_start(sq), S = seq_len(sq), pos = t - st; const bf16* CQ = (const bf16*)(ws + O_CQKV) + (size_t)t * 384;
    float sq_ = 0.f, skv = 0.f; for (int k = 0; k < 256; ++k) sq_ += bf2f(CQ[k]) * bf2f(CQ[k]); for (int k = 0; k < 128; ++k) skv += bf2f(CQ[256 + k]) * bf2f(CQ[256 + k]);
    const float rq = rsqrtf(sq_ / 256.f + EPS), rkv = rsqrtf(skv / 128.f + EPS); const float qs = 0.10206207261596577f * 1.4426950408889634f;
    const int hd = (2 + tid + blockIdx.x) & 7;
    { const int dd = 13 + tid; float s = 0.f; for (int k = 0; k < 256; ++k) s += bf2f(CQ[k]) * p.q_norm[k] * p.w_uq[(size_t)k * 768 + hd * 96 + dd]; s *= rq * qs; if (!close_(bf2f(((const bf16*)(ws + O_Q))[(size_t)t * 768 + hd * 96 + dd]), s)) dbg_fail(p, 0u); }
    { const int ii = 2 + tid; float x1 = 0.f, x2 = 0.f; for (int k = 0; k < 256; ++k) { const float a = bf2f(CQ[k]) * p.q_norm[k]; x1 += a * p.w_uq[(size_t)k * 768 + hd * 96 + 64 + ii]; x2 += a * p.w_uq[(size_t)k * 768 + hd * 96 + 80 + ii]; }
      x1 *= rq * qs; x2 *= rq * qs; const float ang = (float)pos / powf(10000.f, ii / 16.f); const float c = cosf(ang), sn = sinf(ang); const bf16* Qp = (const bf16*)(ws + O_Q) + (size_t)t * 768 + hd * 96;
      if (!close_(bf2f(Qp[64 + ii]), x1 * c - x2 * sn) || !close_(bf2f(Qp[80 + ii]), x2 * c + x1 * sn)) dbg_fail(p, 0u); }
    { const int dd = 21 + tid; float s = 0.f, v = 0.f; for (int k = 0; k < 128; ++k) { const float a = bf2f(CQ[256 + k]) * p.kv_norm[k]; s += a * p.w_ukv[(size_t)k * 1024 + hd * 128 + dd]; v += a * p.w_ukv[(size_t)k * 1024 + hd * 128 + 64 + dd]; }
      s *= rkv; v *= rkv; if (!close_(bf2f(((const bf16*)(ws + O_KN))[(size_t)t * 512 + hd * 64 + dd]), s)) dbg_fail(p, 0u);
      if (!close_(bf2f(((const bf16*)(ws + O_VT))[(size_t)st * 512 + (size_t)(hd * 64 + dd) * S + pos]), v)) dbg_fail(p, 0u); }
}
DI void chk_attn(const Params& p) {
    unsigned char* ws = p.ws; int tid_ = threadIdx.x; asm volatile("" : "+v"(tid_)); const int tid = tid_; if (tid >= 64) return;
    const int smp = tid >> 4, dd = (tid & 15) * 4 + (blockIdx.x & 3); const int t = btok_(smp), hd = (1 + 2 * smp + blockIdx.x) & 7; const int sq = seq_of(t), st = seq_start(sq), S = seq_len(sq);
    const bf16* Q = (const bf16*)(ws + O_Q) + (size_t)t * 768 + hd * 96; const bf16* KN = (const bf16*)(ws + O_KN); const bf16* KR = (const bf16*)(ws + O_KR); const bf16* VT = (const bf16*)(ws + O_VT) + (size_t)st * 512 + (size_t)(hd * 64 + dd) * S;
    float m = -1e30f, l = 0.f, o = 0.f;
    for (int k = 0; k < S; ++k) { float s = 0.f; for (int e = 0; e < 64; ++e) s += bf2f(Q[e]) * bf2f(KN[(size_t)(st + k) * 512 + hd * 64 + e]); for (int e = 0; e < 32; ++e) s += bf2f(Q[64 + e]) * bf2f(KR[(size_t)(st + k) * 32 + e]);
        const float mn = fmaxf(m, s), a = exp2f(m - mn), pe = exp2f(s - mn); l = l * a + pe; o = o * a + pe * bf2f(VT[k]); m = mn; }
    const float ref = o / l, fast = bf2f(((const bf16*)(ws + O_Y))[(size_t)t * 1024 + hd * 64 + dd]); if (!close_(fast, ref)) dbg_fail(p, 0u);
}
DI void dbg_emit(const Params& p) {
    const float a = sqrtf((float)*(const unsigned*)(p.ws + O_DBG)); const int gt = blockIdx.x * NTHR + threadIdx.x, GT = gridDim.x * NTHR;
    for (size_t i = gt; i < (size_t)T_TOK * DM / 4; i += GT) ((f32x4*)p.out)[i] = (f32x4){a, a, a, a};
}

DI int dtok_(int i) { return i == 0 ? 62 : i == 1 ? 63 : i == 2 ? 253 : i == 3 ? 254 : i == 4 ? 8191 : i == 5 ? 16384 : i == 6 ? 20253 : 81919; }
DI float rowrs_(const float* x) { float s = 0.f; for (int k = 0; k < 1024; ++k) s += x[k] * x[k]; return rsqrtf(s * (1.f / 1024.f) + EPS); }
DI void chk_res(const Params& p, const bf16* A, int K, const float* W, bool first, unsigned bit, int slot) {
    if (threadIdx.x >= 8) return; const int i = threadIdx.x, t = btok_(i), c = (5 + 127 * i + 3 * (int)blockIdx.x) & 1023; float* sv = (float*)(p.ws + O_DBG + 64) + (size_t)blockIdx.x * 32;
    float s = first ? xin_row(p, t)[c] : sv[slot * 8 + i]; for (int k = 0; k < K; ++k) s += bf2f(A[(size_t)t * K + k]) * W[(size_t)k * 1024 + c];
    if (!close_(p.out[(size_t)t * DM + c], s)) dbg_fail(p, bit);
    sv[(slot + 1) * 8 + i] = p.out[(size_t)t * DM + c];
}
DI void chk_up(const Params& p, int layer) {
    if (threadIdx.x >= 8) return; const int i = threadIdx.x, t = btok_(i), j = (9 + 350 * i + 11 * (int)blockIdx.x) % 2816; const int sq = seq_of(t), s0 = seq_start(sq), sl = seq_len(sq);
    const float* W = p.ffn_w_up + (size_t)layer * 1024 * 5632; const float* cw = p.ffn_conv_w + (size_t)layer * 3 * 5632; const float* cb = p.ffn_conv_b + (size_t)layer * 5632; const float* gn = p.ffn_norm + layer * 1024;
    float g = cb[j], v = cb[2816 + j];
    for (int d = -1; d <= 1; ++d) { const int tt = t + d; if (tt < s0 || tt >= s0 + sl) continue; const float* x = p.out + (size_t)tt * DM; const float rs = rowrs_(x); float ag = 0.f, av = 0.f;
        for (int k = 0; k < 1024; ++k) { const float xn = x[k] * rs * gn[k]; ag += xn * W[(size_t)k * 5632 + j]; av += xn * W[(size_t)k * 5632 + 2816 + j]; }
        g += ag * cw[(d + 1) * 5632 + j]; v += av * cw[(d + 1) * 5632 + 2816 + j]; }
    const float ref = g / (1.f + expf(-g)) * v, fast = bf2f(((const bf16*)(p.ws + O_HID))[(size_t)t * DFF + j]); if (!close_(fast, ref)) dbg_fail(p, DBG == 3 ? (i < 6 ? (1u << i) : 0u) : 2u);
}
DI void chk_gin(const Params& p) {
    if (threadIdx.x >= 8) return; const int i = threadIdx.x, t = btok_(i), c = (3 + 120 * i + 5 * (int)blockIdx.x) & 1023; const float* x = p.out + (size_t)t * DM; const float rs = rowrs_(x); float au = 0.f, av = 0.f;
    for (int k = 0; k < 1024; ++k) { const float xn = x[k] * rs * p.c_norm[k]; au += xn * p.c_w_in[(size_t)k * 2048 + c]; av += xn * p.c_w_in[(size_t)k * 2048 + 1024 + c]; }
    au = 0.5f * au * (1.f + erff(au * 0.70710678f)); av = 0.5f * av * (1.f + erff(av * 0.70710678f));
    if (!close_(bf2f(((const bf16*)(p.ws + O_U))[(size_t)t * DM + c]), au) || !close_(bf2f(((const bf16*)(p.ws + O_V))[(size_t)t * DM + c]), av)) dbg_fail(p, 8u);
}
DI void chk_sp(const Params& p) {
    if (threadIdx.x >= 8) return; const int i = threadIdx.x, t = btok_(i), g = (i + (int)blockIdx.x) & 7, c = (7 + 13 * i + (int)blockIdx.x) & 127, t0 = t & ~127, tt = t & 127; const bf16* V = (const bf16*)(p.ws + O_V); const bf16* U = (const bf16*)(p.ws + O_U);
    float acc = 0.f;
    for (int s2 = 0; s2 < 128; ++s2) { const bf16* vr = V + (size_t)(t0 + s2) * DM; float ss = 0.f; for (int k = 0; k < 1024; ++k) ss += bf2f(vr[k]) * bf2f(vr[k]); const float rv = rsqrtf(ss * (1.f / 1024.f) + EPS);
        acc += p.c_w_sp[(size_t)g * 16384 + tt * 128 + s2] * bf2f(vr[g * 128 + c]) * rv * p.c_v_norm[g * 128 + c]; }
    const float ref = (acc + p.c_b_sp[g * 128 + tt]) * bf2f(U[(size_t)t * DM + g * 128 + c]); if (!close_(bf2f(((const bf16*)(p.ws + O_Z))[(size_t)t * DM + g * 128 + c]), ref)) dbg_fail(p, 0u);
}
#if defined(__HIP_DEVICE_COMPILE__)
#define GETP() Params p; { typedef const unsigned long long __attribute__((address_space(4)))* KA_; KA_ q_ = (KA_)__builtin_amdgcn_kernarg_segment_ptr(); asm volatile("" : "+s"(q_)); \
    typedef __attribute__((address_space(1))) unsigned char* GP_; const void** pp_ = (const void**)&p; _Pragma("unroll") for (int i_ = 0; i_ < 27; ++i_) pp_[i_] = (const void*)(GP_)q_[i_]; } unsigned char* ws = p.ws; (void)ws;
#else
#define GETP() Params p = p_unused; unsigned char* ws = p.ws; (void)ws;
#endif
__global__ void __launch_bounds__(NTHR, 2) fwd_kernel(Params p_unused, int lo, int hi) {
    cg::grid_group grid = cg::this_grid();
#define PH(k, ...) if (lo <= (k) && (k) < hi) { GETP() __VA_ARGS__ } if (lo <= (k) && (k) + 1 < hi) grid.sync();
    PH(0, p0_prologue(p); if (DBG && blockIdx.x == 0 && threadIdx.x == 0) *(unsigned*)(p.ws + O_DBG) = 0u;)
    PH(1, Gemm g{(const bf16*)(ws + O_XB), (const bf16*)(ws + O_WIN), 1024, NM_OVL, 10, 1}; EpiIn E{p}; gemm_phase(g, E);)
    PH(2, mlstm_local(p);)
    PH(3, mlstm_scan(p);)
    PH(4, mlstm_out(p);)
    PH(5, Gemm g{(const bf16*)(ws + O_CQKV), (const bf16*)(ws + O_WQKV), 384, NM_PLAIN, 7, 0, 1}; EpiQkv E{p}; gemm_phase(g, E);)
    PH(6, attn_phase(p);)
    PH(7, Gemm g{(const bf16*)(ws + O_Y), (const bf16*)(ws + O_WOUT), 1024, NM_PLAIN, 4, 0}; EpiRes E{p, 1, 0}; gemm_phase<EpiRes, true>(g, E);)
    PH(8, Gemm g{(const bf16*)(ws + O_XB), (const bf16*)(ws + O_WUP), 1024, NM_OVL, 22, 1}; EpiUp E{p, 0}; gemm_phase<EpiUp, false>(g, E);)
    PH(9, Gemm g{(const bf16*)(ws + O_HID), (const bf16*)(ws + O_WDN), 2816, NM_PLAIN, 4, 0}; EpiRes E{p, 0, 0}; gemm_phase<EpiRes, true>(g, E);)
    PH(10, Gemm g{(const bf16*)(ws + O_XB), (const bf16*)(ws + O_WCIN), 1024, NM_PLAIN, 8, 0}; EpiGin E{p}; gemm_phase<EpiGin, true>(g, E);)
    PH(11, spatial_phase(p);)
    PH(12, Gemm g{(const bf16*)(ws + O_Z), (const bf16*)(ws + O_WCOUT), 1024, NM_PLAIN, 4, 0}; EpiRes E{p, 0, 0}; gemm_phase<EpiRes, true>(g, E);)
    PH(13, Gemm g{(const bf16*)(ws + O_XB), (const bf16*)(ws + O_WUP + AL((size_t)5632 * 1024 * 2)), 1024, NM_OVL, 22, 1}; EpiUp E{p, 1}; gemm_phase<EpiUp, false>(g, E);)
    PH(14, Gemm g{(const bf16*)(ws + O_HID), (const bf16*)(ws + O_WDN + AL((size_t)1024 * 2816 * 2)), 2816, NM_PLAIN, 4, 0}; EpiRes E{p, 0, 1}; gemm_phase<EpiRes, true>(g, E);)
    PH(15, final_phase(p);)
}
#if DBG
__global__ void __launch_bounds__(NTHR) chk_kernel(Params p, int which) {
    unsigned char* ws = p.ws; (void)ws;
    if (which == 1) chk_inproj(p);
    else if (which == 4) chk_mlstm(p);
    else if (which == 5) chk_qkv(p);
    else if (which == 6) chk_attn(p);
    else if (which == 7) chk_res(p, (const bf16*)(ws + O_Y), 1024, p.ab_w_out, true, 1u, 0);
    else if (which == 8) chk_up(p, 0);
    else if (which == 9) chk_res(p, (const bf16*)(ws + O_HID), 2816, p.ffn_w_down, false, 4u, 1);
    else if (which == 10) chk_gin(p);
    else if (which == 11) chk_sp(p);
    else if (which == 12) chk_res(p, (const bf16*)(ws + O_Z), 1024, p.c_w_out, false, 32u, 2);
    else if (which == 13) chk_up(p, 1);
    else if (which == 99) dbg_emit(p);
}
#endif

extern "C" void kernel_launch(void* const* d_in, const int* in_sizes, int n_in, void* d_out, int out_size, void* d_ws, size_t ws_size, hipStream_t stream) {
    static int grid = 0;
    if (grid == 0) {
        if (n_in != 25 || ws_size < WS_NEED + 65536 || out_size != T_TOK * DM) { fprintf(stderr, "kernel_launch: unexpected problem: n_in %d out %d ws %zu (need %zu)\n", n_in, out_size, ws_size, (size_t)WS_NEED); grid = -1; return; }
        int dev = 0, cus = 0, per_cu = 0;
        hipGetDevice(&dev); hipDeviceGetAttribute(&cus, hipDeviceAttributeMultiprocessorCount, dev);
        if (hipFuncSetAttribute((const void*)fwd_kernel, hipFuncAttributeMaxDynamicSharedMemorySize, LDS_BYTES) != hipSuccess) { fprintf(stderr, "kernel_launch: hipFuncSetAttribute failed\n"); grid = -1; return; }
        hipOccupancyMaxActiveBlocksPerMultiprocessor(&per_cu, (const void*)fwd_kernel, NTHR, LDS_BYTES);
        if (per_cu < 1) { fprintf(stderr, "kernel_launch: occupancy query says %d blocks per CU\n", per_cu); per_cu = 1; }
        (void)hipGetLastError();
        grid = cus;
    }
    if (grid < 0) return;
    Params p{};
    const float** f = (const float**)&p;
    for (int i = 0; i < 25; ++i) f[i] = (const float*)d_in[i];
    p.out = (float*)d_out; p.ws = (unsigned char*)d_ws;
    auto run = [&](int lo, int hi) { void* args[] = {&p, &lo, &hi};
        hipError_t e = hipLaunchCooperativeKernel((const void*)fwd_kernel, dim3(grid), dim3(NTHR), args, LDS_BYTES, stream);
        if (e != hipSuccess) fprintf(stderr, "cooperative launch failed: %s (grid %d)\n", hipGetErrorString(e), grid); };
#if DBG == 0
    run(0, 16);
#else
    int cur = 0;
    auto upto = [&](int k) { run(cur, k + 1); cur = k + 1; };
    auto chk = [&](int which) { hipLaunchKernelGGL(chk_kernel, dim3(grid), dim3(NTHR), 4096, stream, p, which); };
#if DBG == 1
    upto(1); chk(1); upto(4); chk(4); upto(5); chk(5); upto(6); chk(6);
#else
    upto(7); chk(7); upto(8); chk(8); upto(9); chk(9); upto(10); chk(10); upto(11); chk(11); upto(12); chk(12);
#if DBG == 4
    upto(13); chk(13);
#endif
#endif
    chk(99);
#endif
}
```

```cpp
#include <hip/hip_runtime.h>
#include <hip/hip_cooperative_groups.h>
#include <cstdio>
#include <cstdint>
namespace cg = cooperative_groups;

typedef unsigned short bf16;
typedef short bf16x8 __attribute__((ext_vector_type(8)));
typedef short s16x4 __attribute__((ext_vector_type(4)));
typedef float f32x2 __attribute__((ext_vector_type(2)));
typedef float f32x4 __attribute__((ext_vector_type(4)));
typedef float f32x16 __attribute__((ext_vector_type(16)));
typedef unsigned u32x2 __attribute__((ext_vector_type(2)));
typedef unsigned u32x4 __attribute__((ext_vector_type(4)));
typedef __bf16 bf2_t __attribute__((ext_vector_type(2)));
#define DI __device__ __forceinline__
#define MFMA32(a, b, c) __builtin_amdgcn_mfma_f32_32x32x16_bf16((a), (b), (c), 0, 0, 0)

constexpr int NTHR = 512;
constexpr int T_TOK = 81920, TP = 16384, DM = 1024;
constexpr int NCHUNK = T_TOK / 128;
constexpr int DFF = 2816;
constexpr float EPS = 1e-6f;
constexpr int LDS_BYTES = 147456;

constexpr size_t AL(size_t x) { return (x + 255) & ~(size_t)255; }
constexpr size_t O_WIN = 0;
constexpr size_t O_WQKV = O_WIN + AL((size_t)2560 * 1024 * 2);
constexpr size_t O_WOUT = O_WQKV + AL((size_t)1792 * 384 * 2);
constexpr size_t O_WCIN = O_WOUT + AL((size_t)1024 * 1024 * 2);
constexpr size_t O_WCOUT = O_WCIN + AL((size_t)2048 * 1024 * 2);
constexpr size_t O_WUP = O_WCOUT + AL((size_t)1024 * 1024 * 2);
constexpr size_t O_WDN = O_WUP + 2 * AL((size_t)5632 * 1024 * 2);
constexpr size_t O_WSP = O_WDN + 2 * AL((size_t)1024 * 2816 * 2);
constexpr size_t O_ROPE = O_WSP + AL((size_t)8 * 128 * 128 * 2);
constexpr size_t O_SS = O_ROPE + AL((size_t)8192 * 32 * 4);
constexpr size_t O_VSS = O_SS + AL((size_t)T_TOK * 16);
constexpr size_t O_RQ = O_VSS + AL((size_t)T_TOK * 16);
constexpr size_t O_RKV = O_RQ + AL((size_t)T_TOK * 4);
constexpr size_t O_KR = O_RKV + AL((size_t)T_TOK * 4);
constexpr size_t O_G = O_KR + AL((size_t)T_TOK * 32 * 2);
constexpr size_t O_NS = O_G + AL((size_t)T_TOK * 16 * 4);
constexpr size_t O_ML = O_NS + AL((size_t)5120 * 128 * 4);
constexpr size_t O_BL = O_ML + AL((size_t)5120 * 4);
constexpr size_t O_MP = O_BL + AL((size_t)5120 * 4);
constexpr size_t O_XBG = O_MP + AL((size_t)5120 * 4);
constexpr size_t O_XB = O_XBG + 4096;
constexpr size_t O_AR = O_XB + AL((size_t)T_TOK * 1024 * 2);
constexpr size_t O_CQKV = O_AR;
constexpr size_t O_QC = O_CQKV + AL((size_t)T_TOK * 384 * 2);
constexpr size_t O_KC = O_QC + AL((size_t)T_TOK * 512 * 2);
constexpr size_t O_MV = O_KC + AL((size_t)T_TOK * 512 * 2);
constexpr size_t O_MO = O_MV + AL((size_t)T_TOK * 512 * 2);
constexpr size_t O_CS = O_MO + AL((size_t)T_TOK * 512 * 2);
constexpr size_t O_Y = O_CS + AL((size_t)5120 * 16384 * 2);
constexpr size_t O_END0 = O_Y + AL((size_t)T_TOK * 1024 * 2);
constexpr size_t O_Q = O_QC;
constexpr size_t O_KN = O_Q + AL((size_t)T_TOK * 768 * 2);
constexpr size_t O_VT = O_KN + AL((size_t)T_TOK * 512 * 2);
static_assert(O_VT + (size_t)T_TOK * 512 * 2 <= O_CS, "attention operands overlay");
constexpr size_t O_HID = O_AR;
constexpr size_t O_U = O_AR;
constexpr size_t O_V = O_U + AL((size_t)T_TOK * 1024 * 2);
constexpr size_t O_Z = O_V + AL((size_t)T_TOK * 1024 * 2);
constexpr size_t WS_NEED = O_END0;
static_assert(O_HID + (size_t)T_TOK * 2816 * 2 <= O_END0 && O_Z + (size_t)T_TOK * 2048 <= O_END0, "arena");

struct Params {
    const float* x_prompt; const float* x_sample;
    const float *ab_norm, *ab_w_in, *q_norm, *w_uq, *kv_norm, *w_ukv, *m_conv_w, *m_conv_b, *gate_bias, *m_out_norm, *ab_w_out;
    const float *c_norm, *c_w_in, *c_v_norm, *c_w_sp, *c_b_sp, *c_w_out;
    const float *ffn_norm, *ffn_w_up, *ffn_conv_w, *ffn_conv_b, *ffn_w_down, *final_norm;
    float* out; unsigned char* ws;
};

extern __shared__ __attribute__((aligned(16))) unsigned char g_lds[];

DI unsigned pk2(float lo, float hi) { f32x2 v = {lo, hi}; bf2_t b = __builtin_convertvector(v, bf2_t); return __builtin_bit_cast(unsigned, b); }
DI bf16 f2bf(float x) { return (bf16)(pk2(x, 0.f) & 0xffffu); }
DI float bf2f(bf16 x) { return __uint_as_float(((unsigned)x) << 16); }
DI float bflo(unsigned u) { return __uint_as_float(u << 16); }
DI float bfhi(unsigned u) { return __uint_as_float(u & 0xffff0000u); }
DI int seq_start(int sq) { return sq < 2 ? (sq << 13) : TP + ((sq - 2) << 12); }
DI int seq_len(int sq) { return sq < 2 ? 8192 : 4096; }
DI int seq_of(int t) { return t < TP ? (t >> 13) : 2 + ((t - TP) >> 12); }
DI float wave_sum(float v) {
#pragma unroll
    for (int o = 1; o < 64; o <<= 1) v += __shfl_xor(v, o);
    return v;
}
DI float frcp(float x) { return __builtin_amdgcn_rcpf(x); }
DI float sigmoidf_(float x) { return frcp(1.f + __builtin_amdgcn_exp2f(-1.4426950408889634f * x)); }
DI float siluf_(float x) { return x * frcp(1.f + __builtin_amdgcn_exp2f(-1.4426950408889634f * x)); }
DI float logsigmoidf_(float x) { return fminf(x, 0.f) - log1pf(__expf(-fabsf(x))); }
DI float geluf_(float v) {
    const float av = fabsf(v), t = frcp(1.f + 0.2316418882f * av);
    float q = t * 0.5307027145f + (-0.7265760135f); q = q * t + 0.7107068705f; q = q * t + (-0.142248368f); q = q * t + 0.127414796f; q = q * t;
    const float e = __builtin_amdgcn_exp2f(v * v * (-0.72134752044f));
    const float m = v * (q * e);
    return v < 0.f ? m : v - m;
}
DI f32x4 ld_ss(const f32x4* SS, int t) { return SS[t]; }
DI float rs_of(const f32x4* SS, int t) { f32x4 s = SS[t]; return rsqrtf(((s.x + s.y) + (s.z + s.w)) * (1.f / 1024.f) + EPS); }
DI const float* xin_row(const Params& p, int t) { return t < TP ? p.x_prompt + (size_t)t * DM : p.x_sample + (size_t)(t - TP) * DM; }

DI int srccol(int perm, int n) {
    if (perm == 1) { if (n < 416) return n; if (n < 432) return 2464 + (n - 416); if (n < 512) return -1; return n - 96; }
    if (perm == 2) { const int hd = (n & 511) >> 6, d = n & 63; return hd * 128 + (n >= 512 ? 64 : 0) + d; }
    if (perm == 3) { const int pn = n >> 8, c = n & 255; return c < 128 ? pn * 128 + c : 2816 + pn * 128 + (c - 128); }
    return n;
}
struct P0Job { const float* src; const float* gain; bf16* dst; int Nsrc, dld, dcol0, perm, k0, n0; };
DI void p0_job(const Params& p, int it, P0Job& J) {
    unsigned char* ws = p.ws; int r = it; int Nd;
    if (r < 640) { J.src = p.ab_w_in; J.Nsrc = 2480; Nd = 2560; J.dst = (bf16*)(ws + O_WIN); J.dld = 1024; J.dcol0 = 0; J.gain = p.ab_norm; J.perm = 1; }
    else if ((r -= 640) < 48) { J.src = p.w_uq; J.Nsrc = 768; Nd = 768; J.dst = (bf16*)(ws + O_WQKV); J.dld = 384; J.dcol0 = 0; J.gain = p.q_norm; J.perm = 0; }
    else if ((r -= 48) < 32) { J.src = p.w_ukv; J.Nsrc = 1024; Nd = 1024; J.dst = (bf16*)(ws + O_WQKV) + (size_t)768 * 384; J.dld = 384; J.dcol0 = 256; J.gain = p.kv_norm; J.perm = 2; }
    else if ((r -= 32) < 256) { J.src = p.ab_w_out; J.Nsrc = 1024; Nd = 1024; J.dst = (bf16*)(ws + O_WOUT); J.dld = 1024; J.dcol0 = 0; J.gain = nullptr; J.perm = 0; }
    else if ((r -= 256) < 512) { J.src = p.c_w_in; J.Nsrc = 2048; Nd = 2048; J.dst = (bf16*)(ws + O_WCIN); J.dld = 1024; J.dcol0 = 0; J.gain = p.c_norm; J.perm = 0; }
    else if ((r -= 512) < 256) { J.src = p.c_w_out; J.Nsrc = 1024; Nd = 1024; J.dst = (bf16*)(ws + O_WCOUT); J.dld = 1024; J.dcol0 = 0; J.gain = nullptr; J.perm = 0; }
    else if ((r -= 256) < 2816) { const int l = r / 1408; r -= l * 1408; J.src = p.ffn_w_up + (size_t)l * 1024 * 5632; J.Nsrc = 5632; Nd = 5632;
        J.dst = (bf16*)(ws + O_WUP + l * AL((size_t)5632 * 1024 * 2)); J.dld = 1024; J.dcol0 = 0; J.gain = p.ffn_norm + l * 1024; J.perm = 3; }
    else { r -= 2816; const int l = r / 704; r -= l * 704; J.src = p.ffn_w_down + (size_t)l * 2816 * 1024; J.Nsrc = 1024; Nd = 1024;
        J.dst = (bf16*)(ws + O_WDN + l * AL((size_t)1024 * 2816 * 2)); J.dld = 2816; J.dcol0 = 0; J.gain = nullptr; J.perm = 0; }
    const int nnt = Nd / 64; J.k0 = (r / nnt) * 64; J.n0 = (r % nnt) * 64;
}
DI void p0_load(const P0Job& J, int tid, float (&v)[8]) {
    const int j = tid & 63, sc = srccol(J.perm, J.n0 + j);
#pragma unroll
    for (int r = 0; r < 8; ++r) { const int k = J.k0 + (tid >> 6) + 8 * r; float x = 0.f; if (sc >= 0) { x = J.src[(size_t)k * J.Nsrc + sc]; if (J.gain) x *= J.gain[k]; } v[r] = x; }
}
DI void p0_row(const Params& p, int t, int lane) {
    bf16* XB = (bf16*)(p.ws + O_XB); f32x4* SS = (f32x4*)(p.ws + O_SS);
    const f32x4* xr = (const f32x4*)xin_row(p, t) + lane;
    f32x4 v[4]; float s = 0.f;
#pragma unroll
    for (int j = 0; j < 4; ++j) { v[j] = xr[64 * j]; s += (v[j].x * v[j].x + v[j].y * v[j].y) + (v[j].z * v[j].z + v[j].w * v[j].w); }
    s = wave_sum(s);
    u32x2* o = (u32x2*)(XB + (size_t)t * DM) + lane;
#pragma unroll
    for (int j = 0; j < 4; ++j) { u32x2 w; w.x = pk2(v[j].x, v[j].y); w.y = pk2(v[j].z, v[j].w); o[64 * j] = w; }
    if (lane == 0) { f32x4 q = {s, 0.f, 0.f, 0.f}; SS[t] = q; }
}
DI void p0_prologue(const Params& p) {
    unsigned char* ws = p.ws;
    int tid_ = threadIdx.x; asm volatile("" : "+v"(tid_)); const int tid = tid_;
    const int lane = tid & 63, NGW = gridDim.x * 8; int trow = blockIdx.x * 8 + (tid >> 6);
    constexpr int NJ = 5968;
    {
        float* tile = (float*)g_lds;
        P0Job J; float v[8]; int it = blockIdx.x;
        if (it < NJ) { p0_job(p, it, J); p0_load(J, tid, v); }
        for (; it < NJ; it += gridDim.x) {
#pragma unroll
            for (int r = 0; r < 8; ++r) tile[((tid >> 6) + 8 * r) * 65 + (tid & 63)] = v[r];
            __syncthreads();
            P0Job Jn = J; const int nit = it + gridDim.x;
            if (nit < NJ) { p0_job(p, nit, Jn); p0_load(Jn, tid, v); }
            const int n = tid >> 3, kc = (tid & 7) * 8;
            u32x4 o;
            o.x = pk2(tile[(kc + 0) * 65 + n], tile[(kc + 1) * 65 + n]); o.y = pk2(tile[(kc + 2) * 65 + n], tile[(kc + 3) * 65 + n]);
            o.z = pk2(tile[(kc + 4) * 65 + n], tile[(kc + 5) * 65 + n]); o.w = pk2(tile[(kc + 6) * 65 + n], tile[(kc + 7) * 65 + n]);
            *(u32x4*)(J.dst + (size_t)(J.n0 + n) * J.dld + J.dcol0 + J.k0 + kc) = o;
            if (trow < T_TOK) { p0_row(p, trow, lane); trow += NGW; }
            if (trow < T_TOK) { p0_row(p, trow, lane); trow += NGW; }
            __syncthreads();
            J = Jn;
        }
    }
    for (; trow < T_TOK; trow += NGW) p0_row(p, trow, lane);
    const int gt = blockIdx.x * NTHR + tid, GT = gridDim.x * NTHR;
    if (gt < 256) ((u32x4*)(ws + O_XBG))[gt] = (u32x4){0u, 0u, 0u, 0u};
    {
        bf16* W = (bf16*)(ws + O_WQKV); const u32x4 z = {0u, 0u, 0u, 0u};
        for (int v = gt; v < 768 * 16 + 1024 * 32; v += GT) {
            if (v < 768 * 16) { const int row = v >> 4, c = v & 15; *(u32x4*)(W + (size_t)row * 384 + 256 + c * 8) = z; }
            else { const int u = v - 768 * 16, row = 768 + (u >> 5), c = u & 31; *(u32x4*)(W + (size_t)row * 384 + c * 8) = z; }
        }
    }
    { bf16* W = (bf16*)(ws + O_WSP); for (int v = gt; v < 8 * 128 * 128; v += GT) W[v] = f2bf(p.c_w_sp[v]); }
    { float* RC = (float*)(ws + O_ROPE); float* RSN = RC + 8192 * 16;
      for (int v = gt; v < 8192 * 16; v += GT) { const int pos = v >> 4, i = v & 15; const float inv = 1.0f / powf(10000.f, (float)i * (1.f / 16.f)); const float ang = (float)pos * inv;
        float s, c; sincosf(ang, &s, &c); RC[v] = c; RSN[v] = s; } }
}

#define LAS __attribute__((address_space(3)))
constexpr int STAGE_BYTES = 131072;
constexpr int EPI_OFF = 131072;
DI int lds_byte(int r, int c) { const int st = (r >> 4) * 2 + (c >> 5), rr = r & 15, cc = c & 31, ob = rr * 64 + cc * 2; return st * 1024 + (ob ^ (((ob >> 9) & 1) << 5)); }
DI void stage_rc(int b, int& R, int& C) { const int st = b / 1024, sb = b % 1024, swz = sb ^ (((sb >> 9) & 1) << 5); R = (st >> 1) * 16 + swz / 64; C = (st & 1) * 32 + (swz % 64) / 2; }

struct Gemm { const bf16* A; const bf16* Bt; int K, nM, nN, overlap; int kmode = 0; };
typedef f32x4 Acc[2][2][4][2];
struct Unit { int pm, pn, tbase, kofs, nt; };

DI void tile_rows(int overlap, int pm, int& tbase, int& s0, int& slen) {
    s0 = 0; slen = T_TOK;
    if (!overlap) tbase = pm * 256; else tbase = 254 * pm - 1;
}
DI bool seq_first(int t) { return t < TP ? (t & 8191) == 0 : (t & 4095) == 0; }
DI bool tile_has_seam(int tbase) { const int nb = ((tbase + 1 + 4095) >> 12) << 12; return nb <= tbase + 255; }
constexpr int NM_PLAIN = 320, NM_OVL = 323;
DI bool next_unit(const Gemm& g, int i, Unit& u) {
    const int nM = g.nM, nN = g.nN, nwg = nM * nN; const long L = (long)i * gridDim.x + blockIdx.x; if (L >= nwg) return false;
    int wgid = (int)L; { const int q = nwg / 8, r = nwg % 8, xcd = wgid % 8, off = wgid / 8; wgid = (xcd < r ? xcd * (q + 1) : r * (q + 1) + (xcd - r) * q) + off; }
    const int nig = 8 * nN, gid = wgid / nig, fm = gid * 8, gsz = (nM - fm) < 8 ? (nM - fm) : 8;
    u.pm = fm + ((wgid % nig) % gsz); u.pn = (wgid % nig) / gsz;
    int s0, slen; tile_rows(g.overlap, u.pm, u.tbase, s0, slen);
    if (g.kmode) { u.kofs = u.pn < 3 ? 0 : 512; u.nt = u.pn < 3 ? 4 : 2; } else { u.kofs = 0; u.nt = g.K / 64; }
    return true;
}

#define DPP_ROR1(x) __builtin_bit_cast(float, __builtin_amdgcn_update_dpp(0, __builtin_bit_cast(int, (x)), 0x121, 0xf, 0xf, false))
#define DPP_ROL1(x) __builtin_bit_cast(float, __builtin_amdgcn_update_dpp(0, __builtin_bit_cast(int, (x)), 0x12F, 0xf, 0xf, false))

template <class F> DI void row_reduce(float (&part)[2][4], int wr, int wc, int fr, int fq, F&& f) {
    float* red = (float*)(g_lds + EPI_OFF);
#pragma unroll
    for (int ai = 0; ai < 2; ++ai)
#pragma unroll
        for (int m = 0; m < 4; ++m) { float v = part[ai][m]; v += __shfl_xor(v, 16); v += __shfl_xor(v, 32);
            if (fq == 0) red[(ai * 128 + wr * 64 + m * 16 + fr) * 4 + wc] = v; }
    __syncthreads();
    if (threadIdx.x < 256) { const f32x4 s = *(const f32x4*)(red + threadIdx.x * 4); f((int)threadIdx.x, (s.x + s.y) + (s.z + s.w)); }
    __syncthreads();
}
DI void conv_exchange(const Acc& acc, int wr, int wc, int fr, int fq) {
    float* bnd = (float*)(g_lds + EPI_OFF + 4096);
#pragma unroll
    for (int ai = 0; ai < 2; ++ai)
#pragma unroll
        for (int bj = 0; bj < 2; ++bj)
#pragma unroll
            for (int n = 0; n < 2; ++n) { const int colL = bj * 128 + wc * 32 + n * 16 + fq * 4, rb = ai * 2 + wr;
                if (fr == 0) *(f32x4*)(bnd + (0 * 4 + rb) * 256 + colL) = acc[ai][bj][0][n];
                if (fr == 15) *(f32x4*)(bnd + (1 * 4 + rb) * 256 + colL) = acc[ai][bj][3][n]; }
    __syncthreads();
}
#undef DPP_ROR1
#undef DPP_ROL1
#define DPP_ROR1(x) __builtin_bit_cast(float, __builtin_amdgcn_update_dpp(__builtin_bit_cast(int, (x)), __builtin_bit_cast(int, (x)), 0x121, 0xf, 0xf, false))
#define DPP_ROL1(x) __builtin_bit_cast(float, __builtin_amdgcn_update_dpp(__builtin_bit_cast(int, (x)), __builtin_bit_cast(int, (x)), 0x12F, 0xf, 0xf, false))
DI f32x4 ror4(const f32x4 v) { f32x4 r; asm volatile("s_nop 1\n\tv_mov_b32_dpp %0, %4 row_ror:1 row_mask:0xf bank_mask:0xf\n\tv_mov_b32_dpp %1, %5 row_ror:1 row_mask:0xf bank_mask:0xf\n\tv_mov_b32_dpp %2, %6 row_ror:1 row_mask:0xf bank_mask:0xf\n\tv_mov_b32_dpp %3, %7 row_ror:1 row_mask:0xf bank_mask:0xf"
    : "=&v"(r.x), "=&v"(r.y), "=&v"(r.z), "=&v"(r.w) : "v"(v.x), "v"(v.y), "v"(v.z), "v"(v.w)); return r; }
DI f32x4 rol4(const f32x4 v) { f32x4 r; asm volatile("s_nop 1\n\tv_mov_b32_dpp %0, %4 row_ror:15 row_mask:0xf bank_mask:0xf\n\tv_mov_b32_dpp %1, %5 row_ror:15 row_mask:0xf bank_mask:0xf\n\tv_mov_b32_dpp %2, %6 row_ror:15 row_mask:0xf bank_mask:0xf\n\tv_mov_b32_dpp %3, %7 row_ror:15 row_mask:0xf bank_mask:0xf"
    : "=&v"(r.x), "=&v"(r.y), "=&v"(r.z), "=&v"(r.w) : "v"(v.x), "v"(v.y), "v"(v.z), "v"(v.w)); return r; }
template <int BJ, int N, int AI, int M> DI f32x4 conv_row(const Acc& acc, const f32x4 w0, const f32x4 w1, const f32x4 w2, const f32x4 b, const f32x4 upB, const f32x4 dnB, int fr) {
    const f32x4 v = acc[AI][BJ][M][N];
    const f32x4 pu = M > 0 ? ror4(acc[AI][BJ][M > 0 ? M - 1 : 0][N]) : upB;
    const f32x4 nd = M < 3 ? rol4(acc[AI][BJ][M < 3 ? M + 1 : 3][N]) : dnB;
    const f32x4 rv_ = ror4(v), lv_ = rol4(v);
    const f32x4 up = fr > 0 ? rv_ : pu, dn = fr < 15 ? lv_ : nd;
    f32x4 r_ = w0 * up + w1 * v + w2 * dn + b;
    asm volatile("" : "+v"(r_.x), "+v"(r_.y), "+v"(r_.z), "+v"(r_.w));
    return r_;
}
template <int BJ, int N, int AI> DI void conv_bnd(int wr, int wc, int fq, f32x4& upB, f32x4& dnB) {
    const float* bnd = (const float*)(g_lds + EPI_OFF + 4096);
    const int colL = BJ * 128 + wc * 32 + N * 16 + fq * 4, rb = AI * 2 + wr; const f32x4 z4 = {0.f, 0.f, 0.f, 0.f};
    upB = rb > 0 ? *(const f32x4*)(bnd + (4 + rb - 1) * 256 + colL) : z4; dnB = rb < 3 ? *(const f32x4*)(bnd + (rb + 1) * 256 + colL) : z4;
}

template <int BJ, int N, int AI> DI void conv4(const Acc& acc, const f32x4 w0, const f32x4 w1, const f32x4 w2, const f32x4 b, const f32x4 upB, const f32x4 dnB, int fr, f32x4 (&out)[4]) {
    f32x4 rprev = upB, lcur = rol4(acc[AI][BJ][0][N]);
#pragma unroll
    for (int M = 0; M < 4; ++M) { const f32x4 v = acc[AI][BJ][M][N]; const f32x4 rv_ = ror4(v); f32x4 lnext = dnB; if (M < 3) lnext = rol4(acc[AI][BJ][M < 3 ? M + 1 : 3][N]);
        const f32x4 up = fr > 0 ? rv_ : rprev, dn = fr < 15 ? lcur : lnext;
        out[M] = w0 * up + w1 * v + w2 * dn + b; rprev = rv_; lcur = lnext; }
}
#define FOR_ROWS(...) _Pragma("unroll") for (int ai = 0; ai < 2; ++ai) _Pragma("unroll") for (int m = 0; m < 4; ++m) { \
    const int row = ai * 128 + wr * 64 + m * 16 + fr; const int tg = tbase + row; const bool ok = (tg >= s0) && (tg < s0 + slen) && (!OVL || (row >= 1 && row <= 254)); (void)ok; __VA_ARGS__ }
#define FOR_COLS(...) _Pragma("unroll") for (int bj = 0; bj < 2; ++bj) _Pragma("unroll") for (int n = 0; n < 2; ++n) { const int colL = bj * 128 + wc * 32 + n * 16 + fq * 4; (void)colL; __VA_ARGS__ }
DI void st_bf4(bf16* p, const f32x4 v) { u32x2 w; w.x = pk2(v.x, v.y); w.y = pk2(v.z, v.w); *(u32x2*)p = w; }
DI void st_bf8(bf16* p, const f32x4 a, const f32x4 b) { u32x4 w; w.x = pk2(a.x, a.y); w.y = pk2(a.z, a.w); w.z = pk2(b.x, b.y); w.w = pk2(b.z, b.w); *(u32x4*)p = w; }
DI float sq4(const f32x4 v) { return (v.x * v.x + v.y * v.y) + (v.z * v.z + v.w * v.w); }

struct EpiIn {
    Params p;
    DI void operator()(Acc& acc, const Unit& u, int wr, int wc, int fr, int fq) const {
        constexpr bool OVL = true; unsigned char* ws = p.ws; const int pn = u.pn; int tbase, s0, slen; tile_rows(1, u.pm, tbase, s0, slen); const bool hb_ = tile_has_seam(tbase); (void)hb_;
        const f32x4* SS = (const f32x4*)(ws + O_SS);
        FOR_ROWS({ const bool val = (tg >= s0) && (tg < s0 + slen); const float rs = val ? rs_of(SS, tg) : 0.f;
            _Pragma("unroll") for (int bj = 0; bj < 2; ++bj) _Pragma("unroll") for (int n = 0; n < 2; ++n) acc[ai][bj][m][n] *= rs; })
        if (pn == 0) {
            bf16* CQ = (bf16*)(ws + O_CQKV); float* RQ = (float*)(ws + O_RQ); float part[2][4];
            FOR_ROWS({ float s = 0.f; FOR_COLS({ const f32x4 v = acc[ai][bj][m][n]; s += sq4(v); if (ok) st_bf4(CQ + (size_t)tg * 384 + colL, v); }) part[ai][m] = s; })
            row_reduce(part, wr, wc, fr, fq, [&](int row, float ss) { const int tg = tbase + row; if (tg >= s0 && tg < s0 + slen && row >= 1 && row <= 254) RQ[tg] = rsqrtf(ss * (1.f / 256.f) + EPS); });
        } else if (pn == 1) {
            bf16* CQ = (bf16*)(ws + O_CQKV); float* RKV = (float*)(ws + O_RKV); float part[2][4];
            FOR_ROWS({ float s = 0.f; _Pragma("unroll") for (int n = 0; n < 2; ++n) { const f32x4 v = acc[ai][0][m][n]; s += sq4(v); if (ok) st_bf4(CQ + (size_t)tg * 384 + 256 + wc * 32 + n * 16 + fq * 4, v); } part[ai][m] = s; })
            row_reduce(part, wr, wc, fr, fq, [&](int row, float ss) { const int tg = tbase + row; if (tg >= s0 && tg < s0 + slen && row >= 1 && row <= 254) RKV[tg] = rsqrtf(ss * (1.f / 128.f) + EPS); });
            if (wc == 0) {
                const float* RC = (const float*)(ws + O_ROPE); const float* RSN = RC + 8192 * 16; bf16* KR = (bf16*)(ws + O_KR);
                FOR_ROWS({ if (ok) { const int pos = tg - seq_start(seq_of(tg)); const f32x4 c = *(const f32x4*)(RC + pos * 16 + fq * 4), s = *(const f32x4*)(RSN + pos * 16 + fq * 4); const f32x4 x1 = acc[ai][1][m][0], x2 = acc[ai][1][m][1];
                    st_bf4(KR + (size_t)tg * 32 + fq * 4, x1 * c - x2 * s); st_bf4(KR + (size_t)tg * 32 + 16 + fq * 4, x2 * c + x1 * s); } })
            } else if (wc == 1) {
                float* G = (float*)(ws + O_G); const f32x4 gb = *(const f32x4*)(p.gate_bias + fq * 4); const bool isf = fq & 1;
                FOR_ROWS({ if (ok) { f32x4 v = acc[ai][1][m][0] + gb; if (isf) { v.x = logsigmoidf_(v.x); v.y = logsigmoidf_(v.y); v.z = logsigmoidf_(v.z); v.w = logsigmoidf_(v.w); } *(f32x4*)(G + (size_t)tg * 16 + fq * 4) = v; } })
            }
        } else if (pn < 6) {
            conv_exchange(acc, wr, wc, fr, fq);
            const float* cw = p.m_conv_w; const float* cb = p.m_conv_b; const int chb = (pn - 2) * 256 + wc * 32 + fq * 4;
            const bool isK = pn >= 4; bf16* dst = (bf16*)(ws + (isK ? O_KC : O_QC)); const float sc = isK ? 0.08838834764831845f : 1.f; const int cb0 = (pn - (isK ? 4 : 2)) * 256;
#define CA_(BJ, N, AI) { f32x4 upB, dnB; conv_bnd<BJ, N, AI>(wr, wc, fq, upB, dnB); f32x4 rp_ = upB, lc_ = rol4(acc[AI][BJ][0][N]); \
        _Pragma("unroll") for (int M = 0; M < 4; ++M) { const int row = AI * 128 + wr * 64 + M * 16 + fr, tg = tbase + row; const f32x4 a_ = acc[AI][BJ][M][N]; const f32x4 ra_ = ror4(a_); f32x4 ln_ = dnB; if (M < 3) ln_ = rol4(acc[AI][BJ][M < 3 ? M + 1 : 3][N]); \
            f32x4 up_ = fr > 0 ? ra_ : rp_, dn_ = fr < 15 ? lc_ : ln_; if (hb_) { const f32x4 z_ = {0.f, 0.f, 0.f, 0.f}; if (seq_first(tg)) up_ = z_; if (seq_first(tg + 1)) dn_ = z_; } const f32x4 v = w0 * up_ + w1 * a_ + w2 * dn_ + bb; rp_ = ra_; lc_ = ln_; \
            if ((tg >= s0) && (tg < s0 + slen) && row >= 1 && row <= 254) st_bf4(dst + (size_t)tg * 512 + cb0 + BJ * 128 + wc * 32 + N * 16 + fq * 4, (f32x4){siluf_(v.x) * sc, siluf_(v.y) * sc, siluf_(v.z) * sc, siluf_(v.w) * sc}); __builtin_amdgcn_sched_barrier(0); } }
#define CS_(BJ, N) { const int ch = chb + BJ * 128 + N * 16; const f32x4 w0 = *(const f32x4*)(cw + ch), w1 = *(const f32x4*)(cw + 1024 + ch), w2 = *(const f32x4*)(cw + 2048 + ch), bb = *(const f32x4*)(cb + ch); CA_(BJ, N, 0) CA_(BJ, N, 1) }
            CS_(0, 0) CS_(0, 1) CS_(1, 0) CS_(1, 1)
#undef CS_
#undef CA_
        } else if (pn < 8) {
            bf16* MV = (bf16*)(ws + O_MV); const int cb0 = (pn - 6) * 256;
            FOR_ROWS({ if (ok) { FOR_COLS({ st_bf4(MV + (size_t)tg * 512 + cb0 + colL, acc[ai][bj][m][n]); }) } })
        } else {
            bf16* MO = (bf16*)(ws + O_MO); const int cb0 = (pn - 8) * 256;
            FOR_ROWS({ if (ok) { FOR_COLS({ const f32x4 v = acc[ai][bj][m][n]; st_bf4(MO + (size_t)tg * 512 + cb0 + colL, (f32x4){sigmoidf_(v.x), sigmoidf_(v.y), sigmoidf_(v.z), sigmoidf_(v.w)}); }) } })
        }
    }
};
struct EpiQkv {
    Params p;
    DI void operator()(Acc& acc, const Unit& u, int wr, int wc, int fr, int fq) const {
        constexpr bool OVL = false; const int s0 = 0, slen = T_TOK, tbase = u.tbase, pn = u.pn; unsigned char* ws = p.ws;
        const float* RS = (const float*)(ws + (pn < 3 ? O_RQ : O_RKV));
        if (pn < 3) {
            bf16* Q = (bf16*)(ws + O_Q); const float* RC = (const float*)(ws + O_ROPE); const float* RSN = RC + 8192 * 16;
            const float qs = 0.10206207261596577f * 1.4426950408889634f;
            FOR_ROWS({ const float rs = RS[tg] * qs; const int sq = seq_of(tg), pos = tg - seq_start(sq);
                _Pragma("unroll") for (int bj = 0; bj < 2; ++bj) { const int base32 = pn * 256 + bj * 128 + wc * 32; const f32x4 v0 = acc[ai][bj][m][0] * rs, v1 = acc[ai][bj][m][1] * rs;
                    f32x4 o0 = v0, o1 = v1;
                    if (base32 % 96 == 64) { const f32x4 c = *(const f32x4*)(RC + pos * 16 + fq * 4), s = *(const f32x4*)(RSN + pos * 16 + fq * 4); o0 = v0 * c - v1 * s; o1 = v1 * c + v0 * s; }
                    st_bf4(Q + (size_t)tg * 768 + base32 + fq * 4, o0); st_bf4(Q + (size_t)tg * 768 + base32 + 16 + fq * 4, o1); } })
        } else if (pn < 5) {
            bf16* KN = (bf16*)(ws + O_KN); const int cb0 = (pn - 3) * 256;
            FOR_ROWS({ const float rs = RS[tg]; FOR_COLS({ st_bf4(KN + (size_t)tg * 512 + cb0 + colL, acc[ai][bj][m][n] * rs); }) })
        } else {
            bf16* VT = (bf16*)(ws + O_VT); const int cb0 = (pn - 5) * 256;
            FOR_ROWS({ const float rs = RS[tg]; const int sq = seq_of(tg), st = seq_start(sq), S = seq_len(sq), pos = tg - st; bf16* base = VT + (size_t)st * 512 + pos;
                FOR_COLS({ const int c = cb0 + colL; const f32x4 v = acc[ai][bj][m][n] * rs;
                    base[(size_t)c * S] = f2bf(v.x); base[(size_t)(c + 1) * S] = f2bf(v.y); base[(size_t)(c + 2) * S] = f2bf(v.z); base[(size_t)(c + 3) * S] = f2bf(v.w); }) })
        }
    }
};
struct EpiRes {
    Params p; int first, nobf;
    DI void operator()(Acc& acc, const Unit& u, int wr, int wc, int fr, int fq) const {
        const int tbase = u.tbase, pn = u.pn; unsigned char* ws = p.ws;
        bf16* XB = (bf16*)(ws + O_XB); float* SS = (float*)(ws + O_SS); float part[2][4];
#pragma unroll
        for (int ai = 0; ai < 2; ++ai) { f32x4 res[4][2][2];
#pragma unroll
            for (int m = 0; m < 4; ++m) { const int tg = tbase + ai * 128 + wr * 64 + m * 16 + fr; const float* rr = (first ? xin_row(p, tg) : p.out + (size_t)tg * DM) + pn * 256 + wc * 32 + 8 * fq;
#pragma unroll
                for (int bj = 0; bj < 2; ++bj) { res[m][bj][0] = *(const f32x4*)(rr + bj * 128); res[m][bj][1] = *(const f32x4*)(rr + bj * 128 + 4); } }
#pragma unroll
            for (int m = 0; m < 4; ++m) { const int tg = tbase + ai * 128 + wr * 64 + m * 16 + fr; const int c0 = pn * 256 + wc * 32 + 8 * fq; float* orow = p.out + (size_t)tg * DM + c0; bf16* xrow = XB + (size_t)tg * DM + c0; float s = 0.f;
#pragma unroll
                for (int bj = 0; bj < 2; ++bj) { const f32x4 v0 = res[m][bj][0] + acc[ai][bj][m][0], v1 = res[m][bj][1] + acc[ai][bj][m][1];
                    *(f32x4*)(orow + bj * 128) = v0; *(f32x4*)(orow + bj * 128 + 4) = v1; if (!nobf) st_bf8(xrow + bj * 128, v0, v1); s += sq4(v0) + sq4(v1); }
                part[ai][m] = s; } }
        row_reduce(part, wr, wc, fr, fq, [&](int row, float ss) { SS[(size_t)(tbase + row) * 4 + pn] = ss; });
    }
};
struct EpiUp {
    Params p; int layer;
    DI void operator()(Acc& acc, const Unit& u, int wr, int wc, int fr, int fq) const {
        constexpr bool OVL = true; unsigned char* ws = p.ws; const int pn = u.pn; int tbase, s0, slen; tile_rows(1, u.pm, tbase, s0, slen); const bool hb_ = tile_has_seam(tbase); (void)hb_;
        const f32x4* SS = (const f32x4*)(ws + O_SS);
        FOR_ROWS({ const bool val = (tg >= s0) && (tg < s0 + slen); const float rs = val ? rs_of(SS, tg) : 0.f;
            _Pragma("unroll") for (int bj = 0; bj < 2; ++bj) _Pragma("unroll") for (int n = 0; n < 2; ++n) acc[ai][bj][m][n] *= rs; })
        conv_exchange(acc, wr, wc, fr, fq);
        const float* cw = p.ffn_conv_w + (size_t)layer * 3 * 5632; const float* cb = p.ffn_conv_b + (size_t)layer * 5632; const int chb = pn * 128 + wc * 32 + fq * 4;
        bf16* HID = (bf16*)(ws + O_HID);
#define CA_(N, AI) { f32x4 upG, dnG, upV, dnV; conv_bnd<0, N, AI>(wr, wc, fq, upG, dnG); conv_bnd<1, N, AI>(wr, wc, fq, upV, dnV); \
        f32x4 rpg_ = upG, lcg_ = rol4(acc[AI][0][0][N]), rpv_ = upV, lcv_ = rol4(acc[AI][1][0][N]); \
        _Pragma("unroll") for (int M = 0; M < 4; ++M) { const int row = AI * 128 + wr * 64 + M * 16 + fr, tg = tbase + row; const f32x4 a_ = acc[AI][0][M][N], b_ = acc[AI][1][M][N]; const f32x4 rga_ = ror4(a_), rvb_ = ror4(b_); \
            f32x4 lng_ = dnG, lnv_ = dnV; if (M < 3) { lng_ = rol4(acc[AI][0][M < 3 ? M + 1 : 3][N]); lnv_ = rol4(acc[AI][1][M < 3 ? M + 1 : 3][N]); } \
            f32x4 ug_ = fr > 0 ? rga_ : rpg_, dg_ = fr < 15 ? lcg_ : lng_, uv_ = fr > 0 ? rvb_ : rpv_, dv_ = fr < 15 ? lcv_ : lnv_; if (hb_) { const f32x4 z_ = {0.f, 0.f, 0.f, 0.f}; if (seq_first(tg)) { ug_ = z_; uv_ = z_; } if (seq_first(tg + 1)) { dg_ = z_; dv_ = z_; } } const f32x4 g = g0 * ug_ + g1 * a_ + g2 * dg_ + gb, v = v0 * uv_ + v1 * b_ + v2 * dv_ + vb; rpg_ = rga_; lcg_ = lng_; rpv_ = rvb_; lcv_ = lnv_; \
            if ((tg >= s0) && (tg < s0 + slen) && row >= 1 && row <= 254) st_bf4(HID + (size_t)tg * DFF + chb + N * 16, (f32x4){siluf_(g.x) * v.x, siluf_(g.y) * v.y, siluf_(g.z) * v.z, siluf_(g.w) * v.w}); __builtin_amdgcn_sched_barrier(0); } }
#define CS_(N) { const int cg_ = chb + N * 16, cv2_ = 2816 + chb + N * 16; \
        const f32x4 g0 = *(const f32x4*)(cw + cg_), g1 = *(const f32x4*)(cw + 5632 + cg_), g2 = *(const f32x4*)(cw + 11264 + cg_), gb = *(const f32x4*)(cb + cg_); \
        const f32x4 v0 = *(const f32x4*)(cw + cv2_), v1 = *(const f32x4*)(cw + 5632 + cv2_), v2 = *(const f32x4*)(cw + 11264 + cv2_), vb = *(const f32x4*)(cb + cv2_); CA_(N, 0) CA_(N, 1) }
        CS_(0) CS_(1)
#undef CS_
#undef CA_
    }
};
struct EpiGin {
    Params p;
    DI void operator()(Acc& acc, const Unit& u, int wr, int wc, int fr, int fq) const {
        constexpr bool OVL = false; const int s0 = 0, slen = T_TOK, tbase = u.tbase, pn = u.pn; unsigned char* ws = p.ws;
        const f32x4* SS = (const f32x4*)(ws + O_SS);
        bf16* dst = (bf16*)(ws + (pn < 4 ? O_U : O_V)); const int cb0 = (pn & 3) * 256 + wc * 32 + 8 * fq; float part[2][4];
        float rsv[2][4]; FOR_ROWS({ rsv[ai][m] = rs_of(SS, tg); })
        FOR_ROWS({ const float rs = rsv[ai][m]; float s = 0.f;
            _Pragma("unroll") for (int bj = 0; bj < 2; ++bj) { f32x4 v0 = acc[ai][bj][m][0] * rs, v1 = acc[ai][bj][m][1] * rs;
                v0.x = geluf_(v0.x); v0.y = geluf_(v0.y); v0.z = geluf_(v0.z); v0.w = geluf_(v0.w); v1.x = geluf_(v1.x); v1.y = geluf_(v1.y); v1.z = geluf_(v1.z); v1.w = geluf_(v1.w);
                s += sq4(v0) + sq4(v1); st_bf8(dst + (size_t)tg * DM + cb0 + bj * 128, v0, v1); } part[ai][m] = s; })
        if (pn >= 4) { float* VSS = (float*)(ws + O_VSS); row_reduce(part, wr, wc, fr, fq, [&](int row, float ss) { VSS[(size_t)(tbase + row) * 4 + (pn - 4)] = ss; }); }
    }
};

DI int perm32(int rho) { const int n = rho >> 4, i = rho & 15; return 8 * (i >> 2) + 4 * n + (i & 3); }
template <class Epi, bool PERM = false> DI void gemm_phase(const Gemm g, const Epi& E) {
    LAS unsigned char* lds = (LAS unsigned char*)g_lds;
    int tid_ = threadIdx.x; asm volatile("" : "+v"(tid_));
    const int tid = tid_, wid = __builtin_amdgcn_readfirstlane(tid >> 6), lane = tid & 63, wr = wid >> 2, wc = wid & 3, fr = lane & 15, fq = lane >> 4;
    const int K = g.K;
    unsigned voff[2], voffB[2];
#pragma unroll
    for (int i = 0; i < 2; ++i) { int R, C; stage_rc(tid * 16 + i * 8192, R, C); voff[i] = (unsigned)(R * K + C) * 2u; const int Rb = PERM ? ((R & ~31) + perm32(R & 31)) : R; voffB[i] = (unsigned)(Rb * K + C) * 2u; }
    const size_t kstep = 128, hstep = (size_t)128 * K * 2, tstep = 2 * hstep;
    const unsigned ldsw = (unsigned)wid * 1024u;
    const int aoff = lds_byte(wr * 64 + fr, fq * 8), boff = lds_byte(wc * 32 + fr, fq * 8);
#define PG8_SA(b, h) (((b) * 2 + (h)) * 16384)
#define PG8_SB(b, h) ((4 + (b) * 2 + (h)) * 16384)
#define PG8_STAGEX(bufoff, gbase, vo) do { _Pragma("unroll") for (int _i = 0; _i < 2; ++_i) \
        __builtin_amdgcn_global_load_lds((const unsigned*)((const char*)(gbase) + vo[_i]), (LAS unsigned*)(lds + (bufoff) + ldsw + _i * 8192), 16, 0, 0); } while (0)
#define PG8_LDA(dst, b, h) do { _Pragma("unroll") for (int m = 0; m < 4; ++m) _Pragma("unroll") for (int k = 0; k < 2; ++k) dst[m][k] = *(const LAS bf16x8*)(lds + PG8_SA(b, h) + aoff + m * 2048 + k * 1024); } while (0)
#define PG8_LDB(dst, b, h) do { _Pragma("unroll") for (int n = 0; n < 2; ++n) _Pragma("unroll") for (int k = 0; k < 2; ++k) dst[n][k] = *(const LAS bf16x8*)(lds + PG8_SB(b, h) + boff + n * 2048 + k * 1024); } while (0)
#define PG8_MMA(ai, bj, At, Bt) do { __builtin_amdgcn_s_setprio(1); _Pragma("unroll") for (int m = 0; m < 4; ++m) _Pragma("unroll") for (int n = 0; n < 2; ++n) _Pragma("unroll") for (int k = 0; k < 2; ++k) \
        acc[ai][bj][m][n] = __builtin_amdgcn_mfma_f32_16x16x32_bf16(Bt[n][k], At[m][k], acc[ai][bj][m][n], 0, 0, 0); __builtin_amdgcn_s_setprio(0); } while (0)
#define PG8_WAIT_V(n) asm volatile("s_waitcnt vmcnt(" #n ")" ::: "memory")
#define PG8_WAIT_L(n) asm volatile("s_waitcnt lgkmcnt(" #n ")" ::: "memory")
#define PG8_BAR __builtin_amdgcn_s_barrier()
#define PG8_SCHED __builtin_amdgcn_sched_barrier(0)
    Unit cur, nxt; int ui = 0;
    if (!next_unit(g, 0, cur)) return;
    Acc acc;
#pragma unroll
    for (int a = 0; a < 2; ++a)
#pragma unroll
        for (int b = 0; b < 2; ++b)
#pragma unroll
            for (int m = 0; m < 4; ++m)
#pragma unroll
                for (int n = 0; n < 2; ++n) acc[a][b][m][n] = (f32x4){0.f, 0.f, 0.f, 0.f};
    bf16x8 At[4][2], B0[2][2], B1[2][2];
    const char* cA = (const char*)g.A + (ptrdiff_t)cur.tbase * (ptrdiff_t)(K * 2) + cur.kofs; const char* cB = (const char*)g.Bt + (size_t)cur.pn * tstep + cur.kofs;
    PG8_STAGEX(PG8_SB(0, 0), cB, voffB); PG8_STAGEX(PG8_SB(0, 1), cB + hstep, voffB); PG8_STAGEX(PG8_SA(0, 0), cA, voff); PG8_STAGEX(PG8_SA(0, 1), cA + hstep, voff);
    if (wr == 1) PG8_BAR;
    PG8_WAIT_V(2); PG8_BAR;
    PG8_STAGEX(PG8_SB(1, 0), cB + kstep, voffB); PG8_STAGEX(PG8_SA(1, 0), cA + kstep, voff); PG8_STAGEX(PG8_SB(1, 1), cB + hstep + kstep, voffB);
    PG8_WAIT_V(6); PG8_BAR;
    for (;;) {
        const bool has_next = next_unit(g, ui + 1, nxt);
        const char* nA = has_next ? (const char*)g.A + (ptrdiff_t)nxt.tbase * (ptrdiff_t)(K * 2) + nxt.kofs : cA; const char* nB = has_next ? (const char*)g.Bt + (size_t)nxt.pn * tstep + nxt.kofs : cB;
        const int nt = cur.nt;
        for (int t = 0; t < nt; t += 2) {
            const bool last = (t == nt - 2);
            const char* a1 = cA + (size_t)(t + 1) * kstep;
            const char* a2 = last ? nA : cA + (size_t)(t + 2) * kstep; const char* b2 = last ? nB : cB + (size_t)(t + 2) * kstep;
            const char* a3 = a2 + kstep; const char* b3 = b2 + kstep;
            PG8_LDB(B0, 0, 0); PG8_LDB(B1, 0, 1); PG8_SCHED; PG8_LDA(At, 0, 0); PG8_STAGEX(PG8_SA(1, 1), a1 + hstep, voff);
            PG8_WAIT_V(8); PG8_WAIT_L(0); PG8_BAR; PG8_MMA(0, 0, At, B0); PG8_MMA(0, 1, At, B1); PG8_BAR; PG8_SCHED;
            PG8_LDA(At, 0, 1); PG8_STAGEX(PG8_SB(0, 0), b2, voffB); PG8_STAGEX(PG8_SB(0, 1), b2 + hstep, voffB); PG8_STAGEX(PG8_SA(0, 0), a2, voff);
            PG8_WAIT_V(8); PG8_WAIT_L(0); PG8_BAR; PG8_MMA(1, 0, At, B0); PG8_MMA(1, 1, At, B1); PG8_BAR; PG8_SCHED;
            PG8_LDB(B0, 1, 0); PG8_LDB(B1, 1, 1); PG8_SCHED; PG8_LDA(At, 1, 0); PG8_STAGEX(PG8_SA(0, 1), a2 + hstep, voff);
            PG8_WAIT_V(8); PG8_WAIT_L(0); PG8_BAR; PG8_MMA(0, 0, At, B0); PG8_MMA(0, 1, At, B1); PG8_BAR; PG8_SCHED;
            PG8_LDA(At, 1, 1); PG8_STAGEX(PG8_SB(1, 0), b3, voffB); PG8_STAGEX(PG8_SB(1, 1), b3 + hstep, voffB); PG8_STAGEX(PG8_SA(1, 0), a3, voff);
            PG8_WAIT_V(8); PG8_WAIT_L(0); PG8_BAR; PG8_MMA(1, 0, At, B0); PG8_MMA(1, 1, At, B1); PG8_BAR; PG8_SCHED;
        }
        if (wr == 0) PG8_BAR;
        { int fr2 = fr, fq2 = fq; asm volatile("" : "+v"(fr2), "+v"(fq2)); E(acc, cur, wr, wc, fr2, fq2); }
        if (!has_next) break;
#pragma unroll
        for (int a = 0; a < 2; ++a)
#pragma unroll
            for (int b = 0; b < 2; ++b)
#pragma unroll
                for (int m = 0; m < 4; ++m)
#pragma unroll
                    for (int n = 0; n < 2; ++n) acc[a][b][m][n] = (f32x4){0.f, 0.f, 0.f, 0.f};
        cur = nxt; cA = nA; cB = nB; ++ui;
        if (wr == 1) PG8_BAR;
    }
    PG8_WAIT_V(0);
    PG8_BAR;
    __syncthreads();
}

constexpr int LDT = 136;
constexpr int TILE_B = 128 * LDT * 2;
DI int crow(int i, int h) { return (i & 3) + 8 * (i >> 2) + 4 * h; }
template <int KS> DI void mm_lds(f32x16 (&acc)[2], const bf16* sA, const bf16* sB, int rb, int cb0, int lane) {
    const int r = lane & 31, h = lane >> 5;
#pragma unroll
    for (int ks = 0; ks < KS; ++ks) {
        const bf16x8 a = *(const bf16x8*)(sA + (32 * rb + r) * LDT + 16 * ks + 8 * h);
#pragma unroll
        for (int c = 0; c < 2; ++c) { const bf16x8 b = *(const bf16x8*)(sB + (32 * (cb0 + c) + r) * LDT + 16 * ks + 8 * h); acc[c] = MFMA32(a, b, acc[c]); }
    }
}
DI float scan_add(float v, int lane) {
#pragma unroll
    for (int o = 1; o < 64; o <<= 1) { const float t = __shfl_up(v, o); if (lane >= o) v += t; }
    return v;
}
DI float scan_max(float v, int lane) {
#pragma unroll
    for (int o = 1; o < 64; o <<= 1) { const float t = __shfl_up(v, o); if (lane >= o) v = fmaxf(v, t); }
    return v;
}
DI float wave_max(float v) {
#pragma unroll
    for (int o = 1; o < 64; o <<= 1) v = fmaxf(v, __shfl_xor(v, o));
    return v;
}
DI void load_tile_nat(bf16* sT, const bf16* g, int gld, int tid) {
#pragma unroll
    for (int i = 0; i < 4; ++i) { const int id = tid + 512 * i, row = id >> 4, c = (id & 15) * 8; *(u32x4*)(sT + row * LDT + c) = *(const u32x4*)(g + (size_t)row * gld + c); }
}
DI void load_tile_tr(bf16* sT, const bf16* g, int gld, const float* w, int tid) {
#pragma unroll
    for (int i = 0; i < 4; ++i) { const int id = tid + 512 * i, row = id & 127, c = (id >> 7) * 8; const u32x4 v = *(const u32x4*)(g + (size_t)row * gld + c); const float ww = w ? w[row] : 1.f;
        const unsigned uu[4] = {v.x, v.y, v.z, v.w};
#pragma unroll
        for (int e = 0; e < 4; ++e) { sT[(c + 2 * e) * LDT + row] = f2bf(bflo(uu[e]) * ww); sT[(c + 2 * e + 1) * LDT + row] = f2bf(bfhi(uu[e]) * ww); } }
}

DI void write_tile_tr(bf16* sT, const u32x4 (&v)[4], const float* w, int tid) {
#pragma unroll
    for (int i = 0; i < 4; ++i) { const int id = tid + 512 * i, row = id & 127, c = (id >> 7) * 8; const float ww = w ? w[row] : 1.f;
        const unsigned uu[4] = {v[i].x, v[i].y, v[i].z, v[i].w};
#pragma unroll
        for (int e = 0; e < 4; ++e) { sT[(c + 2 * e) * LDT + row] = f2bf(bflo(uu[e]) * ww); sT[(c + 2 * e + 1) * LDT + row] = f2bf(bfhi(uu[e]) * ww); } }
}
DI void mlstm_local(const Params& p) {
    unsigned char* ws = p.ws; int tid_ = threadIdx.x; asm volatile("" : "+v"(tid_)); const int tid = tid_, lane = tid & 63, wid = tid >> 6;
    bf16* sV = (bf16*)g_lds; bf16* sK = (bf16*)(g_lds + TILE_B); float* sW = (float*)(g_lds + 2 * TILE_B);
    const float* G = (const float*)(ws + O_G); const bf16* MV = (const bf16*)(ws + O_MV); const bf16* KC = (const bf16*)(ws + O_KC);
    bf16* CS = (bf16*)(ws + O_CS); float* NS = (float*)(ws + O_NS); float* ML = (float*)(ws + O_ML); float* BL = (float*)(ws + O_BL);
    const int rb = wid & 3, cb0 = (wid >> 2) * 2;
    for (int it2 = blockIdx.x; it2 < 2560; it2 += gridDim.x) {
        const int cgk = it2 >> 2, h = it2 & 3, t0 = cgk * 128;
        u32x4 vr[4], kr[4];
#pragma unroll
        for (int i = 0; i < 4; ++i) { const int id = tid + 512 * i, row = id & 127, c = (id >> 7) * 8; vr[i] = *(const u32x4*)(MV + (size_t)(t0 + row) * 512 + h * 128 + c); kr[i] = *(const u32x4*)(KC + (size_t)(t0 + row) * 512 + h * 128 + c); }
        if (wid < 2) { const int dir = wid, item = it2 * 2 + dir;
            const int o0 = dir ? 127 - lane : lane, o1 = dir ? 63 - lane : lane + 64;
            const float lf0 = G[(size_t)(t0 + o0) * 16 + dir * 8 + 4 + h], li0 = G[(size_t)(t0 + o0) * 16 + dir * 8 + h];
            const float lf1 = G[(size_t)(t0 + o1) * 16 + dir * 8 + 4 + h], li1 = G[(size_t)(t0 + o1) * 16 + dir * 8 + h];
            const float b0 = scan_add(lf0, lane), tot0 = __shfl(b0, 63), b1 = scan_add(lf1, lane) + tot0, bL = __shfl(b1, 63);
            const float g0 = bL - b0 + li0, g1 = bL - b1 + li1, ml = wave_max(fmaxf(g0, g1));
            sW[dir * 128 + o0] = __expf(g0 - ml); sW[dir * 128 + o1] = __expf(g1 - ml);
            if (lane == 0) { ML[item] = ml; BL[item] = bL; }
        }
        write_tile_tr(sK, kr, nullptr, tid);
        __syncthreads();
#pragma unroll 1
        for (int dir = 0; dir < 2; ++dir) { const int item = it2 * 2 + dir; const float* sWd = sW + dir * 128;
            write_tile_tr(sV, vr, sWd, tid);
            __syncthreads();
            if (tid < 128) { float s = 0.f;
#pragma unroll 4
                for (int l = 0; l < 128; l += 8) { const u32x4 kk = *(const u32x4*)(sK + tid * LDT + l); const f32x4 wa = *(const f32x4*)(sWd + l), wb = *(const f32x4*)(sWd + l + 4);
                    s += (wa.x * bflo(kk.x) + wa.y * bfhi(kk.x)) + (wa.z * bflo(kk.y) + wa.w * bfhi(kk.y)) + (wb.x * bflo(kk.z) + wb.y * bfhi(kk.z)) + (wb.z * bflo(kk.w) + wb.w * bfhi(kk.w)); }
                NS[(size_t)item * 128 + tid] = s; }
            f32x16 acc[2];
#pragma unroll
            for (int c = 0; c < 2; ++c)
#pragma unroll
                for (int i = 0; i < 16; ++i) acc[c][i] = 0.f;
            mm_lds<8>(acc, sV, sK, rb, cb0, lane);
            bf16* Co = CS + (size_t)item * 16384;
#pragma unroll
            for (int c = 0; c < 2; ++c)
#pragma unroll
                for (int i = 0; i < 16; ++i) Co[(32 * rb + crow(i, lane >> 5)) * 128 + 32 * (cb0 + c) + (lane & 31)] = f2bf(acc[c][i]);
            __syncthreads();
        }
    }
}
DI void mlstm_scan(const Params& p) {
    unsigned char* ws = p.ws; int tid_ = threadIdx.x; asm volatile("" : "+v"(tid_)); const int gt = blockIdx.x * NTHR + tid_, GT = gridDim.x * NTHR;
    bf16* CS = (bf16*)(ws + O_CS); float* NS = (float*)(ws + O_NS); const float* ML = (const float*)(ws + O_ML); const float* BL = (const float*)(ws + O_BL); float* MP = (float*)(ws + O_MP);
    for (int u = gt; u < 144 * 2080; u += GT) {
        const int st = u / 2080, v = u % 2080, sq = st >> 3, h = (st >> 1) & 3, dir = st & 1, nc = seq_len(sq) >> 7, c0 = seq_start(sq) >> 7;
        float m = 0.f;
        if (v < 2048) {
            float C[8];
#pragma unroll
            for (int e = 0; e < 8; ++e) C[e] = 0.f;
            for (int j = 0; j < nc; j += 4) {
                u32x4 t[4]; float bl[4], mlv[4]; int itm[4];
#pragma unroll
                for (int q = 0; q < 4; ++q) { const int n = dir ? nc - 1 - (j + q) : j + q; itm[q] = ((c0 + n) * 4 + h) * 2 + dir; t[q] = *(const u32x4*)(CS + (size_t)itm[q] * 16384 + v * 8); bl[q] = BL[itm[q]]; mlv[q] = ML[itm[q]]; }
#pragma unroll
                for (int q = 0; q < 4; ++q) { u32x4 o; o.x = pk2(C[0], C[1]); o.y = pk2(C[2], C[3]); o.z = pk2(C[4], C[5]); o.w = pk2(C[6], C[7]); *(u32x4*)(CS + (size_t)itm[q] * 16384 + v * 8) = o;
                    if (v == 0) MP[itm[q]] = m;
                    const float mn = fmaxf(bl[q] + m, mlv[q]), a = __expf(bl[q] + m - mn), c = __expf(mlv[q] - mn);
                    C[0] = a * C[0] + c * bflo(t[q].x); C[1] = a * C[1] + c * bfhi(t[q].x); C[2] = a * C[2] + c * bflo(t[q].y); C[3] = a * C[3] + c * bfhi(t[q].y);
                    C[4] = a * C[4] + c * bflo(t[q].z); C[5] = a * C[5] + c * bfhi(t[q].z); C[6] = a * C[6] + c * bflo(t[q].w); C[7] = a * C[7] + c * bfhi(t[q].w); m = mn; }
            }
        } else {
            f32x4 N = {0.f, 0.f, 0.f, 0.f};
            for (int j = 0; j < nc; j += 4) {
                f32x4 t[4]; float bl[4], mlv[4]; int itm[4];
#pragma unroll
                for (int q = 0; q < 4; ++q) { const int n = dir ? nc - 1 - (j + q) : j + q; itm[q] = ((c0 + n) * 4 + h) * 2 + dir; t[q] = *(const f32x4*)(NS + (size_t)itm[q] * 128 + (v - 2048) * 4); bl[q] = BL[itm[q]]; mlv[q] = ML[itm[q]]; }
#pragma unroll
                for (int q = 0; q < 4; ++q) { *(f32x4*)(NS + (size_t)itm[q] * 128 + (v - 2048) * 4) = N;
                    const float mn = fmaxf(bl[q] + m, mlv[q]), a = __expf(bl[q] + m - mn), c = __expf(mlv[q] - mn); N = a * N + c * t[q]; m = mn; }
            }
        }
    }
}
DI void mlstm_out(const Params& p) {
    unsigned char* ws = p.ws; int tid_ = threadIdx.x; asm volatile("" : "+v"(tid_)); const int tid = tid_, lane = tid & 63, wid = tid >> 6, hh = lane >> 5;
    bf16* sQ = (bf16*)g_lds; bf16* sK = (bf16*)(g_lds + TILE_B); bf16* sVT = (bf16*)(g_lds + 2 * TILE_B); bf16* sC = (bf16*)(g_lds + 3 * TILE_B); bf16* sP = sK;
    float* sBv2 = (float*)(g_lds + 4 * TILE_B); float* sLi2 = sBv2 + 256; float* sMt2 = sBv2 + 512; float* sInter2 = sBv2 + 768; float* sInv = sBv2 + 1024; float* sN = sBv2 + 1152;
    float* sH = (float*)g_lds;
    const float* G = (const float*)(ws + O_G); const bf16* QC = (const bf16*)(ws + O_QC); const bf16* KC = (const bf16*)(ws + O_KC); const bf16* MV = (const bf16*)(ws + O_MV); const bf16* MO = (const bf16*)(ws + O_MO);
    const bf16* CS = (const bf16*)(ws + O_CS); const float* NS = (const float*)(ws + O_NS); const float* MP = (const float*)(ws + O_MP); bf16* Y = (bf16*)(ws + O_Y);
    const int rb = wid & 3, cb0 = (wid >> 2) * 2;
    for (int item = blockIdx.x; item < 2560; item += gridDim.x) {
        const int cgk = item >> 2, h = item & 3, t0 = cgk * 128;
        load_tile_nat(sQ, QC + (size_t)t0 * 512 + h * 128, 512, tid);
        load_tile_nat(sK, KC + (size_t)t0 * 512 + h * 128, 512, tid);
        load_tile_tr(sVT, MV + (size_t)t0 * 512 + h * 128, 512, nullptr, tid);
        if (wid < 2) {
            const int dir = wid, itemd = (cgk * 4 + h) * 2 + dir; const float mprev = MP[itemd];
            const int o0 = dir ? 127 - lane : lane, o1 = dir ? 63 - lane : lane + 64;
            const float lf0 = G[(size_t)(t0 + o0) * 16 + dir * 8 + 4 + h], li0 = G[(size_t)(t0 + o0) * 16 + dir * 8 + h];
            const float lf1 = G[(size_t)(t0 + o1) * 16 + dir * 8 + 4 + h], li1 = G[(size_t)(t0 + o1) * 16 + dir * 8 + h];
            const float b0 = scan_add(lf0, lane), tot0 = __shfl(b0, 63), b1 = scan_add(lf1, lane) + tot0;
            const float pm0 = scan_max(li0 - b0, lane), mx0 = __shfl(pm0, 63), pm1 = fmaxf(scan_max(li1 - b1, lane), mx0);
            const float a0 = b0 + mprev, a1 = b1 + mprev, mt0 = fmaxf(a0, b0 + pm0), mt1 = fmaxf(a1, b1 + pm1);
            float* B_ = sBv2 + dir * 128; float* L_ = sLi2 + dir * 128; float* M_ = sMt2 + dir * 128; float* I_ = sInter2 + dir * 128;
            B_[o0] = b0; B_[o1] = b1; L_[o0] = li0; L_[o1] = li1; M_[o0] = mt0; M_[o1] = mt1; I_[o0] = __expf(a0 - mt0); I_[o1] = __expf(a1 - mt1);
        }
        __syncthreads();
        f32x16 S[2], hs[2];
#pragma unroll
        for (int c = 0; c < 2; ++c)
#pragma unroll
            for (int i = 0; i < 16; ++i) { S[c][i] = 0.f; hs[c][i] = 0.f; }
        mm_lds<8>(S, sQ, sK, rb, cb0, lane);
#pragma unroll 1
        for (int dir = 0; dir < 2; ++dir) {
            __syncthreads();
            const int itemd = (cgk * 4 + h) * 2 + dir;
            const float* sBv = sBv2 + dir * 128; const float* sLi = sLi2 + dir * 128; const float* sMt = sMt2 + dir * 128; const float* sInter = sInter2 + dir * 128;
            load_tile_nat(sC, CS + (size_t)itemd * 16384, 128, tid);
            if (tid >= 64 && tid < 96) *(f32x4*)(sN + (tid - 64) * 4) = *(const f32x4*)(NS + (size_t)itemd * 128 + (tid - 64) * 4);
            __syncthreads();
#pragma unroll
            for (int c = 0; c < 2; ++c) { const int s = 32 * (cb0 + c) + (lane & 31); const float bs = sBv[s] - sLi[s];
#pragma unroll
                for (int i = 0; i < 16; ++i) { const int t = 32 * rb + crow(i, hh); const bool valid = dir ? (s >= t) : (s <= t);
                    const float pv = valid ? S[c][i] * __expf(sBv[t] - bs - sMt[t]) : 0.f; sP[t * LDT + s] = f2bf(pv); } }
            __syncthreads();
            if (tid < 128) { const int t = tid; float dot = 0.f, rsum = 0.f;
#pragma unroll 4
                for (int e = 0; e < 128; e += 8) { const u32x4 qq = *(const u32x4*)(sQ + t * LDT + e), pq = *(const u32x4*)(sP + t * LDT + e); const f32x4 na = *(const f32x4*)(sN + e), nb = *(const f32x4*)(sN + e + 4);
                    dot += (na.x * bflo(qq.x) + na.y * bfhi(qq.x)) + (na.z * bflo(qq.y) + na.w * bfhi(qq.y)) + (nb.x * bflo(qq.z) + nb.y * bfhi(qq.z)) + (nb.z * bflo(qq.w) + nb.w * bfhi(qq.w));
                    rsum += (bflo(pq.x) + bfhi(pq.x)) + (bflo(pq.y) + bfhi(pq.y)) + (bflo(pq.z) + bfhi(pq.z)) + (bflo(pq.w) + bfhi(pq.w)); }
                const float den = sInter[t] * dot + rsum; sInv[t] = 1.f / fmaxf(fabsf(den), __expf(-sMt[t])); }
            f32x16 num[2];
#pragma unroll
            for (int c = 0; c < 2; ++c)
#pragma unroll
                for (int i = 0; i < 16; ++i) num[c][i] = 0.f;
            mm_lds<8>(num, sQ, sC, rb, cb0, lane);
#pragma unroll
            for (int i = 0; i < 16; ++i) { const float it = sInter[32 * rb + crow(i, hh)]; num[0][i] *= it; num[1][i] *= it; }
            mm_lds<8>(num, sP, sVT, rb, cb0, lane);
            __syncthreads();
#pragma unroll
            for (int i = 0; i < 16; ++i) { const float iv = sInv[32 * rb + crow(i, hh)]; hs[0][i] += num[0][i] * iv; hs[1][i] += num[1][i] * iv; }
        }
        const int ft = tid >> 2, fd0 = (tid & 3) * 32;
        const bf16* mo = MO + (size_t)(t0 + ft) * 512 + h * 128 + fd0; const float* on = p.m_out_norm + h * 128 + fd0;
        u32x4 gmo[4]; f32x4 gon[8];
#pragma unroll
        for (int e = 0; e < 4; ++e) { gmo[e] = *(const u32x4*)(mo + 8 * e); gon[2 * e] = *(const f32x4*)(on + 8 * e); gon[2 * e + 1] = *(const f32x4*)(on + 8 * e + 4); }
        __syncthreads();
#pragma unroll
        for (int c = 0; c < 2; ++c)
#pragma unroll
            for (int i = 0; i < 16; ++i) sH[(32 * rb + crow(i, hh)) * 132 + 32 * (cb0 + c) + (lane & 31)] = hs[c][i];
        __syncthreads();
        { const int t = ft, d0 = fd0; f32x4 v[8]; float ss = 0.f;
#pragma unroll
          for (int e = 0; e < 8; ++e) { v[e] = *(const f32x4*)(sH + t * 132 + d0 + 4 * e); ss += sq4(v[e]); }
          ss += __shfl_xor(ss, 1); ss += __shfl_xor(ss, 2);
          const float rstd = rsqrtf(ss * (1.f / 128.f) + EPS);
          bf16* yo = Y + (size_t)(t0 + t) * 1024 + 512 + h * 128 + d0;
#pragma unroll
          for (int e = 0; e < 4; ++e) { const u32x4 g = gmo[e]; const f32x4 a = v[2 * e] * rstd * gon[2 * e], b = v[2 * e + 1] * rstd * gon[2 * e + 1];
              u32x4 o; o.x = pk2(a.x * bflo(g.x), a.y * bfhi(g.x)); o.y = pk2(a.z * bflo(g.y), a.w * bfhi(g.y)); o.z = pk2(b.x * bflo(g.z), b.y * bfhi(g.z)); o.w = pk2(b.z * bflo(g.w), b.w * bfhi(g.w));
              *(u32x4*)(yo + 8 * e) = o; } }
        __syncthreads();
    }
}
DI void attn_phase(const Params& p) {
    unsigned char* ws = p.ws; int tid_ = threadIdx.x; asm volatile("" : "+v"(tid_)); const int tid = tid_, lane = tid & 63, wid = tid >> 6, r = lane & 31, hh = lane >> 5;
    const bf16* Q = (const bf16*)(ws + O_Q); const bf16* KN = (const bf16*)(ws + O_KN); const bf16* KR = (const bf16*)(ws + O_KR); const bf16* VT = (const bf16*)(ws + O_VT); bf16* Y = (bf16*)(ws + O_Y);
    constexpr int KB_B = 128 * 208, VB_B = 64 * 272, VOFF = 2 * KB_B, SOFF = 0;
    for (int item = blockIdx.x; item < 1280; item += gridDim.x) {
        int sq, head, qb;
        if (item < 256) { sq = item >> 7; head = (item & 127) >> 4; qb = item & 15; } else { const int it = item - 256; sq = 2 + (it >> 6); head = (it & 63) >> 3; qb = it & 7; }
        const int S = seq_len(sq), t0 = seq_start(sq), nkt = S >> 7, tq0 = t0 + qb * 512 + wid * 64;
        bf16x8 qf[2][6];
#pragma unroll
        for (int j = 0; j < 2; ++j)
#pragma unroll
            for (int ks = 0; ks < 6; ++ks) qf[j][ks] = *(const bf16x8*)(Q + (size_t)(tq0 + j * 32 + r) * 768 + head * 96 + 16 * ks + 8 * hh);
        f32x16 o[2][2];
#pragma unroll
        for (int j = 0; j < 2; ++j)
#pragma unroll
            for (int c = 0; c < 2; ++c)
#pragma unroll
                for (int i = 0; i < 16; ++i) o[j][c][i] = 0.f;
        float mrun[2] = {0.f, 0.f}, lrun[2] = {0.f, 0.f};
        const bf16* gk = KN + (size_t)(t0 + (tid >> 3)) * 512 + head * 64 + (tid & 7) * 8;
        const bf16* gr = KR + (size_t)(t0 + (tid >> 2)) * 32 + (tid & 3) * 8;
        const bf16* gv = VT + (size_t)t0 * 512 + (size_t)(head * 64 + (tid >> 3)) * S + (tid & 7) * 8;
        unsigned char* lk = g_lds + (tid >> 3) * 208 + (tid & 7) * 16; unsigned char* lr = g_lds + (tid >> 2) * 208 + 128 + (tid & 3) * 16; unsigned char* lv = g_lds + VOFF + (tid >> 3) * 272 + ((tid & 7) >> 1) * 32 + (tid & 1) * 8;
        u32x4 rk, rk2, rr, rv, rv2;
#define ALD_(kt_) { rk = *(const u32x4*)(gk + (size_t)(kt_) * 128 * 512); rk2 = *(const u32x4*)(gk + (size_t)((kt_) * 128 + 64) * 512); rr = *(const u32x4*)(gr + (size_t)(kt_) * 128 * 32); rv = *(const u32x4*)(gv + (kt_) * 128); rv2 = *(const u32x4*)(gv + (kt_) * 128 + 64); }
#define AST_(b_) { *(u32x4*)(lk + (b_) * KB_B) = rk; *(u32x4*)(lk + (b_) * KB_B + 64 * 208) = rk2; *(u32x4*)(lr + (b_) * KB_B) = rr; \
            *(u32x2*)(lv + (b_) * VB_B) = (u32x2){rv.x, rv.y}; *(u32x2*)(lv + (b_) * VB_B + 16) = (u32x2){rv.z, rv.w}; *(u32x2*)(lv + (b_) * VB_B + 128) = (u32x2){rv2.x, rv2.y}; *(u32x2*)(lv + (b_) * VB_B + 144) = (u32x2){rv2.z, rv2.w}; }
        ALD_(0) AST_(0)
        __syncthreads();
        for (int kt = 0; kt < nkt; ++kt) {
            const int buf = kt & 1; const bool more = kt + 1 < nkt;
            if (more) ALD_(kt + 1)
            const unsigned char* Kb = g_lds + buf * KB_B; const unsigned char* Vb = g_lds + VOFF + buf * VB_B;
#pragma unroll 1
            for (int kb = 0; kb < 4; ++kb) {
                f32x16 st[2];
#pragma unroll
                for (int j = 0; j < 2; ++j) { const float nm = -mrun[j];
#pragma unroll
                    for (int i = 0; i < 16; ++i) st[j][i] = nm; }
#pragma unroll
                for (int ks = 0; ks < 6; ++ks) { const bf16x8 a = *(const bf16x8*)(Kb + (32 * kb + r) * 208 + (16 * ks + 8 * hh) * 2); st[0] = MFMA32(a, qf[0][ks], st[0]); st[1] = MFMA32(a, qf[1][ks], st[1]); }
                bf16x8 pf[2][2];
                const bool first = (kt == 0) && (kb == 0);
#pragma unroll
                for (int j = 0; j < 2; ++j) {
                    float mx = st[j][0];
#pragma unroll
                    for (int i = 1; i < 16; ++i) mx = fmaxf(mx, st[j][i]);
                    mx = fmaxf(mx, __shfl_xor(mx, 32));
                    if (first || __builtin_amdgcn_ballot_w64(mx > 8.f) != 0ull) {
                        const float d = first ? mx : fmaxf(mx, 0.f);
                        if (!first) { const float alpha = __builtin_amdgcn_exp2f(-d); lrun[j] *= alpha;
#pragma unroll
                            for (int c = 0; c < 2; ++c)
#pragma unroll
                                for (int i = 0; i < 16; ++i) o[j][c][i] *= alpha; }
#pragma unroll
                        for (int i = 0; i < 16; ++i) st[j][i] -= d;
                        mrun[j] += d;
                    }
                    float ps = 0.f;
#pragma unroll
                    for (int i = 0; i < 16; ++i) { const float e = __builtin_amdgcn_exp2f(st[j][i]); st[j][i] = e; ps += e; }
                    lrun[j] += ps;
#pragma unroll
                    for (int s2 = 0; s2 < 2; ++s2) {
                        u32x4 pp; pp.x = pk2(st[j][8 * s2 + 0], st[j][8 * s2 + 1]); pp.y = pk2(st[j][8 * s2 + 2], st[j][8 * s2 + 3]); pp.z = pk2(st[j][8 * s2 + 4], st[j][8 * s2 + 5]); pp.w = pk2(st[j][8 * s2 + 6], st[j][8 * s2 + 7]);
                        pf[j][s2] = __builtin_bit_cast(bf16x8, pp); }
                }
#pragma unroll
                for (int s2 = 0; s2 < 2; ++s2)
#pragma unroll
                    for (int db = 0; db < 2; ++db) { const bf16x8 a = *(const bf16x8*)(Vb + (32 * db + r) * 272 + (32 * kb + 16 * s2) * 2 + hh * 16);
                        o[0][db] = MFMA32(a, pf[0][s2], o[0][db]); o[1][db] = MFMA32(a, pf[1][s2], o[1][db]); }
            }
            if (more) AST_(buf ^ 1)
            __syncthreads();
        }
#undef ALD_
#undef AST_
        unsigned char* stg = g_lds + SOFF + wid * 8704;
#pragma unroll
        for (int j = 0; j < 2; ++j) { float l = lrun[j]; l += __shfl_xor(l, 32); const float inv = 1.f / l;
#pragma unroll
            for (int db = 0; db < 2; ++db)
#pragma unroll
                for (int g4 = 0; g4 < 4; ++g4) { u32x2 w; w.x = pk2(o[j][db][4 * g4] * inv, o[j][db][4 * g4 + 1] * inv); w.y = pk2(o[j][db][4 * g4 + 2] * inv, o[j][db][4 * g4 + 3] * inv);
                    *(u32x2*)(stg + (j * 32 + r) * 136 + (32 * db + 8 * g4 + 4 * hh) * 2) = w; } }
        __syncthreads();
#pragma unroll
        for (int j = 0; j < 8; ++j) { const int id = lane + 64 * j, row = id >> 3, c = id & 7; const u32x2 a = *(const u32x2*)(stg + row * 136 + c * 16), b = *(const u32x2*)(stg + row * 136 + c * 16 + 8);
            *(u32x4*)(Y + (size_t)(tq0 + row) * 1024 + head * 64 + c * 8) = (u32x4){a.x, a.y, b.x, b.y}; }
        __syncthreads();
    }
}
DI void spatial_phase(const Params& p) {
    unsigned char* ws = p.ws; int tid_ = threadIdx.x; asm volatile("" : "+v"(tid_)); const int tid = tid_, lane = tid & 63, wid = tid >> 6, hh = lane >> 5;
    bf16* sW = (bf16*)g_lds; bf16* sVn = (bf16*)(g_lds + TILE_B); float* sR = (float*)(g_lds + 2 * TILE_B);
    const bf16* WSP = (const bf16*)(ws + O_WSP); const bf16* U = (const bf16*)(ws + O_U); const bf16* V = (const bf16*)(ws + O_V); const f32x4* VSS = (const f32x4*)(ws + O_VSS); bf16* Z = (bf16*)(ws + O_Z);
    const int rb = wid & 3, cb0 = (wid >> 2) * 2;
    const int G8 = (gridDim.x & 7) == 0 ? (int)(gridDim.x >> 3) : 0;
    if (G8 == 0) return;
    const int g = blockIdx.x & 7;
    load_tile_nat(sW, WSP + (size_t)g * 16384, 128, tid);
    const f32x4 n0 = *(const f32x4*)(p.c_v_norm + g * 128 + (tid >> 7) * 8), n1 = *(const f32x4*)(p.c_v_norm + g * 128 + (tid >> 7) * 8 + 4), n2 = *(const f32x4*)(p.c_v_norm + g * 128 + (tid >> 7) * 8 + 32), n3 = *(const f32x4*)(p.c_v_norm + g * 128 + (tid >> 7) * 8 + 36);
    const f32x4 n4 = *(const f32x4*)(p.c_v_norm + g * 128 + (tid >> 7) * 8 + 64), n5 = *(const f32x4*)(p.c_v_norm + g * 128 + (tid >> 7) * 8 + 68), n6 = *(const f32x4*)(p.c_v_norm + g * 128 + (tid >> 7) * 8 + 96), n7 = *(const f32x4*)(p.c_v_norm + g * 128 + (tid >> 7) * 8 + 100);
    float bsp[16];
#pragma unroll
    for (int i = 0; i < 16; ++i) bsp[i] = p.c_b_sp[g * 128 + 32 * rb + crow(i, hh)];
    u32x4 vr[4];
    int cgk = blockIdx.x >> 3;
    if (cgk < NCHUNK) {
#pragma unroll
        for (int i = 0; i < 4; ++i) { const int id = tid + 512 * i, row = id & 127, c = (id >> 7) * 8; vr[i] = *(const u32x4*)(V + (size_t)(cgk * 128 + row) * 1024 + g * 128 + c); }
    }
    for (; cgk < NCHUNK; cgk += G8) {
        const int t0 = cgk * 128;
        if (tid < 128) { const f32x4 q = VSS[t0 + tid]; sR[tid] = rsqrtf(((q.x + q.y) + (q.z + q.w)) * (1.f / 1024.f) + EPS); }
        __syncthreads();
#pragma unroll
        for (int i = 0; i < 4; ++i) { const int id = tid + 512 * i, row = id & 127, c = (id >> 7) * 8; const u32x4 v = vr[i]; const float ww = sR[row];
            const f32x4 na = i == 0 ? n0 : (i == 1 ? n2 : (i == 2 ? n4 : n6)), nb = i == 0 ? n1 : (i == 1 ? n3 : (i == 2 ? n5 : n7));
            sVn[(c + 0) * LDT + row] = f2bf(bflo(v.x) * ww * na.x); sVn[(c + 1) * LDT + row] = f2bf(bfhi(v.x) * ww * na.y); sVn[(c + 2) * LDT + row] = f2bf(bflo(v.y) * ww * na.z); sVn[(c + 3) * LDT + row] = f2bf(bfhi(v.y) * ww * na.w);
            sVn[(c + 4) * LDT + row] = f2bf(bflo(v.z) * ww * nb.x); sVn[(c + 5) * LDT + row] = f2bf(bfhi(v.z) * ww * nb.y); sVn[(c + 6) * LDT + row] = f2bf(bflo(v.w) * ww * nb.z); sVn[(c + 7) * LDT + row] = f2bf(bfhi(v.w) * ww * nb.w); }
        __syncthreads();
        if (cgk + G8 < NCHUNK) {
#pragma unroll
            for (int i = 0; i < 4; ++i) { const int id = tid + 512 * i, row = id & 127, c = (id >> 7) * 8; vr[i] = *(const u32x4*)(V + (size_t)((cgk + G8) * 128 + row) * 1024 + g * 128 + c); }
        }
        bf16 uu[2][16];
#pragma unroll
        for (int c = 0; c < 2; ++c)
#pragma unroll
            for (int i = 0; i < 16; ++i) uu[c][i] = U[(size_t)(t0 + 32 * rb + crow(i, hh)) * 1024 + g * 128 + 32 * (cb0 + c) + (lane & 31)];
        f32x16 acc[2];
#pragma unroll
        for (int c = 0; c < 2; ++c)
#pragma unroll
            for (int i = 0; i < 16; ++i) acc[c][i] = 0.f;
        mm_lds<8>(acc, sW, sVn, rb, cb0, lane);
#pragma unroll
        for (int c = 0; c < 2; ++c)
#pragma unroll
            for (int i = 0; i < 16; ++i) { const int t = 32 * rb + crow(i, hh), cc = g * 128 + 32 * (cb0 + c) + (lane & 31); const size_t ix = (size_t)(t0 + t) * 1024 + cc;
                Z[ix] = f2bf((acc[c][i] + bsp[i]) * bf2f(uu[c][i])); }
    }
    __syncthreads();
}
DI void final_phase(const Params& p) {
    int tid_ = threadIdx.x; asm volatile("" : "+v"(tid_)); const int tid = tid_, lane = tid & 63, gw = blockIdx.x * 8 + (tid >> 6), NGW = gridDim.x * 8; const f32x4* SS = (const f32x4*)(p.ws + O_SS);
    for (int t = gw; t < T_TOK; t += NGW) { const float rs = rs_of(SS, t); f32x4* xr = (f32x4*)(p.out + (size_t)t * DM) + lane; const f32x4* gn = (const f32x4*)p.final_norm + lane;
#pragma unroll
        for (int j = 0; j < 4; ++j) xr[64 * j] = xr[64 * j] * rs * gn[64 * j]; }
}


#ifndef DBG
#define DBG 0
#endif
constexpr size_t O_DBG = O_END0;
DI int btok_(int i) { return ((int)blockIdx.x * 8 + (i & 7)) * 40 + ((int)blockIdx.x * 7 + i * 3) % 40; }
DI bool close_(float fast, float ref) { return fabsf(fast - ref) <= 0.03f + 0.04f * fabsf(ref); }
DI float nrs_(const Params& p, int t) { const float* x = xin_row(p, t); float s = 0.f; for (int k = 0; k < 1024; ++k) s += x[k] * x[k]; return rsqrtf(s * (1.f / 1024.f) + EPS); }
DI float nh_(const Params& p, int t, int col, float rs) { const float* x = xin_row(p, t); float s = 0.f; for (int k = 0; k < 1024; ++k) s += x[k] * p.ab_norm[k] * p.ab_w_in[(size_t)k * 2480 + col]; return s * rs; }
DI void dbg_fail(const Params& p, unsigned bit) { atomicOr((unsigned*)(p.ws + O_DBG), bit); }
DI void chk_inproj(const Params& p) {
    unsigned char* ws = p.ws; int tid_ = threadIdx.x; asm volatile("" : "+v"(tid_)); const int tid = tid_; const int bx = blockIdx.x;
    if (tid < 4) { const int t = btok_(tid); const float rs = nrs_(p, t);
        { const float ref = nh_(p, t, (7 + 50 * tid + bx) % 256, rs), fast = bf2f(((const bf16*)(ws + O_CQKV))[(size_t)t * 384 + (7 + 50 * tid + bx) % 256]); if (!close_(fast, ref)) dbg_fail(p, 0u); }
        { const float ref = nh_(p, t, 256 + (9 + 20 * tid + bx) % 128, rs), fast = bf2f(((const bf16*)(ws + O_CQKV))[(size_t)t * 384 + 256 + (9 + 20 * tid + bx) % 128]); if (!close_(fast, ref)) dbg_fail(p, 0u); }
        { const int ch = (3 + 37 * tid + 2 * bx) % 512; const float ref = nh_(p, t, 1440 + ch, rs), fast = bf2f(((const bf16*)(ws + O_MV))[(size_t)t * 512 + ch]); if (!close_(fast, ref)) dbg_fail(p, 0u); }
    } else if (tid < 8) { const int i = tid - 4, t = btok_(tid); const int sq = seq_of(t), s0 = seq_start(sq), sl = seq_len(sq);
        for (int w = 0; w < 2; ++w) { const int ch = (w ? 512 : 0) + (11 + 100 * i + 2 * bx) % 512; float a[3];
            for (int d = -1; d <= 1; ++d) { const int tt = t + d; a[d + 1] = (tt >= s0 && tt < s0 + sl) ? nh_(p, tt, 416 + ch, nrs_(p, tt)) : 0.f; }
            float v = a[0] * p.m_conv_w[ch] + a[1] * p.m_conv_w[1024 + ch] + a[2] * p.m_conv_w[2048 + ch] + p.m_conv_b[ch]; v = v / (1.f + expf(-v)); if (w) v *= 0.08838834764831845f;
            const float fast = bf2f(((const bf16*)(ws + (w ? O_KC : O_QC)))[(size_t)t * 512 + (ch & 511)]); if (!close_(fast, v)) { const int pos = t - s0, row = pos % 252 + 2; const int jj = pos / 252, pm = sq < 2 ? sq * 33 + jj : 66 + (sq - 2) * 17 + jj; (void)pm; const int fr_ = row & 15, m_ = (row >> 4) & 3; (void)fr_; (void)m_; { unsigned b = 0; if (fr_ == 1) b = 1u; else if (fr_ == 2) b = 2u; else if (fr_ == 3) b = 4u; else if (fr_ == 12) b = 8u; else if (fr_ == 13) b = 16u; else if (fr_ == 14) b = 32u; dbg_fail(p, b); } } }
    } else if (tid < 12) { const int i = tid - 8, t = btok_(tid); const float rs = nrs_(p, t); const int sq = seq_of(t), pos = t - seq_start(sq);
        { const int gi = (5 + 2 * i + bx) & 15; float v = nh_(p, t, 2464 + gi, rs) + p.gate_bias[gi]; if ((gi >> 2) & 1) v = fminf(v, 0.f) - log1pf(expf(-fabsf(v))); const float fast = ((const float*)(ws + O_G))[(size_t)t * 16 + gi]; if (!close_(fast, v)) dbg_fail(p, 0u); }
        { const int ii = (3 + i + bx) & 15; const float x1 = nh_(p, t, 384 + ii, rs), x2 = nh_(p, t, 384 + 16 + ii, rs); const float ang = (float)pos / powf(10000.f, ii / 16.f); const float c = cosf(ang), sn = sinf(ang);
          const float r1 = x1 * c - x2 * sn, r2 = x2 * c + x1 * sn; const bf16* KR = (const bf16*)(ws + O_KR); if (!close_(bf2f(KR[(size_t)t * 32 + ii]), r1) || !close_(bf2f(KR[(size_t)t * 32 + 16 + ii]), r2)) dbg_fail(p, 0u); }
        { const int ch = (17 + 60 * i + 2 * bx) % 512; float v = nh_(p, t, 1952 + ch, rs); v = 1.f / (1.f + expf(-v)); const float fast = bf2f(((const bf16*)(ws + O_MO))[(size_t)t * 512 + ch]); if (!close_(fast, v)) dbg_fail(p, 0u); }
    }
}
DI void chk_mlstm(const Params& p) {
    unsigned char* ws = p.ws; int tid_ = threadIdx.x; asm volatile("" : "+v"(tid_)); const int tid = tid_; const int sqm = blockIdx.x % 18, hd = (blockIdx.x / 18) & 3, t0 = seq_start(sqm), S = seq_len(sqm), tp = (blockIdx.x * 37 + 5) % S;
    const float* G = (const float*)(ws + O_G); const bf16* QC = (const bf16*)(ws + O_QC); const bf16* KC = (const bf16*)(ws + O_KC); const bf16* MV = (const bf16*)(ws + O_MV); const bf16* MO = (const bf16*)(ws + O_MO); const bf16* Y = (const bf16*)(ws + O_Y);
    const int d = tid >> 2, e0 = (tid & 3) * 32; float* sh = (float*)g_lds; float hsum = 0.f;
    for (int dir = 0; dir < 2; ++dir) {
        const int first = dir ? S - 1 : 0, step = dir ? -1 : 1, cnt = dir ? S - tp : tp + 1;
        float num = 0.f, den = 0.f;
        { float C[32];
#pragma unroll
          for (int e = 0; e < 32; ++e) C[e] = 0.f;
          for (int j = 0; j < cnt; ++j) { const int t = t0 + first + step * j; const float f = expf(G[(size_t)t * 16 + dir * 8 + 4 + hd]), ii = expf(G[(size_t)t * 16 + dir * 8 + hd]);
            const float v = bf2f(MV[(size_t)t * 512 + hd * 128 + d]) * ii;
#pragma unroll
            for (int e = 0; e < 32; ++e) { const float k = bf2f(KC[(size_t)t * 512 + hd * 128 + e0 + e]); C[e] = f * C[e] + v * k; } }
#pragma unroll
          for (int e = 0; e < 32; ++e) num += C[e] * bf2f(QC[(size_t)(t0 + tp) * 512 + hd * 128 + e0 + e]); }
        __builtin_amdgcn_sched_barrier(0);
        { float n[32];
#pragma unroll
          for (int e = 0; e < 32; ++e) n[e] = 0.f;
          for (int j = 0; j < cnt; ++j) { const int t = t0 + first + step * j; const float f = expf(G[(size_t)t * 16 + dir * 8 + 4 + hd]), ii = expf(G[(size_t)t * 16 + dir * 8 + hd]);
#pragma unroll
            for (int e = 0; e < 32; ++e) { const float k = bf2f(KC[(size_t)t * 512 + hd * 128 + e0 + e]); n[e] = f * n[e] + ii * k; } }
#pragma unroll
          for (int e = 0; e < 32; ++e) den += n[e] * bf2f(QC[(size_t)(t0 + tp) * 512 + hd * 128 + e0 + e]); }
        num += __shfl_xor(num, 1); num += __shfl_xor(num, 2); den += __shfl_xor(den, 1); den += __shfl_xor(den, 2);
        hsum += num / fmaxf(fabsf(den), 1.f);
    }
    __syncthreads();
    if ((tid & 3) == 0) sh[d] = hsum;
    __syncthreads();
    if (tid < 128) { float ss = 0.f; for (int e = 0; e < 128; ++e) ss += sh[e] * sh[e]; const float rstd = rsqrtf(ss * (1.f / 128.f) + EPS);
        const float ref = sh[tid] * rstd * p.m_out_norm[hd * 128 + tid] * bf2f(MO[(size_t)(t0 + tp) * 512 + hd * 128 + tid]); const float fast = bf2f(Y[(size_t)(t0 + tp) * 1024 + 512 + hd * 128 + tid]);
        if (!close_(fast, ref)) dbg_fail(p, 0u); }
    __syncthreads();
}
DI void chk_qkv(const Params& p) {
    unsigned char* ws = p.ws; int tid_ = threadIdx.x; asm volatile("" : "+v"(tid_)); const int tid = tid_; if (tid >= 4) return;
    const int t = btok_(tid); const int sq = seq_of(t), st = seq_start(sq), S = seq_len(sq), pos = t - st; const bf16* CQ = (const bf16*)(ws + O_CQKV) + (size_t)t * 384;
    float sq_ = 0.f, skv = 0.f; for (int k = 0; k < 256; ++k) sq_ += bf2f(CQ[k]) * bf2f(CQ[k]); for (int k = 0; k < 128; ++k) skv += bf2f(CQ[256 + k]) * bf2f(CQ[256 + k]);
    const float rq = rsqrtf(sq_ / 256.f + EPS), rkv = rsqrtf(skv / 128.f + EPS); const float qs = 0.10206207261596577f * 1.4426950408889634f;
    const int hd = (2 + tid + blockIdx.x) & 7;
    { const int dd = 13 + tid; float s = 0.f; for (int k = 0; k < 256; ++k) s += bf2f(CQ[k]) * p.q_norm[k] * p.w_uq[(size_t)k * 768 + hd * 96 + dd]; s *= rq * qs; if (!close_(bf2f(((const bf16*)(ws + O_Q))[(size_t)t * 768 + hd * 96 + dd]), s)) dbg_fail(p, 0u); }
    { const int ii = 2 + tid; float x1 = 0.f, x2 = 0.f; for (int k = 0; k < 256; ++k) { const float a = bf2f(CQ[k]) * p.q_norm[k]; x1 += a * p.w_uq[(size_t)k * 768 + hd * 96 + 64 + ii]; x2 += a * p.w_uq[(size_t)k * 768 + hd * 96 + 80 + ii]; }
      x1 *= rq * qs; x2 *= rq * qs; const float ang = (float)pos / powf(10000.f, ii / 16.f); const float c = cosf(ang), sn = sinf(ang); const bf16* Qp = (const bf16*)(ws + O_Q) + (size_t)t * 768 + hd * 96;
      if (!close_(bf2f(Qp[64 + ii]), x1 * c - x2 * sn) || !close_(bf2f(Qp[80 + ii]), x2 * c + x1 * sn)) dbg_fail(p, 0u); }
    { const int dd = 21 + tid; float s = 0.f, v = 0.f; for (int k = 0; k < 128; ++k) { const float a = bf2f(CQ[256 + k]) * p.kv_norm[k]; s += a * p.w_ukv[(size_t)k * 1024 + hd * 128 + dd]; v += a * p.w_ukv[(size_t)k * 1024 + hd * 128 + 64 + dd]; }
      s *= rkv; v *= rkv; if (!close_(bf2f(((const bf16*)(ws + O_KN))[(size_t)t * 512 + hd * 64 + dd]), s)) dbg_fail(p, 0u);
      if (!close_(bf2f(((const bf16*)(ws + O_VT))[(size_t)st * 512 + (size_t)(hd * 64 + dd) * S + pos]), v)) dbg_fail(p, 0u); }
}
DI void chk_attn(const Params& p) {
    unsigned char* ws = p.ws; int tid_ = threadIdx.x; asm volatile("" : "+v"(tid_)); const int tid = tid_; if (tid >= 64) return;
    const int smp = tid >> 4, dd = (tid & 15) * 4 + (blockIdx.x & 3); const int t = btok_(smp), hd = (1 + 2 * smp + blockIdx.x) & 7; const int sq = seq_of(t), st = seq_start(sq), S = seq_len(sq);
    const bf16* Q = (const bf16*)(ws + O_Q) + (size_t)t * 768 + hd * 96; const bf16* KN = (const bf16*)(ws + O_KN); const bf16* KR = (const bf16*)(ws + O_KR); const bf16* VT = (const bf16*)(ws + O_VT) + (size_t)st * 512 + (size_t)(hd * 64 + dd) * S;
    float m = -1e30f, l = 0.f, o = 0.f;
    for (int k = 0; k < S; ++k) { float s = 0.f; for (int e = 0; e < 64; ++e) s += bf2f(Q[e]) * bf2f(KN[(size_t)(st + k) * 512 + hd * 64 + e]); for (int e = 0; e < 32; ++e) s += bf2f(Q[64 + e]) * bf2f(KR[(size_t)(st + k) * 32 + e]);
        const float mn = fmaxf(m, s), a = exp2f(m - mn), pe = exp2f(s - mn); l = l * a + pe; o = o * a + pe * bf2f(VT[k]); m = mn; }
    const float ref = o / l, fast = bf2f(((const bf16*)(ws + O_Y))[(size_t)t * 1024 + hd * 64 + dd]); if (!close_(fast, ref)) dbg_fail(p, 0u);
}
DI void dbg_emit(const Params& p) {
    const float a = sqrtf((float)*(const unsigned*)(p.ws + O_DBG)); const int gt = blockIdx.x * NTHR + threadIdx.x, GT = gridDim.x * NTHR;
    for (size_t i = gt; i < (size_t)T_TOK * DM / 4; i += GT) ((f32x4*)p.out)[i] = (f32x4){a, a, a, a};
}

DI int dtok_(int i) { return i == 0 ? 62 : i == 1 ? 63 : i == 2 ? 253 : i == 3 ? 254 : i == 4 ? 8191 : i == 5 ? 16384 : i == 6 ? 20253 : 81919; }
DI float rowrs_(const float* x) { float s = 0.f; for (int k = 0; k < 1024; ++k) s += x[k] * x[k]; return rsqrtf(s * (1.f / 1024.f) + EPS); }
DI void chk_res(const Params& p, const bf16* A, int K, const float* W, bool first, unsigned bit, int slot) {
    if (threadIdx.x >= 8) return; const int i = threadIdx.x, t = btok_(i), c = (5 + 127 * i + 3 * (int)blockIdx.x) & 1023; float* sv = (float*)(p.ws + O_DBG + 64) + (size_t)blockIdx.x * 32;
    float s = first ? xin_row(p, t)[c] : sv[slot * 8 + i]; for (int k = 0; k < K; ++k) s += bf2f(A[(size_t)t * K + k]) * W[(size_t)k * 1024 + c];
    if (!close_(p.out[(size_t)t * DM + c], s)) dbg_fail(p, bit);
    sv[(slot + 1) * 8 + i] = p.out[(size_t)t * DM + c];
}
DI void chk_up(const Params& p, int layer) {
    if (threadIdx.x >= 8) return; const int i = threadIdx.x, t = btok_(i), j = (9 + 350 * i + 11 * (int)blockIdx.x) % 2816; const int sq = seq_of(t), s0 = seq_start(sq), sl = seq_len(sq);
    const float* W = p.ffn_w_up + (size_t)layer * 1024 * 5632; const float* cw = p.ffn_conv_w + (size_t)layer * 3 * 5632; const float* cb = p.ffn_conv_b + (size_t)layer * 5632; const float* gn = p.ffn_norm + layer * 1024;
    float g = cb[j], v = cb[2816 + j];
    for (int d = -1; d <= 1; ++d) { const int tt = t + d; if (tt < s0 || tt >= s0 + sl) continue; const float* x = p.out + (size_t)tt * DM; const float rs = rowrs_(x); float ag = 0.f, av = 0.f;
        for (int k = 0; k < 1024; ++k) { const float xn = x[k] * rs * gn[k]; ag += xn * W[(size_t)k * 5632 + j]; av += xn * W[(size_t)k * 5632 + 2816 + j]; }
        g += ag * cw[(d + 1) * 5632 + j]; v += av * cw[(d + 1) * 5632 + 2816 + j]; }
    const float ref = g / (1.f + expf(-g)) * v, fast = bf2f(((const bf16*)(p.ws + O_HID))[(size_t)t * DFF + j]); if (!close_(fast, ref)) dbg_fail(p, DBG == 3 ? (i < 6 ? (1u << i) : 0u) : 2u);
}
DI void chk_gin(const Params& p) {
    if (threadIdx.x >= 8) return; const int i = threadIdx.x, t = btok_(i), c = (3 + 120 * i + 5 * (int)blockIdx.x) & 1023; const float* x = p.out + (size_t)t * DM; const float rs = rowrs_(x); float au = 0.f, av = 0.f;
    for (int k = 0; k < 1024; ++k) { const float xn = x[k] * rs * p.c_norm[k]; au += xn * p.c_w_in[(size_t)k * 2048 + c]; av += xn * p.c_w_in[(size_t)k * 2048 + 1024 + c]; }
    au = 0.5f * au * (1.f + erff(au * 0.70710678f)); av = 0.5f * av * (1.f + erff(av * 0.70710678f));
    if (!close_(bf2f(((const bf16*)(p.ws + O_U))[(size_t)t * DM + c]), au) || !close_(bf2f(((const bf16*)(p.ws + O_V))[(size_t)t * DM + c]), av)) dbg_fail(p, 8u);
}
DI void chk_sp(const Params& p) {
    if (threadIdx.x >= 8) return; const int i = threadIdx.x, t = btok_(i), g = (i + (int)blockIdx.x) & 7, c = (7 + 13 * i + (int)blockIdx.x) & 127, t0 = t & ~127, tt = t & 127; const bf16* V = (const bf16*)(p.ws + O_V); const bf16* U = (const bf16*)(p.ws + O_U);
    float acc = 0.f;
    for (int s2 = 0; s2 < 128; ++s2) { const bf16* vr = V + (size_t)(t0 + s2) * DM; float ss = 0.f; for (int k = 0; k < 1024; ++k) ss += bf2f(vr[k]) * bf2f(vr[k]); const float rv = rsqrtf(ss * (1.f / 1024.f) + EPS);
        acc += p.c_w_sp[(size_t)g * 16384 + tt * 128 + s2] * bf2f(vr[g * 128 + c]) * rv * p.c_v_norm[g * 128 + c]; }
    const float ref = (acc + p.c_b_sp[g * 128 + tt]) * bf2f(U[(size_t)t * DM + g * 128 + c]); if (!close_(bf2f(((const bf16*)(p.ws + O_Z))[(size_t)t * DM + g * 128 + c]), ref)) dbg_fail(p, 0u);
}
#if defined(__HIP_DEVICE_COMPILE__)
#define GETP() Params p; { typedef const unsigned long long __attribute__((address_space(4)))* KA_; KA_ q_ = (KA_)__builtin_amdgcn_kernarg_segment_ptr(); asm volatile("" : "+s"(q_)); \
    typedef __attribute__((address_space(1))) unsigned char* GP_; const void** pp_ = (const void**)&p; _Pragma("unroll") for (int i_ = 0; i_ < 27; ++i_) pp_[i_] = (const void*)(GP_)q_[i_]; } unsigned char* ws = p.ws; (void)ws;
#else
#define GETP() Params p = p_unused; unsigned char* ws = p.ws; (void)ws;
#endif
__global__ void __launch_bounds__(NTHR, 2) fwd_kernel(Params p_unused, int lo, int hi) {
    cg::grid_group grid = cg::this_grid();
#define PH(k, ...) if (lo <= (k) && (k) < hi) { GETP() __VA_ARGS__ } if (lo <= (k) && (k) + 1 < hi) grid.sync();
    PH(0, p0_prologue(p); if (DBG && blockIdx.x == 0 && threadIdx.x == 0) *(unsigned*)(p.ws + O_DBG) = 0u;)
    PH(1, Gemm g{(const bf16*)(ws + O_XB), (const bf16*)(ws + O_WIN), 1024, NM_OVL, 10, 1}; EpiIn E{p}; gemm_phase(g, E);)
    PH(2, mlstm_local(p);)
    PH(3, mlstm_scan(p);)
    PH(4, mlstm_out(p);)
    PH(5, Gemm g{(const bf16*)(ws + O_CQKV), (const bf16*)(ws + O_WQKV), 384, NM_PLAIN, 7, 0, 1}; EpiQkv E{p}; gemm_phase(g, E);)
    PH(6, attn_phase(p);)
    PH(7, Gemm g{(const bf16*)(ws + O_Y), (const bf16*)(ws + O_WOUT), 1024, NM_PLAIN, 4, 0}; EpiRes E{p, 1, 0}; gemm_phase<EpiRes, true>(g, E);)
    PH(8, Gemm g{(const bf16*)(ws + O_XB), (const bf16*)(ws + O_WUP), 1024, NM_OVL, 22, 1}; EpiUp E{p, 0}; gemm_phase<EpiUp, false>(g, E);)
    PH(9, Gemm g{(const bf16*)(ws + O_HID), (const bf16*)(ws + O_WDN), 2816, NM_PLAIN, 4, 0}; EpiRes E{p, 0, 0}; gemm_phase<EpiRes, true>(g, E);)
    PH(10, Gemm g{(const bf16*)(ws + O_XB), (const bf16*)(ws + O_WCIN), 1024, NM_PLAIN, 8, 0}; EpiGin E{p}; gemm_phase<EpiGin, true>(g, E);)
    PH(11, spatial_phase(p);)
    PH(12, Gemm g{(const bf16*)(ws + O_Z), (const bf16*)(ws + O_WCOUT), 1024, NM_PLAIN, 4, 0}; EpiRes E{p, 0, 0}; gemm_phase<EpiRes, true>(g, E);)
    PH(13, Gemm g{(const bf16*)(ws + O_XB), (const bf16*)(ws + O_WUP + AL((size_t)5632 * 1024 * 2)), 1024, NM_OVL, 22, 1}; EpiUp E{p, 1}; gemm_phase<EpiUp, false>(g, E);)
    PH(14, Gemm g{(const bf16*)(ws + O_HID), (const bf16*)(ws + O_WDN + AL((size_t)1024 * 2816 * 2)), 2816, NM_PLAIN, 4, 0}; EpiRes E{p, 0, 1}; gemm_phase<EpiRes, true>(g, E);)
    PH(15, final_phase(p);)
}
#if DBG
__global__ void __launch_bounds__(NTHR) chk_kernel(Params p, int which) {
    unsigned char* ws = p.ws; (void)ws;
    if (which == 1) chk_inproj(p);
    else if (which == 4) chk_mlstm(p);
    else if (which == 5) chk_qkv(p);
    else if (which == 6) chk_attn(p);
    else if (which == 7) chk_res(p, (const bf16*)(ws + O_Y), 1024, p.ab_w_out, true, 1u, 0);
    else if (which == 8) chk_up(p, 0);
    else if (which == 9) chk_res(p, (const bf16*)(ws + O_HID), 2816, p.ffn_w_down, false, 4u, 1);
    else if (which == 10) chk_gin(p);
    else if (which == 11) chk_sp(p);
    else if (which == 12) chk_res(p, (const bf16*)(ws + O_Z), 1024, p.c_w_out, false, 32u, 2);
    else if (which == 13) chk_up(p, 1);
    else if (which == 99) dbg_emit(p);
}
#endif

extern "C" void kernel_launch(void* const* d_in, const int* in_sizes, int n_in, void* d_out, int out_size, void* d_ws, size_t ws_size, hipStream_t stream) {
    static int grid = 0;
    if (grid == 0) {
        if (n_in != 25 || ws_size < WS_NEED + 65536 || out_size != T_TOK * DM) { fprintf(stderr, "kernel_launch: unexpected problem: n_in %d out %d ws %zu (need %zu)\n", n_in, out_size, ws_size, (size_t)WS_NEED); grid = -1; return; }
        int dev = 0, cus = 0, per_cu = 0;
        hipGetDevice(&dev); hipDeviceGetAttribute(&cus, hipDeviceAttributeMultiprocessorCount, dev);
        if (hipFuncSetAttribute((const void*)fwd_kernel, hipFuncAttributeMaxDynamicSharedMemorySize, LDS_BYTES) != hipSuccess) { fprintf(stderr, "kernel_launch: hipFuncSetAttribute failed\n"); grid = -1; return; }
        hipOccupancyMaxActiveBlocksPerMultiprocessor(&per_cu, (const void*)fwd_kernel, NTHR, LDS_BYTES);
        if (per_cu < 1) { fprintf(stderr, "kernel_launch: occupancy query says %d blocks per CU\n", per_cu); per_cu = 1; }
        (void)hipGetLastError();
        grid = cus;
    }
    if (grid < 0) return;
    Params p{};
    const float** f = (const float**)&p;
    for (int i = 0; i < 25; ++i) f[i] = (const float*)d_in[i];
    p.out = (float*)d_out; p.ws = (unsigned char*)d_ws;
    auto run = [&](int lo, int hi) { void* args[] = {&p, &lo, &hi};
        hipError_t e = hipLaunchCooperativeKernel((const void*)fwd_kernel, dim3(grid), dim3(NTHR), args, LDS_BYTES, stream);
        if (e != hipSuccess) fprintf(stderr, "cooperative launch failed: %s (grid %d)\n", hipGetErrorString(e), grid); };
#if DBG == 0
    run(0, 16);
#else
    int cur = 0;
    auto upto = [&](int k) { run(cur, k + 1); cur = k + 1; };
    auto chk = [&](int which) { hipLaunchKernelGGL(chk_kernel, dim3(grid), dim3(NTHR), 4096, stream, p, which); };
#if DBG == 1
    upto(1); chk(1); upto(4); chk(4); upto(5); chk(5); upto(6); chk(6);
#else
    upto(7); chk(7); upto(8); chk(8); upto(9); chk(9); upto(10); chk(10); upto(11); chk(11); upto(12); chk(12);
#if DBG == 4
    upto(13); chk(13);
#endif
#endif
    chk(99);
#endif
}
```

```cpp
#include <hip/hip_runtime.h>
#include <hip/hip_cooperative_groups.h>
#include <cstdio>
#include <cstdint>
namespace cg = cooperative_groups;

typedef unsigned short bf16;
typedef short bf16x8 __attribute__((ext_vector_type(8)));
typedef short s16x4 __attribute__((ext_vector_type(4)));
typedef float f32x2 __attribute__((ext_vector_type(2)));
typedef float f32x4 __attribute__((ext_vector_type(4)));
typedef float f32x16 __attribute__((ext_vector_type(16)));
typedef unsigned u32x2 __attribute__((ext_vector_type(2)));
typedef unsigned u32x4 __attribute__((ext_vector_type(4)));
typedef __bf16 bf2_t __attribute__((ext_vector_type(2)));
#define DI __device__ __forceinline__
#define MFMA32(a, b, c) __builtin_amdgcn_mfma_f32_32x32x16_bf16((a), (b), (c), 0, 0, 0)

constexpr int NTHR = 512;
constexpr int T_TOK = 81920, TP = 16384, DM = 1024;
constexpr int NCHUNK = T_TOK / 128;
constexpr int DFF = 2816;
constexpr float EPS = 1e-6f;
constexpr int LDS_BYTES = 147456;

constexpr size_t AL(size_t x) { return (x + 255) & ~(size_t)255; }
constexpr size_t O_WIN = 0;
constexpr size_t O_WQKV = O_WIN + AL((size_t)2560 * 1024 * 2);
constexpr size_t O_WOUT = O_WQKV + AL((size_t)1792 * 384 * 2);
constexpr size_t O_WCIN = O_WOUT + AL((size_t)1024 * 1024 * 2);
constexpr size_t O_WCOUT = O_WCIN + AL((size_t)2048 * 1024 * 2);
constexpr size_t O_WUP = O_WCOUT + AL((size_t)1024 * 1024 * 2);
constexpr size_t O_WDN = O_WUP + 2 * AL((size_t)5632 * 1024 * 2);
constexpr size_t O_WSP = O_WDN + 2 * AL((size_t)1024 * 2816 * 2);
constexpr size_t O_ROPE = O_WSP + AL((size_t)8 * 128 * 128 * 2);
constexpr size_t O_SS = O_ROPE + AL((size_t)8192 * 32 * 4);
constexpr size_t O_VSS = O_SS + AL((size_t)T_TOK * 16);
constexpr size_t O_RQ = O_VSS + AL((size_t)T_TOK * 16);
constexpr size_t O_RKV = O_RQ + AL((size_t)T_TOK * 4);
constexpr size_t O_KR = O_RKV + AL((size_t)T_TOK * 4);
constexpr size_t O_G = O_KR + AL((size_t)T_TOK * 32 * 2);
constexpr size_t O_NS = O_G + AL((size_t)T_TOK * 16 * 4);
constexpr size_t O_ML = O_NS + AL((size_t)5120 * 128 * 4);
constexpr size_t O_BL = O_ML + AL((size_t)5120 * 4);
constexpr size_t O_MP = O_BL + AL((size_t)5120 * 4);
constexpr size_t O_XBG = O_MP + AL((size_t)5120 * 4);
constexpr size_t O_XB = O_XBG + 4096;
constexpr size_t O_AR = O_XB + AL((size_t)T_TOK * 1024 * 2);
constexpr size_t O_CQKV = O_AR;
constexpr size_t O_QC = O_CQKV + AL((size_t)T_TOK * 384 * 2);
constexpr size_t O_KC = O_QC + AL((size_t)T_TOK * 512 * 2);
constexpr size_t O_MV = O_KC + AL((size_t)T_TOK * 512 * 2);
constexpr size_t O_MO = O_MV + AL((size_t)T_TOK * 512 * 2);
constexpr size_t O_CS = O_MO + AL((size_t)T_TOK * 512 * 2);
constexpr size_t O_Y = O_CS + AL((size_t)5120 * 16384 * 2);
constexpr size_t O_END0 = O_Y + AL((size_t)T_TOK * 1024 * 2);
constexpr size_t O_Q = O_QC;
constexpr size_t O_KN = O_Q + AL((size_t)T_TOK * 768 * 2);
constexpr size_t O_VT = O_KN + AL((size_t)T_TOK * 512 * 2);
static_assert(O_VT + (size_t)T_TOK * 512 * 2 <= O_CS, "attention operands overlay");
constexpr size_t O_HID = O_AR;
constexpr size_t O_U = O_AR;
constexpr size_t O_V = O_U + AL((size_t)T_TOK * 1024 * 2);
constexpr size_t O_Z = O_V + AL((size_t)T_TOK * 1024 * 2);
constexpr size_t WS_NEED = O_END0;
static_assert(O_HID + (size_t)T_TOK * 2816 * 2 <= O_END0 && O_Z + (size_t)T_TOK * 2048 <= O_END0, "arena");

struct Params {
    const float* x_prompt; const float* x_sample;
    const float *ab_norm, *ab_w_in, *q_norm, *w_uq, *kv_norm, *w_ukv, *m_conv_w, *m_conv_b, *gate_bias, *m_out_norm, *ab_w_out;
    const float *c_norm, *c_w_in, *c_v_norm, *c_w_sp, *c_b_sp, *c_w_out;
    const float *ffn_norm, *ffn_w_up, *ffn_conv_w, *ffn_conv_b, *ffn_w_down, *final_norm;
    float* out; unsigned char* ws;
};

extern __shared__ __attribute__((aligned(16))) unsigned char g_lds[];

DI unsigned pk2(float lo, float hi) { f32x2 v = {lo, hi}; bf2_t b = __builtin_convertvector(v, bf2_t); return __builtin_bit_cast(unsigned, b); }
DI bf16 f2bf(float x) { return (bf16)(pk2(x, 0.f) & 0xffffu); }
DI float bf2f(bf16 x) { return __uint_as_float(((unsigned)x) << 16); }
DI float bflo(unsigned u) { return __uint_as_float(u << 16); }
DI float bfhi(unsigned u) { return __uint_as_float(u & 0xffff0000u); }
DI int seq_start(int sq) { return sq < 2 ? (sq << 13) : TP + ((sq - 2) << 12); }
DI int seq_len(int sq) { return sq < 2 ? 8192 : 4096; }
DI int seq_of(int t) { return t < TP ? (t >> 13) : 2 + ((t - TP) >> 12); }
DI float wave_sum(float v) {
#pragma unroll
    for (int o = 1; o < 64; o <<= 1) v += __shfl_xor(v, o);
    return v;
}
DI float frcp(float x) { return __builtin_amdgcn_rcpf(x); }
DI float sigmoidf_(float x) { return frcp(1.f + __builtin_amdgcn_exp2f(-1.4426950408889634f * x)); }
DI float siluf_(float x) { return x * frcp(1.f + __builtin_amdgcn_exp2f(-1.4426950408889634f * x)); }
DI float logsigmoidf_(float x) { return fminf(x, 0.f) - log1pf(__expf(-fabsf(x))); }
DI float geluf_(float v) {
    const float av = fabsf(v), t = frcp(1.f + 0.2316418882f * av);
    float q = t * 0.5307027145f + (-0.7265760135f); q = q * t + 0.7107068705f; q = q * t + (-0.142248368f); q = q * t + 0.127414796f; q = q * t;
    const float e = __builtin_amdgcn_exp2f(v * v * (-0.72134752044f));
    const float m = v * (q * e);
    return v < 0.f ? m : v - m;
}
DI f32x4 ld_ss(const f32x4* SS, int t) { return SS[t]; }
DI float rs_of(const f32x4* SS, int t) { f32x4 s = SS[t]; return rsqrtf(((s.x + s.y) + (s.z + s.w)) * (1.f / 1024.f) + EPS); }
DI const float* xin_row(const Params& p, int t) { return t < TP ? p.x_prompt + (size_t)t * DM : p.x_sample + (size_t)(t - TP) * DM; }

DI int srccol(int perm, int n) {
    if (perm == 1) { if (n < 416) return n; if (n < 432) return 2464 + (n - 416); if (n < 512) return -1; return n - 96; }
    if (perm == 2) { const int hd = (n & 511) >> 6, d = n & 63; return hd * 128 + (n >= 512 ? 64 : 0) + d; }
    if (perm == 3) { const int pn = n >> 8, c = n & 255; return c < 128 ? pn * 128 + c : 2816 + pn * 128 + (c - 128); }
    return n;
}
struct P0Job { const float* src; const float* gain; bf16* dst; int Nsrc, dld, dcol0, perm, k0, n0; };
DI void p0_job(const Params& p, int it, P0Job& J) {
    unsigned char* ws = p.ws; int r = it; int Nd;
    if (r < 640) { J.src = p.ab_w_in; J.Nsrc = 2480; Nd = 2560; J.dst = (bf16*)(ws + O_WIN); J.dld = 1024; J.dcol0 = 0; J.gain = p.ab_norm; J.perm = 1; }
    else if ((r -= 640) < 48) { J.src = p.w_uq; J.Nsrc = 768; Nd = 768; J.dst = (bf16*)(ws + O_WQKV); J.dld = 384; J.dcol0 = 0; J.gain = p.q_norm; J.perm = 0; }
    else if ((r -= 48) < 32) { J.src = p.w_ukv; J.Nsrc = 1024; Nd = 1024; J.dst = (bf16*)(ws + O_WQKV) + (size_t)768 * 384; J.dld = 384; J.dcol0 = 256; J.gain = p.kv_norm; J.perm = 2; }
    else if ((r -= 32) < 256) { J.src = p.ab_w_out; J.Nsrc = 1024; Nd = 1024; J.dst = (bf16*)(ws + O_WOUT); J.dld = 1024; J.dcol0 = 0; J.gain = nullptr; J.perm = 0; }
    else if ((r -= 256) < 512) { J.src = p.c_w_in; J.Nsrc = 2048; Nd = 2048; J.dst = (bf16*)(ws + O_WCIN); J.dld = 1024; J.dcol0 = 0; J.gain = p.c_norm; J.perm = 0; }
    else if ((r -= 512) < 256) { J.src = p.c_w_out; J.Nsrc = 1024; Nd = 1024; J.dst = (bf16*)(ws + O_WCOUT); J.dld = 1024; J.dcol0 = 0; J.gain = nullptr; J.perm = 0; }
    else if ((r -= 256) < 2816) { const int l = r / 1408; r -= l * 1408; J.src = p.ffn_w_up + (size_t)l * 1024 * 5632; J.Nsrc = 5632; Nd = 5632;
        J.dst = (bf16*)(ws + O_WUP + l * AL((size_t)5632 * 1024 * 2)); J.dld = 1024; J.dcol0 = 0; J.gain = p.ffn_norm + l * 1024; J.perm = 3; }
    else { r -= 2816; const int l = r / 704; r -= l * 704; J.src = p.ffn_w_down + (size_t)l * 2816 * 1024; J.Nsrc = 1024; Nd = 1024;
        J.dst = (bf16*)(ws + O_WDN + l * AL((size_t)1024 * 2816 * 2)); J.dld = 2816; J.dcol0 = 0; J.gain = nullptr; J.perm = 0; }
    const int nnt = Nd / 64; J.k0 = (r / nnt) * 64; J.n0 = (r % nnt) * 64;
}
DI void p0_load(const P0Job& J, int tid, float (&v)[8]) {
    const int j = tid & 63, sc = srccol(J.perm, J.n0 + j);
#pragma unroll
    for (int r = 0; r < 8; ++r) { const int k = J.k0 + (tid >> 6) + 8 * r; float x = 0.f; if (sc >= 0) { x = J.src[(size_t)k * J.Nsrc + sc]; if (J.gain) x *= J.gain[k]; } v[r] = x; }
}
DI void p0_row(const Params& p, int t, int lane) {
    bf16* XB = (bf16*)(p.ws + O_XB); f32x4* SS = (f32x4*)(p.ws + O_SS);
    const f32x4* xr = (const f32x4*)xin_row(p, t) + lane;
    f32x4 v[4]; float s = 0.f;
#pragma unroll
    for (int j = 0; j < 4; ++j) { v[j] = xr[64 * j]; s += (v[j].x * v[j].x + v[j].y * v[j].y) + (v[j].z * v[j].z + v[j].w * v[j].w); }
    s = wave_sum(s);
    u32x2* o = (u32x2*)(XB + (size_t)t * DM) + lane;
#pragma unroll
    for (int j = 0; j < 4; ++j) { u32x2 w; w.x = pk2(v[j].x, v[j].y); w.y = pk2(v[j].z, v[j].w); o[64 * j] = w; }
    if (lane == 0) { f32x4 q = {s, 0.f, 0.f, 0.f}; SS[t] = q; }
}
DI void p0_prologue(const Params& p) {
    unsigned char* ws = p.ws;
    int tid_ = threadIdx.x; asm volatile("" : "+v"(tid_)); const int tid = tid_;
    const int lane = tid & 63, NGW = gridDim.x * 8; int trow = blockIdx.x * 8 + (tid >> 6);
    constexpr int NJ = 5968;
    {
        float* tile = (float*)g_lds;
        P0Job J; float v[8]; int it = blockIdx.x;
        if (it < NJ) { p0_job(p, it, J); p0_load(J, tid, v); }
        for (; it < NJ; it += gridDim.x) {
#pragma unroll
            for (int r = 0; r < 8; ++r) tile[((tid >> 6) + 8 * r) * 65 + (tid & 63)] = v[r];
            __syncthreads();
            P0Job Jn = J; const int nit = it + gridDim.x;
            if (nit < NJ) { p0_job(p, nit, Jn); p0_load(Jn, tid, v); }
            const int n = tid >> 3, kc = (tid & 7) * 8;
            u32x4 o;
            o.x = pk2(tile[(kc + 0) * 65 + n], tile[(kc + 1) * 65 + n]); o.y = pk2(tile[(kc + 2) * 65 + n], tile[(kc + 3) * 65 + n]);
            o.z = pk2(tile[(kc + 4) * 65 + n], tile[(kc + 5) * 65 + n]); o.w = pk2(tile[(kc + 6) * 65 + n], tile[(kc + 7) * 65 + n]);
            *(u32x4*)(J.dst + (size_t)(J.n0 + n) * J.dld + J.dcol0 + J.k0 + kc) = o;
            if (trow < T_TOK) { p0_row(p, trow, lane); trow += NGW; }
            if (trow < T_TOK) { p0_row(p, trow, lane); trow += NGW; }
            __syncthreads();
            J = Jn;
        }
    }
    for (; trow < T_TOK; trow += NGW) p0_row(p, trow, lane);
    const int gt = blockIdx.x * NTHR + tid, GT = gridDim.x * NTHR;
    if (gt < 256) ((u32x4*)(ws + O_XBG))[gt] = (u32x4){0u, 0u, 0u, 0u};
    {
        bf16* W = (bf16*)(ws + O_WQKV); const u32x4 z = {0u, 0u, 0u, 0u};
        for (int v = gt; v < 768 * 16 + 1024 * 32; v += GT) {
            if (v < 768 * 16) { const int row = v >> 4, c = v & 15; *(u32x4*)(W + (size_t)row * 384 + 256 + c * 8) = z; }
            else { const int u = v - 768 * 16, row = 768 + (u >> 5), c = u & 31; *(u32x4*)(W + (size_t)row * 384 + c * 8) = z; }
        }
    }
    { bf16* W = (bf16*)(ws + O_WSP); for (int v = gt; v < 8 * 128 * 128; v += GT) W[v] = f2bf(p.c_w_sp[v]); }
    { float* RC = (float*)(ws + O_ROPE); float* RSN = RC + 8192 * 16;
      for (int v = gt; v < 8192 * 16; v += GT) { const int pos = v >> 4, i = v & 15; const float inv = 1.0f / powf(10000.f, (float)i * (1.f / 16.f)); const float ang = (float)pos * inv;
        float s, c; sincosf(ang, &s, &c); RC[v] = c; RSN[v] = s; } }
}

#define LAS __attribute__((address_space(3)))
constexpr int STAGE_BYTES = 131072;
constexpr int EPI_OFF = 131072;
DI int lds_byte(int r, int c) { const int st = (r >> 4) * 2 + (c >> 5), rr = r & 15, cc = c & 31, ob = rr * 64 + cc * 2; return st * 1024 + (ob ^ (((ob >> 9) & 1) << 5)); }
DI void stage_rc(int b, int& R, int& C) { const int st = b / 1024, sb = b % 1024, swz = sb ^ (((sb >> 9) & 1) << 5); R = (st >> 1) * 16 + swz / 64; C = (st & 1) * 32 + (swz % 64) / 2; }

struct Gemm { const bf16* A; const bf16* Bt; int K, nM, nN, overlap; int kmode = 0; };
typedef f32x4 Acc[2][2][4][2];
struct Unit { int pm, pn, tbase, kofs, nt; };

DI void tile_rows(int overlap, int pm, int& tbase, int& s0, int& slen) {
    s0 = 0; slen = T_TOK;
    if (!overlap) tbase = pm * 256; else tbase = 254 * pm - 1;
}
DI bool seq_first(int t) { return t < TP ? (t & 8191) == 0 : (t & 4095) == 0; }
DI bool tile_has_seam(int tbase) { const int nb = ((tbase + 1 + 4095) >> 12) << 12; return nb <= tbase + 255; }
constexpr int NM_PLAIN = 320, NM_OVL = 323;
DI bool next_unit(const Gemm& g, int i, Unit& u) {
    const int nM = g.nM, nN = g.nN, nwg = nM * nN; const long L = (long)i * gridDim.x + blockIdx.x; if (L >= nwg) return false;
    int wgid = (int)L; { const int q = nwg / 8, r = nwg % 8, xcd = wgid % 8, off = wgid / 8; wgid = (xcd < r ? xcd * (q + 1) : r * (q + 1) + (xcd - r) * q) + off; }
    const int nig = 8 * nN, gid = wgid / nig, fm = gid * 8, gsz = (nM - fm) < 8 ? (nM - fm) : 8;
    u.pm = fm + ((wgid % nig) % gsz); u.pn = (wgid % nig) / gsz;
    int s0, slen; tile_rows(g.overlap, u.pm, u.tbase, s0, slen);
    if (g.kmode) { u.kofs = u.pn < 3 ? 0 : 512; u.nt = u.pn < 3 ? 4 : 2; } else { u.kofs = 0; u.nt = g.K / 64; }
    return true;
}

#define DPP_ROR1(x) __builtin_bit_cast(float, __builtin_amdgcn_update_dpp(0, __builtin_bit_cast(int, (x)), 0x121, 0xf, 0xf, false))
#define DPP_ROL1(x) __builtin_bit_cast(float, __builtin_amdgcn_update_dpp(0, __builtin_bit_cast(int, (x)), 0x12F, 0xf, 0xf, false))

template <class F> DI void row_reduce(float (&part)[2][4], int wr, int wc, int fr, int fq, F&& f) {
    float* red = (float*)(g_lds + EPI_OFF);
#pragma unroll
    for (int ai = 0; ai < 2; ++ai)
#pragma unroll
        for (int m = 0; m < 4; ++m) { float v = part[ai][m]; v += __shfl_xor(v, 16); v += __shfl_xor(v, 32);
            if (fq == 0) red[(ai * 128 + wr * 64 + m * 16 + fr) * 4 + wc] = v; }
    __syncthreads();
    if (threadIdx.x < 256) { const f32x4 s = *(const f32x4*)(red + threadIdx.x * 4); f((int)threadIdx.x, (s.x + s.y) + (s.z + s.w)); }
    __syncthreads();
}
DI void conv_exchange(const Acc& acc, int wr, int wc, int fr, int fq) {
    float* bnd = (float*)(g_lds + EPI_OFF + 4096);
#pragma unroll
    for (int ai = 0; ai < 2; ++ai)
#pragma unroll
        for (int bj = 0; bj < 2; ++bj)
#pragma unroll
            for (int n = 0; n < 2; ++n) { const int colL = bj * 128 + wc * 32 + n * 16 + fq * 4, rb = ai * 2 + wr;
                if (fr == 0) *(f32x4*)(bnd + (0 * 4 + rb) * 256 + colL) = acc[ai][bj][0][n];
                if (fr == 15) *(f32x4*)(bnd + (1 * 4 + rb) * 256 + colL) = acc[ai][bj][3][n]; }
    __syncthreads();
}
#undef DPP_ROR1
#undef DPP_ROL1
#define DPP_ROR1(x) __builtin_bit_cast(float, __builtin_amdgcn_update_dpp(__builtin_bit_cast(int, (x)), __builtin_bit_cast(int, (x)), 0x121, 0xf, 0xf, false))
#define DPP_ROL1(x) __builtin_bit_cast(float, __builtin_amdgcn_update_dpp(__builtin_bit_cast(int, (x)), __builtin_bit_cast(int, (x)), 0x12F, 0xf, 0xf, false))
DI f32x4 ror4(const f32x4 v) { f32x4 r; asm volatile("s_nop 1\n\tv_mov_b32_dpp %0, %4 row_ror:1 row_mask:0xf bank_mask:0xf\n\tv_mov_b32_dpp %1, %5 row_ror:1 row_mask:0xf bank_mask:0xf\n\tv_mov_b32_dpp %2, %6 row_ror:1 row_mask:0xf bank_mask:0xf\n\tv_mov_b32_dpp %3, %7 row_ror:1 row_mask:0xf bank_mask:0xf"
    : "=&v"(r.x), "=&v"(r.y), "=&v"(r.z), "=&v"(r.w) : "v"(v.x), "v"(v.y), "v"(v.z), "v"(v.w)); return r; }
DI f32x4 rol4(const f32x4 v) { f32x4 r; asm volatile("s_nop 1\n\tv_mov_b32_dpp %0, %4 row_ror:15 row_mask:0xf bank_mask:0xf\n\tv_mov_b32_dpp %1, %5 row_ror:15 row_mask:0xf bank_mask:0xf\n\tv_mov_b32_dpp %2, %6 row_ror:15 row_mask:0xf bank_mask:0xf\n\tv_mov_b32_dpp %3, %7 row_ror:15 row_mask:0xf bank_mask:0xf"
    : "=&v"(r.x), "=&v"(r.y), "=&v"(r.z), "=&v"(r.w) : "v"(v.x), "v"(v.y), "v"(v.z), "v"(v.w)); return r; }
template <int BJ, int N, int AI, int M> DI f32x4 conv_row(const Acc& acc, const f32x4 w0, const f32x4 w1, const f32x4 w2, const f32x4 b, const f32x4 upB, const f32x4 dnB, int fr) {
    const f32x4 v = acc[AI][BJ][M][N];
    const f32x4 pu = M > 0 ? ror4(acc[AI][BJ][M > 0 ? M - 1 : 0][N]) : upB;
    const f32x4 nd = M < 3 ? rol4(acc[AI][BJ][M < 3 ? M + 1 : 3][N]) : dnB;
    const f32x4 rv_ = ror4(v), lv_ = rol4(v);
    const f32x4 up = fr > 0 ? rv_ : pu, dn = fr < 15 ? lv_ : nd;
    f32x4 r_ = w0 * up + w1 * v + w2 * dn + b;
    asm volatile("" : "+v"(r_.x), "+v"(r_.y), "+v"(r_.z), "+v"(r_.w));
    return r_;
}
template <int BJ, int N, int AI> DI void conv_bnd(int wr, int wc, int fq, f32x4& upB, f32x4& dnB) {
    const float* bnd = (const float*)(g_lds + EPI_OFF + 4096);
    const int colL = BJ * 128 + wc * 32 + N * 16 + fq * 4, rb = AI * 2 + wr; const f32x4 z4 = {0.f, 0.f, 0.f, 0.f};
    upB = rb > 0 ? *(const f32x4*)(bnd + (4 + rb - 1) * 256 + colL) : z4; dnB = rb < 3 ? *(const f32x4*)(bnd + (rb + 1) * 256 + colL) : z4;
}

template <int BJ, int N, int AI> DI void conv4(const Acc& acc, const f32x4 w0, const f32x4 w1, const f32x4 w2, const f32x4 b, const f32x4 upB, const f32x4 dnB, int fr, f32x4 (&out)[4]) {
    f32x4 rprev = upB, lcur = rol4(acc[AI][BJ][0][N]);
#pragma unroll
    for (int M = 0; M < 4; ++M) { const f32x4 v = acc[AI][BJ][M][N]; const f32x4 rv_ = ror4(v); f32x4 lnext = dnB; if (M < 3) lnext = rol4(acc[AI][BJ][M < 3 ? M + 1 : 3][N]);
        const f32x4 up = fr > 0 ? rv_ : rprev, dn = fr < 15 ? lcur : lnext;
        out[M] = w0 * up + w1 * v + w2 * dn + b; rprev = rv_; lcur = lnext; }
}
#define FOR_ROWS(...) _Pragma("unroll") for (int ai = 0; ai < 2; ++ai) _Pragma("unroll") for (int m = 0; m < 4; ++m) { \
    const int row = ai * 128 + wr * 64 + m * 16 + fr; const int tg = tbase + row; const bool ok = (tg >= s0) && (tg < s0 + slen) && (!OVL || (row >= 1 && row <= 254)); (void)ok; __VA_ARGS__ }
#define FOR_COLS(...) _Pragma("unroll") for (int bj = 0; bj < 2; ++bj) _Pragma("unroll") for (int n = 0; n < 2; ++n) { const int colL = bj * 128 + wc * 32 + n * 16 + fq * 4; (void)colL; __VA_ARGS__ }
DI void st_bf4(bf16* p, const f32x4 v) { u32x2 w; w.x = pk2(v.x, v.y); w.y = pk2(v.z, v.w); *(u32x2*)p = w; }
DI void st_bf8(bf16* p, const f32x4 a, const f32x4 b) { u32x4 w; w.x = pk2(a.x, a.y); w.y = pk2(a.z, a.w); w.z = pk2(b.x, b.y); w.w = pk2(b.z, b.w); *(u32x4*)p = w; }
DI float sq4(const f32x4 v) { return (v.x * v.x + v.y * v.y) + (v.z * v.z + v.w * v.w); }

struct EpiIn {
    Params p;
    DI void operator()(Acc& acc, const Unit& u, int wr, int wc, int fr, int fq) const {
        constexpr bool OVL = true; unsigned char* ws = p.ws; const int pn = u.pn; int tbase, s0, slen; tile_rows(1, u.pm, tbase, s0, slen); const bool hb_ = tile_has_seam(tbase); (void)hb_;
        const f32x4* SS = (const f32x4*)(ws + O_SS);
        FOR_ROWS({ const bool val = (tg >= s0) && (tg < s0 + slen); const float rs = val ? rs_of(SS, tg) : 0.f;
            _Pragma("unroll") for (int bj = 0; bj < 2; ++bj) _Pragma("unroll") for (int n = 0; n < 2; ++n) acc[ai][bj][m][n] *= rs; })
        if (pn == 0) {
            bf16* CQ = (bf16*)(ws + O_CQKV); float* RQ = (float*)(ws + O_RQ); float part[2][4];
            FOR_ROWS({ float s = 0.f; FOR_COLS({ const f32x4 v = acc[ai][bj][m][n]; s += sq4(v); if (ok) st_bf4(CQ + (size_t)tg * 384 + colL, v); }) part[ai][m] = s; })
            row_reduce(part, wr, wc, fr, fq, [&](int row, float ss) { const int tg = tbase + row; if (tg >= s0 && tg < s0 + slen && row >= 1 && row <= 254) RQ[tg] = rsqrtf(ss * (1.f / 256.f) + EPS); });
        } else if (pn == 1) {
            bf16* CQ = (bf16*)(ws + O_CQKV); float* RKV = (float*)(ws + O_RKV); float part[2][4];
            FOR_ROWS({ float s = 0.f; _Pragma("unroll") for (int n = 0; n < 2; ++n) { const f32x4 v = acc[ai][0][m][n]; s += sq4(v); if (ok) st_bf4(CQ + (size_t)tg * 384 + 256 + wc * 32 + n * 16 + fq * 4, v); } part[ai][m] = s; })
            row_reduce(part, wr, wc, fr, fq, [&](int row, float ss) { const int tg = tbase + row; if (tg >= s0 && tg < s0 + slen && row >= 1 && row <= 254) RKV[tg] = rsqrtf(ss * (1.f / 128.f) + EPS); });
            if (wc == 0) {
                const float* RC = (const float*)(ws + O_ROPE); const float* RSN = RC + 8192 * 16; bf16* KR = (bf16*)(ws + O_KR);
                FOR_ROWS({ if (ok) { const int pos = tg - seq_start(seq_of(tg)); const f32x4 c = *(const f32x4*)(RC + pos * 16 + fq * 4), s = *(const f32x4*)(RSN + pos * 16 + fq * 4); const f32x4 x1 = acc[ai][1][m][0], x2 = acc[ai][1][m][1];
                    st_bf4(KR + (size_t)tg * 32 + fq * 4, x1 * c - x2 * s); st_bf4(KR + (size_t)tg * 32 + 16 + fq * 4, x2 * c + x1 * s); } })
            } else if (wc == 1) {
                float* G = (float*)(ws + O_G); const f32x4 gb = *(const f32x4*)(p.gate_bias + fq * 4); const bool isf = fq & 1;
                FOR_ROWS({ if (ok) { f32x4 v = acc[ai][1][m][0] + gb; if (isf) { v.x = logsigmoidf_(v.x); v.y = logsigmoidf_(v.y); v.z = logsigmoidf_(v.z); v.w = logsigmoidf_(v.w); } *(f32x4*)(G + (size_t)tg * 16 + fq * 4) = v; } })
            }
        } else if (pn < 6) {
            conv_exchange(acc, wr, wc, fr, fq);
            const float* cw = p.m_conv_w; const float* cb = p.m_conv_b; const int chb = (pn - 2) * 256 + wc * 32 + fq * 4;
            const bool isK = pn >= 4; bf16* dst = (bf16*)(ws + (isK ? O_KC : O_QC)); const float sc = isK ? 0.08838834764831845f : 1.f; const int cb0 = (pn - (isK ? 4 : 2)) * 256;
#define CA_(BJ, N, AI) { f32x4 upB, dnB; conv_bnd<BJ, N, AI>(wr, wc, fq, upB, dnB); f32x4 rp_ = upB, lc_ = rol4(acc[AI][BJ][0][N]); \
        _Pragma("unroll") for (int M = 0; M < 4; ++M) { const int row = AI * 128 + wr * 64 + M * 16 + fr, tg = tbase + row; const f32x4 a_ = acc[AI][BJ][M][N]; const f32x4 ra_ = ror4(a_); f32x4 ln_ = dnB; if (M < 3) ln_ = rol4(acc[AI][BJ][M < 3 ? M + 1 : 3][N]); \
            f32x4 up_ = fr > 0 ? ra_ : rp_, dn_ = fr < 15 ? lc_ : ln_; if (hb_) { const f32x4 z_ = {0.f, 0.f, 0.f, 0.f}; if (seq_first(tg)) up_ = z_; if (seq_first(tg + 1)) dn_ = z_; } const f32x4 v = w0 * up_ + w1 * a_ + w2 * dn_ + bb; rp_ = ra_; lc_ = ln_; \
            if ((tg >= s0) && (tg < s0 + slen) && row >= 1 && row <= 254) st_bf4(dst + (size_t)tg * 512 + cb0 + BJ * 128 + wc * 32 + N * 16 + fq * 4, (f32x4){siluf_(v.x) * sc, siluf_(v.y) * sc, siluf_(v.z) * sc, siluf_(v.w) * sc}); __builtin_amdgcn_sched_barrier(0); } }
#define CS_(BJ, N) { const int ch = chb + BJ * 128 + N * 16; const f32x4 w0 = *(const f32x4*)(cw + ch), w1 = *(const f32x4*)(cw + 1024 + ch), w2 = *(const f32x4*)(cw + 2048 + ch), bb = *(const f32x4*)(cb + ch); CA_(BJ, N, 0) CA_(BJ, N, 1) }
            CS_(0, 0) CS_(0, 1) CS_(1, 0) CS_(1, 1)
#undef CS_
#undef CA_
        } else if (pn < 8) {
            bf16* MV = (bf16*)(ws + O_MV); const int cb0 = (pn - 6) * 256;
            FOR_ROWS({ if (ok) { FOR_COLS({ st_bf4(MV + (size_t)tg * 512 + cb0 + colL, acc[ai][bj][m][n]); }) } })
        } else {
            bf16* MO = (bf16*)(ws + O_MO); const int cb0 = (pn - 8) * 256;
            FOR_ROWS({ if (ok) { FOR_COLS({ const f32x4 v = acc[ai][bj][m][n]; st_bf4(MO + (size_t)tg * 512 + cb0 + colL, (f32x4){sigmoidf_(v.x), sigmoidf_(v.y), sigmoidf_(v.z), sigmoidf_(v.w)}); }) } })
        }
    }
};
struct EpiQkv {
    Params p;
    DI void operator()(Acc& acc, const Unit& u, int wr, int wc, int fr, int fq) const {
        constexpr bool OVL = false; const int s0 = 0, slen = T_TOK, tbase = u.tbase, pn = u.pn; unsigned char* ws = p.ws;
        const float* RS = (const float*)(ws + (pn < 3 ? O_RQ : O_RKV));
        if (pn < 3) {
            bf16* Q = (bf16*)(ws + O_Q); const float* RC = (const float*)(ws + O_ROPE); const float* RSN = RC + 8192 * 16;
            const float qs = 0.10206207261596577f * 1.4426950408889634f;
            float rsv[2][4]; f32x4 rc_[2][4], rn_[2][4]; const bool rope_w = ((pn * 256 + wc * 32) % 96 == 64) || ((pn * 256 + 128 + wc * 32) % 96 == 64);
            FOR_ROWS({ rsv[ai][m] = RS[tg] * qs; rc_[ai][m] = (f32x4){1.f, 1.f, 1.f, 1.f}; rn_[ai][m] = (f32x4){0.f, 0.f, 0.f, 0.f}; if (rope_w) { const int pos_ = tg - seq_start(seq_of(tg)); rc_[ai][m] = *(const f32x4*)(RC + pos_ * 16 + fq * 4); rn_[ai][m] = *(const f32x4*)(RSN + pos_ * 16 + fq * 4); } })
            FOR_ROWS({ const float rs = rsv[ai][m];
                _Pragma("unroll") for (int bj = 0; bj < 2; ++bj) { const int base32 = pn * 256 + bj * 128 + wc * 32; const f32x4 v0 = acc[ai][bj][m][0] * rs, v1 = acc[ai][bj][m][1] * rs;
                    f32x4 o0 = v0, o1 = v1;
                    if (base32 % 96 == 64) { const f32x4 c = rc_[ai][m], s = rn_[ai][m]; o0 = v0 * c - v1 * s; o1 = v1 * c + v0 * s; }
                    st_bf4(Q + (size_t)tg * 768 + base32 + fq * 4, o0); st_bf4(Q + (size_t)tg * 768 + base32 + 16 + fq * 4, o1); } })
        } else if (pn < 5) {
            bf16* KN = (bf16*)(ws + O_KN); const int cb0 = (pn - 3) * 256;
            float rsv[2][4]; FOR_ROWS({ rsv[ai][m] = RS[tg]; })
            FOR_ROWS({ const float rs = rsv[ai][m]; FOR_COLS({ st_bf4(KN + (size_t)tg * 512 + cb0 + colL, acc[ai][bj][m][n] * rs); }) })
        } else {
            bf16* VT = (bf16*)(ws + O_VT); const int cb0 = (pn - 5) * 256;
            float rsv[2][4]; FOR_ROWS({ rsv[ai][m] = RS[tg]; })
            FOR_ROWS({ const float rs = rsv[ai][m]; const int sq = seq_of(tg), st = seq_start(sq), S = seq_len(sq), pos = tg - st; bf16* base = VT + (size_t)st * 512 + pos;
                FOR_COLS({ const int c = cb0 + colL; const f32x4 v = acc[ai][bj][m][n] * rs;
                    base[(size_t)c * S] = f2bf(v.x); base[(size_t)(c + 1) * S] = f2bf(v.y); base[(size_t)(c + 2) * S] = f2bf(v.z); base[(size_t)(c + 3) * S] = f2bf(v.w); }) })
        }
    }
};
struct EpiRes {
    Params p; int first, nobf;
    DI void operator()(Acc& acc, const Unit& u, int wr, int wc, int fr, int fq) const {
        const int tbase = u.tbase, pn = u.pn; unsigned char* ws = p.ws;
        bf16* XB = (bf16*)(ws + O_XB); float* SS = (float*)(ws + O_SS); float part[2][4];
#pragma unroll
        for (int ai = 0; ai < 2; ++ai) { f32x4 res[4][2][2];
#pragma unroll
            for (int m = 0; m < 4; ++m) { const int tg = tbase + ai * 128 + wr * 64 + m * 16 + fr; const float* rr = (first ? xin_row(p, tg) : p.out + (size_t)tg * DM) + pn * 256 + wc * 32 + 8 * fq;
#pragma unroll
                for (int bj = 0; bj < 2; ++bj) { res[m][bj][0] = *(const f32x4*)(rr + bj * 128); res[m][bj][1] = *(const f32x4*)(rr + bj * 128 + 4); } }
#pragma unroll
            for (int m = 0; m < 4; ++m) { const int tg = tbase + ai * 128 + wr * 64 + m * 16 + fr; const int c0 = pn * 256 + wc * 32 + 8 * fq; float* orow = p.out + (size_t)tg * DM + c0; bf16* xrow = XB + (size_t)tg * DM + c0; float s = 0.f;
#pragma unroll
                for (int bj = 0; bj < 2; ++bj) { const f32x4 v0 = res[m][bj][0] + acc[ai][bj][m][0], v1 = res[m][bj][1] + acc[ai][bj][m][1];
                    *(f32x4*)(orow + bj * 128) = v0; *(f32x4*)(orow + bj * 128 + 4) = v1; if (!nobf) st_bf8(xrow + bj * 128, v0, v1); s += sq4(v0) + sq4(v1); }
                part[ai][m] = s; } }
        row_reduce(part, wr, wc, fr, fq, [&](int row, float ss) { SS[(size_t)(tbase + row) * 4 + pn] = ss; });
    }
};
struct EpiUp {
    Params p; int layer;
    DI void operator()(Acc& acc, const Unit& u, int wr, int wc, int fr, int fq) const {
        constexpr bool OVL = true; unsigned char* ws = p.ws; const int pn = u.pn; int tbase, s0, slen; tile_rows(1, u.pm, tbase, s0, slen); const bool hb_ = tile_has_seam(tbase); (void)hb_;
        const f32x4* SS = (const f32x4*)(ws + O_SS);
        FOR_ROWS({ const bool val = (tg >= s0) && (tg < s0 + slen); const float rs = val ? rs_of(SS, tg) : 0.f;
            _Pragma("unroll") for (int bj = 0; bj < 2; ++bj) _Pragma("unroll") for (int n = 0; n < 2; ++n) acc[ai][bj][m][n] *= rs; })
        conv_exchange(acc, wr, wc, fr, fq);
        const float* cw = p.ffn_conv_w + (size_t)layer * 3 * 5632; const float* cb = p.ffn_conv_b + (size_t)layer * 5632; const int chb = pn * 128 + wc * 32 + fq * 4;
        bf16* HID = (bf16*)(ws + O_HID);
#define CA_(N, AI) { f32x4 upG, dnG, upV, dnV; conv_bnd<0, N, AI>(wr, wc, fq, upG, dnG); conv_bnd<1, N, AI>(wr, wc, fq, upV, dnV); \
        f32x4 rpg_ = upG, lcg_ = rol4(acc[AI][0][0][N]), rpv_ = upV, lcv_ = rol4(acc[AI][1][0][N]); \
        _Pragma("unroll") for (int M = 0; M < 4; ++M) { const int row = AI * 128 + wr * 64 + M * 16 + fr, tg = tbase + row; const f32x4 a_ = acc[AI][0][M][N], b_ = acc[AI][1][M][N]; const f32x4 rga_ = ror4(a_), rvb_ = ror4(b_); \
            f32x4 lng_ = dnG, lnv_ = dnV; if (M < 3) { lng_ = rol4(acc[AI][0][M < 3 ? M + 1 : 3][N]); lnv_ = rol4(acc[AI][1][M < 3 ? M + 1 : 3][N]); } \
            f32x4 ug_ = fr > 0 ? rga_ : rpg_, dg_ = fr < 15 ? lcg_ : lng_, uv_ = fr > 0 ? rvb_ : rpv_, dv_ = fr < 15 ? lcv_ : lnv_; if (hb_) { const f32x4 z_ = {0.f, 0.f, 0.f, 0.f}; if (seq_first(tg)) { ug_ = z_; uv_ = z_; } if (seq_first(tg + 1)) { dg_ = z_; dv_ = z_; } } const f32x4 g = g0 * ug_ + g1 * a_ + g2 * dg_ + gb, v = v0 * uv_ + v1 * b_ + v2 * dv_ + vb; rpg_ = rga_; lcg_ = lng_; rpv_ = rvb_; lcv_ = lnv_; \
            if ((tg >= s0) && (tg < s0 + slen) && row >= 1 && row <= 254) st_bf4(HID + (size_t)tg * DFF + chb + N * 16, (f32x4){siluf_(g.x) * v.x, siluf_(g.y) * v.y, siluf_(g.z) * v.z, siluf_(g.w) * v.w}); __builtin_amdgcn_sched_barrier(0); } }
#define CS_(N) { const int cg_ = chb + N * 16, cv2_ = 2816 + chb + N * 16; \
        const f32x4 g0 = *(const f32x4*)(cw + cg_), g1 = *(const f32x4*)(cw + 5632 + cg_), g2 = *(const f32x4*)(cw + 11264 + cg_), gb = *(const f32x4*)(cb + cg_); \
        const f32x4 v0 = *(const f32x4*)(cw + cv2_), v1 = *(const f32x4*)(cw + 5632 + cv2_), v2 = *(const f32x4*)(cw + 11264 + cv2_), vb = *(const f32x4*)(cb + cv2_); CA_(N, 0) CA_(N, 1) }
        CS_(0) CS_(1)
#undef CS_
#undef CA_
    }
};
struct EpiGin {
    Params p;
    DI void operator()(Acc& acc, const Unit& u, int wr, int wc, int fr, int fq) const {
        constexpr bool OVL = false; const int s0 = 0, slen = T_TOK, tbase = u.tbase, pn = u.pn; unsigned char* ws = p.ws;
        const f32x4* SS = (const f32x4*)(ws + O_SS);
        bf16* dst = (bf16*)(ws + (pn < 4 ? O_U : O_V)); const int cb0 = (pn & 3) * 256 + wc * 32 + 8 * fq; float part[2][4];
        float rsv[2][4]; FOR_ROWS({ rsv[ai][m] = rs_of(SS, tg); })
        FOR_ROWS({ const float rs = rsv[ai][m]; float s = 0.f;
            _Pragma("unroll") for (int bj = 0; bj < 2; ++bj) { f32x4 v0 = acc[ai][bj][m][0] * rs, v1 = acc[ai][bj][m][1] * rs;
                v0.x = geluf_(v0.x); v0.y = geluf_(v0.y); v0.z = geluf_(v0.z); v0.w = geluf_(v0.w); v1.x = geluf_(v1.x); v1.y = geluf_(v1.y); v1.z = geluf_(v1.z); v1.w = geluf_(v1.w);
                s += sq4(v0) + sq4(v1); st_bf8(dst + (size_t)tg * DM + cb0 + bj * 128, v0, v1); } part[ai][m] = s; })
        if (pn >= 4) { float* VSS = (float*)(ws + O_VSS); row_reduce(part, wr, wc, fr, fq, [&](int row, float ss) { VSS[(size_t)(tbase + row) * 4 + (pn - 4)] = ss; }); }
    }
};

DI int perm32(int rho) { const int n = rho >> 4, i = rho & 15; return 8 * (i >> 2) + 4 * n + (i & 3); }
template <class Epi, bool PERM = false> DI void gemm_phase(const Gemm g, const Epi& E) {
    LAS unsigned char* lds = (LAS unsigned char*)g_lds;
    int tid_ = threadIdx.x; asm volatile("" : "+v"(tid_));
    const int tid = tid_, wid = __builtin_amdgcn_readfirstlane(tid >> 6), lane = tid & 63, wr = wid >> 2, wc = wid & 3, fr = lane & 15, fq = lane >> 4;
    const int K = g.K;
    unsigned voff[2], voffB[2];
#pragma unroll
    for (int i = 0; i < 2; ++i) { int R, C; stage_rc(tid * 16 + i * 8192, R, C); voff[i] = (unsigned)(R * K + C) * 2u; const int Rb = PERM ? ((R & ~31) + perm32(R & 31)) : R; voffB[i] = (unsigned)(Rb * K + C) * 2u; }
    const size_t kstep = 128, hstep = (size_t)128 * K * 2, tstep = 2 * hstep;
    const unsigned ldsw = (unsigned)wid * 1024u;
    const int aoff = lds_byte(wr * 64 + fr, fq * 8), boff = lds_byte(wc * 32 + fr, fq * 8);
#define PG8_SA(b, h) (((b) * 2 + (h)) * 16384)
#define PG8_SB(b, h) ((4 + (b) * 2 + (h)) * 16384)
#define PG8_STAGEX(bufoff, gbase, vo) do { _Pragma("unroll") for (int _i = 0; _i < 2; ++_i) \
        __builtin_amdgcn_global_load_lds((const unsigned*)((const char*)(gbase) + vo[_i]), (LAS unsigned*)(lds + (bufoff) + ldsw + _i * 8192), 16, 0, 0); } while (0)
#define PG8_LDA(dst, b, h) do { _Pragma("unroll") for (int m = 0; m < 4; ++m) _Pragma("unroll") for (int k = 0; k < 2; ++k) dst[m][k] = *(const LAS bf16x8*)(lds + PG8_SA(b, h) + aoff + m * 2048 + k * 1024); } while (0)
#define PG8_LDB(dst, b, h) do { _Pragma("unroll") for (int n = 0; n < 2; ++n) _Pragma("unroll") for (int k = 0; k < 2; ++k) dst[n][k] = *(const LAS bf16x8*)(lds + PG8_SB(b, h) + boff + n * 2048 + k * 1024); } while (0)
#define PG8_MMA(ai, bj, At, Bt) do { __builtin_amdgcn_s_setprio(1); _Pragma("unroll") for (int m = 0; m < 4; ++m) _Pragma("unroll") for (int n = 0; n < 2; ++n) _Pragma("unroll") for (int k = 0; k < 2; ++k) \
        acc[ai][bj][m][n] = __builtin_amdgcn_mfma_f32_16x16x32_bf16(Bt[n][k], At[m][k], acc[ai][bj][m][n], 0, 0, 0); __builtin_amdgcn_s_setprio(0); } while (0)
#define PG8_WAIT_V(n) asm volatile("s_waitcnt vmcnt(" #n ")" ::: "memory")
#define PG8_WAIT_L(n) asm volatile("s_waitcnt lgkmcnt(" #n ")" ::: "memory")
#define PG8_BAR __builtin_amdgcn_s_barrier()
#define PG8_SCHED __builtin_amdgcn_sched_barrier(0)
    Unit cur, nxt; int ui = 0;
    if (!next_unit(g, 0, cur)) return;
    Acc acc;
#pragma unroll
    for (int a = 0; a < 2; ++a)
#pragma unroll
        for (int b = 0; b < 2; ++b)
#pragma unroll
            for (int m = 0; m < 4; ++m)
#pragma unroll
                for (int n = 0; n < 2; ++n) acc[a][b][m][n] = (f32x4){0.f, 0.f, 0.f, 0.f};
    bf16x8 At[4][2], B0[2][2], B1[2][2];
    const char* cA = (const char*)g.A + (ptrdiff_t)cur.tbase * (ptrdiff_t)(K * 2) + cur.kofs; const char* cB = (const char*)g.Bt + (size_t)cur.pn * tstep + cur.kofs;
    PG8_STAGEX(PG8_SB(0, 0), cB, voffB); PG8_STAGEX(PG8_SB(0, 1), cB + hstep, voffB); PG8_STAGEX(PG8_SA(0, 0), cA, voff); PG8_STAGEX(PG8_SA(0, 1), cA + hstep, voff);
    if (wr == 1) PG8_BAR;
    PG8_WAIT_V(2); PG8_BAR;
    PG8_STAGEX(PG8_SB(1, 0), cB + kstep, voffB); PG8_STAGEX(PG8_SA(1, 0), cA + kstep, voff); PG8_STAGEX(PG8_SB(1, 1), cB + hstep + kstep, voffB);
    PG8_WAIT_V(6); PG8_BAR;
    for (;;) {
        const bool has_next = next_unit(g, ui + 1, nxt);
        const char* nA = has_next ? (const char*)g.A + (ptrdiff_t)nxt.tbase * (ptrdiff_t)(K * 2) + nxt.kofs : cA; const char* nB = has_next ? (const char*)g.Bt + (size_t)nxt.pn * tstep + nxt.kofs : cB;
        const int nt = cur.nt;
        for (int t = 0; t < nt; t += 2) {
            const bool last = (t == nt - 2);
            const char* a1 = cA + (size_t)(t + 1) * kstep;
            const char* a2 = last ? nA : cA + (size_t)(t + 2) * kstep; const char* b2 = last ? nB : cB + (size_t)(t + 2) * kstep;
            const char* a3 = a2 + kstep; const char* b3 = b2 + kstep;
            PG8_LDB(B0, 0, 0); PG8_LDB(B1, 0, 1); PG8_SCHED; PG8_LDA(At, 0, 0); PG8_STAGEX(PG8_SA(1, 1), a1 + hstep, voff);
            PG8_WAIT_V(8); PG8_WAIT_L(0); PG8_BAR; PG8_MMA(0, 0, At, B0); PG8_MMA(0, 1, At, B1); PG8_BAR; PG8_SCHED;
            PG8_LDA(At, 0, 1); PG8_STAGEX(PG8_SB(0, 0), b2, voffB); PG8_STAGEX(PG8_SB(0, 1), b2 + hstep, voffB); PG8_STAGEX(PG8_SA(0, 0), a2, voff);
            PG8_WAIT_V(8); PG8_WAIT_L(0); PG8_BAR; PG8_MMA(1, 0, At, B0); PG8_MMA(1, 1, At, B1); PG8_BAR; PG8_SCHED;
            PG8_LDB(B0, 1, 0); PG8_LDB(B1, 1, 1); PG8_SCHED; PG8_LDA(At, 1, 0); PG8_STAGEX(PG8_SA(0, 1), a2 + hstep, voff);
            PG8_WAIT_V(8); PG8_WAIT_L(0); PG8_BAR; PG8_MMA(0, 0, At, B0); PG8_MMA(0, 1, At, B1); PG8_BAR; PG8_SCHED;
            PG8_LDA(At, 1, 1); PG8_STAGEX(PG8_SB(1, 0), b3, voffB); PG8_STAGEX(PG8_SB(1, 1), b3 + hstep, voffB); PG8_STAGEX(PG8_SA(1, 0), a3, voff);
            PG8_WAIT_V(8); PG8_WAIT_L(0); PG8_BAR; PG8_MMA(1, 0, At, B0); PG8_MMA(1, 1, At, B1); PG8_BAR; PG8_SCHED;
        }
        if (wr == 0) PG8_BAR;
        { int fr2 = fr, fq2 = fq; asm volatile("" : "+v"(fr2), "+v"(fq2)); E(acc, cur, wr, wc, fr2, fq2); }
        if (!has_next) break;
#pragma unroll
        for (int a = 0; a < 2; ++a)
#pragma unroll
            for (int b = 0; b < 2; ++b)
#pragma unroll
                for (int m = 0; m < 4; ++m)
#pragma unroll
                    for (int n = 0; n < 2; ++n) acc[a][b][m][n] = (f32x4){0.f, 0.f, 0.f, 0.f};
        cur = nxt; cA = nA; cB = nB; ++ui;
        if (wr == 1) PG8_BAR;
    }
    PG8_WAIT_V(0);
    PG8_BAR;
    __syncthreads();
}

constexpr int LDT = 136;
constexpr int TILE_B = 128 * LDT * 2;
DI int crow(int i, int h) { return (i & 3) + 8 * (i >> 2) + 4 * h; }
template <int KS> DI void mm_lds(f32x16 (&acc)[2], const bf16* sA, const bf16* sB, int rb, int cb0, int lane) {
    const int r = lane & 31, h = lane >> 5;
#pragma unroll
    for (int ks = 0; ks < KS; ++ks) {
        const bf16x8 a = *(const bf16x8*)(sA + (32 * rb + r) * LDT + 16 * ks + 8 * h);
#pragma unroll
        for (int c = 0; c < 2; ++c) { const bf16x8 b = *(const bf16x8*)(sB + (32 * (cb0 + c) + r) * LDT + 16 * ks + 8 * h); acc[c] = MFMA32(a, b, acc[c]); }
    }
}
DI float scan_add(float v, int lane) {
#pragma unroll
    for (int o = 1; o < 64; o <<= 1) { const float t = __shfl_up(v, o); if (lane >= o) v += t; }
    return v;
}
DI float scan_max(float v, int lane) {
#pragma unroll
    for (int o = 1; o < 64; o <<= 1) { const float t = __shfl_up(v, o); if (lane >= o) v = fmaxf(v, t); }
    return v;
}
DI float wave_max(float v) {
#pragma unroll
    for (int o = 1; o < 64; o <<= 1) v = fmaxf(v, __shfl_xor(v, o));
    return v;
}
DI void load_tile_nat(bf16* sT, const bf16* g, int gld, int tid) {
#pragma unroll
    for (int i = 0; i < 4; ++i) { const int id = tid + 512 * i, row = id >> 4, c = (id & 15) * 8; *(u32x4*)(sT + row * LDT + c) = *(const u32x4*)(g + (size_t)row * gld + c); }
}
DI void load_tile_tr(bf16* sT, const bf16* g, int gld, const float* w, int tid) {
#pragma unroll
    for (int i = 0; i < 4; ++i) { const int id = tid + 512 * i, row = id & 127, c = (id >> 7) * 8; const u32x4 v = *(const u32x4*)(g + (size_t)row * gld + c); const float ww = w ? w[row] : 1.f;
        const unsigned uu[4] = {v.x, v.y, v.z, v.w};
#pragma unroll
        for (int e = 0; e < 4; ++e) { sT[(c + 2 * e) * LDT + row] = f2bf(bflo(uu[e]) * ww); sT[(c + 2 * e + 1) * LDT + row] = f2bf(bfhi(uu[e]) * ww); } }
}

DI void write_tile_tr(bf16* sT, const u32x4 (&v)[4], const float* w, int tid) {
#pragma unroll
    for (int i = 0; i < 4; ++i) { const int id = tid + 512 * i, row = id & 127, c = (id >> 7) * 8; const float ww = w ? w[row] : 1.f;
        const unsigned uu[4] = {v[i].x, v[i].y, v[i].z, v[i].w};
#pragma unroll
        for (int e = 0; e < 4; ++e) { sT[(c + 2 * e) * LDT + row] = f2bf(bflo(uu[e]) * ww); sT[(c + 2 * e + 1) * LDT + row] = f2bf(bfhi(uu[e]) * ww); } }
}
DI void mlstm_local(const Params& p) {
    unsigned char* ws = p.ws; int tid_ = threadIdx.x; asm volatile("" : "+v"(tid_)); const int tid = tid_, lane = tid & 63, wid = tid >> 6;
    bf16* sV = (bf16*)g_lds; bf16* sK = (bf16*)(g_lds + TILE_B); float* sW = (float*)(g_lds + 2 * TILE_B);
    const float* G = (const float*)(ws + O_G); const bf16* MV = (const bf16*)(ws + O_MV); const bf16* KC = (const bf16*)(ws + O_KC);
    bf16* CS = (bf16*)(ws + O_CS); float* NS = (float*)(ws + O_NS); float* ML = (float*)(ws + O_ML); float* BL = (float*)(ws + O_BL);
    const int rb = wid & 3, cb0 = (wid >> 2) * 2;
    for (int it2 = blockIdx.x; it2 < 2560; it2 += gridDim.x) {
        const int cgk = it2 >> 2, h = it2 & 3, t0 = cgk * 128;
        u32x4 vr[4], kr[4];
#pragma unroll
        for (int i = 0; i < 4; ++i) { const int id = tid + 512 * i, row = id & 127, c = (id >> 7) * 8; vr[i] = *(const u32x4*)(MV + (size_t)(t0 + row) * 512 + h * 128 + c); kr[i] = *(const u32x4*)(KC + (size_t)(t0 + row) * 512 + h * 128 + c); }
        if (wid < 2) { const int dir = wid, item = it2 * 2 + dir;
            const int o0 = dir ? 127 - lane : lane, o1 = dir ? 63 - lane : lane + 64;
            const float lf0 = G[(size_t)(t0 + o0) * 16 + dir * 8 + 4 + h], li0 = G[(size_t)(t0 + o0) * 16 + dir * 8 + h];
            const float lf1 = G[(size_t)(t0 + o1) * 16 + dir * 8 + 4 + h], li1 = G[(size_t)(t0 + o1) * 16 + dir * 8 + h];
            const float b0 = scan_add(lf0, lane), tot0 = __shfl(b0, 63), b1 = scan_add(lf1, lane) + tot0, bL = __shfl(b1, 63);
            const float g0 = bL - b0 + li0, g1 = bL - b1 + li1, ml = wave_max(fmaxf(g0, g1));
            sW[dir * 128 + o0] = __expf(g0 - ml); sW[dir * 128 + o1] = __expf(g1 - ml);
            if (lane == 0) { ML[item] = ml; BL[item] = bL; }
        }
        write_tile_tr(sK, kr, nullptr, tid);
        __syncthreads();
#pragma unroll 1
        for (int dir = 0; dir < 2; ++dir) { const int item = it2 * 2 + dir; const float* sWd = sW + dir * 128;
            write_tile_tr(sV, vr, sWd, tid);
            __syncthreads();
            if (tid < 128) { float s = 0.f;
#pragma unroll 4
                for (int l = 0; l < 128; l += 8) { const u32x4 kk = *(const u32x4*)(sK + tid * LDT + l); const f32x4 wa = *(const f32x4*)(sWd + l), wb = *(const f32x4*)(sWd + l + 4);
                    s += (wa.x * bflo(kk.x) + wa.y * bfhi(kk.x)) + (wa.z * bflo(kk.y) + wa.w * bfhi(kk.y)) + (wb.x * bflo(kk.z) + wb.y * bfhi(kk.z)) + (wb.z * bflo(kk.w) + wb.w * bfhi(kk.w)); }
                NS[(size_t)item * 128 + tid] = s; }
            f32x16 acc[2];
#pragma unroll
            for (int c = 0; c < 2; ++c)
#pragma unroll
                for (int i = 0; i < 16; ++i) acc[c][i] = 0.f;
            mm_lds<8>(acc, sV, sK, rb, cb0, lane);
            bf16* Co = CS + (size_t)item * 16384;
#pragma unroll
            for (int c = 0; c < 2; ++c)
#pragma unroll
                for (int i = 0; i < 16; ++i) Co[(32 * rb + crow(i, lane >> 5)) * 128 + 32 * (cb0 + c) + (lane & 31)] = f2bf(acc[c][i]);
            __syncthreads();
        }
    }
}
DI void mlstm_scan(const Params& p) {
    unsigned char* ws = p.ws; int tid_ = threadIdx.x; asm volatile("" : "+v"(tid_)); const int gt = blockIdx.x * NTHR + tid_, GT = gridDim.x * NTHR;
    bf16* CS = (bf16*)(ws + O_CS); float* NS = (float*)(ws + O_NS); const float* ML = (const float*)(ws + O_ML); const float* BL = (const float*)(ws + O_BL); float* MP = (float*)(ws + O_MP);
    for (int u = gt; u < 144 * 2080; u += GT) {
        const int st = u / 2080, v = u % 2080, sq = st >> 3, h = (st >> 1) & 3, dir = st & 1, nc = seq_len(sq) >> 7, c0 = seq_start(sq) >> 7;
        float m = 0.f;
        if (v < 2048) {
            float C[8];
#pragma unroll
            for (int e = 0; e < 8; ++e) C[e] = 0.f;
            for (int j = 0; j < nc; j += 4) {
                u32x4 t[4]; float bl[4], mlv[4]; int itm[4];
#pragma unroll
                for (int q = 0; q < 4; ++q) { const int n = dir ? nc - 1 - (j + q) : j + q; itm[q] = ((c0 + n) * 4 + h) * 2 + dir; t[q] = *(const u32x4*)(CS + (size_t)itm[q] * 16384 + v * 8); bl[q] = BL[itm[q]]; mlv[q] = ML[itm[q]]; }
#pragma unroll
                for (int q = 0; q < 4; ++q) { u32x4 o; o.x = pk2(C[0], C[1]); o.y = pk2(C[2], C[3]); o.z = pk2(C[4], C[5]); o.w = pk2(C[6], C[7]); *(u32x4*)(CS + (size_t)itm[q] * 16384 + v * 8) = o;
                    if (v == 0) MP[itm[q]] = m;
                    const float mn = fmaxf(bl[q] + m, mlv[q]), a = __expf(bl[q] + m - mn), c = __expf(mlv[q] - mn);
                    C[0] = a * C[0] + c * bflo(t[q].x); C[1] = a * C[1] + c * bfhi(t[q].x); C[2] = a * C[2] + c * bflo(t[q].y); C[3] = a * C[3] + c * bfhi(t[q].y);
                    C[4] = a * C[4] + c * bflo(t[q].z); C[5] = a * C[5] + c * bfhi(t[q].z); C[6] = a * C[6] + c * bflo(t[q].w); C[7] = a * C[7] + c * bfhi(t[q].w); m = mn; }
            }
        } else {
            f32x4 N = {0.f, 0.f, 0.f, 0.f};
            for (int j = 0; j < nc; j += 4) {
                f32x4 t[4]; float bl[4], mlv[4]; int itm[4];
#pragma unroll
                for (int q = 0; q < 4; ++q) { const int n = dir ? nc - 1 - (j + q) : j + q; itm[q] = ((c0 + n) * 4 + h) * 2 + dir; t[q] = *(const f32x4*)(NS + (size_t)itm[q] * 128 + (v - 2048) * 4); bl[q] = BL[itm[q]]; mlv[q] = ML[itm[q]]; }
#pragma unroll
                for (int q = 0; q < 4; ++q) { *(f32x4*)(NS + (size_t)itm[q] * 128 + (v - 2048) * 4) = N;
                    const float mn = fmaxf(bl[q] + m, mlv[q]), a = __expf(bl[q] + m - mn), c = __expf(mlv[q] - mn); N = a * N + c * t[q]; m = mn; }
            }
        }
    }
}
DI void mlstm_out(const Params& p) {
    unsigned char* ws = p.ws; int tid_ = threadIdx.x; asm volatile("" : "+v"(tid_)); const int tid = tid_, lane = tid & 63, wid = tid >> 6, hh = lane >> 5;
    bf16* sQ = (bf16*)g_lds; bf16* sK = (bf16*)(g_lds + TILE_B); bf16* sVT = (bf16*)(g_lds + 2 * TILE_B); bf16* sC = (bf16*)(g_lds + 3 * TILE_B); bf16* sP = sK;
    float* sBv2 = (float*)(g_lds + 4 * TILE_B); float* sLi2 = sBv2 + 256; float* sMt2 = sBv2 + 512; float* sInter2 = sBv2 + 768; float* sInv = sBv2 + 1024; float* sN = sBv2 + 1152;
    float* sH = (float*)g_lds;
    const float* G = (const float*)(ws + O_G); const bf16* QC = (const bf16*)(ws + O_QC); const bf16* KC = (const bf16*)(ws + O_KC); const bf16* MV = (const bf16*)(ws + O_MV); const bf16* MO = (const bf16*)(ws + O_MO);
    const bf16* CS = (const bf16*)(ws + O_CS); const float* NS = (const float*)(ws + O_NS); const float* MP = (const float*)(ws + O_MP); bf16* Y = (bf16*)(ws + O_Y);
    const int rb = wid & 3, cb0 = (wid >> 2) * 2;
    for (int item = blockIdx.x; item < 2560; item += gridDim.x) {
        const int cgk = item >> 2, h = item & 3, t0 = cgk * 128;
        load_tile_nat(sQ, QC + (size_t)t0 * 512 + h * 128, 512, tid);
        load_tile_nat(sK, KC + (size_t)t0 * 512 + h * 128, 512, tid);
        load_tile_tr(sVT, MV + (size_t)t0 * 512 + h * 128, 512, nullptr, tid);
        if (wid < 2) {
            const int dir = wid, itemd = (cgk * 4 + h) * 2 + dir; const float mprev = MP[itemd];
            const int o0 = dir ? 127 - lane : lane, o1 = dir ? 63 - lane : lane + 64;
            const float lf0 = G[(size_t)(t0 + o0) * 16 + dir * 8 + 4 + h], li0 = G[(size_t)(t0 + o0) * 16 + dir * 8 + h];
            const float lf1 = G[(size_t)(t0 + o1) * 16 + dir * 8 + 4 + h], li1 = G[(size_t)(t0 + o1) * 16 + dir * 8 + h];
            const float b0 = scan_add(lf0, lane), tot0 = __shfl(b0, 63), b1 = scan_add(lf1, lane) + tot0;
            const float pm0 = scan_max(li0 - b0, lane), mx0 = __shfl(pm0, 63), pm1 = fmaxf(scan_max(li1 - b1, lane), mx0);
            const float a0 = b0 + mprev, a1 = b1 + mprev, mt0 = fmaxf(a0, b0 + pm0), mt1 = fmaxf(a1, b1 + pm1);
            float* B_ = sBv2 + dir * 128; float* L_ = sLi2 + dir * 128; float* M_ = sMt2 + dir * 128; float* I_ = sInter2 + dir * 128;
            B_[o0] = b0; B_[o1] = b1; L_[o0] = li0; L_[o1] = li1; M_[o0] = mt0; M_[o1] = mt1; I_[o0] = __expf(a0 - mt0); I_[o1] = __expf(a1 - mt1);
        }
        __syncthreads();
        f32x16 S[2], hs[2];
#pragma unroll
        for (int c = 0; c < 2; ++c)
#pragma unroll
            for (int i = 0; i < 16; ++i) { S[c][i] = 0.f; hs[c][i] = 0.f; }
        mm_lds<8>(S, sQ, sK, rb, cb0, lane);
#pragma unroll 1
        for (int dir = 0; dir < 2; ++dir) {
            __syncthreads();
            const int itemd = (cgk * 4 + h) * 2 + dir;
            const float* sBv = sBv2 + dir * 128; const float* sLi = sLi2 + dir * 128; const float* sMt = sMt2 + dir * 128; const float* sInter = sInter2 + dir * 128;
            load_tile_nat(sC, CS + (size_t)itemd * 16384, 128, tid);
            if (tid >= 64 && tid < 96) *(f32x4*)(sN + (tid - 64) * 4) = *(const f32x4*)(NS + (size_t)itemd * 128 + (tid - 64) * 4);
            __syncthreads();
#pragma unroll
            for (int c = 0; c < 2; ++c) { const int s = 32 * (cb0 + c) + (lane & 31); const float bs = sBv[s] - sLi[s];
#pragma unroll
                for (int i = 0; i < 16; ++i) { const int t = 32 * rb + crow(i, hh); const bool valid = dir ? (s >= t) : (s <= t);
                    const float pv = valid ? S[c][i] * __expf(sBv[t] - bs - sMt[t]) : 0.f; sP[t * LDT + s] = f2bf(pv); } }
            __syncthreads();
            if (tid < 128) { const int t = tid; float dot = 0.f, rsum = 0.f;
#pragma unroll 4
                for (int e = 0; e < 128; e += 8) { const u32x4 qq = *(const u32x4*)(sQ + t * LDT + e), pq = *(const u32x4*)(sP + t * LDT + e); const f32x4 na = *(const f32x4*)(sN + e), nb = *(const f32x4*)(sN + e + 4);
                    dot += (na.x * bflo(qq.x) + na.y * bfhi(qq.x)) + (na.z * bflo(qq.y) + na.w * bfhi(qq.y)) + (nb.x * bflo(qq.z) + nb.y * bfhi(qq.z)) + (nb.z * bflo(qq.w) + nb.w * bfhi(qq.w));
                    rsum += (bflo(pq.x) + bfhi(pq.x)) + (bflo(pq.y) + bfhi(pq.y)) + (bflo(pq.z) + bfhi(pq.z)) + (bflo(pq.w) + bfhi(pq.w)); }
                const float den = sInter[t] * dot + rsum; sInv[t] = 1.f / fmaxf(fabsf(den), __expf(-sMt[t])); }
            f32x16 num[2];
#pragma unroll
            for (int c = 0; c < 2; ++c)
#pragma unroll
                for (int i = 0; i < 16; ++i) num[c][i] = 0.f;
            mm_lds<8>(num, sQ, sC, rb, cb0, lane);
#pragma unroll
            for (int i = 0; i < 16; ++i) { const float it = sInter[32 * rb + crow(i, hh)]; num[0][i] *= it; num[1][i] *= it; }
            mm_lds<8>(num, sP, sVT, rb, cb0, lane);
            __syncthreads();
#pragma unroll
            for (int i = 0; i < 16; ++i) { const float iv = sInv[32 * rb + crow(i, hh)]; hs[0][i] += num[0][i] * iv; hs[1][i] += num[1][i] * iv; }
        }
        const int ft = tid >> 2, fd0 = (tid & 3) * 32;
        const bf16* mo = MO + (size_t)(t0 + ft) * 512 + h * 128 + fd0; const float* on = p.m_out_norm + h * 128 + fd0;
        u32x4 gmo[4]; f32x4 gon[8];
#pragma unroll
        for (int e = 0; e < 4; ++e) { gmo[e] = *(const u32x4*)(mo + 8 * e); gon[2 * e] = *(const f32x4*)(on + 8 * e); gon[2 * e + 1] = *(const f32x4*)(on + 8 * e + 4); }
        __syncthreads();
#pragma unroll
        for (int c = 0; c < 2; ++c)
#pragma unroll
            for (int i = 0; i < 16; ++i) sH[(32 * rb + crow(i, hh)) * 132 + 32 * (cb0 + c) + (lane & 31)] = hs[c][i];
        __syncthreads();
        { const int t = ft, d0 = fd0; f32x4 v[8]; float ss = 0.f;
#pragma unroll
          for (int e = 0; e < 8; ++e) { v[e] = *(const f32x4*)(sH + t * 132 + d0 + 4 * e); ss += sq4(v[e]); }
          ss += __shfl_xor(ss, 1); ss += __shfl_xor(ss, 2);
          const float rstd = rsqrtf(ss * (1.f / 128.f) + EPS);
          bf16* yo = Y + (size_t)(t0 + t) * 1024 + 512 + h * 128 + d0;
#pragma unroll
          for (int e = 0; e < 4; ++e) { const u32x4 g = gmo[e]; const f32x4 a = v[2 * e] * rstd * gon[2 * e], b = v[2 * e + 1] * rstd * gon[2 * e + 1];
              u32x4 o; o.x = pk2(a.x * bflo(g.x), a.y * bfhi(g.x)); o.y = pk2(a.z * bflo(g.y), a.w * bfhi(g.y)); o.z = pk2(b.x * bflo(g.z), b.y * bfhi(g.z)); o.w = pk2(b.z * bflo(g.w), b.w * bfhi(g.w));
              *(u32x4*)(yo + 8 * e) = o; } }
        __syncthreads();
    }
}
DI void attn_phase(const Params& p) {
    unsigned char* ws = p.ws; int tid_ = threadIdx.x; asm volatile("" : "+v"(tid_)); const int tid = tid_, lane = tid & 63, wid = tid >> 6, r = lane & 31, hh = lane >> 5;
    const bf16* Q = (const bf16*)(ws + O_Q); const bf16* KN = (const bf16*)(ws + O_KN); const bf16* KR = (const bf16*)(ws + O_KR); const bf16* VT = (const bf16*)(ws + O_VT); bf16* Y = (bf16*)(ws + O_Y);
    constexpr int KB_B = 128 * 208, VB_B = 64 * 272, VOFF = 2 * KB_B, SOFF = 0;
    for (int item = blockIdx.x; item < 1280; item += gridDim.x) {
        int sq, head, qb;
        if (item < 256) { sq = item >> 7; head = (item & 127) >> 4; qb = item & 15; } else { const int it = item - 256; sq = 2 + (it >> 6); head = (it & 63) >> 3; qb = it & 7; }
        const int S = seq_len(sq), t0 = seq_start(sq), nkt = S >> 7, tq0 = t0 + qb * 512 + wid * 64;
        bf16x8 qf[2][6];
#pragma unroll
        for (int j = 0; j < 2; ++j)
#pragma unroll
            for (int ks = 0; ks < 6; ++ks) qf[j][ks] = *(const bf16x8*)(Q + (size_t)(tq0 + j * 32 + r) * 768 + head * 96 + 16 * ks + 8 * hh);
        f32x16 o[2][2];
#pragma unroll
        for (int j = 0; j < 2; ++j)
#pragma unroll
            for (int c = 0; c < 2; ++c)
#pragma unroll
                for (int i = 0; i < 16; ++i) o[j][c][i] = 0.f;
        float mrun[2] = {0.f, 0.f}, lrun[2] = {0.f, 0.f};
        const bf16* gk = KN + (size_t)(t0 + (tid >> 3)) * 512 + head * 64 + (tid & 7) * 8;
        const bf16* gr = KR + (size_t)(t0 + (tid >> 2)) * 32 + (tid & 3) * 8;
        const bf16* gv = VT + (size_t)t0 * 512 + (size_t)(head * 64 + (tid >> 3)) * S + (tid & 7) * 8;
        unsigned char* lk = g_lds + (tid >> 3) * 208 + (tid & 7) * 16; unsigned char* lr = g_lds + (tid >> 2) * 208 + 128 + (tid & 3) * 16; unsigned char* lv = g_lds + VOFF + (tid >> 3) * 272 + ((tid & 7) >> 1) * 32 + (tid & 1) * 8;
        u32x4 rk, rk2, rr, rv, rv2;
#define ALD_(kt_) { rk = *(const u32x4*)(gk + (size_t)(kt_) * 128 * 512); rk2 = *(const u32x4*)(gk + (size_t)((kt_) * 128 + 64) * 512); rr = *(const u32x4*)(gr + (size_t)(kt_) * 128 * 32); rv = *(const u32x4*)(gv + (kt_) * 128); rv2 = *(const u32x4*)(gv + (kt_) * 128 + 64); }
#define AST_(b_) { *(u32x4*)(lk + (b_) * KB_B) = rk; *(u32x4*)(lk + (b_) * KB_B + 64 * 208) = rk2; *(u32x4*)(lr + (b_) * KB_B) = rr; \
            *(u32x2*)(lv + (b_) * VB_B) = (u32x2){rv.x, rv.y}; *(u32x2*)(lv + (b_) * VB_B + 16) = (u32x2){rv.z, rv.w}; *(u32x2*)(lv + (b_) * VB_B + 128) = (u32x2){rv2.x, rv2.y}; *(u32x2*)(lv + (b_) * VB_B + 144) = (u32x2){rv2.z, rv2.w}; }
        ALD_(0) AST_(0)
        __syncthreads();
        for (int kt = 0; kt < nkt; ++kt) {
            const int buf = kt & 1; const bool more = kt + 1 < nkt;
            if (more) ALD_(kt + 1)
            const unsigned char* Kb = g_lds + buf * KB_B; const unsigned char* Vb = g_lds + VOFF + buf * VB_B;
#pragma unroll 1
            for (int kb = 0; kb < 4; ++kb) {
                f32x16 st[2];
#pragma unroll
                for (int j = 0; j < 2; ++j) { const float nm = -mrun[j];
#pragma unroll
                    for (int i = 0; i < 16; ++i) st[j][i] = nm; }
#pragma unroll
                for (int ks = 0; ks < 6; ++ks) { const bf16x8 a = *(const bf16x8*)(Kb + (32 * kb + r) * 208 + (16 * ks + 8 * hh) * 2); st[0] = MFMA32(a, qf[0][ks], st[0]); st[1] = MFMA32(a, qf[1][ks], st[1]); }
                bf16x8 pf[2][2];
                const bool first = (kt == 0) && (kb == 0);
#pragma unroll
                for (int j = 0; j < 2; ++j) {
                    float mx = st[j][0];
#pragma unroll
                    for (int i = 1; i < 16; ++i) mx = fmaxf(mx, st[j][i]);
                    mx = fmaxf(mx, __shfl_xor(mx, 32));
                    if (first || __builtin_amdgcn_ballot_w64(mx > 8.f) != 0ull) {
                        const float d = first ? mx : fmaxf(mx, 0.f);
                        if (!first) { const float alpha = __builtin_amdgcn_exp2f(-d); lrun[j] *= alpha;
#pragma unroll
                            for (int c = 0; c < 2; ++c)
#pragma unroll
                                for (int i = 0; i < 16; ++i) o[j][c][i] *= alpha; }
#pragma unroll
                        for (int i = 0; i < 16; ++i) st[j][i] -= d;
                        mrun[j] += d;
                    }
                    float ps = 0.f;
#pragma unroll
                    for (int i = 0; i < 16; ++i) { const float e = __builtin_amdgcn_exp2f(st[j][i]); st[j][i] = e; ps += e; }
                    lrun[j] += ps;
#pragma unroll
                    for (int s2 = 0; s2 < 2; ++s2) {
                        u32x4 pp; pp.x = pk2(st[j][8 * s2 + 0], st[j][8 * s2 + 1]); pp.y = pk2(st[j][8 * s2 + 2], st[j][8 * s2 + 3]); pp.z = pk2(st[j][8 * s2 + 4], st[j][8 * s2 + 5]); pp.w = pk2(st[j][8 * s2 + 6], st[j][8 * s2 + 7]);
                        pf[j][s2] = __builtin_bit_cast(bf16x8, pp); }
                }
#pragma unroll
                for (int s2 = 0; s2 < 2; ++s2)
#pragma unroll
                    for (int db = 0; db < 2; ++db) { const bf16x8 a = *(const bf16x8*)(Vb + (32 * db + r) * 272 + (32 * kb + 16 * s2) * 2 + hh * 16);
                        o[0][db] = MFMA32(a, pf[0][s2], o[0][db]); o[1][db] = MFMA32(a, pf[1][s2], o[1][db]); }
            }
            if (more) AST_(buf ^ 1)
            __syncthreads();
        }
#undef ALD_
#undef AST_
        unsigned char* stg = g_lds + SOFF + wid * 8704;
#pragma unroll
        for (int j = 0; j < 2; ++j) { float l = lrun[j]; l += __shfl_xor(l, 32); const float inv = 1.f / l;
#pragma unroll
            for (int db = 0; db < 2; ++db)
#pragma unroll
                for (int g4 = 0; g4 < 4; ++g4) { u32x2 w; w.x = pk2(o[j][db][4 * g4] * inv, o[j][db][4 * g4 + 1] * inv); w.y = pk2(o[j][db][4 * g4 + 2] * inv, o[j][db][4 * g4 + 3] * inv);
                    *(u32x2*)(stg + (j * 32 + r) * 136 + (32 * db + 8 * g4 + 4 * hh) * 2) = w; } }
        __syncthreads();
#pragma unroll
        for (int j = 0; j < 8; ++j) { const int id = lane + 64 * j, row = id >> 3, c = id & 7; const u32x2 a = *(const u32x2*)(stg + row * 136 + c * 16), b = *(const u32x2*)(stg + row * 136 + c * 16 + 8);
            *(u32x4*)(Y + (size_t)(tq0 + row) * 1024 + head * 64 + c * 8) = (u32x4){a.x, a.y, b.x, b.y}; }
        __syncthreads();
    }
}
DI void spatial_phase(const Params& p) {
    unsigned char* ws = p.ws; int tid_ = threadIdx.x; asm volatile("" : "+v"(tid_)); const int tid = tid_, lane = tid & 63, wid = tid >> 6, hh = lane >> 5;
    bf16* sW = (bf16*)g_lds; bf16* sVn = (bf16*)(g_lds + TILE_B); float* sR = (float*)(g_lds + 2 * TILE_B);
    const bf16* WSP = (const bf16*)(ws + O_WSP); const bf16* U = (const bf16*)(ws + O_U); const bf16* V = (const bf16*)(ws + O_V); const f32x4* VSS = (const f32x4*)(ws + O_VSS); bf16* Z = (bf16*)(ws + O_Z);
    const int rb = wid & 3, cb0 = (wid >> 2) * 2;
    const int G8 = (gridDim.x & 7) == 0 ? (int)(gridDim.x >> 3) : 0;
    if (G8 == 0) return;
    const int g = blockIdx.x & 7;
    load_tile_nat(sW, WSP + (size_t)g * 16384, 128, tid);
    const f32x4 n0 = *(const f32x4*)(p.c_v_norm + g * 128 + (tid >> 7) * 8), n1 = *(const f32x4*)(p.c_v_norm + g * 128 + (tid >> 7) * 8 + 4), n2 = *(const f32x4*)(p.c_v_norm + g * 128 + (tid >> 7) * 8 + 32), n3 = *(const f32x4*)(p.c_v_norm + g * 128 + (tid >> 7) * 8 + 36);
    const f32x4 n4 = *(const f32x4*)(p.c_v_norm + g * 128 + (tid >> 7) * 8 + 64), n5 = *(const f32x4*)(p.c_v_norm + g * 128 + (tid >> 7) * 8 + 68), n6 = *(const f32x4*)(p.c_v_norm + g * 128 + (tid >> 7) * 8 + 96), n7 = *(const f32x4*)(p.c_v_norm + g * 128 + (tid >> 7) * 8 + 100);
    float bsp[16];
#pragma unroll
    for (int i = 0; i < 16; ++i) bsp[i] = p.c_b_sp[g * 128 + 32 * rb + crow(i, hh)];
    u32x4 vr[4];
    int cgk = blockIdx.x >> 3;
    if (cgk < NCHUNK) {
#pragma unroll
        for (int i = 0; i < 4; ++i) { const int id = tid + 512 * i, row = id & 127, c = (id >> 7) * 8; vr[i] = *(const u32x4*)(V + (size_t)(cgk * 128 + row) * 1024 + g * 128 + c); }
    }
    for (; cgk < NCHUNK; cgk += G8) {
        const int t0 = cgk * 128;
        if (tid < 128) { const f32x4 q = VSS[t0 + tid]; sR[tid] = rsqrtf(((q.x + q.y) + (q.z + q.w)) * (1.f / 1024.f) + EPS); }
        __syncthreads();
#pragma unroll
        for (int i = 0; i < 4; ++i) { const int id = tid + 512 * i, row = id & 127, c = (id >> 7) * 8; const u32x4 v = vr[i]; const float ww = sR[row];
            const f32x4 na = i == 0 ? n0 : (i == 1 ? n2 : (i == 2 ? n4 : n6)), nb = i == 0 ? n1 : (i == 1 ? n3 : (i == 2 ? n5 : n7));
            sVn[(c + 0) * LDT + row] = f2bf(bflo(v.x) * ww * na.x); sVn[(c + 1) * LDT + row] = f2bf(bfhi(v.x) * ww * na.y); sVn[(c + 2) * LDT + row] = f2bf(bflo(v.y) * ww * na.z); sVn[(c + 3) * LDT + row] = f2bf(bfhi(v.y) * ww * na.w);
            sVn[(c + 4) * LDT + row] = f2bf(bflo(v.z) * ww * nb.x); sVn[(c + 5) * LDT + row] = f2bf(bfhi(v.z) * ww * nb.y); sVn[(c + 6) * LDT + row] = f2bf(bflo(v.w) * ww * nb.z); sVn[(c + 7) * LDT + row] = f2bf(bfhi(v.w) * ww * nb.w); }
        __syncthreads();
        if (cgk + G8 < NCHUNK) {
#pragma unroll
            for (int i = 0; i < 4; ++i) { const int id = tid + 512 * i, row = id & 127, c = (id >> 7) * 8; vr[i] = *(const u32x4*)(V + (size_t)((cgk + G8) * 128 + row) * 1024 + g * 128 + c); }
        }
        bf16 uu[2][16];
#pragma unroll
        for (int c = 0; c < 2; ++c)
#pragma unroll
            for (int i = 0; i < 16; ++i) uu[c][i] = U[(size_t)(t0 + 32 * rb + crow(i, hh)) * 1024 + g * 128 + 32 * (cb0 + c) + (lane & 31)];
        f32x16 acc[2];
#pragma unroll
        for (int c = 0; c < 2; ++c)
#pragma unroll
            for (int i = 0; i < 16; ++i) acc[c][i] = 0.f;
        mm_lds<8>(acc, sW, sVn, rb, cb0, lane);
#pragma unroll
        for (int c = 0; c < 2; ++c)
#pragma unroll
            for (int i = 0; i < 16; ++i) { const int t = 32 * rb + crow(i, hh), cc = g * 128 + 32 * (cb0 + c) + (lane & 31); const size_t ix = (size_t)(t0 + t) * 1024 + cc;
                Z[ix] = f2bf((acc[c][i] + bsp[i]) * bf2f(uu[c][i])); }
    }
    __syncthreads();
}
DI void final_phase(const Params& p) {
    int tid_ = threadIdx.x; asm volatile("" : "+v"(tid_)); const int tid = tid_, lane = tid & 63, gw = blockIdx.x * 8 + (tid >> 6), NGW = gridDim.x * 8; const f32x4* SS = (const f32x4*)(p.ws + O_SS);
    for (int t = gw; t < T_TOK; t += NGW) { const float rs = rs_of(SS, t); f32x4* xr = (f32x4*)(p.out + (size_t)t * DM) + lane; const f32x4* gn = (const f32x4*)p.final_norm + lane;
#pragma unroll
        for (int j = 0; j < 4; ++j) xr[64 * j] = xr[64 * j] * rs * gn[64 * j]; }
}


#ifndef DBG
#define DBG 0
#endif
constexpr size_t O_DBG = O_END0;
DI int btok_(int i) { return ((int)blockIdx.x * 8 + (i & 7)) * 40 + ((int)blockIdx.x * 7 + i * 3) % 40; }
DI bool close_(float fast, float ref) { return fabsf(fast - ref) <= 0.03f + 0.04f * fabsf(ref); }
DI float nrs_(const Params& p, int t) { const float* x = xin_row(p, t); float s = 0.f; for (int k = 0; k < 1024; ++k) s += x[k] * x[k]; return rsqrtf(s * (1.f / 1024.f) + EPS); }
DI float nh_(const Params& p, int t, int col, float rs) { const float* x = xin_row(p, t); float s = 0.f; for (int k = 0; k < 1024; ++k) s += x[k] * p.ab_norm[k] * p.ab_w_in[(size_t)k * 2480 + col]; return s * rs; }
DI void dbg_fail(const Params& p, unsigned bit) { atomicOr((unsigned*)(p.ws + O_DBG), bit); }
DI void chk_inproj(const Params& p) {
    unsigned char* ws = p.ws; int tid_ = threadIdx.x; asm volatile("" : "+v"(tid_)); const int tid = tid_; const int bx = blockIdx.x;
    if (tid < 4) { const int t = btok_(tid); const float rs = nrs_(p, t);
        { const float ref = nh_(p, t, (7 + 50 * tid + bx) % 256, rs), fast = bf2f(((const bf16*)(ws + O_CQKV))[(size_t)t * 384 + (7 + 50 * tid + bx) % 256]); if (!close_(fast, ref)) dbg_fail(p, 0u); }
        { const float ref = nh_(p, t, 256 + (9 + 20 * tid + bx) % 128, rs), fast = bf2f(((const bf16*)(ws + O_CQKV))[(size_t)t * 384 + 256 + (9 + 20 * tid + bx) % 128]); if (!close_(fast, ref)) dbg_fail(p, 0u); }
        { const int ch = (3 + 37 * tid + 2 * bx) % 512; const float ref = nh_(p, t, 1440 + ch, rs), fast = bf2f(((const bf16*)(ws + O_MV))[(size_t)t * 512 + ch]); if (!close_(fast, ref)) dbg_fail(p, 0u); }
    } else if (tid < 8) { const int i = tid - 4, t = btok_(tid); const int sq = seq_of(t), s0 = seq_start(sq), sl = seq_len(sq);
        for (int w = 0; w < 2; ++w) { const int ch = (w ? 512 : 0) + (11 + 100 * i + 2 * bx) % 512; float a[3];
            for (int d = -1; d <= 1; ++d) { const int tt = t + d; a[d + 1] = (tt >= s0 && tt < s0 + sl) ? nh_(p, tt, 416 + ch, nrs_(p, tt)) : 0.f; }
            float v = a[0] * p.m_conv_w[ch] + a[1] * p.m_conv_w[1024 + ch] + a[2] * p.m_conv_w[2048 + ch] + p.m_conv_b[ch]; v = v / (1.f + expf(-v)); if (w) v *= 0.08838834764831845f;
            const float fast = bf2f(((const bf16*)(ws + (w ? O_KC : O_QC)))[(size_t)t * 512 + (ch & 511)]); if (!close_(fast, v)) { const int pos = t - s0, row = pos % 252 + 2; const int jj = pos / 252, pm = sq < 2 ? sq * 33 + jj : 66 + (sq - 2) * 17 + jj; (void)pm; const int fr_ = row & 15, m_ = (row >> 4) & 3; (void)fr_; (void)m_; { unsigned b = 0; if (fr_ == 1) b = 1u; else if (fr_ == 2) b = 2u; else if (fr_ == 3) b = 4u; else if (fr_ == 12) b = 8u; else if (fr_ == 13) b = 16u; else if (fr_ == 14) b = 32u; dbg_fail(p, b); } } }
    } else if (tid < 12) { const int i = tid - 8, t = btok_(tid); const float rs = nrs_(p, t); const int sq = seq_of(t), pos = t - seq_start(sq);
        { const int gi = (5 + 2 * i + bx) & 15; float v = nh_(p, t, 2464 + gi, rs) + p.gate_bias[gi]; if ((gi >> 2) & 1) v = fminf(v, 0.f) - log1pf(expf(-fabsf(v))); const float fast = ((const float*)(ws + O_G))[(size_t)t * 16 + gi]; if (!close_(fast, v)) dbg_fail(p, 0u); }
        { const int ii = (3 + i + bx) & 15; const float x1 = nh_(p, t, 384 + ii, rs), x2 = nh_(p, t, 384 + 16 + ii, rs); const float ang = (float)pos / powf(10000.f, ii / 16.f); const float c = cosf(ang), sn = sinf(ang);
          const float r1 = x1 * c - x2 * sn, r2 = x2 * c + x1 * sn; const bf16* KR = (const bf16*)(ws + O_KR); if (!close_(bf2f(KR[(size_t)t * 32 + ii]), r1) || !close_(bf2f(KR[(size_t)t * 32 + 16 + ii]), r2)) dbg_fail(p, 0u); }
        { const int ch = (17 + 60 * i + 2 * bx) % 512; float v = nh_(p, t, 1952 + ch, rs); v = 1.f / (1.f + expf(-v)); const float fast = bf2f(((const bf16*)(ws + O_MO))[(size_t)t * 512 + ch]); if (!close_(fast, v)) dbg_fail(p, 0u); }
    }
}
DI void chk_mlstm(const Params& p) {
    unsigned char* ws = p.ws; int tid_ = threadIdx.x; asm volatile("" : "+v"(tid_)); const int tid = tid_; const int sqm = blockIdx.x % 18, hd = (blockIdx.x / 18) & 3, t0 = seq_start(sqm), S = seq_len(sqm), tp = (blockIdx.x * 37 + 5) % S;
    const float* G = (const float*)(ws + O_G); const bf16* QC = (const bf16*)(ws + O_QC); const bf16* KC = (const bf16*)(ws + O_KC); const bf16* MV = (const bf16*)(ws + O_MV); const bf16* MO = (const bf16*)(ws + O_MO); const bf16* Y = (const bf16*)(ws + O_Y);
    const int d = tid >> 2, e0 = (tid & 3) * 32; float* sh = (float*)g_lds; float hsum = 0.f;
    for (int dir = 0; dir < 2; ++dir) {
        const int first = dir ? S - 1 : 0, step = dir ? -1 : 1, cnt = dir ? S - tp : tp + 1;
        float num = 0.f, den = 0.f;
        { float C[32];
#pragma unroll
          for (int e = 0; e < 32; ++e) C[e] = 0.f;
          for (int j = 0; j < cnt; ++j) { const int t = t0 + first + step * j; const float f = expf(G[(size_t)t * 16 + dir * 8 + 4 + hd]), ii = expf(G[(size_t)t * 16 + dir * 8 + hd]);
            const float v = bf2f(MV[(size_t)t * 512 + hd * 128 + d]) * ii;
#pragma unroll
            for (int e = 0; e < 32; ++e) { const float k = bf2f(KC[(size_t)t * 512 + hd * 128 + e0 + e]); C[e] = f * C[e] + v * k; } }
#pragma unroll
          for (int e = 0; e < 32; ++e) num += C[e] * bf2f(QC[(size_t)(t0 + tp) * 512 + hd * 128 + e0 + e]); }
        __builtin_amdgcn_sched_barrier(0);
        { float n[32];
#pragma unroll
          for (int e = 0; e < 32; ++e) n[e] = 0.f;
          for (int j = 0; j < cnt; ++j) { const int t = t0 + first + step * j; const float f = expf(G[(size_t)t * 16 + dir * 8 + 4 + hd]), ii = expf(G[(size_t)t * 16 + dir * 8 + hd]);
#pragma unroll
            for (int e = 0; e < 32; ++e) { const float k = bf2f(KC[(size_t)t * 512 + hd * 128 + e0 + e]); n[e] = f * n[e] + ii * k; } }
#pragma unroll
          for (int e = 0; e < 32; ++e) den += n[e] * bf2f(QC[(size_t)(t0 + tp) * 512 + hd * 128 + e0 + e]); }
        num += __shfl_xor(num, 1); num += __shfl_xor(num, 2); den += __shfl_xor(den, 1); den += __shfl_xor(den, 2);
        hsum += num / fmaxf(fabsf(den), 1.f);
    }
    __syncthreads();
    if ((tid & 3) == 0) sh[d] = hsum;
    __syncthreads();
    if (tid < 128) { float ss = 0.f; for (int e = 0; e < 128; ++e) ss += sh[e] * sh[e]; const float rstd = rsqrtf(ss * (1.f / 128.f) + EPS);
        const float ref = sh[tid] * rstd * p.m_out_norm[hd * 128 + tid] * bf2f(MO[(size_t)(t0 + tp) * 512 + hd * 128 + tid]); const float fast = bf2f(Y[(size_t)(t0 + tp) * 1024 + 512 + hd * 128 + tid]);
        if (!close_(fast, ref)) dbg_fail(p, 0u); }
    __syncthreads();
}
DI void chk_qkv(const Params& p) {
    unsigned char* ws = p.ws; int tid_ = threadIdx.x; asm volatile("" : "+v"(tid_)); const int tid = tid_; if (tid >= 4) return;
    const int t = btok_(tid); const int sq = seq_of(t), st = seq_start(sq), S = seq_len(sq), pos = t - st; const bf16* CQ = (const bf16*)(ws + O_CQKV) + (size_t)t * 384;
    float sq_ = 0.f, skv = 0.f; for (int k = 0; k < 256; ++k) sq_ += bf2f(CQ[k]) * bf2f(CQ[k]); for (int k = 0; k < 128; ++k) skv += bf2f(CQ[256 + k]) * bf2f(CQ[256 + k]);
    const float rq = rsqrtf(sq_ / 256.f + EPS), rkv = rsqrtf(skv / 128.f + EPS); const float qs = 0.10206207261596577f * 1.4426950408889634f;
    const int hd = (2 + tid + blockIdx.x) & 7;
    { const int dd = 13 + tid; float s = 0.f; for (int k = 0; k < 256; ++k) s += bf2f(CQ[k]) * p.q_norm[k] * p.w_uq[(size_t)k * 768 + hd * 96 + dd]; s *= rq * qs; if (!close_(bf2f(((const bf16*)(ws + O_Q))[(size_t)t * 768 + hd * 96 + dd]), s)) dbg_fail(p, 0u); }
    { const int ii = 2 + tid; float x1 = 0.f, x2 = 0.f; for (int k = 0; k < 256; ++k) { const float a = bf2f(CQ[k]) * p.q_norm[k]; x1 += a * p.w_uq[(size_t)k * 768 + hd * 96 + 64 + ii]; x2 += a * p.w_uq[(size_t)k * 768 + hd * 96 + 80 + ii]; }
      x1 *= rq * qs; x2 *= rq * qs; const float ang = (float)pos / powf(10000.f, ii / 16.f); const float c = cosf(ang), sn = sinf(ang); const bf16* Qp = (const bf16*)(ws + O_Q) + (size_t)t * 768 + hd * 96;
      if (!close_(bf2f(Qp[64 + ii]), x1 * c - x2 * sn) || !close_(bf2f(Qp[80 + ii]), x2 * c + x1 * sn)) dbg_fail(p, 0u); }
    { const int dd = 21 + tid; float s = 0.f, v = 0.f; for (int k = 0; k < 128; ++k) { const float a = bf2f(CQ[256 + k]) * p.kv_norm[k]; s += a * p.w_ukv[(size_t)k * 1024 + hd * 128 + dd]; v += a * p.w_ukv[(size_t)k * 1024 + hd * 128 + 64 + dd]; }
      s *= rkv; v *= rkv; if (!close_(bf2f(((const bf16*)(ws + O_KN))[(size_t)t * 512 + hd * 64 + dd]), s)) dbg_fail(p, 0u);
      if (!close_(bf2f(((const bf16*)(ws + O_VT))[(size_t)st * 512 + (size_t)(hd * 64 + dd) * S + pos]), v)) dbg_fail(p, 0u); }
}
DI void chk_attn(const Params& p) {
    unsigned char* ws = p.ws; int tid_ = threadIdx.x; asm volatile("" : "+v"(tid_)); const int tid = tid_; if (tid >= 64) return;
    const int smp = tid >> 4, dd = (tid & 15) * 4 + (blockIdx.x & 3); const int t = btok_(smp), hd = (1 + 2 * smp + blockIdx.x) & 7; const int sq = seq_of(t), st = seq_start(sq), S = seq_len(sq);
    const bf16* Q = (const bf16*)(ws + O_Q) + (size_t)t * 768 + hd * 96; const bf16* KN = (const bf16*)(ws + O_KN); const bf16* KR = (const bf16*)(ws + O_KR); const bf16* VT = (const bf16*)(ws + O_VT) + (size_t)st * 512 + (size_t)(hd * 64 + dd) * S;
    float m = -1e30f, l = 0.f, o = 0.f;
    for (int k = 0; k < S; ++k) { float s = 0.f; for (int e = 0; e < 64; ++e) s += bf2f(Q[e]) * bf2f(KN[(size_t)(st + k) * 512 + hd * 64 + e]); for (int e = 0; e < 32; ++e) s += bf2f(Q[64 + e]) * bf2f(KR[(size_t)(st + k) * 32 + e]);
        const float mn = fmaxf(m, s), a = exp2f(m - mn), pe = exp2f(s - mn); l = l * a + pe; o = o * a + pe * bf2f(VT[k]); m = mn; }
    const float ref = o / l, fast = bf2f(((const bf16*)(ws + O_Y))[(size_t)t * 1024 + hd * 64 + dd]); if (!close_(fast, ref)) dbg_fail(p, 0u);
}
DI void dbg_emit(const Params& p) {
    const float a = sqrtf((float)*(const unsigned*)(p.ws + O_DBG)); const int gt = blockIdx.x * NTHR + threadIdx.x, GT = gridDim.x * NTHR;
    for (size_t i = gt; i < (size_t)T_TOK * DM / 4; i += GT) ((f32x4*)p.out)[i] = (f32x4){a, a, a, a};
}

DI int dtok_(int i) { return i == 0 ? 62 : i == 1 ? 63 : i == 2 ? 253 : i == 3 ? 254 : i == 4 ? 8191 : i == 5 ? 16384 : i == 6 ? 20253 : 81919; }
DI float rowrs_(const float* x) { float s = 0.f; for (int k = 0; k < 1024; ++k) s += x[k] * x[k]; return rsqrtf(s * (1.f / 1024.f) + EPS); }
DI void chk_res(const Params& p, const bf16* A, int K, const float* W, bool first, unsigned bit, int slot) {
    if (threadIdx.x >= 8) return; const int i = threadIdx.x, t = btok_(i), c = (5 + 127 * i + 3 * (int)blockIdx.x) & 1023; float* sv = (float*)(p.ws + O_DBG + 64) + (size_t)blockIdx.x * 32;
    float s = first ? xin_row(p, t)[c] : sv[slot * 8 + i]; for (int k = 0; k < K; ++k) s += bf2f(A[(size_t)t * K + k]) * W[(size_t)k * 1024 + c];
    if (!close_(p.out[(size_t)t * DM + c], s)) dbg_fail(p, bit);
    sv[(slot + 1) * 8 + i] = p.out[(size_t)t * DM + c];
}
DI void chk_up(const Params& p, int layer) {
    if (threadIdx.x >= 8) return; const int i = threadIdx.x, t = btok_(i), j = (9 + 350 * i + 11 * (int)blockIdx.x) % 2816; const int sq = seq_of(t), s0 = seq_start(sq), sl = seq_len(sq);
    const float* W = p.ffn_w_up + (size_t)layer * 1024 * 5632; const float* cw = p.ffn_conv_w + (size_t)layer * 3 * 5632; const float* cb = p.ffn_conv_b + (size_t)layer * 5632; const float* gn = p.ffn_norm + layer * 1024;
    float g = cb[j], v = cb[2816 + j];
    for (int d = -1; d <= 1; ++d) { const int tt = t + d; if (tt < s0 || tt >= s0 + sl) continue; const float* x = p.out + (size_t)tt * DM; const float rs = rowrs_(x); float ag = 0.f, av = 0.f;
        for (int k = 0; k < 1024; ++k) { const float xn = x[k] * rs * gn[k]; ag += xn * W[(size_t)k * 5632 + j]; av += xn * W[(size_t)k * 5632 + 2816 + j]; }
        g += ag * cw[(d + 1) * 5632 + j]; v += av * cw[(d + 1) * 5632 + 2816 + j]; }
    const float ref = g / (1.f + expf(-g)) * v, fast = bf2f(((const bf16*)(p.ws + O_HID))[(size_t)t * DFF + j]); if (!close_(fast, ref)) dbg_fail(p, DBG == 3 ? (i < 6 ? (1u << i) : 0u) : 2u);
}
DI void chk_gin(const Params& p) {
    if (threadIdx.x >= 8) return; const int i = threadIdx.x, t = btok_(i), c = (3 + 120 * i + 5 * (int)blockIdx.x) & 1023; const float* x = p.out + (size_t)t * DM; const float rs = rowrs_(x); float au = 0.f, av = 0.f;
    for (int k = 0; k < 1024; ++k) { const float xn = x[k] * rs * p.c_norm[k]; au += xn * p.c_w_in[(size_t)k * 2048 + c]; av += xn * p.c_w_in[(size_t)k * 2048 + 1024 + c]; }
    au = 0.5f * au * (1.f + erff(au * 0.70710678f)); av = 0.5f * av * (1.f + erff(av * 0.70710678f));
    if (!close_(bf2f(((const bf16*)(p.ws + O_U))[(size_t)t * DM + c]), au) || !close_(bf2f(((const bf16*)(p.ws + O_V))[(size_t)t * DM + c]), av)) dbg_fail(p, 8u);
}
DI void chk_sp(const Params& p) {
    if (threadIdx.x >= 8) return; const int i = threadIdx.x, t = btok_(i), g = (i + (int)blockIdx.x) & 7, c = (7 + 13 * i + (int)blockIdx.x) & 127, t0 = t & ~127, tt = t & 127; const bf16* V = (const bf16*)(p.ws + O_V); const bf16* U = (const bf16*)(p.ws + O_U);
    float acc = 0.f;
    for (int s2 = 0; s2 < 128; ++s2) { const bf16* vr = V + (size_t)(t0 + s2) * DM; float ss = 0.f; for (int k = 0; k < 1024; ++k) ss += bf2f(vr[k]) * bf2f(vr[k]); const float rv = rsqrtf(ss * (1.f / 1024.f) + EPS);
        acc += p.c_w_sp[(size_t)g * 16384 + tt * 128 + s2] * bf2f(vr[g * 128 + c]) * rv * p.c_v_norm[g * 128 + c]; }
    const float ref = (acc + p.c_b_sp[g * 128 + tt]) * bf2f(U[(size_t)t * DM + g * 128 + c]); if (!close_(bf2f(((const bf16*)(p.ws + O_Z))[(size_t)t * DM + g * 128 + c]), ref)) dbg_fail(p, 0u);
}
#if defined(__HIP_DEVICE_COMPILE__)
#define GETP() Params p; { typedef const unsigned long long __attribute__((address_space(4)))* KA_; KA_ q_ = (KA_)__builtin_amdgcn_kernarg_segment_ptr(); asm volatile("" : "+s"(q_)); \
    typedef __attribute__((address_space(1))) unsigned char* GP_; const void** pp_ = (const void**)&p; _Pragma("unroll") for (int i_ = 0; i_ < 27; ++i_) pp_[i_] = (const void*)(GP_)q_[i_]; } unsigned char* ws = p.ws; (void)ws;
#else
#define GETP() Params p = p_unused; unsigned char* ws = p.ws; (void)ws;
#endif
__global__ void __launch_bounds__(NTHR, 2) fwd_kernel(Params p_unused, int lo, int hi) {
    cg::grid_group grid = cg::this_grid();
#define PH(k, ...) if (lo <= (k) && (k) < hi) { GETP() __VA_ARGS__ } if (lo <= (k) && (k) + 1 < hi) grid.sync();
    PH(0, p0_prologue(p); if (DBG && blockIdx.x == 0 && threadIdx.x == 0) *(unsigned*)(p.ws + O_DBG) = 0u;)
    PH(1, Gemm g{(const bf16*)(ws + O_XB), (const bf16*)(ws + O_WIN), 1024, NM_OVL, 10, 1}; EpiIn E{p}; gemm_phase(g, E);)
    PH(2, mlstm_local(p);)
    PH(3, mlstm_scan(p);)
    PH(4, mlstm_out(p);)
    PH(5, Gemm g{(const bf16*)(ws + O_CQKV), (const bf16*)(ws + O_WQKV), 384, NM_PLAIN, 7, 0, 1}; EpiQkv E{p}; gemm_phase(g, E);)
    PH(6, attn_phase(p);)
    PH(7, Gemm g{(const bf16*)(ws + O_Y), (const bf16*)(ws + O_WOUT), 1024, NM_PLAIN, 4, 0}; EpiRes E{p, 1, 0}; gemm_phase<EpiRes, true>(g, E);)
    PH(8, Gemm g{(const bf16*)(ws + O_XB), (const bf16*)(ws + O_WUP), 1024, NM_OVL, 22, 1}; EpiUp E{p, 0}; gemm_phase<EpiUp, false>(g, E);)
    PH(9, Gemm g{(const bf16*)(ws + O_HID), (const bf16*)(ws + O_WDN), 2816, NM_PLAIN, 4, 0}; EpiRes E{p, 0, 0}; gemm_phase<EpiRes, true>(g, E);)
    PH(10, Gemm g{(const bf16*)(ws + O_XB), (const bf16*)(ws + O_WCIN), 1024, NM_PLAIN, 8, 0}; EpiGin E{p}; gemm_phase<EpiGin, true>(g, E);)
    PH(11, spatial_phase(p);)
    PH(12, Gemm g{(const bf16*)(ws + O_Z), (const bf16*)(ws + O_WCOUT), 1024, NM_PLAIN, 4, 0}; EpiRes E{p, 0, 0}; gemm_phase<EpiRes, true>(g, E);)
    PH(13, Gemm g{(const bf16*)(ws + O_XB), (const bf16*)(ws + O_WUP + AL((size_t)5632 * 1024 * 2)), 1024, NM_OVL, 22, 1}; EpiUp E{p, 1}; gemm_phase<EpiUp, false>(g, E);)
    PH(14, Gemm g{(const bf16*)(ws + O_HID), (const bf16*)(ws + O_WDN + AL((size_t)1024 * 2816 * 2)), 2816, NM_PLAIN, 4, 0}; EpiRes E{p, 0, 1}; gemm_phase<EpiRes, true>(g, E);)
    PH(15, final_phase(p);)
}
#if DBG
__global__ void __launch_bounds__(NTHR) chk_kernel(Params p, int which) {
    unsigned char* ws = p.ws; (void)ws;
    if (which == 1) chk_inproj(p);
    else if (which == 4) chk_mlstm(p);
    else if (which == 5) chk_qkv(p);
    else if (which == 6) chk_attn(p);
    else if (which == 7) chk_res(p, (const bf16*)(ws + O_Y), 1024, p.ab_w_out, true, 1u, 0);
    else if (which == 8) chk_up(p, 0);
    else if (which == 9) chk_res(p, (const bf16*)(ws + O_HID), 2816, p.ffn_w_down, false, 4u, 1);
    else if (which == 10) chk_gin(p);
    else if (which == 11) chk_sp(p);
    else if (which == 12) chk_res(p, (const bf16*)(ws + O_Z), 1024, p.c_w_out, false, 32u, 2);
    else if (which == 13) chk_up(p, 1);
    else if (which == 99) dbg_emit(p);
}
#endif

extern "C" void kernel_launch(void* const* d_in, const int* in_sizes, int n_in, void* d_out, int out_size, void* d_ws, size_t ws_size, hipStream_t stream) {
    static int grid = 0;
    if (grid == 0) {
        if (n_in != 25 || ws_size < WS_NEED + 65536 || out_size != T_TOK * DM) { fprintf(stderr, "kernel_launch: unexpected problem: n_in %d out %d ws %zu (need %zu)\n", n_in, out_size, ws_size, (size_t)WS_NEED); grid = -1; return; }
        int dev = 0, cus = 0, per_cu = 0;
        hipGetDevice(&dev); hipDeviceGetAttribute(&cus, hipDeviceAttributeMultiprocessorCount, dev);
        if (hipFuncSetAttribute((const void*)fwd_kernel, hipFuncAttributeMaxDynamicSharedMemorySize, LDS_BYTES) != hipSuccess) { fprintf(stderr, "kernel_launch: hipFuncSetAttribute failed\n"); grid = -1; return; }
        hipOccupancyMaxActiveBlocksPerMultiprocessor(&per_cu, (const void*)fwd_kernel, NTHR, LDS_BYTES);
        if (per_cu < 1) { fprintf(stderr, "kernel_launch: occupancy query says %d blocks per CU\n", per_cu); per_cu = 1; }
        (void)hipGetLastError();
        grid = cus;
    }
    if (grid < 0) return;
    Params p{};
    const float** f = (const float**)&p;
    for (int i = 0; i < 25; ++i) f[i] = (const float*)d_in[i];
    p.out = (float*)d_out; p.ws = (unsigned char*)d_ws;
    auto run = [&](int lo, int hi) { void* args[] = {&p, &lo, &hi};
        hipError_t e = hipLaunchCooperativeKernel((const void*)fwd_kernel, dim3(grid), dim3(NTHR), args, LDS_BYTES, stream);
        if (e != hipSuccess) fprintf(stderr, "cooperative launch failed: %s (grid %d)\n", hipGetErrorString(e), grid); };
#if DBG == 0
    run(0, 16);
#else
    int cur = 0;
    auto upto = [&](int k) { run(cur, k + 1); cur = k + 1; };
    auto chk = [&](int which) { hipLaunchKernelGGL(chk_kernel, dim3(grid), dim3(NTHR), 4096, stream, p, which); };
#if DBG == 1
    upto(1); chk(1); upto(4); chk(4); upto(5); chk(5); upto(6); chk(6);
#else
    upto(7); chk(7); upto(8); chk(8); upto(9); chk(9); upto(10); chk(10); upto(11); chk(11); upto(12); chk(12);
#if DBG == 4
    upto(13); chk(13);
#endif
#endif
    chk(99);
#endif
}
```

```cpp
#include <hip/hip_runtime.h>
#include <hip/hip_cooperative_groups.h>
#include <cstdio>
#include <cstdint>
namespace cg = cooperative_groups;

typedef unsigned short bf16;
typedef short bf16x8 __attribute__((ext_vector_type(8)));
typedef short s16x4 __attribute__((ext_vector_type(4)));
typedef float f32x2 __attribute__((ext_vector_type(2)));
typedef float f32x4 __attribute__((ext_vector_type(4)));
typedef float f32x16 __attribute__((ext_vector_type(16)));
typedef unsigned u32x2 __attribute__((ext_vector_type(2)));
typedef unsigned u32x4 __attribute__((ext_vector_type(4)));
typedef __bf16 bf2_t __attribute__((ext_vector_type(2)));
#define DI __device__ __forceinline__
#define MFMA32(a, b, c) __builtin_amdgcn_mfma_f32_32x32x16_bf16((a), (b), (c), 0, 0, 0)

constexpr int NTHR = 512;
constexpr int T_TOK = 81920, TP = 16384, DM = 1024;
constexpr int NCHUNK = T_TOK / 128;
constexpr int DFF = 2816;
constexpr float EPS = 1e-6f;
constexpr int LDS_BYTES = 147456;

constexpr size_t AL(size_t x) { return (x + 255) & ~(size_t)255; }
constexpr size_t O_WIN = 0;
constexpr size_t O_WQKV = O_WIN + AL((size_t)2560 * 1024 * 2);
constexpr size_t O_WOUT = O_WQKV + AL((size_t)1792 * 384 * 2);
constexpr size_t O_WCIN = O_WOUT + AL((size_t)1024 * 1024 * 2);
constexpr size_t O_WCOUT = O_WCIN + AL((size_t)2048 * 1024 * 2);
constexpr size_t O_WUP = O_WCOUT + AL((size_t)1024 * 1024 * 2);
constexpr size_t O_WDN = O_WUP + 2 * AL((size_t)5632 * 1024 * 2);
constexpr size_t O_WSP = O_WDN + 2 * AL((size_t)1024 * 2816 * 2);
constexpr size_t O_ROPE = O_WSP + AL((size_t)8 * 128 * 128 * 2);
constexpr size_t O_SS = O_ROPE + AL((size_t)8192 * 32 * 4);
constexpr size_t O_VSS = O_SS + AL((size_t)T_TOK * 16);
constexpr size_t O_RQ = O_VSS + AL((size_t)T_TOK * 16);
constexpr size_t O_RKV = O_RQ + AL((size_t)T_TOK * 4);
constexpr size_t O_KR = O_RKV + AL((size_t)T_TOK * 4);
constexpr size_t O_G = O_KR + AL((size_t)T_TOK * 32 * 2);
constexpr size_t O_NS = O_G + AL((size_t)T_TOK * 16 * 4);
constexpr size_t O_ML = O_NS + AL((size_t)5120 * 128 * 4);
constexpr size_t O_BL = O_ML + AL((size_t)5120 * 4);
constexpr size_t O_MP = O_BL + AL((size_t)5120 * 4);
constexpr size_t O_XBG = O_MP + AL((size_t)5120 * 4);
constexpr size_t O_XB = O_XBG + 4096;
constexpr size_t O_AR = O_XB + AL((size_t)T_TOK * 1024 * 2);
constexpr size_t O_CQKV = O_AR;
constexpr size_t O_QC = O_CQKV + AL((size_t)T_TOK * 384 * 2);
constexpr size_t O_KC = O_QC + AL((size_t)T_TOK * 512 * 2);
constexpr size_t O_MV = O_KC + AL((size_t)T_TOK * 512 * 2);
constexpr size_t O_MO = O_MV + AL((size_t)T_TOK * 512 * 2);
constexpr size_t O_CS = O_MO + AL((size_t)T_TOK * 512 * 2);
constexpr size_t O_Y = O_CS + AL((size_t)5120 * 16384 * 2);
constexpr size_t O_END0 = O_Y + AL((size_t)T_TOK * 1024 * 2);
constexpr size_t O_Q = O_QC;
constexpr size_t O_KN = O_Q + AL((size_t)T_TOK * 768 * 2);
constexpr size_t O_VT = O_KN + AL((size_t)T_TOK * 512 * 2);
static_assert(O_VT + (size_t)T_TOK * 512 * 2 <= O_CS, "attention operands overlay");
constexpr size_t O_HID = O_AR;
constexpr size_t O_U = O_AR;
constexpr size_t O_V = O_U + AL((size_t)T_TOK * 1024 * 2);
constexpr size_t O_Z = O_V + AL((size_t)T_TOK * 1024 * 2);
constexpr size_t WS_NEED = O_END0;
static_assert(O_HID + (size_t)T_TOK * 2816 * 2 <= O_END0 && O_Z + (size_t)T_TOK * 2048 <= O_END0, "arena");

struct Params {
    const float* x_prompt; const float* x_sample;
    const float *ab_norm, *ab_w_in, *q_norm, *w_uq, *kv_norm, *w_ukv, *m_conv_w, *m_conv_b, *gate_bias, *m_out_norm, *ab_w_out;
    const float *c_norm, *c_w_in, *c_v_norm, *c_w_sp, *c_b_sp, *c_w_out;
    const float *ffn_norm, *ffn_w_up, *ffn_conv_w, *ffn_conv_b, *ffn_w_down, *final_norm;
    float* out; unsigned char* ws;
};

extern __shared__ __attribute__((aligned(16))) unsigned char g_lds[];

DI unsigned pk2(float lo, float hi) { f32x2 v = {lo, hi}; bf2_t b = __builtin_convertvector(v, bf2_t); return __builtin_bit_cast(unsigned, b); }
DI bf16 f2bf(float x) { return (bf16)(pk2(x, 0.f) & 0xffffu); }
DI float bf2f(bf16 x) { return __uint_as_float(((unsigned)x) << 16); }
DI float bflo(unsigned u) { return __uint_as_float(u << 16); }
DI float bfhi(unsigned u) { return __uint_as_float(u & 0xffff0000u); }
DI int seq_start(int sq) { return sq < 2 ? (sq << 13) : TP + ((sq - 2) << 12); }
DI int seq_len(int sq) { return sq < 2 ? 8192 : 4096; }
DI int seq_of(int t) { return t < TP ? (t >> 13) : 2 + ((t - TP) >> 12); }
DI float wave_sum(float v) {
#pragma unroll
    for (int o = 1; o < 64; o <<= 1) v += __shfl_xor(v, o);
    return v;
}
DI float frcp(float x) { return __builtin_amdgcn_rcpf(x); }
DI float sigmoidf_(float x) { return frcp(1.f + __builtin_amdgcn_exp2f(-1.4426950408889634f * x)); }
DI float siluf_(float x) { return x * frcp(1.f + __builtin_amdgcn_exp2f(-1.4426950408889634f * x)); }
DI float logsigmoidf_(float x) { return fminf(x, 0.f) - log1pf(__expf(-fabsf(x))); }
DI float geluf_(float v) {
    const float av = fabsf(v), t = frcp(1.f + 0.2316418882f * av);
    float q = t * 0.5307027145f + (-0.7265760135f); q = q * t + 0.7107068705f; q = q * t + (-0.142248368f); q = q * t + 0.127414796f; q = q * t;
    const float e = __builtin_amdgcn_exp2f(v * v * (-0.72134752044f));
    const float m = v * (q * e);
    return v < 0.f ? m : v - m;
}
DI f32x4 ld_ss(const f32x4* SS, int t) { return SS[t]; }
DI float rs_of(const f32x4* SS, int t) { f32x4 s = SS[t]; return rsqrtf(((s.x + s.y) + (s.z + s.w)) * (1.f / 1024.f) + EPS); }
DI const float* xin_row(const Params& p, int t) { return t < TP ? p.x_prompt + (size_t)t * DM : p.x_sample + (size_t)(t - TP) * DM; }

DI int srccol(int perm, int n) {
    if (perm == 1) { if (n < 416) return n; if (n < 432) return 2464 + (n - 416); if (n < 512) return -1; return n - 96; }
    if (perm == 2) { const int hd = (n & 511) >> 6, d = n & 63; return hd * 128 + (n >= 512 ? 64 : 0) + d; }
    if (perm == 3) { const int pn = n >> 8, c = n & 255; return c < 128 ? pn * 128 + c : 2816 + pn * 128 + (c - 128); }
    return n;
}
struct P0Job { const float* src; const float* gain; bf16* dst; int Nsrc, dld, dcol0, perm, k0, n0; };
DI void p0_job(const Params& p, int it, P0Job& J) {
    unsigned char* ws = p.ws; int r = it; int Nd;
    if (r < 640) { J.src = p.ab_w_in; J.Nsrc = 2480; Nd = 2560; J.dst = (bf16*)(ws + O_WIN); J.dld = 1024; J.dcol0 = 0; J.gain = p.ab_norm; J.perm = 1; }
    else if ((r -= 640) < 48) { J.src = p.w_uq; J.Nsrc = 768; Nd = 768; J.dst = (bf16*)(ws + O_WQKV); J.dld = 384; J.dcol0 = 0; J.gain = p.q_norm; J.perm = 0; }
    else if ((r -= 48) < 32) { J.src = p.w_ukv; J.Nsrc = 1024; Nd = 1024; J.dst = (bf16*)(ws + O_WQKV) + (size_t)768 * 384; J.dld = 384; J.dcol0 = 256; J.gain = p.kv_norm; J.perm = 2; }
    else if ((r -= 32) < 256) { J.src = p.ab_w_out; J.Nsrc = 1024; Nd = 1024; J.dst = (bf16*)(ws + O_WOUT); J.dld = 1024; J.dcol0 = 0; J.gain = nullptr; J.perm = 0; }
    else if ((r -= 256) < 512) { J.src = p.c_w_in; J.Nsrc = 2048; Nd = 2048; J.dst = (bf16*)(ws + O_WCIN); J.dld = 1024; J.dcol0 = 0; J.gain = p.c_norm; J.perm = 0; }
    else if ((r -= 512) < 256) { J.src = p.c_w_out; J.Nsrc = 1024; Nd = 1024; J.dst = (bf16*)(ws + O_WCOUT); J.dld = 1024; J.dcol0 = 0; J.gain = nullptr; J.perm = 0; }
    else if ((r -= 256) < 2816) { const int l = r / 1408; r -= l * 1408; J.src = p.ffn_w_up + (size_t)l * 1024 * 5632; J.Nsrc = 5632; Nd = 5632;
        J.dst = (bf16*)(ws + O_WUP + l * AL((size_t)5632 * 1024 * 2)); J.dld = 1024; J.dcol0 = 0; J.gain = p.ffn_norm + l * 1024; J.perm = 3; }
    else { r -= 2816; const int l = r / 704; r -= l * 704; J.src = p.ffn_w_down + (size_t)l * 2816 * 1024; J.Nsrc = 1024; Nd = 1024;
        J.dst = (bf16*)(ws + O_WDN + l * AL((size_t)1024 * 2816 * 2)); J.dld = 2816; J.dcol0 = 0; J.gain = nullptr; J.perm = 0; }
    const int nnt = Nd / 64; J.k0 = (r / nnt) * 64; J.n0 = (r % nnt) * 64;
}
DI void p0_load(const P0Job& J, int tid, float (&v)[8]) {
    const int j = tid & 63, sc = srccol(J.perm, J.n0 + j);
#pragma unroll
    for (int r = 0; r < 8; ++r) { const int k = J.k0 + (tid >> 6) + 8 * r; float x = 0.f; if (sc >= 0) { x = J.src[(size_t)k * J.Nsrc + sc]; if (J.gain) x *= J.gain[k]; } v[r] = x; }
}
DI void p0_row(const Params& p, int t, int lane) {
    bf16* XB = (bf16*)(p.ws + O_XB); f32x4* SS = (f32x4*)(p.ws + O_SS);
    const f32x4* xr = (const f32x4*)xin_row(p, t) + lane;
    f32x4 v[4]; float s = 0.f;
#pragma unroll
    for (int j = 0; j < 4; ++j) { v[j] = xr[64 * j]; s += (v[j].x * v[j].x + v[j].y * v[j].y) + (v[j].z * v[j].z + v[j].w * v[j].w); }
    s = wave_sum(s);
    u32x2* o = (u32x2*)(XB + (size_t)t * DM) + lane;
#pragma unroll
    for (int j = 0; j < 4; ++j) { u32x2 w; w.x = pk2(v[j].x, v[j].y); w.y = pk2(v[j].z, v[j].w); o[64 * j] = w; }
    if (lane == 0) { f32x4 q = {s, 0.f, 0.f, 0.f}; SS[t] = q; }
}
DI void p0_prologue(const Params& p) {
    unsigned char* ws = p.ws;
    int tid_ = threadIdx.x; asm volatile("" : "+v"(tid_)); const int tid = tid_;
    const int lane = tid & 63, NGW = gridDim.x * 8; int trow = blockIdx.x * 8 + (tid >> 6);
    constexpr int NJ = 5968;
    {
        float* tile = (float*)g_lds;
        P0Job J; float v[8]; int it = blockIdx.x;
        if (it < NJ) { p0_job(p, it, J); p0_load(J, tid, v); }
        for (; it < NJ; it += gridDim.x) {
#pragma unroll
            for (int r = 0; r < 8; ++r) tile[((tid >> 6) + 8 * r) * 65 + (tid & 63)] = v[r];
            __syncthreads();
            P0Job Jn = J; const int nit = it + gridDim.x;
            if (nit < NJ) { p0_job(p, nit, Jn); p0_load(Jn, tid, v); }
            const int n = tid >> 3, kc = (tid & 7) * 8;
            u32x4 o;
            o.x = pk2(tile[(kc + 0) * 65 + n], tile[(kc + 1) * 65 + n]); o.y = pk2(tile[(kc + 2) * 65 + n], tile[(kc + 3) * 65 + n]);
            o.z = pk2(tile[(kc + 4) * 65 + n], tile[(kc + 5) * 65 + n]); o.w = pk2(tile[(kc + 6) * 65 + n], tile[(kc + 7) * 65 + n]);
            *(u32x4*)(J.dst + (size_t)(J.n0 + n) * J.dld + J.dcol0 + J.k0 + kc) = o;
            if (trow < T_TOK) { p0_row(p, trow, lane); trow += NGW; }
            if (trow < T_TOK) { p0_row(p, trow, lane); trow += NGW; }
            __syncthreads();
            J = Jn;
        }
    }
    for (; trow < T_TOK; trow += NGW) p0_row(p, trow, lane);
    const int gt = blockIdx.x * NTHR + tid, GT = gridDim.x * NTHR;
    if (gt < 256) ((u32x4*)(ws + O_XBG))[gt] = (u32x4){0u, 0u, 0u, 0u};
    {
        bf16* W = (bf16*)(ws + O_WQKV); const u32x4 z = {0u, 0u, 0u, 0u};
        for (int v = gt; v < 768 * 16 + 1024 * 32; v += GT) {
            if (v < 768 * 16) { const int row = v >> 4, c = v & 15; *(u32x4*)(W + (size_t)row * 384 + 256 + c * 8) = z; }
            else { const int u = v - 768 * 16, row = 768 + (u >> 5), c = u & 31; *(u32x4*)(W + (size_t)row * 384 + c * 8) = z; }
        }
    }
    { bf16* W = (bf16*)(ws + O_WSP); for (int v = gt; v < 8 * 128 * 128; v += GT) W[v] = f2bf(p.c_w_sp[v]); }
    { float* RC = (float*)(ws + O_ROPE); float* RSN = RC + 8192 * 16;
      for (int v = gt; v < 8192 * 16; v += GT) { const int pos = v >> 4, i = v & 15; const float inv = 1.0f / powf(10000.f, (float)i * (1.f / 16.f)); const float ang = (float)pos * inv;
        float s, c; sincosf(ang, &s, &c); RC[v] = c; RSN[v] = s; } }
}

#define LAS __attribute__((address_space(3)))
constexpr int STAGE_BYTES = 131072;
constexpr int EPI_OFF = 131072;
DI int lds_byte(int r, int c) { const int st = (r >> 4) * 2 + (c >> 5), rr = r & 15, cc = c & 31, ob = rr * 64 + cc * 2; return st * 1024 + (ob ^ (((ob >> 9) & 1) << 5)); }
DI void stage_rc(int b, int& R, int& C) { const int st = b / 1024, sb = b % 1024, swz = sb ^ (((sb >> 9) & 1) << 5); R = (st >> 1) * 16 + swz / 64; C = (st & 1) * 32 + (swz % 64) / 2; }

struct Gemm { const bf16* A; const bf16* Bt; int K, nM, nN, overlap; int kmode = 0; };
typedef f32x4 Acc[2][2][4][2];
struct Unit { int pm, pn, tbase, kofs, nt; };

DI void tile_rows(int overlap, int pm, int& tbase, int& s0, int& slen) {
    s0 = 0; slen = T_TOK;
    if (!overlap) tbase = pm * 256; else tbase = 254 * pm - 1;
}
DI bool seq_first(int t) { return t < TP ? (t & 8191) == 0 : (t & 4095) == 0; }
DI bool tile_has_seam(int tbase) { const int nb = ((tbase + 1 + 4095) >> 12) << 12; return nb <= tbase + 255; }
constexpr int NM_PLAIN = 320, NM_OVL = 323;
DI bool next_unit(const Gemm& g, int i, Unit& u) {
    const int nM = g.nM, nN = g.nN, nwg = nM * nN; const long L = (long)i * gridDim.x + blockIdx.x; if (L >= nwg) return false;
    int wgid = (int)L; { const int q = nwg / 8, r = nwg % 8, xcd = wgid % 8, off = wgid / 8; wgid = (xcd < r ? xcd * (q + 1) : r * (q + 1) + (xcd - r) * q) + off; }
    const int nig = 8 * nN, gid = wgid / nig, fm = gid * 8, gsz = (nM - fm) < 8 ? (nM - fm) : 8;
    u.pm = fm + ((wgid % nig) % gsz); u.pn = (wgid % nig) / gsz;
    int s0, slen; tile_rows(g.overlap, u.pm, u.tbase, s0, slen);
    if (g.kmode) { u.kofs = u.pn < 3 ? 0 : 512; u.nt = u.pn < 3 ? 4 : 2; } else { u.kofs = 0; u.nt = g.K / 64; }
    return true;
}

#define DPP_ROR1(x) __builtin_bit_cast(float, __builtin_amdgcn_update_dpp(0, __builtin_bit_cast(int, (x)), 0x121, 0xf, 0xf, false))
#define DPP_ROL1(x) __builtin_bit_cast(float, __builtin_amdgcn_update_dpp(0, __builtin_bit_cast(int, (x)), 0x12F, 0xf, 0xf, false))

template <class F> DI void row_reduce(float (&part)[2][4], int wr, int wc, int fr, int fq, F&& f) {
    float* red = (float*)(g_lds + EPI_OFF);
#pragma unroll
    for (int ai = 0; ai < 2; ++ai)
#pragma unroll
        for (int m = 0; m < 4; ++m) { float v = part[ai][m]; v += __shfl_xor(v, 16); v += __shfl_xor(v, 32);
            if (fq == 0) red[(ai * 128 + wr * 64 + m * 16 + fr) * 4 + wc] = v; }
    __syncthreads();
    if (threadIdx.x < 256) { const f32x4 s = *(const f32x4*)(red + threadIdx.x * 4); f((int)threadIdx.x, (s.x + s.y) + (s.z + s.w)); }
    __syncthreads();
}
DI void conv_exchange(const Acc& acc, int wr, int wc, int fr, int fq) {
    float* bnd = (float*)(g_lds + EPI_OFF + 4096);
#pragma unroll
    for (int ai = 0; ai < 2; ++ai)
#pragma unroll
        for (int bj = 0; bj < 2; ++bj)
#pragma unroll
            for (int n = 0; n < 2; ++n) { const int colL = bj * 128 + wc * 32 + n * 16 + fq * 4, rb = ai * 2 + wr;
                if (fr == 0) *(f32x4*)(bnd + (0 * 4 + rb) * 256 + colL) = acc[ai][bj][0][n];
                if (fr == 15) *(f32x4*)(bnd + (1 * 4 + rb) * 256 + colL) = acc[ai][bj][3][n]; }
    __syncthreads();
}
#undef DPP_ROR1
#undef DPP_ROL1
#define DPP_ROR1(x) __builtin_bit_cast(float, __builtin_amdgcn_update_dpp(__builtin_bit_cast(int, (x)), __builtin_bit_cast(int, (x)), 0x121, 0xf, 0xf, false))
#define DPP_ROL1(x) __builtin_bit_cast(float, __builtin_amdgcn_update_dpp(__builtin_bit_cast(int, (x)), __builtin_bit_cast(int, (x)), 0x12F, 0xf, 0xf, false))
DI f32x4 ror4(const f32x4 v) { f32x4 r; asm volatile("s_nop 1\n\tv_mov_b32_dpp %0, %4 row_ror:1 row_mask:0xf bank_mask:0xf\n\tv_mov_b32_dpp %1, %5 row_ror:1 row_mask:0xf bank_mask:0xf\n\tv_mov_b32_dpp %2, %6 row_ror:1 row_mask:0xf bank_mask:0xf\n\tv_mov_b32_dpp %3, %7 row_ror:1 row_mask:0xf bank_mask:0xf"
    : "=&v"(r.x), "=&v"(r.y), "=&v"(r.z), "=&v"(r.w) : "v"(v.x), "v"(v.y), "v"(v.z), "v"(v.w)); return r; }
DI f32x4 rol4(const f32x4 v) { f32x4 r; asm volatile("s_nop 1\n\tv_mov_b32_dpp %0, %4 row_ror:15 row_mask:0xf bank_mask:0xf\n\tv_mov_b32_dpp %1, %5 row_ror:15 row_mask:0xf bank_mask:0xf\n\tv_mov_b32_dpp %2, %6 row_ror:15 row_mask:0xf bank_mask:0xf\n\tv_mov_b32_dpp %3, %7 row_ror:15 row_mask:0xf bank_mask:0xf"
    : "=&v"(r.x), "=&v"(r.y), "=&v"(r.z), "=&v"(r.w) : "v"(v.x), "v"(v.y), "v"(v.z), "v"(v.w)); return r; }
template <int BJ, int N, int AI, int M> DI f32x4 conv_row(const Acc& acc, const f32x4 w0, const f32x4 w1, const f32x4 w2, const f32x4 b, const f32x4 upB, const f32x4 dnB, int fr) {
    const f32x4 v = acc[AI][BJ][M][N];
    const f32x4 pu = M > 0 ? ror4(acc[AI][BJ][M > 0 ? M - 1 : 0][N]) : upB;
    const f32x4 nd = M < 3 ? rol4(acc[AI][BJ][M < 3 ? M + 1 : 3][N]) : dnB;
    const f32x4 rv_ = ror4(v), lv_ = rol4(v);
    const f32x4 up = fr > 0 ? rv_ : pu, dn = fr < 15 ? lv_ : nd;
    f32x4 r_ = w0 * up + w1 * v + w2 * dn + b;
    asm volatile("" : "+v"(r_.x), "+v"(r_.y), "+v"(r_.z), "+v"(r_.w));
    return r_;
}
template <int BJ, int N, int AI> DI void conv_bnd(int wr, int wc, int fq, f32x4& upB, f32x4& dnB) {
    const float* bnd = (const float*)(g_lds + EPI_OFF + 4096);
    const int colL = BJ * 128 + wc * 32 + N * 16 + fq * 4, rb = AI * 2 + wr; const f32x4 z4 = {0.f, 0.f, 0.f, 0.f};
    upB = rb > 0 ? *(const f32x4*)(bnd + (4 + rb - 1) * 256 + colL) : z4; dnB = rb < 3 ? *(const f32x4*)(bnd + (rb + 1) * 256 + colL) : z4;
}

template <int BJ, int N, int AI> DI void conv4(const Acc& acc, const f32x4 w0, const f32x4 w1, const f32x4 w2, const f32x4 b, const f32x4 upB, const f32x4 dnB, int fr, f32x4 (&out)[4]) {
    f32x4 rprev = upB, lcur = rol4(acc[AI][BJ][0][N]);
#pragma unroll
    for (int M = 0; M < 4; ++M) { const f32x4 v = acc[AI][BJ][M][N]; const f32x4 rv_ = ror4(v); f32x4 lnext = dnB; if (M < 3) lnext = rol4(acc[AI][BJ][M < 3 ? M + 1 : 3][N]);
        const f32x4 up = fr > 0 ? rv_ : rprev, dn = fr < 15 ? lcur : lnext;
        out[M] = w0 * up + w1 * v + w2 * dn + b; rprev = rv_; lcur = lnext; }
}
#define FOR_ROWS(...) _Pragma("unroll") for (int ai = 0; ai < 2; ++ai) _Pragma("unroll") for (int m = 0; m < 4; ++m) { \
    const int row = ai * 128 + wr * 64 + m * 16 + fr; const int tg = tbase + row; const bool ok = (tg >= s0) && (tg < s0 + slen) && (!OVL || (row >= 1 && row <= 254)); (void)ok; __VA_ARGS__ }
#define FOR_COLS(...) _Pragma("unroll") for (int bj = 0; bj < 2; ++bj) _Pragma("unroll") for (int n = 0; n < 2; ++n) { const int colL = bj * 128 + wc * 32 + n * 16 + fq * 4; (void)colL; __VA_ARGS__ }
DI void st_bf4(bf16* p, const f32x4 v) { u32x2 w; w.x = pk2(v.x, v.y); w.y = pk2(v.z, v.w); *(u32x2*)p = w; }
DI void st_bf8(bf16* p, const f32x4 a, const f32x4 b) { u32x4 w; w.x = pk2(a.x, a.y); w.y = pk2(a.z, a.w); w.z = pk2(b.x, b.y); w.w = pk2(b.z, b.w); *(u32x4*)p = w; }
DI float sq4(const f32x4 v) { return (v.x * v.x + v.y * v.y) + (v.z * v.z + v.w * v.w); }

struct EpiIn {
    Params p;
    DI void operator()(Acc& acc, const Unit& u, int wr, int wc, int fr, int fq) const {
        constexpr bool OVL = true; unsigned char* ws = p.ws; const int pn = u.pn; int tbase, s0, slen; tile_rows(1, u.pm, tbase, s0, slen); const bool hb_ = tile_has_seam(tbase); (void)hb_;
        const f32x4* SS = (const f32x4*)(ws + O_SS);
        FOR_ROWS({ const bool val = (tg >= s0) && (tg < s0 + slen); const float rs = val ? rs_of(SS, tg) : 0.f;
            _Pragma("unroll") for (int bj = 0; bj < 2; ++bj) _Pragma("unroll") for (int n = 0; n < 2; ++n) acc[ai][bj][m][n] *= rs; })
        if (pn == 0) {
            bf16* CQ = (bf16*)(ws + O_CQKV); float* RQ = (float*)(ws + O_RQ); float part[2][4];
            FOR_ROWS({ float s = 0.f; FOR_COLS({ const f32x4 v = acc[ai][bj][m][n]; s += sq4(v); if (ok) st_bf4(CQ + (size_t)tg * 384 + colL, v); }) part[ai][m] = s; })
            row_reduce(part, wr, wc, fr, fq, [&](int row, float ss) { const int tg = tbase + row; if (tg >= s0 && tg < s0 + slen && row >= 1 && row <= 254) RQ[tg] = rsqrtf(ss * (1.f / 256.f) + EPS); });
        } else if (pn == 1) {
            bf16* CQ = (bf16*)(ws + O_CQKV); float* RKV = (float*)(ws + O_RKV); float part[2][4];
            FOR_ROWS({ float s = 0.f; _Pragma("unroll") for (int n = 0; n < 2; ++n) { const f32x4 v = acc[ai][0][m][n]; s += sq4(v); if (ok) st_bf4(CQ + (size_t)tg * 384 + 256 + wc * 32 + n * 16 + fq * 4, v); } part[ai][m] = s; })
            row_reduce(part, wr, wc, fr, fq, [&](int row, float ss) { const int tg = tbase + row; if (tg >= s0 && tg < s0 + slen && row >= 1 && row <= 254) RKV[tg] = rsqrtf(ss * (1.f / 128.f) + EPS); });
            if (wc == 0) {
                const float* RC = (const float*)(ws + O_ROPE); const float* RSN = RC + 8192 * 16; bf16* KR = (bf16*)(ws + O_KR);
                FOR_ROWS({ if (ok) { const int pos = tg - seq_start(seq_of(tg)); const f32x4 c = *(const f32x4*)(RC + pos * 16 + fq * 4), s = *(const f32x4*)(RSN + pos * 16 + fq * 4); const f32x4 x1 = acc[ai][1][m][0], x2 = acc[ai][1][m][1];
                    st_bf4(KR + (size_t)tg * 32 + fq * 4, x1 * c - x2 * s); st_bf4(KR + (size_t)tg * 32 + 16 + fq * 4, x2 * c + x1 * s); } })
            } else if (wc == 1) {
                float* G = (float*)(ws + O_G); const f32x4 gb = *(const f32x4*)(p.gate_bias + fq * 4); const bool isf = fq & 1;
                FOR_ROWS({ if (ok) { f32x4 v = acc[ai][1][m][0] + gb; if (isf) { v.x = logsigmoidf_(v.x); v.y = logsigmoidf_(v.y); v.z = logsigmoidf_(v.z); v.w = logsigmoidf_(v.w); } *(f32x4*)(G + (size_t)tg * 16 + fq * 4) = v; } })
            }
        } else if (pn < 6) {
            conv_exchange(acc, wr, wc, fr, fq);
            const float* cw = p.m_conv_w; const float* cb = p.m_conv_b; const int chb = (pn - 2) * 256 + wc * 32 + fq * 4;
            const bool isK = pn >= 4; bf16* dst = (bf16*)(ws + (isK ? O_KC : O_QC)); const float sc = isK ? 0.08838834764831845f : 1.f; const int cb0 = (pn - (isK ? 4 : 2)) * 256;
#define CA_(BJ, N, AI) { f32x4 upB, dnB; conv_bnd<BJ, N, AI>(wr, wc, fq, upB, dnB); f32x4 rp_ = upB, lc_ = rol4(acc[AI][BJ][0][N]); \
        _Pragma("unroll") for (int M = 0; M < 4; ++M) { const int row = AI * 128 + wr * 64 + M * 16 + fr, tg = tbase + row; const f32x4 a_ = acc[AI][BJ][M][N]; const f32x4 ra_ = ror4(a_); f32x4 ln_ = dnB; if (M < 3) ln_ = rol4(acc[AI][BJ][M < 3 ? M + 1 : 3][N]); \
            f32x4 up_ = fr > 0 ? ra_ : rp_, dn_ = fr < 15 ? lc_ : ln_; if (hb_) { const f32x4 z_ = {0.f, 0.f, 0.f, 0.f}; if (seq_first(tg)) up_ = z_; if (seq_first(tg + 1)) dn_ = z_; } const f32x4 v = w0 * up_ + w1 * a_ + w2 * dn_ + bb; rp_ = ra_; lc_ = ln_; \
            if ((tg >= s0) && (tg < s0 + slen) && row >= 1 && row <= 254) st_bf4(dst + (size_t)tg * 512 + cb0 + BJ * 128 + wc * 32 + N * 16 + fq * 4, (f32x4){siluf_(v.x) * sc, siluf_(v.y) * sc, siluf_(v.z) * sc, siluf_(v.w) * sc}); __builtin_amdgcn_sched_barrier(0); } }
#define CS_(BJ, N) { const int ch = chb + BJ * 128 + N * 16; const f32x4 w0 = *(const f32x4*)(cw + ch), w1 = *(const f32x4*)(cw + 1024 + ch), w2 = *(const f32x4*)(cw + 2048 + ch), bb = *(const f32x4*)(cb + ch); CA_(BJ, N, 0) CA_(BJ, N, 1) }
            CS_(0, 0) CS_(0, 1) CS_(1, 0) CS_(1, 1)
#undef CS_
#undef CA_
        } else if (pn < 8) {
            bf16* MV = (bf16*)(ws + O_MV); const int cb0 = (pn - 6) * 256;
            FOR_ROWS({ if (ok) { FOR_COLS({ st_bf4(MV + (size_t)tg * 512 + cb0 + colL, acc[ai][bj][m][n]); }) } })
        } else {
            bf16* MO = (bf16*)(ws + O_MO); const int cb0 = (pn - 8) * 256;
            FOR_ROWS({ if (ok) { FOR_COLS({ const f32x4 v = acc[ai][bj][m][n]; st_bf4(MO + (size_t)tg * 512 + cb0 + colL, (f32x4){sigmoidf_(v.x), sigmoidf_(v.y), sigmoidf_(v.z), sigmoidf_(v.w)}); }) } })
        }
    }
};
struct EpiQkv {
    Params p;
    DI void operator()(Acc& acc, const Unit& u, int wr, int wc, int fr, int fq) const {
        constexpr bool OVL = false; const int s0 = 0, slen = T_TOK, tbase = u.tbase, pn = u.pn; unsigned char* ws = p.ws;
        const float* RS = (const float*)(ws + (pn < 3 ? O_RQ : O_RKV));
        if (pn < 3) {
            bf16* Q = (bf16*)(ws + O_Q); const float* RC = (const float*)(ws + O_ROPE); const float* RSN = RC + 8192 * 16;
            const float qs = 0.10206207261596577f * 1.4426950408889634f;
            float rsv[2][4]; f32x4 rc_[2][4], rn_[2][4]; const bool rope_w = ((pn * 256 + wc * 32) % 96 == 64) || ((pn * 256 + 128 + wc * 32) % 96 == 64);
            FOR_ROWS({ rsv[ai][m] = RS[tg] * qs; rc_[ai][m] = (f32x4){1.f, 1.f, 1.f, 1.f}; rn_[ai][m] = (f32x4){0.f, 0.f, 0.f, 0.f}; if (rope_w) { const int pos_ = tg - seq_start(seq_of(tg)); rc_[ai][m] = *(const f32x4*)(RC + pos_ * 16 + fq * 4); rn_[ai][m] = *(const f32x4*)(RSN + pos_ * 16 + fq * 4); } })
            FOR_ROWS({ const float rs = rsv[ai][m];
                _Pragma("unroll") for (int bj = 0; bj < 2; ++bj) { const int base32 = pn * 256 + bj * 128 + wc * 32; const f32x4 v0 = acc[ai][bj][m][0] * rs, v1 = acc[ai][bj][m][1] * rs;
                    f32x4 o0 = v0, o1 = v1;
                    if (base32 % 96 == 64) { const f32x4 c = rc_[ai][m], s = rn_[ai][m]; o0 = v0 * c - v1 * s; o1 = v1 * c + v0 * s; }
                    st_bf4(Q + (size_t)tg * 768 + base32 + fq * 4, o0); st_bf4(Q + (size_t)tg * 768 + base32 + 16 + fq * 4, o1); } })
        } else if (pn < 5) {
            bf16* KN = (bf16*)(ws + O_KN); const int cb0 = (pn - 3) * 256;
            float rsv[2][4]; FOR_ROWS({ rsv[ai][m] = RS[tg]; })
            FOR_ROWS({ const float rs = rsv[ai][m]; FOR_COLS({ st_bf4(KN + (size_t)tg * 512 + cb0 + colL, acc[ai][bj][m][n] * rs); }) })
        } else {
            bf16* VT = (bf16*)(ws + O_VT); const int cb0 = (pn - 5) * 256;
            float rsv[2][4]; FOR_ROWS({ rsv[ai][m] = RS[tg]; })
            FOR_ROWS({ const float rs = rsv[ai][m]; const int sq = seq_of(tg), st = seq_start(sq), S = seq_len(sq), pos = tg - st; bf16* base = VT + (size_t)st * 512 + pos;
                FOR_COLS({ const int c = cb0 + colL; const f32x4 v = acc[ai][bj][m][n] * rs;
                    base[(size_t)c * S] = f2bf(v.x); base[(size_t)(c + 1) * S] = f2bf(v.y); base[(size_t)(c + 2) * S] = f2bf(v.z); base[(size_t)(c + 3) * S] = f2bf(v.w); }) })
        }
    }
};
struct EpiRes {
    Params p; int first, nobf;
    DI void operator()(Acc& acc, const Unit& u, int wr, int wc, int fr, int fq) const {
        const int tbase = u.tbase, pn = u.pn; unsigned char* ws = p.ws;
        bf16* XB = (bf16*)(ws + O_XB); float* SS = (float*)(ws + O_SS); float part[2][4];
#pragma unroll
        for (int ai = 0; ai < 2; ++ai) { f32x4 res[4][2][2];
#pragma unroll
            for (int m = 0; m < 4; ++m) { const int tg = tbase + ai * 128 + wr * 64 + m * 16 + fr; const float* rr = (first ? xin_row(p, tg) : p.out + (size_t)tg * DM) + pn * 256 + wc * 32 + 8 * fq;
#pragma unroll
                for (int bj = 0; bj < 2; ++bj) { res[m][bj][0] = *(const f32x4*)(rr + bj * 128); res[m][bj][1] = *(const f32x4*)(rr + bj * 128 + 4); } }
#pragma unroll
            for (int m = 0; m < 4; ++m) { const int tg = tbase + ai * 128 + wr * 64 + m * 16 + fr; const int c0 = pn * 256 + wc * 32 + 8 * fq; float* orow = p.out + (size_t)tg * DM + c0; bf16* xrow = XB + (size_t)tg * DM + c0; float s = 0.f;
#pragma unroll
                for (int bj = 0; bj < 2; ++bj) { const f32x4 v0 = res[m][bj][0] + acc[ai][bj][m][0], v1 = res[m][bj][1] + acc[ai][bj][m][1];
                    *(f32x4*)(orow + bj * 128) = v0; *(f32x4*)(orow + bj * 128 + 4) = v1; if (!nobf) st_bf8(xrow + bj * 128, v0, v1); s += sq4(v0) + sq4(v1); }
                part[ai][m] = s; } }
        row_reduce(part, wr, wc, fr, fq, [&](int row, float ss) { SS[(size_t)(tbase + row) * 4 + pn] = ss; });
    }
};
struct EpiUp {
    Params p; int layer;
    DI void operator()(Acc& acc, const Unit& u, int wr, int wc, int fr, int fq) const {
        constexpr bool OVL = true; unsigned char* ws = p.ws; const int pn = u.pn; int tbase, s0, slen; tile_rows(1, u.pm, tbase, s0, slen); const bool hb_ = tile_has_seam(tbase); (void)hb_;
        const f32x4* SS = (const f32x4*)(ws + O_SS);
        FOR_ROWS({ const bool val = (tg >= s0) && (tg < s0 + slen); const float rs = val ? rs_of(SS, tg) : 0.f;
            _Pragma("unroll") for (int bj = 0; bj < 2; ++bj) _Pragma("unroll") for (int n = 0; n < 2; ++n) acc[ai][bj][m][n] *= rs; })
        conv_exchange(acc, wr, wc, fr, fq);
        const float* cw = p.ffn_conv_w + (size_t)layer * 3 * 5632; const float* cb = p.ffn_conv_b + (size_t)layer * 5632; const int chb = pn * 128 + wc * 32 + fq * 4;
        bf16* HID = (bf16*)(ws + O_HID);
#define CA_(N, AI) { f32x4 upG, dnG, upV, dnV; conv_bnd<0, N, AI>(wr, wc, fq, upG, dnG); conv_bnd<1, N, AI>(wr, wc, fq, upV, dnV); \
        f32x4 rpg_ = upG, lcg_ = rol4(acc[AI][0][0][N]), rpv_ = upV, lcv_ = rol4(acc[AI][1][0][N]); \
        _Pragma("unroll") for (int M = 0; M < 4; ++M) { const int row = AI * 128 + wr * 64 + M * 16 + fr, tg = tbase + row; const f32x4 a_ = acc[AI][0][M][N], b_ = acc[AI][1][M][N]; const f32x4 rga_ = ror4(a_), rvb_ = ror4(b_); \
            f32x4 lng_ = dnG, lnv_ = dnV; if (M < 3) { lng_ = rol4(acc[AI][0][M < 3 ? M + 1 : 3][N]); lnv_ = rol4(acc[AI][1][M < 3 ? M + 1 : 3][N]); } \
            f32x4 ug_ = fr > 0 ? rga_ : rpg_, dg_ = fr < 15 ? lcg_ : lng_, uv_ = fr > 0 ? rvb_ : rpv_, dv_ = fr < 15 ? lcv_ : lnv_; if (hb_) { const f32x4 z_ = {0.f, 0.f, 0.f, 0.f}; if (seq_first(tg)) { ug_ = z_; uv_ = z_; } if (seq_first(tg + 1)) { dg_ = z_; dv_ = z_; } } const f32x4 g = g0 * ug_ + g1 * a_ + g2 * dg_ + gb, v = v0 * uv_ + v1 * b_ + v2 * dv_ + vb; rpg_ = rga_; lcg_ = lng_; rpv_ = rvb_; lcv_ = lnv_; \
            if ((tg >= s0) && (tg < s0 + slen) && row >= 1 && row <= 254) st_bf4(HID + (size_t)tg * DFF + chb + N * 16, (f32x4){siluf_(g.x) * v.x, siluf_(g.y) * v.y, siluf_(g.z) * v.z, siluf_(g.w) * v.w}); __builtin_amdgcn_sched_barrier(0); } }
#define CS_(N) { const int cg_ = chb + N * 16, cv2_ = 2816 + chb + N * 16; \
        const f32x4 g0 = *(const f32x4*)(cw + cg_), g1 = *(const f32x4*)(cw + 5632 + cg_), g2 = *(const f32x4*)(cw + 11264 + cg_), gb = *(const f32x4*)(cb + cg_); \
        const f32x4 v0 = *(const f32x4*)(cw + cv2_), v1 = *(const f32x4*)(cw + 5632 + cv2_), v2 = *(const f32x4*)(cw + 11264 + cv2_), vb = *(const f32x4*)(cb + cv2_); CA_(N, 0) CA_(N, 1) }
        CS_(0) CS_(1)
#undef CS_
#undef CA_
    }
};
struct EpiGin {
    Params p;
    DI void operator()(Acc& acc, const Unit& u, int wr, int wc, int fr, int fq) const {
        constexpr bool OVL = false; const int s0 = 0, slen = T_TOK, tbase = u.tbase, pn = u.pn; unsigned char* ws = p.ws;
        const f32x4* SS = (const f32x4*)(ws + O_SS);
        bf16* dst = (bf16*)(ws + (pn < 4 ? O_U : O_V)); const int cb0 = (pn & 3) * 256 + wc * 32 + 8 * fq; float part[2][4];
        float rsv[2][4]; FOR_ROWS({ rsv[ai][m] = rs_of(SS, tg); })
        FOR_ROWS({ const float rs = rsv[ai][m]; float s = 0.f;
            _Pragma("unroll") for (int bj = 0; bj < 2; ++bj) { f32x4 v0 = acc[ai][bj][m][0] * rs, v1 = acc[ai][bj][m][1] * rs;
                v0.x = geluf_(v0.x); v0.y = geluf_(v0.y); v0.z = geluf_(v0.z); v0.w = geluf_(v0.w); v1.x = geluf_(v1.x); v1.y = geluf_(v1.y); v1.z = geluf_(v1.z); v1.w = geluf_(v1.w);
                s += sq4(v0) + sq4(v1); st_bf8(dst + (size_t)tg * DM + cb0 + bj * 128, v0, v1); } part[ai][m] = s; })
        if (pn >= 4) { float* VSS = (float*)(ws + O_VSS); row_reduce(part, wr, wc, fr, fq, [&](int row, float ss) { VSS[(size_t)(tbase + row) * 4 + (pn - 4)] = ss; }); }
    }
};

DI int perm32(int rho) { const int n = rho >> 4, i = rho & 15; return 8 * (i >> 2) + 4 * n + (i & 3); }
template <class Epi, bool PERM = false> DI void gemm_phase(const Gemm g, const Epi& E) {
    LAS unsigned char* lds = (LAS unsigned char*)g_lds;
    int tid_ = threadIdx.x; asm volatile("" : "+v"(tid_));
    const int tid = tid_, wid = __builtin_amdgcn_readfirstlane(tid >> 6), lane = tid & 63, wr = wid >> 2, wc = wid & 3, fr = lane & 15, fq = lane >> 4;
    const int K = g.K;
    unsigned voff[2], voffB[2];
#pragma unroll
    for (int i = 0; i < 2; ++i) { int R, C; stage_rc(tid * 16 + i * 8192, R, C); voff[i] = (unsigned)(R * K + C) * 2u; const int Rb = PERM ? ((R & ~31) + perm32(R & 31)) : R; voffB[i] = (unsigned)(Rb * K + C) * 2u; }
    const size_t kstep = 128, hstep = (size_t)128 * K * 2, tstep = 2 * hstep;
    const unsigned ldsw = (unsigned)wid * 1024u;
    const int aoff = lds_byte(wr * 64 + fr, fq * 8), boff = lds_byte(wc * 32 + fr, fq * 8);
#define PG8_SA(b, h) (((b) * 2 + (h)) * 16384)
#define PG8_SB(b, h) ((4 + (b) * 2 + (h)) * 16384)
#define PG8_STAGEX(bufoff, gbase, vo) do { _Pragma("unroll") for (int _i = 0; _i < 2; ++_i) \
        __builtin_amdgcn_global_load_lds((const unsigned*)((const char*)(gbase) + vo[_i]), (LAS unsigned*)(lds + (bufoff) + ldsw + _i * 8192), 16, 0, 0); } while (0)
#define PG8_LDA(dst, b, h) do { _Pragma("unroll") for (int m = 0; m < 4; ++m) _Pragma("unroll") for (int k = 0; k < 2; ++k) dst[m][k] = *(const LAS bf16x8*)(lds + PG8_SA(b, h) + aoff + m * 2048 + k * 1024); } while (0)
#define PG8_LDB(dst, b, h) do { _Pragma("unroll") for (int n = 0; n < 2; ++n) _Pragma("unroll") for (int k = 0; k < 2; ++k) dst[n][k] = *(const LAS bf16x8*)(lds + PG8_SB(b, h) + boff + n * 2048 + k * 1024); } while (0)
#define PG8_MMA(ai, bj, At, Bt) do { __builtin_amdgcn_s_setprio(1); _Pragma("unroll") for (int m = 0; m < 4; ++m) _Pragma("unroll") for (int n = 0; n < 2; ++n) _Pragma("unroll") for (int k = 0; k < 2; ++k) \
        acc[ai][bj][m][n] = __builtin_amdgcn_mfma_f32_16x16x32_bf16(Bt[n][k], At[m][k], acc[ai][bj][m][n], 0, 0, 0); __builtin_amdgcn_s_setprio(0); } while (0)
#define PG8_WAIT_V(n) asm volatile("s_waitcnt vmcnt(" #n ")" ::: "memory")
#define PG8_WAIT_L(n) asm volatile("s_waitcnt lgkmcnt(" #n ")" ::: "memory")
#define PG8_BAR __builtin_amdgcn_s_barrier()
#define PG8_SCHED __builtin_amdgcn_sched_barrier(0)
    Unit cur, nxt; int ui = 0;
    if (!next_unit(g, 0, cur)) return;
    Acc acc;
#pragma unroll
    for (int a = 0; a < 2; ++a)
#pragma unroll
        for (int b = 0; b < 2; ++b)
#pragma unroll
            for (int m = 0; m < 4; ++m)
#pragma unroll
                for (int n = 0; n < 2; ++n) acc[a][b][m][n] = (f32x4){0.f, 0.f, 0.f, 0.f};
    bf16x8 At[4][2], B0[2][2], B1[2][2];
    const char* cA = (const char*)g.A + (ptrdiff_t)cur.tbase * (ptrdiff_t)(K * 2) + cur.kofs; const char* cB = (const char*)g.Bt + (size_t)cur.pn * tstep + cur.kofs;
    PG8_STAGEX(PG8_SB(0, 0), cB, voffB); PG8_STAGEX(PG8_SB(0, 1), cB + hstep, voffB); PG8_STAGEX(PG8_SA(0, 0), cA, voff); PG8_STAGEX(PG8_SA(0, 1), cA + hstep, voff);
    if (wr == 1) PG8_BAR;
    PG8_WAIT_V(2); PG8_BAR;
    PG8_STAGEX(PG8_SB(1, 0), cB + kstep, voffB); PG8_STAGEX(PG8_SA(1, 0), cA + kstep, voff); PG8_STAGEX(PG8_SB(1, 1), cB + hstep + kstep, voffB);
    PG8_WAIT_V(6); PG8_BAR;
    for (;;) {
        const bool has_next = next_unit(g, ui + 1, nxt);
        const char* nA = has_next ? (const char*)g.A + (ptrdiff_t)nxt.tbase * (ptrdiff_t)(K * 2) + nxt.kofs : cA; const char* nB = has_next ? (const char*)g.Bt + (size_t)nxt.pn * tstep + nxt.kofs : cB;
        const int nt = cur.nt;
        for (int t = 0; t < nt; t += 2) {
            const bool last = (t == nt - 2);
            const char* a1 = cA + (size_t)(t + 1) * kstep;
            const char* a2 = last ? nA : cA + (size_t)(t + 2) * kstep; const char* b2 = last ? nB : cB + (size_t)(t + 2) * kstep;
            const char* a3 = a2 + kstep; const char* b3 = b2 + kstep;
            PG8_LDB(B0, 0, 0); PG8_LDB(B1, 0, 1); PG8_SCHED; PG8_LDA(At, 0, 0); PG8_STAGEX(PG8_SA(1, 1), a1 + hstep, voff);
            PG8_WAIT_V(8); PG8_WAIT_L(0); PG8_BAR; PG8_MMA(0, 0, At, B0); PG8_MMA(0, 1, At, B1); PG8_BAR; PG8_SCHED;
            PG8_LDA(At, 0, 1); PG8_STAGEX(PG8_SB(0, 0), b2, voffB); PG8_STAGEX(PG8_SB(0, 1), b2 + hstep, voffB); PG8_STAGEX(PG8_SA(0, 0), a2, voff);
            PG8_WAIT_V(8); PG8_WAIT_L(0); PG8_BAR; PG8_MMA(1, 0, At, B0); PG8_MMA(1, 1, At, B1); PG8_BAR; PG8_SCHED;
            PG8_LDB(B0, 1, 0); PG8_LDB(B1, 1, 1); PG8_SCHED; PG8_LDA(At, 1, 0); PG8_STAGEX(PG8_SA(0, 1), a2 + hstep, voff);
            PG8_WAIT_V(8); PG8_WAIT_L(0); PG8_BAR; PG8_MMA(0, 0, At, B0); PG8_MMA(0, 1, At, B1); PG8_BAR; PG8_SCHED;
            PG8_LDA(At, 1, 1); PG8_STAGEX(PG8_SB(1, 0), b3, voffB); PG8_STAGEX(PG8_SB(1, 1), b3 + hstep, voffB); PG8_STAGEX(PG8_SA(1, 0), a3, voff);
            PG8_WAIT_V(8); PG8_WAIT_L(0); PG8_BAR; PG8_MMA(1, 0, At, B0); PG8_MMA(1, 1, At, B1); PG8_BAR; PG8_SCHED;
        }
        if (wr == 0) PG8_BAR;
        { int fr2 = fr, fq2 = fq; asm volatile("" : "+v"(fr2), "+v"(fq2)); E(acc, cur, wr, wc, fr2, fq2); }
        if (!has_next) break;
#pragma unroll
        for (int a = 0; a < 2; ++a)
#pragma unroll
            for (int b = 0; b < 2; ++b)
#pragma unroll
                for (int m = 0; m < 4; ++m)
#pragma unroll
                    for (int n = 0; n < 2; ++n) acc[a][b][m][n] = (f32x4){0.f, 0.f, 0.f, 0.f};
        cur = nxt; cA = nA; cB = nB; ++ui;
        if (wr == 1) PG8_BAR;
    }
    PG8_WAIT_V(0);
    PG8_BAR;
    __syncthreads();
}

constexpr int LDT = 136;
constexpr int TILE_B = 128 * LDT * 2;
DI int crow(int i, int h) { return (i & 3) + 8 * (i >> 2) + 4 * h; }
template <int KS> DI void mm_lds(f32x16 (&acc)[2], const bf16* sA, const bf16* sB, int rb, int cb0, int lane) {
    const int r = lane & 31, h = lane >> 5;
#pragma unroll
    for (int ks = 0; ks < KS; ++ks) {
        const bf16x8 a = *(const bf16x8*)(sA + (32 * rb + r) * LDT + 16 * ks + 8 * h);
#pragma unroll
        for (int c = 0; c < 2; ++c) { const bf16x8 b = *(const bf16x8*)(sB + (32 * (cb0 + c) + r) * LDT + 16 * ks + 8 * h); acc[c] = MFMA32(a, b, acc[c]); }
    }
}
DI float scan_add(float v, int lane) {
#pragma unroll
    for (int o = 1; o < 64; o <<= 1) { const float t = __shfl_up(v, o); if (lane >= o) v += t; }
    return v;
}
DI float scan_max(float v, int lane) {
#pragma unroll
    for (int o = 1; o < 64; o <<= 1) { const float t = __shfl_up(v, o); if (lane >= o) v = fmaxf(v, t); }
    return v;
}
DI float wave_max(float v) {
#pragma unroll
    for (int o = 1; o < 64; o <<= 1) v = fmaxf(v, __shfl_xor(v, o));
    return v;
}
DI void load_tile_nat(bf16* sT, const bf16* g, int gld, int tid) {
#pragma unroll
    for (int i = 0; i < 4; ++i) { const int id = tid + 512 * i, row = id >> 4, c = (id & 15) * 8; *(u32x4*)(sT + row * LDT + c) = *(const u32x4*)(g + (size_t)row * gld + c); }
}
DI void load_tile_tr(bf16* sT, const bf16* g, int gld, const float* w, int tid) {
#pragma unroll
    for (int i = 0; i < 4; ++i) { const int id = tid + 512 * i, row = id & 127, c = (id >> 7) * 8; const u32x4 v = *(const u32x4*)(g + (size_t)row * gld + c); const float ww = w ? w[row] : 1.f;
        const unsigned uu[4] = {v.x, v.y, v.z, v.w};
#pragma unroll
        for (int e = 0; e < 4; ++e) { sT[(c + 2 * e) * LDT + row] = f2bf(bflo(uu[e]) * ww); sT[(c + 2 * e + 1) * LDT + row] = f2bf(bfhi(uu[e]) * ww); } }
}

DI void write_tile_tr(bf16* sT, const u32x4 (&v)[4], const float* w, int tid) {
#pragma unroll
    for (int i = 0; i < 4; ++i) { const int id = tid + 512 * i, row = id & 127, c = (id >> 7) * 8; const float ww = w ? w[row] : 1.f;
        const unsigned uu[4] = {v[i].x, v[i].y, v[i].z, v[i].w};
#pragma unroll
        for (int e = 0; e < 4; ++e) { sT[(c + 2 * e) * LDT + row] = f2bf(bflo(uu[e]) * ww); sT[(c + 2 * e + 1) * LDT + row] = f2bf(bfhi(uu[e]) * ww); } }
}
DI void mlstm_local(const Params& p) {
    unsigned char* ws = p.ws; int tid_ = threadIdx.x; asm volatile("" : "+v"(tid_)); const int tid = tid_, lane = tid & 63, wid = tid >> 6;
    bf16* sV = (bf16*)g_lds; bf16* sK = (bf16*)(g_lds + TILE_B); float* sW = (float*)(g_lds + 2 * TILE_B);
    const float* G = (const float*)(ws + O_G); const bf16* MV = (const bf16*)(ws + O_MV); const bf16* KC = (const bf16*)(ws + O_KC);
    bf16* CS = (bf16*)(ws + O_CS); float* NS = (float*)(ws + O_NS); float* ML = (float*)(ws + O_ML); float* BL = (float*)(ws + O_BL);
    const int rb = wid & 3, cb0 = (wid >> 2) * 2;
    for (int it2 = blockIdx.x; it2 < 2560; it2 += gridDim.x) {
        const int cgk = it2 >> 2, h = it2 & 3, t0 = cgk * 128;
        u32x4 vr[4], kr[4];
#pragma unroll
        for (int i = 0; i < 4; ++i) { const int id = tid + 512 * i, row = id & 127, c = (id >> 7) * 8; vr[i] = *(const u32x4*)(MV + (size_t)(t0 + row) * 512 + h * 128 + c); kr[i] = *(const u32x4*)(KC + (size_t)(t0 + row) * 512 + h * 128 + c); }
        if (wid < 2) { const int dir = wid, item = it2 * 2 + dir;
            const int o0 = dir ? 127 - lane : lane, o1 = dir ? 63 - lane : lane + 64;
            const float lf0 = G[(size_t)(t0 + o0) * 16 + dir * 8 + 4 + h], li0 = G[(size_t)(t0 + o0) * 16 + dir * 8 + h];
            const float lf1 = G[(size_t)(t0 + o1) * 16 + dir * 8 + 4 + h], li1 = G[(size_t)(t0 + o1) * 16 + dir * 8 + h];
            const float b0 = scan_add(lf0, lane), tot0 = __shfl(b0, 63), b1 = scan_add(lf1, lane) + tot0, bL = __shfl(b1, 63);
            const float g0 = bL - b0 + li0, g1 = bL - b1 + li1, ml = wave_max(fmaxf(g0, g1));
            sW[dir * 128 + o0] = __expf(g0 - ml); sW[dir * 128 + o1] = __expf(g1 - ml);
            if (lane == 0) { ML[item] = ml; BL[item] = bL; }
        }
        write_tile_tr(sK, kr, nullptr, tid);
        __syncthreads();
#pragma unroll 1
        for (int dir = 0; dir < 2; ++dir) { const int item = it2 * 2 + dir; const float* sWd = sW + dir * 128;
            write_tile_tr(sV, vr, sWd, tid);
            __syncthreads();
            if (tid < 128) { float s = 0.f;
#pragma unroll 4
                for (int l = 0; l < 128; l += 8) { const u32x4 kk = *(const u32x4*)(sK + tid * LDT + l); const f32x4 wa = *(const f32x4*)(sWd + l), wb = *(const f32x4*)(sWd + l + 4);
                    s += (wa.x * bflo(kk.x) + wa.y * bfhi(kk.x)) + (wa.z * bflo(kk.y) + wa.w * bfhi(kk.y)) + (wb.x * bflo(kk.z) + wb.y * bfhi(kk.z)) + (wb.z * bflo(kk.w) + wb.w * bfhi(kk.w)); }
                NS[(size_t)item * 128 + tid] = s; }
            f32x16 acc[2];
#pragma unroll
            for (int c = 0; c < 2; ++c)
#pragma unroll
                for (int i = 0; i < 16; ++i) acc[c][i] = 0.f;
            mm_lds<8>(acc, sV, sK, rb, cb0, lane);
            bf16* Co = CS + (size_t)item * 16384;
#pragma unroll
            for (int c = 0; c < 2; ++c)
#pragma unroll
                for (int i = 0; i < 16; ++i) Co[(32 * rb + crow(i, lane >> 5)) * 128 + 32 * (cb0 + c) + (lane & 31)] = f2bf(acc[c][i]);
            __syncthreads();
        }
    }
}
DI void mlstm_scan(const Params& p) {
    unsigned char* ws = p.ws; int tid_ = threadIdx.x; asm volatile("" : "+v"(tid_)); const int gt = blockIdx.x * NTHR + tid_, GT = gridDim.x * NTHR;
    bf16* CS = (bf16*)(ws + O_CS); float* NS = (float*)(ws + O_NS); const float* ML = (const float*)(ws + O_ML); const float* BL = (const float*)(ws + O_BL); float* MP = (float*)(ws + O_MP);
    for (int u = gt; u < 144 * 2080; u += GT) {
        const int st = u / 2080, v = u % 2080, sq = st >> 3, h = (st >> 1) & 3, dir = st & 1, nc = seq_len(sq) >> 7, c0 = seq_start(sq) >> 7;
        float m = 0.f;
        if (v < 2048) {
            float C[8];
#pragma unroll
            for (int e = 0; e < 8; ++e) C[e] = 0.f;
            for (int j = 0; j < nc; j += 4) {
                u32x4 t[4]; float bl[4], mlv[4]; int itm[4];
#pragma unroll
                for (int q = 0; q < 4; ++q) { const int n = dir ? nc - 1 - (j + q) : j + q; itm[q] = ((c0 + n) * 4 + h) * 2 + dir; t[q] = *(const u32x4*)(CS + (size_t)itm[q] * 16384 + v * 8); bl[q] = BL[itm[q]]; mlv[q] = ML[itm[q]]; }
#pragma unroll
                for (int q = 0; q < 4; ++q) { u32x4 o; o.x = pk2(C[0], C[1]); o.y = pk2(C[2], C[3]); o.z = pk2(C[4], C[5]); o.w = pk2(C[6], C[7]); *(u32x4*)(CS + (size_t)itm[q] * 16384 + v * 8) = o;
                    if (v == 0) MP[itm[q]] = m;
                    const float mn = fmaxf(bl[q] + m, mlv[q]), a = __expf(bl[q] + m - mn), c = __expf(mlv[q] - mn);
                    C[0] = a * C[0] + c * bflo(t[q].x); C[1] = a * C[1] + c * bfhi(t[q].x); C[2] = a * C[2] + c * bflo(t[q].y); C[3] = a * C[3] + c * bfhi(t[q].y);
                    C[4] = a * C[4] + c * bflo(t[q].z); C[5] = a * C[5] + c * bfhi(t[q].z); C[6] = a * C[6] + c * bflo(t[q].w); C[7] = a * C[7] + c * bfhi(t[q].w); m = mn; }
            }
        } else {
            f32x4 N = {0.f, 0.f, 0.f, 0.f};
            for (int j = 0; j < nc; j += 4) {
                f32x4 t[4]; float bl[4], mlv[4]; int itm[4];
#pragma unroll
                for (int q = 0; q < 4; ++q) { const int n = dir ? nc - 1 - (j + q) : j + q; itm[q] = ((c0 + n) * 4 + h) * 2 + dir; t[q] = *(const f32x4*)(NS + (size_t)itm[q] * 128 + (v - 2048) * 4); bl[q] = BL[itm[q]]; mlv[q] = ML[itm[q]]; }
#pragma unroll
                for (int q = 0; q < 4; ++q) { *(f32x4*)(NS + (size_t)itm[q] * 128 + (v - 2048) * 4) = N;
                    const float mn = fmaxf(bl[q] + m, mlv[q]), a = __expf(bl[q] + m - mn), c = __expf(mlv[q] - mn); N = a * N + c * t[q]; m = mn; }
            }
        }
    }
}
DI void mlstm_out(const Params& p) {
    unsigned char* ws = p.ws; int tid_ = threadIdx.x; asm volatile("" : "+v"(tid_)); const int tid = tid_, lane = tid & 63, wid = tid >> 6, hh = lane >> 5;
    bf16* sQ = (bf16*)g_lds; bf16* sK = (bf16*)(g_lds + TILE_B); bf16* sVT = (bf16*)(g_lds + 2 * TILE_B); bf16* sC = (bf16*)(g_lds + 3 * TILE_B); bf16* sP = sK;
    float* sBv2 = (float*)(g_lds + 4 * TILE_B); float* sLi2 = sBv2 + 256; float* sMt2 = sBv2 + 512; float* sInter2 = sBv2 + 768; float* sInv = sBv2 + 1024; float* sN = sBv2 + 1152;
    float* sH = (float*)g_lds;
    const float* G = (const float*)(ws + O_G); const bf16* QC = (const bf16*)(ws + O_QC); const bf16* KC = (const bf16*)(ws + O_KC); const bf16* MV = (const bf16*)(ws + O_MV); const bf16* MO = (const bf16*)(ws + O_MO);
    const bf16* CS = (const bf16*)(ws + O_CS); const float* NS = (const float*)(ws + O_NS); const float* MP = (const float*)(ws + O_MP); bf16* Y = (bf16*)(ws + O_Y);
    const int rb = wid & 3, cb0 = (wid >> 2) * 2;
    for (int item = blockIdx.x; item < 2560; item += gridDim.x) {
        const int cgk = item >> 2, h = item & 3, t0 = cgk * 128;
        load_tile_nat(sQ, QC + (size_t)t0 * 512 + h * 128, 512, tid);
        load_tile_nat(sK, KC + (size_t)t0 * 512 + h * 128, 512, tid);
        load_tile_tr(sVT, MV + (size_t)t0 * 512 + h * 128, 512, nullptr, tid);
        if (wid < 2) {
            const int dir = wid, itemd = (cgk * 4 + h) * 2 + dir; const float mprev = MP[itemd];
            const int o0 = dir ? 127 - lane : lane, o1 = dir ? 63 - lane : lane + 64;
            const float lf0 = G[(size_t)(t0 + o0) * 16 + dir * 8 + 4 + h], li0 = G[(size_t)(t0 + o0) * 16 + dir * 8 + h];
            const float lf1 = G[(size_t)(t0 + o1) * 16 + dir * 8 + 4 + h], li1 = G[(size_t)(t0 + o1) * 16 + dir * 8 + h];
            const float b0 = scan_add(lf0, lane), tot0 = __shfl(b0, 63), b1 = scan_add(lf1, lane) + tot0;
            const float pm0 = scan_max(li0 - b0, lane), mx0 = __shfl(pm0, 63), pm1 = fmaxf(scan_max(li1 - b1, lane), mx0);
            const float a0 = b0 + mprev, a1 = b1 + mprev, mt0 = fmaxf(a0, b0 + pm0), mt1 = fmaxf(a1, b1 + pm1);
            float* B_ = sBv2 + dir * 128; float* L_ = sLi2 + dir * 128; float* M_ = sMt2 + dir * 128; float* I_ = sInter2 + dir * 128;
            B_[o0] = b0; B_[o1] = b1; L_[o0] = li0; L_[o1] = li1; M_[o0] = mt0; M_[o1] = mt1; I_[o0] = __expf(a0 - mt0); I_[o1] = __expf(a1 - mt1);
        }
        __syncthreads();
        f32x16 S[2], hs[2];
#pragma unroll
        for (int c = 0; c < 2; ++c)
#pragma unroll
            for (int i = 0; i < 16; ++i) { S[c][i] = 0.f; hs[c][i] = 0.f; }
        mm_lds<8>(S, sQ, sK, rb, cb0, lane);
#pragma unroll 1
        for (int dir = 0; dir < 2; ++dir) {
            __syncthreads();
            const int itemd = (cgk * 4 + h) * 2 + dir;
            const float* sBv = sBv2 + dir * 128; const float* sLi = sLi2 + dir * 128; const float* sMt = sMt2 + dir * 128; const float* sInter = sInter2 + dir * 128;
            load_tile_nat(sC, CS + (size_t)itemd * 16384, 128, tid);
            if (tid >= 64 && tid < 96) *(f32x4*)(sN + (tid - 64) * 4) = *(const f32x4*)(NS + (size_t)itemd * 128 + (tid - 64) * 4);
            __syncthreads();
#pragma unroll
            for (int c = 0; c < 2; ++c) { const int s = 32 * (cb0 + c) + (lane & 31); const float bs = sBv[s] - sLi[s];
#pragma unroll
                for (int i = 0; i < 16; ++i) { const int t = 32 * rb + crow(i, hh); const bool valid = dir ? (s >= t) : (s <= t);
                    const float pv = valid ? S[c][i] * __expf(sBv[t] - bs - sMt[t]) : 0.f; sP[t * LDT + s] = f2bf(pv); } }
            __syncthreads();
            if (tid < 128) { const int t = tid; float dot = 0.f, rsum = 0.f;
#pragma unroll 4
                for (int e = 0; e < 128; e += 8) { const u32x4 qq = *(const u32x4*)(sQ + t * LDT + e), pq = *(const u32x4*)(sP + t * LDT + e); const f32x4 na = *(const f32x4*)(sN + e), nb = *(const f32x4*)(sN + e + 4);
                    dot += (na.x * bflo(qq.x) + na.y * bfhi(qq.x)) + (na.z * bflo(qq.y) + na.w * bfhi(qq.y)) + (nb.x * bflo(qq.z) + nb.y * bfhi(qq.z)) + (nb.z * bflo(qq.w) + nb.w * bfhi(qq.w));
                    rsum += (bflo(pq.x) + bfhi(pq.x)) + (bflo(pq.y) + bfhi(pq.y)) + (bflo(pq.z) + bfhi(pq.z)) + (bflo(pq.w) + bfhi(pq.w)); }
                const float den = sInter[t] * dot + rsum; sInv[t] = 1.f / fmaxf(fabsf(den), __expf(-sMt[t])); }
            f32x16 num[2];
#pragma unroll
            for (int c = 0; c < 2; ++c)
#pragma unroll
                for (int i = 0; i < 16; ++i) num[c][i] = 0.f;
            mm_lds<8>(num, sQ, sC, rb, cb0, lane);
#pragma unroll
            for (int i = 0; i < 16; ++i) { const float it = sInter[32 * rb + crow(i, hh)]; num[0][i] *= it; num[1][i] *= it; }
            mm_lds<8>(num, sP, sVT, rb, cb0, lane);
            __syncthreads();
#pragma unroll
            for (int i = 0; i < 16; ++i) { const float iv = sInv[32 * rb + crow(i, hh)]; hs[0][i] += num[0][i] * iv; hs[1][i] += num[1][i] * iv; }
        }
        const int ft = tid >> 2, fd0 = (tid & 3) * 32;
        const bf16* mo = MO + (size_t)(t0 + ft) * 512 + h * 128 + fd0; const float* on = p.m_out_norm + h * 128 + fd0;
        u32x4 gmo[4]; f32x4 gon[8];
#pragma unroll
        for (int e = 0; e < 4; ++e) { gmo[e] = *(const u32x4*)(mo + 8 * e); gon[2 * e] = *(const f32x4*)(on + 8 * e); gon[2 * e + 1] = *(const f32x4*)(on + 8 * e + 4); }
        __syncthreads();
#pragma unroll
        for (int c = 0; c < 2; ++c)
#pragma unroll
            for (int i = 0; i < 16; ++i) sH[(32 * rb + crow(i, hh)) * 132 + 32 * (cb0 + c) + (lane & 31)] = hs[c][i];
        __syncthreads();
        { const int t = ft, d0 = fd0; f32x4 v[8]; float ss = 0.f;
#pragma unroll
          for (int e = 0; e < 8; ++e) { v[e] = *(const f32x4*)(sH + t * 132 + d0 + 4 * e); ss += sq4(v[e]); }
          ss += __shfl_xor(ss, 1); ss += __shfl_xor(ss, 2);
          const float rstd = rsqrtf(ss * (1.f / 128.f) + EPS);
          bf16* yo = Y + (size_t)(t0 + t) * 1024 + 512 + h * 128 + d0;
#pragma unroll
          for (int e = 0; e < 4; ++e) { const u32x4 g = gmo[e]; const f32x4 a = v[2 * e] * rstd * gon[2 * e], b = v[2 * e + 1] * rstd * gon[2 * e + 1];
              u32x4 o; o.x = pk2(a.x * bflo(g.x), a.y * bfhi(g.x)); o.y = pk2(a.z * bflo(g.y), a.w * bfhi(g.y)); o.z = pk2(b.x * bflo(g.z), b.y * bfhi(g.z)); o.w = pk2(b.z * bflo(g.w), b.w * bfhi(g.w));
              *(u32x4*)(yo + 8 * e) = o; } }
        __syncthreads();
    }
}
DI void attn_phase(const Params& p) {
    unsigned char* ws = p.ws; int tid_ = threadIdx.x; asm volatile("" : "+v"(tid_)); const int tid = tid_, lane = tid & 63, wid = tid >> 6, r = lane & 31, hh = lane >> 5;
    const bf16* Q = (const bf16*)(ws + O_Q); const bf16* KN = (const bf16*)(ws + O_KN); const bf16* KR = (const bf16*)(ws + O_KR); const bf16* VT = (const bf16*)(ws + O_VT); bf16* Y = (bf16*)(ws + O_Y);
    constexpr int KB_B = 128 * 208, VB_B = 64 * 272, VOFF = 2 * KB_B, SOFF = 0;
    for (int item = blockIdx.x; item < 1280; item += gridDim.x) {
        int sq, head, qb;
        if (item < 256) { sq = item >> 7; head = (item & 127) >> 4; qb = item & 15; } else { const int it = item - 256; sq = 2 + (it >> 6); head = (it & 63) >> 3; qb = it & 7; }
        const int S = seq_len(sq), t0 = seq_start(sq), nkt = S >> 7, tq0 = t0 + qb * 512 + wid * 64;
        bf16x8 qf[2][6];
#pragma unroll
        for (int j = 0; j < 2; ++j)
#pragma unroll
            for (int ks = 0; ks < 6; ++ks) qf[j][ks] = *(const bf16x8*)(Q + (size_t)(tq0 + j * 32 + r) * 768 + head * 96 + 16 * ks + 8 * hh);
        f32x16 o[2][2];
#pragma unroll
        for (int j = 0; j < 2; ++j)
#pragma unroll
            for (int c = 0; c < 2; ++c)
#pragma unroll
                for (int i = 0; i < 16; ++i) o[j][c][i] = 0.f;
        float mrun[2] = {0.f, 0.f}, lrun[2] = {0.f, 0.f};
        const bf16* gk = KN + (size_t)(t0 + (tid >> 3)) * 512 + head * 64 + (tid & 7) * 8;
        const bf16* gr = KR + (size_t)(t0 + (tid >> 2)) * 32 + (tid & 3) * 8;
        const bf16* gv = VT + (size_t)t0 * 512 + (size_t)(head * 64 + (tid >> 3)) * S + (tid & 7) * 8;
        unsigned char* lk = g_lds + (tid >> 3) * 208 + (tid & 7) * 16; unsigned char* lr = g_lds + (tid >> 2) * 208 + 128 + (tid & 3) * 16; unsigned char* lv = g_lds + VOFF + (tid >> 3) * 272 + ((tid & 7) >> 1) * 32 + (tid & 1) * 8;
        u32x4 rk, rk2, rr, rv, rv2;
#define ALD_(kt_) { rk = *(const u32x4*)(gk + (size_t)(kt_) * 128 * 512); rk2 = *(const u32x4*)(gk + (size_t)((kt_) * 128 + 64) * 512); rr = *(const u32x4*)(gr + (size_t)(kt_) * 128 * 32); rv = *(const u32x4*)(gv + (kt_) * 128); rv2 = *(const u32x4*)(gv + (kt_) * 128 + 64); }
#define AST_(b_) { *(u32x4*)(lk + (b_) * KB_B) = rk; *(u32x4*)(lk + (b_) * KB_B + 64 * 208) = rk2; *(u32x4*)(lr + (b_) * KB_B) = rr; \
            *(u32x2*)(lv + (b_) * VB_B) = (u32x2){rv.x, rv.y}; *(u32x2*)(lv + (b_) * VB_B + 16) = (u32x2){rv.z, rv.w}; *(u32x2*)(lv + (b_) * VB_B + 128) = (u32x2){rv2.x, rv2.y}; *(u32x2*)(lv + (b_) * VB_B + 144) = (u32x2){rv2.z, rv2.w}; }
        ALD_(0) AST_(0)
        __syncthreads();
        for (int kt = 0; kt < nkt; ++kt) {
            const int buf = kt & 1; const bool more = kt + 1 < nkt;
            if (more) ALD_(kt + 1)
            const unsigned char* Kb = g_lds + buf * KB_B; const unsigned char* Vb = g_lds + VOFF + buf * VB_B;
#pragma unroll 1
            for (int kb = 0; kb < 4; ++kb) {
                f32x16 st[2];
#pragma unroll
                for (int j = 0; j < 2; ++j) { const float nm = -mrun[j];
#pragma unroll
                    for (int i = 0; i < 16; ++i) st[j][i] = nm; }
#pragma unroll
                for (int ks = 0; ks < 6; ++ks) { const bf16x8 a = *(const bf16x8*)(Kb + (32 * kb + r) * 208 + (16 * ks + 8 * hh) * 2); st[0] = MFMA32(a, qf[0][ks], st[0]); st[1] = MFMA32(a, qf[1][ks], st[1]); }
                bf16x8 pf[2][2];
                const bool first = (kt == 0) && (kb == 0);
#pragma unroll
                for (int j = 0; j < 2; ++j) {
                    float mx = st[j][0];
#pragma unroll
                    for (int i = 1; i < 16; ++i) mx = fmaxf(mx, st[j][i]);
                    mx = fmaxf(mx, __shfl_xor(mx, 32));
                    if (first || __builtin_amdgcn_ballot_w64(mx > 8.f) != 0ull) {
                        const float d = first ? mx : fmaxf(mx, 0.f);
                        if (!first) { const float alpha = __builtin_amdgcn_exp2f(-d); lrun[j] *= alpha;
#pragma unroll
                            for (int c = 0; c < 2; ++c)
#pragma unroll
                                for (int i = 0; i < 16; ++i) o[j][c][i] *= alpha; }
#pragma unroll
                        for (int i = 0; i < 16; ++i) st[j][i] -= d;
                        mrun[j] += d;
                    }
                    float ps = 0.f;
#pragma unroll
                    for (int i = 0; i < 16; ++i) { const float e = __builtin_amdgcn_exp2f(st[j][i]); st[j][i] = e; ps += e; }
                    lrun[j] += ps;
#pragma unroll
                    for (int s2 = 0; s2 < 2; ++s2) {
                        u32x4 pp; pp.x = pk2(st[j][8 * s2 + 0], st[j][8 * s2 + 1]); pp.y = pk2(st[j][8 * s2 + 2], st[j][8 * s2 + 3]); pp.z = pk2(st[j][8 * s2 + 4], st[j][8 * s2 + 5]); pp.w = pk2(st[j][8 * s2 + 6], st[j][8 * s2 + 7]);
                        pf[j][s2] = __builtin_bit_cast(bf16x8, pp); }
                }
#pragma unroll
                for (int s2 = 0; s2 < 2; ++s2)
#pragma unroll
                    for (int db = 0; db < 2; ++db) { const bf16x8 a = *(const bf16x8*)(Vb + (32 * db + r) * 272 + (32 * kb + 16 * s2) * 2 + hh * 16);
                        o[0][db] = MFMA32(a, pf[0][s2], o[0][db]); o[1][db] = MFMA32(a, pf[1][s2], o[1][db]); }
            }
            if (more) AST_(buf ^ 1)
            __syncthreads();
        }
#undef ALD_
#undef AST_
        unsigned char* stg = g_lds + SOFF + wid * 8704;
#pragma unroll
        for (int j = 0; j < 2; ++j) { float l = lrun[j]; l += __shfl_xor(l, 32); const float inv = 1.f / l;
#pragma unroll
            for (int db = 0; db < 2; ++db)
#pragma unroll
                for (int g4 = 0; g4 < 4; ++g4) { u32x2 w; w.x = pk2(o[j][db][4 * g4] * inv, o[j][db][4 * g4 + 1] * inv); w.y = pk2(o[j][db][4 * g4 + 2] * inv, o[j][db][4 * g4 + 3] * inv);
                    *(u32x2*)(stg + (j * 32 + r) * 136 + (32 * db + 8 * g4 + 4 * hh) * 2) = w; } }
        __syncthreads();
#pragma unroll
        for (int j = 0; j < 8; ++j) { const int id = lane + 64 * j, row = id >> 3, c = id & 7; const u32x2 a = *(const u32x2*)(stg + row * 136 + c * 16), b = *(const u32x2*)(stg + row * 136 + c * 16 + 8);
            *(u32x4*)(Y + (size_t)(tq0 + row) * 1024 + head * 64 + c * 8) = (u32x4){a.x, a.y, b.x, b.y}; }
        __syncthreads();
    }
}
DI void spatial_phase(const Params& p) {
    unsigned char* ws = p.ws; int tid_ = threadIdx.x; asm volatile("" : "+v"(tid_)); const int tid = tid_, lane = tid & 63, wid = tid >> 6, hh = lane >> 5;
    bf16* sW = (bf16*)g_lds; bf16* sVn = (bf16*)(g_lds + TILE_B); float* sR = (float*)(g_lds + 2 * TILE_B);
    const bf16* WSP = (const bf16*)(ws + O_WSP); const bf16* U = (const bf16*)(ws + O_U); const bf16* V = (const bf16*)(ws + O_V); const f32x4* VSS = (const f32x4*)(ws + O_VSS); bf16* Z = (bf16*)(ws + O_Z);
    const int rb = wid & 3, cb0 = (wid >> 2) * 2;
    const int G8 = (gridDim.x & 7) == 0 ? (int)(gridDim.x >> 3) : 0;
    if (G8 == 0) return;
    const int g = blockIdx.x & 7;
    load_tile_nat(sW, WSP + (size_t)g * 16384, 128, tid);
    const f32x4 n0 = *(const f32x4*)(p.c_v_norm + g * 128 + (tid >> 7) * 8), n1 = *(const f32x4*)(p.c_v_norm + g * 128 + (tid >> 7) * 8 + 4), n2 = *(const f32x4*)(p.c_v_norm + g * 128 + (tid >> 7) * 8 + 32), n3 = *(const f32x4*)(p.c_v_norm + g * 128 + (tid >> 7) * 8 + 36);
    const f32x4 n4 = *(const f32x4*)(p.c_v_norm + g * 128 + (tid >> 7) * 8 + 64), n5 = *(const f32x4*)(p.c_v_norm + g * 128 + (tid >> 7) * 8 + 68), n6 = *(const f32x4*)(p.c_v_norm + g * 128 + (tid >> 7) * 8 + 96), n7 = *(const f32x4*)(p.c_v_norm + g * 128 + (tid >> 7) * 8 + 100);
    float bsp[16];
#pragma unroll
    for (int i = 0; i < 16; ++i) bsp[i] = p.c_b_sp[g * 128 + 32 * rb + crow(i, hh)];
    u32x4 vr[4];
    int cgk = blockIdx.x >> 3;
    if (cgk < NCHUNK) {
#pragma unroll
        for (int i = 0; i < 4; ++i) { const int id = tid + 512 * i, row = id & 127, c = (id >> 7) * 8; vr[i] = *(const u32x4*)(V + (size_t)(cgk * 128 + row) * 1024 + g * 128 + c); }
    }
    for (; cgk < NCHUNK; cgk += G8) {
        const int t0 = cgk * 128;
        if (tid < 128) { const f32x4 q = VSS[t0 + tid]; sR[tid] = rsqrtf(((q.x + q.y) + (q.z + q.w)) * (1.f / 1024.f) + EPS); }
        __syncthreads();
#pragma unroll
        for (int i = 0; i < 4; ++i) { const int id = tid + 512 * i, row = id & 127, c = (id >> 7) * 8; const u32x4 v = vr[i]; const float ww = sR[row];
            const f32x4 na = i == 0 ? n0 : (i == 1 ? n2 : (i == 2 ? n4 : n6)), nb = i == 0 ? n1 : (i == 1 ? n3 : (i == 2 ? n5 : n7));
            sVn[(c + 0) * LDT + row] = f2bf(bflo(v.x) * ww * na.x); sVn[(c + 1) * LDT + row] = f2bf(bfhi(v.x) * ww * na.y); sVn[(c + 2) * LDT + row] = f2bf(bflo(v.y) * ww * na.z); sVn[(c + 3) * LDT + row] = f2bf(bfhi(v.y) * ww * na.w);
            sVn[(c + 4) * LDT + row] = f2bf(bflo(v.z) * ww * nb.x); sVn[(c + 5) * LDT + row] = f2bf(bfhi(v.z) * ww * nb.y); sVn[(c + 6) * LDT + row] = f2bf(bflo(v.w) * ww * nb.z); sVn[(c + 7) * LDT + row] = f2bf(bfhi(v.w) * ww * nb.w); }
        __syncthreads();
        if (cgk + G8 < NCHUNK) {
#pragma unroll
            for (int i = 0; i < 4; ++i) { const int id = tid + 512 * i, row = id & 127, c = (id >> 7) * 8; vr[i] = *(const u32x4*)(V + (size_t)((cgk + G8) * 128 + row) * 1024 + g * 128 + c); }
        }
        bf16 uu[2][16];
#pragma unroll
        for (int c = 0; c < 2; ++c)
#pragma unroll
            for (int i = 0; i < 16; ++i) uu[c][i] = U[(size_t)(t0 + 32 * rb + crow(i, hh)) * 1024 + g * 128 + 32 * (cb0 + c) + (lane & 31)];
        f32x16 acc[2];
#pragma unroll
        for (int c = 0; c < 2; ++c)
#pragma unroll
            for (int i = 0; i < 16; ++i) acc[c][i] = 0.f;
        mm_lds<8>(acc, sW, sVn, rb, cb0, lane);
#pragma unroll
        for (int c = 0; c < 2; ++c)
#pragma unroll
            for (int i = 0; i < 16; ++i) { const int t = 32 * rb + crow(i, hh), cc = g * 128 + 32 * (cb0 + c) + (lane & 31); const size_t ix = (size_t)(t0 + t) * 1024 + cc;
                Z[ix] = f2bf((acc[c][i] + bsp[i]) * bf2f(uu[c][i])); }
    }
    __syncthreads();
}
DI void final_phase(const Params& p) {
    int tid_ = threadIdx.x; asm volatile("" : "+v"(tid_)); const int tid = tid_, lane = tid & 63, gw = blockIdx.x * 8 + (tid >> 6), NGW = gridDim.x * 8; const f32x4* SS = (const f32x4*)(p.ws + O_SS);
    const f32x4* gn = (const f32x4*)p.final_norm + lane; const f32x4 g0 = gn[0], g1 = gn[64], g2 = gn[128], g3 = gn[192];
    for (int t = gw; t < T_TOK; t += NGW) { const float rs = rs_of(SS, t); f32x4* xr = (f32x4*)(p.out + (size_t)t * DM) + lane;
        const f32x4 a = xr[0], b = xr[64], c = xr[128], d = xr[192];
        xr[0] = a * rs * g0; xr[64] = b * rs * g1; xr[128] = c * rs * g2; xr[192] = d * rs * g3; }
}


#ifndef DBG
#define DBG 0
#endif
constexpr size_t O_DBG = O_END0;
DI int btok_(int i) { return ((int)blockIdx.x * 8 + (i & 7)) * 40 + ((int)blockIdx.x * 7 + i * 3) % 40; }
DI bool close_(float fast, float ref) { return fabsf(fast - ref) <= 0.03f + 0.04f * fabsf(ref); }
DI float nrs_(const Params& p, int t) { const float* x = xin_row(p, t); float s = 0.f; for (int k = 0; k < 1024; ++k) s += x[k] * x[k]; return rsqrtf(s * (1.f / 1024.f) + EPS); }
DI float nh_(const Params& p, int t, int col, float rs) { const float* x = xin_row(p, t); float s = 0.f; for (int k = 0; k < 1024; ++k) s += x[k] * p.ab_norm[k] * p.ab_w_in[(size_t)k * 2480 + col]; return s * rs; }
DI void dbg_fail(const Params& p, unsigned bit) { atomicOr((unsigned*)(p.ws + O_DBG), bit); }
DI void chk_inproj(const Params& p) {
    unsigned char* ws = p.ws; int tid_ = threadIdx.x; asm volatile("" : "+v"(tid_)); const int tid = tid_; const int bx = blockIdx.x;
    if (tid < 4) { const int t = btok_(tid); const float rs = nrs_(p, t);
        { const float ref = nh_(p, t, (7 + 50 * tid + bx) % 256, rs), fast = bf2f(((const bf16*)(ws + O_CQKV))[(size_t)t * 384 + (7 + 50 * tid + bx) % 256]); if (!close_(fast, ref)) dbg_fail(p, 0u); }
        { const float ref = nh_(p, t, 256 + (9 + 20 * tid + bx) % 128, rs), fast = bf2f(((const bf16*)(ws + O_CQKV))[(size_t)t * 384 + 256 + (9 + 20 * tid + bx) % 128]); if (!close_(fast, ref)) dbg_fail(p, 0u); }
        { const int ch = (3 + 37 * tid + 2 * bx) % 512; const float ref = nh_(p, t, 1440 + ch, rs), fast = bf2f(((const bf16*)(ws + O_MV))[(size_t)t * 512 + ch]); if (!close_(fast, ref)) dbg_fail(p, 0u); }
    } else if (tid < 8) { const int i = tid - 4, t = btok_(tid); const int sq = seq_of(t), s0 = seq_start(sq), sl = seq_len(sq);
        for (int w = 0; w < 2; ++w) { const int ch = (w ? 512 : 0) + (11 + 100 * i + 2 * bx) % 512; float a[3];
            for (int d = -1; d <= 1; ++d) { const int tt = t + d; a[d + 1] = (tt >= s0 && tt < s0 + sl) ? nh_(p, tt, 416 + ch, nrs_(p, tt)) : 0.f; }
            float v = a[0] * p.m_conv_w[ch] + a[1] * p.m_conv_w[1024 + ch] + a[2] * p.m_conv_w[2048 + ch] + p.m_conv_b[ch]; v = v / (1.f + expf(-v)); if (w) v *= 0.08838834764831845f;
            const float fast = bf2f(((const bf16*)(ws + (w ? O_KC : O_QC)))[(size_t)t * 512 + (ch & 511)]); if (!close_(fast, v)) { const int pos = t - s0, row = pos % 252 + 2; const int jj = pos / 252, pm = sq < 2 ? sq * 33 + jj : 66 + (sq - 2) * 17 + jj; (void)pm; const int fr_ = row & 15, m_ = (row >> 4) & 3; (void)fr_; (void)m_; { unsigned b = 0; if (fr_ == 1) b = 1u; else if (fr_ == 2) b = 2u; else if (fr_ == 3) b = 4u; else if (fr_ == 12) b = 8u; else if (fr_ == 13) b = 16u; else if (fr_ == 14) b = 32u; dbg_fail(p, b); } } }
    } else if (tid < 12) { const int i = tid - 8, t = btok_(tid); const float rs = nrs_(p, t); const int sq = seq_of(t), pos = t - seq_start(sq);
        { const int gi = (5 + 2 * i + bx) & 15; float v = nh_(p, t, 2464 + gi, rs) + p.gate_bias[gi]; if ((gi >> 2) & 1) v = fminf(v, 0.f) - log1pf(expf(-fabsf(v))); const float fast = ((const float*)(ws + O_G))[(size_t)t * 16 + gi]; if (!close_(fast, v)) dbg_fail(p, 0u); }
        { const int ii = (3 + i + bx) & 15; const float x1 = nh_(p, t, 384 + ii, rs), x2 = nh_(p, t, 384 + 16 + ii, rs); const float ang = (float)pos / powf(10000.f, ii / 16.f); const float c = cosf(ang), sn = sinf(ang);
          const float r1 = x1 * c - x2 * sn, r2 = x2 * c + x1 * sn; const bf16* KR = (const bf16*)(ws + O_KR); if (!close_(bf2f(KR[(size_t)t * 32 + ii]), r1) || !close_(bf2f(KR[(size_t)t * 32 + 16 + ii]), r2)) dbg_fail(p, 0u); }
        { const int ch = (17 + 60 * i + 2 * bx) % 512; float v = nh_(p, t, 1952 + ch, rs); v = 1.f / (1.f + expf(-v)); const float fast = bf2f(((const bf16*)(ws + O_MO))[(size_t)t * 512 + ch]); if (!close_(fast, v)) dbg_fail(p, 0u); }
    }
}
DI void chk_mlstm(const Params& p) {
    unsigned char* ws = p.ws; int tid_ = threadIdx.x; asm volatile("" : "+v"(tid_)); const int tid = tid_; const int sqm = blockIdx.x % 18, hd = (blockIdx.x / 18) & 3, t0 = seq_start(sqm), S = seq_len(sqm), tp = (blockIdx.x * 37 + 5) % S;
    const float* G = (const float*)(ws + O_G); const bf16* QC = (const bf16*)(ws + O_QC); const bf16* KC = (const bf16*)(ws + O_KC); const bf16* MV = (const bf16*)(ws + O_MV); const bf16* MO = (const bf16*)(ws + O_MO); const bf16* Y = (const bf16*)(ws + O_Y);
    const int d = tid >> 2, e0 = (tid & 3) * 32; float* sh = (float*)g_lds; float hsum = 0.f;
    for (int dir = 0; dir < 2; ++dir) {
        const int first = dir ? S - 1 : 0, step = dir ? -1 : 1, cnt = dir ? S - tp : tp + 1;
        float num = 0.f, den = 0.f;
        { float C[32];
#pragma unroll
          for (int e = 0; e < 32; ++e) C[e] = 0.f;
          for (int j = 0; j < cnt; ++j) { const int t = t0 + first + step * j; const float f = expf(G[(size_t)t * 16 + dir * 8 + 4 + hd]), ii = expf(G[(size_t)t * 16 + dir * 8 + hd]);
            const float v = bf2f(MV[(size_t)t * 512 + hd * 128 + d]) * ii;
#pragma unroll
            for (int e = 0; e < 32; ++e) { const float k = bf2f(KC[(size_t)t * 512 + hd * 128 + e0 + e]); C[e] = f * C[e] + v * k; } }
#pragma unroll
          for (int e = 0; e < 32; ++e) num += C[e] * bf2f(QC[(size_t)(t0 + tp) * 512 + hd * 128 + e0 + e]); }
        __builtin_amdgcn_sched_barrier(0);
        { float n[32];
#pragma unroll
          for (int e = 0; e < 32; ++e) n[e] = 0.f;
          for (int j = 0; j < cnt; ++j) { const int t = t0 + first + step * j; const float f = expf(G[(size_t)t * 16 + dir * 8 + 4 + hd]), ii = expf(G[(size_t)t * 16 + dir * 8 + hd]);
#pragma unroll
            for (int e = 0; e < 32; ++e) { const float k = bf2f(KC[(size_t)t * 512 + hd * 128 + e0 + e]); n[e] = f * n[e] + ii * k; } }
#pragma unroll
          for (int e = 0; e < 32; ++e) den += n[e] * bf2f(QC[(size_t)(t0 + tp) * 512 + hd * 128 + e0 + e]); }
        num += __shfl_xor(num, 1); num += __shfl_xor(num, 2); den += __shfl_xor(den, 1); den += __shfl_xor(den, 2);
        hsum += num / fmaxf(fabsf(den), 1.f);
    }
    __syncthreads();
    if ((tid & 3) == 0) sh[d] = hsum;
    __syncthreads();
    if (tid < 128) { float ss = 0.f; for (int e = 0; e < 128; ++e) ss += sh[e] * sh[e]; const float rstd = rsqrtf(ss * (1.f / 128.f) + EPS);
        const float ref = sh[tid] * rstd * p.m_out_norm[hd * 128 + tid] * bf2f(MO[(size_t)(t0 + tp) * 512 + hd * 128 + tid]); const float fast = bf2f(Y[(size_t)(t0 + tp) * 1024 + 512 + hd * 128 + tid]);
        if (!close_(fast, ref)) dbg_fail(p, 0u); }
    __syncthreads();
}
DI void chk_qkv(const Params& p) {
    unsigned char* ws = p.ws; int tid_ = threadIdx.x; asm volatile("" : "+v"(tid_)); const int tid = tid_; if (tid >= 4) return;
    const int t = btok_(tid); const int sq = seq_of(t), st = seq_start(sq), S = seq_len(sq), pos = t - st; const bf16* CQ = (const bf16*)(ws + O_CQKV) + (size_t)t * 384;
    float sq_ = 0.f, skv = 0.f; for (int k = 0; k < 256; ++k) sq_ += bf2f(CQ[k]) * bf2f(CQ[k]); for (int k = 0; k < 128; ++k) skv += bf2f(CQ[256 + k]) * bf2f(CQ[256 + k]);
    const float rq = rsqrtf(sq_ / 256.f + EPS), rkv = rsqrtf(skv / 128.f + EPS); const float qs = 0.10206207261596577f * 1.4426950408889634f;
    const int hd = (2 + tid + blockIdx.x) & 7;
    { const int dd = 13 + tid; float s = 0.f; for (int k = 0; k < 256; ++k) s += bf2f(CQ[k]) * p.q_norm[k] * p.w_uq[(size_t)k * 768 + hd * 96 + dd]; s *= rq * qs; if (!close_(bf2f(((const bf16*)(ws + O_Q))[(size_t)t * 768 + hd * 96 + dd]), s)) dbg_fail(p, 0u); }
    { const int ii = 2 + tid; float x1 = 0.f, x2 = 0.f; for (int k = 0; k < 256; ++k) { const float a = bf2f(CQ[k]) * p.q_norm[k]; x1 += a * p.w_uq[(size_t)k * 768 + hd * 96 + 64 + ii]; x2 += a * p.w_uq[(size_t)k * 768 + hd * 96 + 80 + ii]; }
      x1 *= rq * qs; x2 *= rq * qs; const float ang = (float)pos / powf(10000.f, ii / 16.f); const float c = cosf(ang), sn = sinf(ang); const bf16* Qp = (const bf16*)(ws + O_Q) + (size_t)t * 768 + hd * 96;
      if (!close_(bf2f(Qp[64 + ii]), x1 * c - x2 * sn) || !close_(bf2f(Qp[80 + ii]), x2 * c + x1 * sn)) dbg_fail(p, 0u); }
    { const int dd = 21 + tid; float s = 0.f, v = 0.f; for (int k = 0; k < 128; ++k) { const float a = bf2f(CQ[256 + k]) * p.kv_norm[k]; s += a * p.w_ukv[(size_t)k * 1024 + hd * 128 + dd]; v += a * p.w_ukv[(size_t)k * 1024 + hd * 128 + 64 + dd]; }
      s *= rkv; v *= rkv; if (!close_(bf2f(((const bf16*)(ws + O_KN))[(size_t)t * 512 + hd * 64 + dd]), s)) dbg_fail(p, 0u);
      if (!close_(bf2f(((const bf16*)(ws + O_VT))[(size_t)st * 512 + (size_t)(hd * 64 + dd) * S + pos]), v)) dbg_fail(p, 0u); }
}
DI void chk_attn(const Params& p) {
    unsigned char* ws = p.ws; int tid_ = threadIdx.x; asm volatile("" : "+v"(tid_)); const int tid = tid_; if (tid >= 64) return;
    const int smp = tid >> 4, dd = (tid & 15) * 4 + (blockIdx.x & 3); const int t = btok_(smp), hd = (1 + 2 * smp + blockIdx.x) & 7; const int sq = seq_of(t), st = seq_start(sq), S = seq_len(sq);
    const bf16* Q = (const bf16*)(ws + O_Q) + (size_t)t * 768 + hd * 96; const bf16* KN = (const bf16*)(ws + O_KN); const bf16* KR = (const bf16*)(ws + O_KR); const bf16* VT = (const bf16*)(ws + O_VT) + (size_t)st * 512 + (size_t)(hd * 64 + dd) * S;
    float m = -1e30f, l = 0.f, o = 0.f;
    for (int k = 0; k < S; ++k) { float s = 0.f; for (int e = 0; e < 64; ++e) s += bf2f(Q[e]) * bf2f(KN[(size_t)(st + k) * 512 + hd * 64 + e]); for (int e = 0; e < 32; ++e) s += bf2f(Q[64 + e]) * bf2f(KR[(size_t)(st + k) * 32 + e]);
        const float mn = fmaxf(m, s), a = exp2f(m - mn), pe = exp2f(s - mn); l = l * a + pe; o = o * a + pe * bf2f(VT[k]); m = mn; }
    const float ref = o / l, fast = bf2f(((const bf16*)(ws + O_Y))[(size_t)t * 1024 + hd * 64 + dd]); if (!close_(fast, ref)) dbg_fail(p, 0u);
}
DI void dbg_emit(const Params& p) {
    const float a = sqrtf((float)*(const unsigned*)(p.ws + O_DBG)); const int gt = blockIdx.x * NTHR + threadIdx.x, GT = gridDim.x * NTHR;
    for (size_t i = gt; i < (size_t)T_TOK * DM / 4; i += GT) ((f32x4*)p.out)[i] = (f32x4){a, a, a, a};
}

DI int dtok_(int i) { return i == 0 ? 62 : i == 1 ? 63 : i == 2 ? 253 : i == 3 ? 254 : i == 4 ? 8191 : i == 5 ? 16384 : i == 6 ? 20253 : 81919; }
DI float rowrs_(const float* x) { float s = 0.f; for (int k = 0; k < 1024; ++k) s += x[k] * x[k]; return rsqrtf(s * (1.f / 1024.f) + EPS); }
DI void chk_res(const Params& p, const bf16* A, int K, const float* W, bool first, unsigned bit, int slot) {
    if (threadIdx.x >= 8) return; const int i = threadIdx.x, t = btok_(i), c = (5 + 127 * i + 3 * (int)blockIdx.x) & 1023; float* sv = (float*)(p.ws + O_DBG + 64) + (size_t)blockIdx.x * 32;
    float s = first ? xin_row(p, t)[c] : sv[slot * 8 + i]; for (int k = 0; k < K; ++k) s += bf2f(A[(size_t)t * K + k]) * W[(size_t)k * 1024 + c];
    if (!close_(p.out[(size_t)t * DM + c], s)) dbg_fail(p, bit);
    sv[(slot + 1) * 8 + i] = p.out[(size_t)t * DM + c];
}
DI void chk_up(const Params& p, int layer) {
    if (threadIdx.x >= 8) return; const int i = threadIdx.x, t = btok_(i), j = (9 + 350 * i + 11 * (int)blockIdx.x) % 2816; const int sq = seq_of(t), s0 = seq_start(sq), sl = seq_len(sq);
    const float* W = p.ffn_w_up + (size_t)layer * 1024 * 5632; const float* cw = p.ffn_conv_w + (size_t)layer * 3 * 5632; const float* cb = p.ffn_conv_b + (size_t)layer * 5632; const float* gn = p.ffn_norm + layer * 1024;
    float g = cb[j], v = cb[2816 + j];
    for (int d = -1; d <= 1; ++d) { const int tt = t + d; if (tt < s0 || tt >= s0 + sl) continue; const float* x = p.out + (size_t)tt * DM; const float rs = rowrs_(x); float ag = 0.f, av = 0.f;
        for (int k = 0; k < 1024; ++k) { const float xn = x[k] * rs * gn[k]; ag += xn * W[(size_t)k * 5632 + j]; av += xn * W[(size_t)k * 5632 + 2816 + j]; }
        g += ag * cw[(d + 1) * 5632 + j]; v += av * cw[(d + 1) * 5632 + 2816 + j]; }
    const float ref = g / (1.f + expf(-g)) * v, fast = bf2f(((const bf16*)(p.ws + O_HID))[(size_t)t * DFF + j]); if (!close_(fast, ref)) dbg_fail(p, DBG == 3 ? (i < 6 ? (1u << i) : 0u) : 2u);
}
DI void chk_gin(const Params& p) {
    if (threadIdx.x >= 8) return; const int i = threadIdx.x, t = btok_(i), c = (3 + 120 * i + 5 * (int)blockIdx.x) & 1023; const float* x = p.out + (size_t)t * DM; const float rs = rowrs_(x); float au = 0.f, av = 0.f;
    for (int k = 0; k < 1024; ++k) { const float xn = x[k] * rs * p.c_norm[k]; au += xn * p.c_w_in[(size_t)k * 2048 + c]; av += xn * p.c_w_in[(size_t)k * 2048 + 1024 + c]; }
    au = 0.5f * au * (1.f + erff(au * 0.70710678f)); av = 0.5f * av * (1.f + erff(av * 0.70710678f));
    if (!close_(bf2f(((const bf16*)(p.ws + O_U))[(size_t)t * DM + c]), au) || !close_(bf2f(((const bf16*)(p.ws + O_V))[(size_t)t * DM + c]), av)) dbg_fail(p, 8u);
}
DI void chk_sp(const Params& p) {
    if (threadIdx.x >= 8) return; const int i = threadIdx.x, t = btok_(i), g = (i + (int)blockIdx.x) & 7, c = (7 + 13 * i + (int)blockIdx.x) & 127, t0 = t & ~127, tt = t & 127; const bf16* V = (const bf16*)(p.ws + O_V); const bf16* U = (const bf16*)(p.ws + O_U);
    float acc = 0.f;
    for (int s2 = 0; s2 < 128; ++s2) { const bf16* vr = V + (size_t)(t0 + s2) * DM; float ss = 0.f; for (int k = 0; k < 1024; ++k) ss += bf2f(vr[k]) * bf2f(vr[k]); const float rv = rsqrtf(ss * (1.f / 1024.f) + EPS);
        acc += p.c_w_sp[(size_t)g * 16384 + tt * 128 + s2] * bf2f(vr[g * 128 + c]) * rv * p.c_v_norm[g * 128 + c]; }
    const float ref = (acc + p.c_b_sp[g * 128 + tt]) * bf2f(U[(size_t)t * DM + g * 128 + c]); if (!close_(bf2f(((const bf16*)(p.ws + O_Z))[(size_t)t * DM + g * 128 + c]), ref)) dbg_fail(p, 0u);
}
#if defined(__HIP_DEVICE_COMPILE__)
#define GETP() Params p; { typedef const unsigned long long __attribute__((address_space(4)))* KA_; KA_ q_ = (KA_)__builtin_amdgcn_kernarg_segment_ptr(); asm volatile("" : "+s"(q_)); \
    typedef __attribute__((address_space(1))) unsigned char* GP_; const void** pp_ = (const void**)&p; _Pragma("unroll") for (int i_ = 0; i_ < 27; ++i_) pp_[i_] = (const void*)(GP_)q_[i_]; } unsigned char* ws = p.ws; (void)ws;
#else
#define GETP() Params p = p_unused; unsigned char* ws = p.ws; (void)ws;
#endif
__global__ void __launch_bounds__(NTHR, 2) fwd_kernel(Params p_unused, int lo, int hi) {
    cg::grid_group grid = cg::this_grid();
#define PH(k, ...) if (lo <= (k) && (k) < hi) { GETP() __VA_ARGS__ } if (lo <= (k) && (k) + 1 < hi) grid.sync();
    PH(0, p0_prologue(p); if (DBG && blockIdx.x == 0 && threadIdx.x == 0) *(unsigned*)(p.ws + O_DBG) = 0u;)
    PH(1, Gemm g{(const bf16*)(ws + O_XB), (const bf16*)(ws + O_WIN), 1024, NM_OVL, 10, 1}; EpiIn E{p}; gemm_phase(g, E);)
    PH(2, mlstm_local(p);)
    PH(3, mlstm_scan(p);)
    PH(4, mlstm_out(p);)
    PH(5, Gemm g{(const bf16*)(ws + O_CQKV), (const bf16*)(ws + O_WQKV), 384, NM_PLAIN, 7, 0, 1}; EpiQkv E{p}; gemm_phase(g, E);)
    PH(6, attn_phase(p);)
    PH(7, Gemm g{(const bf16*)(ws + O_Y), (const bf16*)(ws + O_WOUT), 1024, NM_PLAIN, 4, 0}; EpiRes E{p, 1, 0}; gemm_phase<EpiRes, true>(g, E);)
    PH(8, Gemm g{(const bf16*)(ws + O_XB), (const bf16*)(ws + O_WUP), 1024, NM_OVL, 22, 1}; EpiUp E{p, 0}; gemm_phase<EpiUp, false>(g, E);)
    PH(9, Gemm g{(const bf16*)(ws + O_HID), (const bf16*)(ws + O_WDN), 2816, NM_PLAIN, 4, 0}; EpiRes E{p, 0, 0}; gemm_phase<EpiRes, true>(g, E);)
    PH(10, Gemm g{(const bf16*)(ws + O_XB), (const bf16*)(ws + O_WCIN), 1024, NM_PLAIN, 8, 0}; EpiGin E{p}; gemm_phase<EpiGin, true>(g, E);)
    PH(11, spatial_phase(p);)
    PH(12, Gemm g{(const bf16*)(ws + O_Z), (const bf16*)(ws + O_WCOUT), 1024, NM_PLAIN, 4, 0}; EpiRes E{p, 0, 0}; gemm_phase<EpiRes, true>(g, E);)
    PH(13, Gemm g{(const bf16*)(ws + O_XB), (const bf16*)(ws + O_WUP + AL((size_t)5632 * 1024 * 2)), 1024, NM_OVL, 22, 1}; EpiUp E{p, 1}; gemm_phase<EpiUp, false>(g, E);)
    PH(14, Gemm g{(const bf16*)(ws + O_HID), (const bf16*)(ws + O_WDN + AL((size_t)1024 * 2816 * 2)), 2816, NM_PLAIN, 4, 0}; EpiRes E{p, 0, 1}; gemm_phase<EpiRes, true>(g, E);)
    PH(15, final_phase(p);)
}
#if DBG
__global__ void __launch_bounds__(NTHR) chk_kernel(Params p, int which) {
    unsigned char* ws = p.ws; (void)ws;
    if (which == 1) chk_inproj(p);
    else if (which == 4) chk_mlstm(p);
    else if (which == 5) chk_qkv(p);
    else if (which == 6) chk_attn(p);
    else if (which == 7) chk_res(p, (const bf16*)(ws + O_Y), 1024, p.ab_w_out, true, 1u, 0);
    else if (which == 8) chk_up(p, 0);
    else if (which == 9) chk_res(p, (const bf16*)(ws + O_HID), 2816, p.ffn_w_down, false, 4u, 1);
    else if (which == 10) chk_gin(p);
    else if (which == 11) chk_sp(p);
    else if (which == 12) chk_res(p, (const bf16*)(ws + O_Z), 1024, p.c_w_out, false, 32u, 2);
    else if (which == 13) chk_up(p, 1);
    else if (which == 99) dbg_emit(p);
}
#endif

extern "C" void kernel_launch(void* const* d_in, const int* in_sizes, int n_in, void* d_out, int out_size, void* d_ws, size_t ws_size, hipStream_t stream) {
    static int grid = 0;
    if (grid == 0) {
        if (n_in != 25 || ws_size < WS_NEED + 65536 || out_size != T_TOK * DM) { fprintf(stderr, "kernel_launch: unexpected problem: n_in %d out %d ws %zu (need %zu)\n", n_in, out_size, ws_size, (size_t)WS_NEED); grid = -1; return; }
        int dev = 0, cus = 0, per_cu = 0;
        hipGetDevice(&dev); hipDeviceGetAttribute(&cus, hipDeviceAttributeMultiprocessorCount, dev);
        if (hipFuncSetAttribute((const void*)fwd_kernel, hipFuncAttributeMaxDynamicSharedMemorySize, LDS_BYTES) != hipSuccess) { fprintf(stderr, "kernel_launch: hipFuncSetAttribute failed\n"); grid = -1; return; }
        hipOccupancyMaxActiveBlocksPerMultiprocessor(&per_cu, (const void*)fwd_kernel, NTHR, LDS_BYTES);
        if (per_cu < 1) { fprintf(stderr, "kernel_launch: occupancy query says %d blocks per CU\n", per_cu); per_cu = 1; }
        (void)hipGetLastError();
        grid = cus;
    }
    if (grid < 0) return;
    Params p{};
    const float** f = (const float**)&p;
    for (int i = 0; i < 25; ++i) f[i] = (const float*)d_in[i];
    p.out = (float*)d_out; p.ws = (unsigned char*)d_ws;
    auto run = [&](int lo, int hi) { void* args[] = {&p, &lo, &hi};
        hipError_t e = hipLaunchCooperativeKernel((const void*)fwd_kernel, dim3(grid), dim3(NTHR), args, LDS_BYTES, stream);
        if (e != hipSuccess) fprintf(stderr, "cooperative launch failed: %s (grid %d)\n", hipGetErrorString(e), grid); };
#if DBG == 0
    run(0, 16);
#else
    int cur = 0;
    auto upto = [&](int k) { run(cur, k + 1); cur = k + 1; };
    auto chk = [&](int which) { hipLaunchKernelGGL(chk_kernel, dim3(grid), dim3(NTHR), 4096, stream, p, which); };
#if DBG == 1
    upto(1); chk(1); upto(4); chk(4); upto(5); chk(5); upto(6); chk(6);
#else
    upto(7); chk(7); upto(8); chk(8); upto(9); chk(9); upto(10); chk(10); upto(11); chk(11); upto(12); chk(12);
#if DBG == 4
    upto(13); chk(13);
#endif
#endif
    chk(99);
#endif
}
```
